# Optimizing an MI355X kernel written in HIP

```python
import jax
import jax.numpy as jnp
from jax import lax
import numpy as np


D_MODEL = 2048
BATCH = 16
SEQ = 2048
DEPTH = 2

EPS = 1e-6
M_HEADS = 4
M_HEAD_DIM = D_MODEL // 16
M_WIDTH = M_HEADS * M_HEAD_DIM
M_CONV = 4
M_CHUNK = 64
M_FGATE_BIAS = 3.0
S_HEADS = 16
S_HEAD_DIM = D_MODEL // 32
S_WIDTH = S_HEADS * S_HEAD_DIM
S_GROUPS = 2
S_STATE = 128
S_CONV = 4
S_CHUNK = 128
S_XBC = S_WIDTH + 2 * S_GROUPS * S_STATE
A_HEADS = 4
A_HEAD_DIM = D_MODEL // 16
A_WIDTH = A_HEADS * A_HEAD_DIM
A_BLOCK = 256
A_TOPK = 3
A_QCHUNK = 32
D_MIX = M_WIDTH + S_WIDTH + A_WIDTH
PROJ_SIZES = (M_WIDTH, M_WIDTH, M_WIDTH, M_WIDTH, M_HEADS, M_HEADS,
              S_WIDTH, S_XBC, S_HEADS,
              A_WIDTH, A_WIDTH, A_WIDTH)
D_PROJ = sum(PROJ_SIZES)
D_FF = D_MODEL * 11 // 4
N_EXPERTS = 8
TOP_K = 2
D_FF_EXPERT = D_MODEL * 7 // 2
N_DENSE = (DEPTH + 1) // 2
N_MOE = DEPTH // 2
PLE_DIM = 256

kernel_name = "hybrid_mlstm_ssd_moba_moe_block"

F32 = jnp.float32


def rmsnorm(x, g):
    xf = x.astype(F32)
    y = xf * lax.rsqrt(jnp.mean(xf * xf, axis=-1, keepdims=True) + EPS)
    return (y * g.astype(F32)).astype(x.dtype)


def causal_dwconv(x, w, b):
    k, c = w.shape
    y = lax.conv_general_dilated(x, w[:, None, :].astype(x.dtype), window_strides=(1,),
                                 padding=((k - 1, 0),), dimension_numbers=('NWC', 'WIO', 'NWC'),
                                 feature_group_count=c)
    return y + b.astype(x.dtype)


def mlstm_mixer(q, k, v, o, i_pre, f_pre, conv_w, conv_b, gate_b, norm_g):
    bsz, seq, _ = q.shape
    H, Dh, L = M_HEADS, M_HEAD_DIM, M_CHUNK
    nc = seq // L
    qk = jax.nn.silu(causal_dwconv(jnp.concatenate([q, k], axis=-1), conv_w, conv_b))
    q, k = jnp.split(qk.astype(F32), 2, axis=-1)
    k = k * (Dh ** -0.5)

    def to_chunks(t):
        return t.reshape(bsz, nc, L, H, Dh).transpose(1, 0, 3, 2, 4)

    def gate_chunks(t):
        return t.reshape(bsz, nc, L, H).transpose(1, 0, 3, 2)

    li = gate_chunks(i_pre.astype(F32) + gate_b[:H].astype(F32))
    lf = gate_chunks(jax.nn.log_sigmoid(f_pre.astype(F32) + gate_b[H:].astype(F32)))
    causal = jnp.tril(jnp.ones((L, L), dtype=bool))

    def step(carry, inp):
        C, n, m = carry
        qc, kc, vc, lic, lfc = inp
        b = jnp.cumsum(lfc, axis=-1)
        logw = jnp.where(causal, b[..., :, None] - b[..., None, :] + lic[..., None, :], -jnp.inf)
        m_inter = b + m[..., None]
        m_j = jnp.maximum(m_inter, logw.max(axis=-1))
        w = jnp.exp(logw - m_j[..., None])
        s_inter = jnp.exp(m_inter - m_j)
        sqk = jnp.einsum('bhjd,bhsd->bhjs', qc, kc) * w
        num = s_inter[..., None] * jnp.einsum('bhvk,bhjk->bhjv', C, qc) + jnp.einsum('bhjs,bhsv->bhjv', sqk, vc)
        den = s_inter * jnp.einsum('bhk,bhjk->bhj', n, qc) + sqk.sum(axis=-1)
        h = num / jnp.maximum(jnp.abs(den), jnp.exp(-m_j))[..., None]
        total = b[..., -1]
        lw_end = total[..., None] - b + lic
        m_new = jnp.maximum(total + m, lw_end.max(axis=-1))
        a = jnp.exp(lw_end - m_new[..., None])
        decay = jnp.exp(total + m - m_new)
        C = decay[..., None, None] * C + jnp.einsum('bhs,bhsv,bhsk->bhvk', a, vc, kc)
        n = decay[..., None] * n + jnp.einsum('bhs,bhsk->bhk', a, kc)
        return (C, n, m_new), h

    init = (jnp.zeros((bsz, H, Dh, Dh), F32), jnp.zeros((bsz, H, Dh), F32), jnp.zeros((bsz, H), F32))
    _, h = lax.scan(step, init, (to_chunks(q), to_chunks(k), to_chunks(v.astype(F32)), li, lf))
    h = h.transpose(1, 0, 3, 2, 4).reshape(bsz, seq, H, Dh)
    h = h * lax.rsqrt(jnp.mean(h * h, axis=-1, keepdims=True) + EPS)
    return h.reshape(bsz, seq, M_WIDTH) * norm_g.astype(F32) * jax.nn.sigmoid(o.astype(F32))


def mamba2_mixer(z, xbc, dt_raw, conv_w, conv_b, dt_bias, a_log, d_skip, norm_g):
    bsz, seq, _ = z.shape
    L, G, E, P, N = S_CHUNK, S_GROUPS, S_HEADS // S_GROUPS, S_HEAD_DIM, S_STATE
    nc = seq // L
    xbc = jax.nn.silu(causal_dwconv(xbc, conv_w, conv_b)).astype(F32)
    xs, bm, cm = jnp.split(xbc, [S_WIDTH, S_WIDTH + G * N], axis=-1)
    X = xs.reshape(bsz, nc, L, G, E, P)
    Bc = bm.reshape(bsz, nc, L, G, N)
    Cc = cm.reshape(bsz, nc, L, G, N)
    dt = jax.nn.softplus(dt_raw.astype(F32) + dt_bias.astype(F32)).reshape(bsz, nc, L, G, E)
    a = dt * (-jnp.exp(a_log.astype(F32))).reshape(G, E)
    acum = jnp.cumsum(a, axis=2)
    Xdt = X * dt[..., None]
    causal = jnp.tril(jnp.ones((L, L), dtype=bool))[:, :, None, None]
    seg = acum[:, :, :, None] - acum[:, :, None, :]
    Lmat = jnp.exp(jnp.where(causal, seg, -jnp.inf))
    CB = jnp.einsum('bclgn,bcsgn->bclsg', Cc, Bc)
    y_diag = jnp.einsum('bclsge,bcsgep->bclgep', CB[..., None] * Lmat, Xdt)
    decay_to_end = jnp.exp(acum[:, :, -1:] - acum)
    states = jnp.einsum('bclgn,bclgep->bcgepn', Bc, Xdt * decay_to_end[..., None])
    chunk_decay = jnp.exp(acum[:, :, -1])

    def step(h, inp):
        st, dec = inp
        return h * dec[..., None, None] + st, h

    _, h_in = lax.scan(step, jnp.zeros((bsz, G, E, P, N), F32),
                       (jnp.moveaxis(states, 1, 0), jnp.moveaxis(chunk_decay, 1, 0)))
    h_in = jnp.moveaxis(h_in, 0, 1)
    y_off = jnp.einsum('bclgn,bcgepn->bclgep', Cc, h_in) * jnp.exp(acum)[..., None]
    y = y_diag + y_off + X * d_skip.astype(F32).reshape(G, E, 1)
    gw = S_WIDTH // G
    y = y.reshape(bsz, seq, G, gw) * jax.nn.silu(z.astype(F32)).reshape(bsz, seq, G, gw)
    y = y * lax.rsqrt(jnp.mean(y * y, axis=-1, keepdims=True) + EPS)
    return y.reshape(bsz, seq, S_WIDTH) * norm_g.astype(F32)


def moba_mixer(q, k, v):
    bsz, seq, _ = q.shape
    H, Dh, BS, QC = A_HEADS, A_HEAD_DIM, A_BLOCK, A_QCHUNK
    nb = -(-seq // BS)
    pad = nb * BS - seq
    nqc = seq // QC
    k_sel = max(1, min(A_TOPK, nb - 1))

    def heads(t):
        return t.astype(F32).reshape(bsz, seq, H, Dh).transpose(0, 2, 1, 3)

    q = heads(q) * (Dh ** -0.5)
    kb = jnp.pad(heads(k), ((0, 0), (0, 0), (0, pad), (0, 0))).reshape(bsz, H, nb, BS, Dh)
    vb = jnp.pad(heads(v), ((0, 0), (0, 0), (0, pad), (0, 0))).reshape(bsz, H, nb, BS, Dh)
    k_mean = kb.mean(axis=3)
    q_blk = jnp.arange(seq) // BS
    past = jnp.arange(nb)[None, :] < q_blk[:, None]
    blk_score = jnp.where(past, jnp.einsum('bhsd,bhnd->bhsn', q, k_mean), -jnp.inf)
    _, sel = lax.top_k(blk_score, k_sel)
    valid = jnp.arange(k_sel)[None, :] < q_blk[:, None]
    gather = jax.vmap(jax.vmap(lambda blocks, idx: blocks[idx]))

    def chunk(args):
        qc, selc, validc, c = args
        t0 = c * QC
        bt = t0 // BS
        k_g = gather(kb, selc)
        v_g = gather(vb, selc)
        s_sel = jnp.einsum('bhqd,bhqrkd->bhqrk', qc, k_g)
        s_sel = jnp.where(validc[None, None, :, :, None], s_sel, -jnp.inf).reshape(bsz, H, QC, k_sel * BS)
        k_own = lax.dynamic_index_in_dim(kb, bt, axis=2, keepdims=False)
        v_own = lax.dynamic_index_in_dim(vb, bt, axis=2, keepdims=False)
        own_mask = (bt * BS + jnp.arange(BS))[None, :] <= (t0 + jnp.arange(QC))[:, None]
        s_own = jnp.where(own_mask, jnp.einsum('bhqd,bhkd->bhqk', qc, k_own), -jnp.inf)
        probs = jax.nn.softmax(jnp.concatenate([s_sel, s_own], axis=-1), axis=-1)
        p_sel = probs[..., :k_sel * BS].reshape(bsz, H, QC, k_sel, BS)
        p_own = probs[..., k_sel * BS:]
        return jnp.einsum('bhqrk,bhqrkd->bhqd', p_sel, v_g) + jnp.einsum('bhqk,bhkd->bhqd', p_own, v_own)

    xs = (jnp.moveaxis(q.reshape(bsz, H, nqc, QC, Dh), 2, 0),
          jnp.moveaxis(sel.reshape(bsz, H, nqc, QC, k_sel), 2, 0),
          valid.reshape(nqc, QC, k_sel),
          jnp.arange(nqc))
    out = lax.map(chunk, xs)
    out = jnp.moveaxis(out, 0, 2).reshape(bsz, H, seq, Dh).transpose(0, 2, 1, 3)
    return out.reshape(bsz, seq, A_WIDTH)


def swiglu(x, wg, wu, wd):
    return (jax.nn.silu(x @ wg) * (x @ wu)) @ wd


def moe_swiglu(x, w_router, w_gate, w_up, w_down):
    bsz, seq, d = x.shape
    xt = x.reshape(bsz * seq, d)
    logits = (xt @ w_router).astype(F32)
    top_logit, top_idx = lax.top_k(logits, TOP_K)
    top_w = jax.nn.softmax(top_logit, axis=-1)
    combine = jnp.einsum('tk,tke->te', top_w, jax.nn.one_hot(top_idx, N_EXPERTS, dtype=F32)).astype(x.dtype)
    out = jnp.zeros_like(xt)
    for e in range(N_EXPERTS):
        out = out + combine[:, e:e + 1] * swiglu(xt, w_gate[e], w_up[e], w_down[e])
    return out.reshape(bsz, seq, d)


def setup_inputs(seed: int = 0) -> dict:
    key = jax.random.key(seed)
    ks = iter(jax.random.split(key, 40))

    def nrm(shape, scale):
        return jax.random.normal(next(ks), shape, F32) * scale

    def gain(shape):
        return 1.0 + 0.02 * jax.random.normal(next(ks), shape, F32)

    dt0 = jnp.exp(jax.random.uniform(next(ks), (DEPTH, S_HEADS), F32) * (np.log(0.1) - np.log(0.001)) + np.log(0.001))
    return {
        'x': nrm((BATCH, SEQ, D_MODEL), 1.0),
        'p': nrm((DEPTH, BATCH, SEQ, PLE_DIM), 1.0),
        'ln_mix': gain((DEPTH, D_MODEL)),
        'w_in': nrm((DEPTH, D_MODEL, D_PROJ), D_MODEL ** -0.5),
        'w_out': nrm((DEPTH, D_MIX, D_MODEL), D_MIX ** -0.5),
        'm_conv_w': nrm((DEPTH, M_CONV, 2 * M_WIDTH), M_CONV ** -0.5),
        'm_conv_b': nrm((DEPTH, 2 * M_WIDTH), 0.02),
        'm_gate_b': jnp.concatenate([nrm((DEPTH, M_HEADS), 0.1),
                                     M_FGATE_BIAS + nrm((DEPTH, M_HEADS), 0.5)], axis=-1),
        'm_norm_g': gain((DEPTH, M_WIDTH)),
        's_conv_w': nrm((DEPTH, S_CONV, S_XBC), S_CONV ** -0.5),
        's_conv_b': nrm((DEPTH, S_XBC), 0.02),
        's_dt_bias': dt0 + jnp.log(-jnp.expm1(-dt0)),
        's_a_log': jnp.log(jax.random.uniform(next(ks), (DEPTH, S_HEADS), F32, 1.0, 16.0)),
        's_d': 1.0 + nrm((DEPTH, S_HEADS), 0.1),
        's_norm_g': gain((DEPTH, S_WIDTH)),
        'ln_ffn': gain((DEPTH, D_MODEL)),
        'ffn_w_gate': nrm((N_DENSE, D_MODEL, D_FF), D_MODEL ** -0.5),
        'ffn_w_up': nrm((N_DENSE, D_MODEL, D_FF), D_MODEL ** -0.5),
        'ffn_w_down': nrm((N_DENSE, D_FF, D_MODEL), D_FF ** -0.5),
        'moe_router': nrm((N_MOE, D_MODEL, N_EXPERTS), D_MODEL ** -0.5),
        'moe_w_gate': nrm((N_MOE, N_EXPERTS, D_MODEL, D_FF_EXPERT), D_MODEL ** -0.5),
        'moe_w_up': nrm((N_MOE, N_EXPERTS, D_MODEL, D_FF_EXPERT), D_MODEL ** -0.5),
        'moe_w_down': nrm((N_MOE, N_EXPERTS, D_FF_EXPERT, D_MODEL), D_FF_EXPERT ** -0.5),
        'ln_ple': gain((DEPTH, D_MODEL)),
        'ple_proj': nrm((DEPTH, PLE_DIM, D_MODEL), PLE_DIM ** -0.5),
        'ple_gate': nrm((DEPTH, D_MODEL, D_MODEL), D_MODEL ** -0.5),
        'ln_final': gain((D_MODEL,)),
    }


def reference(x, p, ln_mix, w_in, w_out, m_conv_w, m_conv_b, m_gate_b, m_norm_g,
              s_conv_w, s_conv_b, s_dt_bias, s_a_log, s_d, s_norm_g,
              ln_ffn, ffn_w_gate, ffn_w_up, ffn_w_down,
              moe_router, moe_w_gate, moe_w_up, moe_w_down,
              ln_ple, ple_proj, ple_gate, ln_final):
    split_idx = [int(s) for s in np.cumsum(PROJ_SIZES)[:-1]]
    for i in range(DEPTH):
        u = rmsnorm(x, ln_mix[i]) @ w_in[i]
        (mq, mk, mv, mo, mi, mf, sz, sxbc, sdt, aq, ak, av) = jnp.split(u, split_idx, axis=-1)
        y_m = mlstm_mixer(mq, mk, mv, mo, mi, mf, m_conv_w[i], m_conv_b[i], m_gate_b[i], m_norm_g[i])
        y_s = mamba2_mixer(sz, sxbc, sdt, s_conv_w[i], s_conv_b[i], s_dt_bias[i], s_a_log[i], s_d[i], s_norm_g[i])
        y_a = moba_mixer(aq, ak, av)
        mixed = jnp.concatenate([y_m.astype(x.dtype), y_s.astype(x.dtype), y_a.astype(x.dtype)], axis=-1)
        x = x + mixed @ w_out[i]
        hn = rmsnorm(x, ln_ffn[i])
        if i % 2 == 0:
            j = i // 2
            x = x + swiglu(hn, ffn_w_gate[j], ffn_w_up[j], ffn_w_down[j])
        else:
            j = i // 2
            x = x + moe_swiglu(hn, moe_router[j], moe_w_gate[j], moe_w_up[j], moe_w_down[j])
        gate = jax.nn.sigmoid(rmsnorm(x, ln_ple[i]) @ ple_gate[i])
        x = x + (p[i] @ ple_proj[i]) * gate
    return rmsnorm(x, ln_final)
```

```cpp
#include <hip/hip_runtime.h>
#include <cstdio>
#include <cstdint>

#define GAS __attribute__((address_space(1)))
#define LAS __attribute__((address_space(3)))
typedef unsigned short bf16_t;
typedef short bf16x8 __attribute__((ext_vector_type(8)));
typedef short s16x4 __attribute__((ext_vector_type(4)));
typedef float f32x4 __attribute__((ext_vector_type(4)));
typedef float f32x2 __attribute__((ext_vector_type(2)));
typedef unsigned u32x4 __attribute__((ext_vector_type(4)));
typedef unsigned u32x2 __attribute__((ext_vector_type(2)));
typedef __bf16 bf16x2_t __attribute__((ext_vector_type(2)));

__device__ __forceinline__ unsigned pk2(float lo, float hi) { f32x2 v = {lo, hi}; bf16x2_t b = __builtin_convertvector(v, bf16x2_t); return __builtin_bit_cast(unsigned, b); }
__device__ __forceinline__ float bflo(unsigned w) { return __builtin_bit_cast(float, w << 16); }
__device__ __forceinline__ float bfhi(unsigned w) { return __builtin_bit_cast(float, w & 0xffff0000u); }
__device__ __forceinline__ float bf1(bf16_t h) { return __builtin_bit_cast(float, ((unsigned)h) << 16); }
__device__ __forceinline__ bf16_t f2bf(float f) { return (bf16_t)(pk2(f, 0.f) & 0xffffu); }
__device__ __forceinline__ float fast_exp(float x) { return __builtin_amdgcn_exp2f(x * 1.4426950408889634f); }
__device__ __forceinline__ float sigmoidf_(float x) { return __builtin_amdgcn_rcpf(1.0f + fast_exp(-x)); }
__device__ __forceinline__ float siluf_(float x) { return x * sigmoidf_(x); }

namespace pg8 {
constexpr int BM = 256, BK = 64, HALF = 128, HTB = HALF * BK * 2  , STAGE_BYTES = 8 * HTB, NXCD = 8, WGM = 8;

__host__ __device__ __forceinline__ int lds_byte(int r, int c) { const int st = (r >> 4) * 2 + (c >> 5), rr = r & 15, cc = c & 31, ob = rr * 64 + cc * 2; return st * 1024 + (ob ^ (((ob >> 9) & 1) << 5)); }
__host__ __device__ __forceinline__ void stage_rc(int b, int& R, int& C) { const int st = b / 1024, sb = b % 1024, swz = sb ^ (((sb >> 9) & 1) << 5); R = (st >> 1) * 16 + swz / 64; C = (st & 1) * 32 + (swz % 64) / 2; }
__host__ __device__ __forceinline__ int perm32(int rho) { const int n = rho >> 4, i = rho & 15; return 8 * (i >> 2) + 4 * n + (i & 3); }

struct Unit { int pm, pn, e; };
struct Gemm { const bf16_t* A; const bf16_t* Bt; int lda, ldb, K; size_t estride; };

struct StaticOrder {
    int nM, nN, nwg, G, c;
    __device__ void init(int M, int N, int G_, int c_) { nM = M / BM; nN = N / BM; nwg = nM * nN; G = G_; c = c_; }
    __device__ bool next(int i, Unit& u) const {
        const long L = (long)i * G + c; if (L >= nwg) return false;
        int wgid = (int)L; { const int q = nwg / NXCD, r = nwg % NXCD, xcd = wgid % NXCD, off = wgid / NXCD; wgid = (xcd < r ? xcd * (q + 1) : r * (q + 1) + (xcd - r) * q) + off; }
        const int nig = WGM * nN, gid = wgid / nig, fm = gid * WGM, gsz = (nM - fm) < WGM ? (nM - fm) : WGM;
        u.pm = fm + ((wgid % nig) % gsz); u.pn = (wgid % nig) / gsz; u.e = 0; return true;
    }
};
struct MoeOrder {
    int rt0, nrt, nN, G, c; const LAS int* tab;
    __device__ bool next(int i, Unit& u) const {
        const int nwg = nrt * nN; const long L = (long)i * G + c; if (L >= nwg) return false;
        int wgid = (int)L; { const int q = nwg / NXCD, r = nwg % NXCD, xcd = wgid % NXCD, off = wgid / NXCD; wgid = (xcd < r ? xcd * (q + 1) : r * (q + 1) + (xcd - r) * q) + off; }
        const int nig = WGM * nN, gid = wgid / nig, fm = gid * WGM, gsz = (nrt - fm) < WGM ? (nrt - fm) : WGM;
        u.pm = rt0 + fm + ((wgid % nig) % gsz); u.pn = (wgid % nig) / gsz; u.e = tab[u.pm]; return true;
    }
};


__device__ __forceinline__ float epi_shfl(float v, int src) { return __builtin_bit_cast(float, __builtin_amdgcn_ds_bpermute(src << 2, __builtin_bit_cast(int, v))); }
constexpr float RMS_EPS = 1e-6f, INV_D = 1.0f / 2048.0f, SSQ_SCALE = 16777216.0f, SSQ_INV = INV_D / 16777216.0f;
typedef unsigned long long ssq_t;
__device__ __forceinline__ float ssq_rstd(const ssq_t* p, int row) { return __builtin_amdgcn_rsqf((float)p[row] * SSQ_INV + RMS_EPS); }
__device__ __forceinline__ void ssq_add(ssq_t* p, int row, float q) { __hip_atomic_fetch_add(p + row, (ssq_t)(q * SSQ_SCALE + 0.5f), __ATOMIC_RELAXED, __HIP_MEMORY_SCOPE_AGENT); }
struct EpiBf16 {
    static constexpr bool PERM = true;
    bf16_t* O; int ldc; const ssq_t* ssq;
    __device__ __forceinline__ void operator()(const f32x4 (&acc)[2][2][4][2], const Unit& u, int wr, int wc, int fr, int fq) const {
        const int row0 = u.pm * BM + wr * 64 + fr, col0 = u.pn * BM + wc * 32 + 8 * fq;
#pragma unroll
        for (int ai = 0; ai < 2; ++ai)
#pragma unroll
            for (int m = 0; m < 4; ++m) { const int row = row0 + ai * HALF + m * 16; const float s = ssq ? ssq_rstd(ssq, row) : 1.0f;
                bf16_t* rowp = O + (size_t)row * ldc + col0;
#pragma unroll
                for (int bj = 0; bj < 2; ++bj) { const f32x4 v0 = acc[ai][bj][m][0] * s, v1 = acc[ai][bj][m][1] * s;
                    u32x4 w; w.x = pk2(v0[0], v0[1]); w.y = pk2(v0[2], v0[3]); w.z = pk2(v1[0], v1[1]); w.w = pk2(v1[2], v1[3]);
                    *(u32x4*)(rowp + bj * HALF) = w; } }
    }
};
struct EpiSwiGLU {
    static constexpr bool PERM = true;
    bf16_t* H; int ldc; const float* wgt; int rt0; const ssq_t* ssq; const float* rs;
    __device__ __forceinline__ void operator()(const f32x4 (&acc)[2][2][4][2], const Unit& u, int wr, int wc, int fr, int fq) const {
        const int row0 = u.pm * BM + wr * 64 + fr, col0 = u.pn * HALF + wc * 32 + 8 * fq;
#pragma unroll
        for (int ai = 0; ai < 2; ++ai)
#pragma unroll
            for (int m = 0; m < 4; ++m) { const int row = row0 + ai * HALF + m * 16; const float s = wgt ? wgt[row] : 1.0f; const float rn = rs ? rs[row] : ssq_rstd(ssq, row);
                bf16_t* rowp = H + (size_t)(row - rt0 * BM) * ldc + col0;
                f32x4 o0, o1;
#pragma unroll
                for (int j = 0; j < 4; ++j) { o0[j] = siluf_(acc[ai][0][m][0][j] * rn) * (acc[ai][1][m][0][j] * rn) * s; o1[j] = siluf_(acc[ai][0][m][1][j] * rn) * (acc[ai][1][m][1][j] * rn) * s; }
                u32x4 w; w.x = pk2(o0[0], o0[1]); w.y = pk2(o0[2], o0[3]); w.z = pk2(o1[0], o1[1]); w.w = pk2(o1[2], o1[3]);
                *(u32x4*)rowp = w; }
    }
};
struct EpiResidualStat {
    static constexpr bool PERM = false;
    float* X; bf16_t* XB; ssq_t* ssq; int ldc;
    __device__ __forceinline__ void operator()(const f32x4 (&acc)[2][2][4][2], const Unit& u, int wr, int wc, int fr, int fq) const {
        const int row0 = u.pm * BM + wr * 64 + fr, col0 = u.pn * BM + wc * 32 + 4 * fq, lane = fq * 16 + fr;
#pragma unroll
        for (int ai = 0; ai < 2; ++ai) {
            f32x4 xv[4][2][2]; float q[4];
#pragma unroll
            for (int m = 0; m < 4; ++m)
#pragma unroll
                for (int bj = 0; bj < 2; ++bj)
#pragma unroll
                    for (int n = 0; n < 2; ++n) xv[m][bj][n] = *(const f32x4*)(X + (size_t)(row0 + ai * HALF + m * 16) * ldc + col0 + bj * HALF + n * 16);
#pragma unroll
            for (int m = 0; m < 4; ++m) { const size_t off = (size_t)(row0 + ai * HALF + m * 16) * ldc + col0; q[m] = 0.f;
#pragma unroll
                for (int bj = 0; bj < 2; ++bj)
#pragma unroll
                    for (int n = 0; n < 2; ++n) { const f32x4 x = xv[m][bj][n] + acc[ai][bj][m][n]; *(f32x4*)(X + off + bj * HALF + n * 16) = x;
                        u32x2 w; w.x = pk2(x[0], x[1]); w.y = pk2(x[2], x[3]); *(u32x2*)(XB + off + bj * HALF + n * 16) = w; q[m] += (x[0] * x[0] + x[1] * x[1]) + (x[2] * x[2] + x[3] * x[3]); } }
#pragma unroll
            for (int m = 0; m < 4; ++m) { q[m] += epi_shfl(q[m], lane ^ 16); q[m] += epi_shfl(q[m], lane ^ 32); }
            if (fq == 0) {
#pragma unroll
                for (int m = 0; m < 4; ++m) ssq_add(ssq, row0 + ai * HALF + m * 16, q[m]); }
        }
    }
};
template <bool STAT> struct EpiScatter {
    static constexpr bool PERM = false;
    float* X; int ldc; const int* tok; bf16_t* XB; ssq_t* ssq;
    __device__ __forceinline__ void operator()(const f32x4 (&acc)[2][2][4][2], const Unit& u, int wr, int wc, int fr, int fq) const {
        const int row0 = u.pm * BM + wr * 64 + fr, col0 = u.pn * BM + wc * 32 + 4 * fq, lane = fq * 16 + fr;
        int tk[2][4];
#pragma unroll
        for (int ai = 0; ai < 2; ++ai)
#pragma unroll
            for (int m = 0; m < 4; ++m) tk[ai][m] = tok[row0 + ai * HALF + m * 16];
#pragma unroll
        for (int ai = 0; ai < 2; ++ai) {
            f32x4 xv[4][2][2]; float q[4];
#pragma unroll
            for (int m = 0; m < 4; ++m) { const int t = tk[ai][m] >= 0 ? tk[ai][m] : 0;
#pragma unroll
                for (int bj = 0; bj < 2; ++bj)
#pragma unroll
                    for (int n = 0; n < 2; ++n) xv[m][bj][n] = *(const f32x4*)(X + (size_t)t * ldc + col0 + bj * HALF + n * 16); }
#pragma unroll
            for (int m = 0; m < 4; ++m) { const int t = tk[ai][m]; q[m] = 0.f;
                if (t >= 0) { const size_t off = (size_t)t * ldc + col0;
#pragma unroll
                    for (int bj = 0; bj < 2; ++bj)
#pragma unroll
                        for (int n = 0; n < 2; ++n) { const f32x4 x = xv[m][bj][n] + acc[ai][bj][m][n]; *(f32x4*)(X + off + bj * HALF + n * 16) = x;
                            if (STAT) { u32x2 w; w.x = pk2(x[0], x[1]); w.y = pk2(x[2], x[3]); *(u32x2*)(XB + off + bj * HALF + n * 16) = w; q[m] += (x[0] * x[0] + x[1] * x[1]) + (x[2] * x[2] + x[3] * x[3]); } } } }
            if (STAT) {
#pragma unroll
                for (int m = 0; m < 4; ++m) { q[m] += epi_shfl(q[m], lane ^ 16); q[m] += epi_shfl(q[m], lane ^ 32); }
                if (fq == 0) {
#pragma unroll
                    for (int m = 0; m < 4; ++m) if (tk[ai][m] >= 0) ssq_add(ssq, tk[ai][m], q[m]); } }
        }
    }
};
struct EpiPleGate {
    static constexpr bool PERM = false;
    float* X; const bf16_t* PPB; int ldc; const ssq_t* ssq_in; bf16_t* XBo; ssq_t* ssq_out;
    __device__ __forceinline__ void operator()(const f32x4 (&acc)[2][2][4][2], const Unit& u, int wr, int wc, int fr, int fq) const {
        const int row0 = u.pm * BM + wr * 64 + fr, col0 = u.pn * BM + wc * 32 + 4 * fq, lane = fq * 16 + fr;
        float rn[2][4];
#pragma unroll
        for (int ai = 0; ai < 2; ++ai)
#pragma unroll
            for (int m = 0; m < 4; ++m) rn[ai][m] = ssq_rstd(ssq_in, row0 + ai * HALF + m * 16);
#pragma unroll
        for (int ai = 0; ai < 2; ++ai)
#pragma unroll
            for (int mp = 0; mp < 2; ++mp) {
                f32x4 xv[2][2][2]; u32x2 pw[2][2][2]; float q[2];
#pragma unroll
                for (int mm = 0; mm < 2; ++mm)
#pragma unroll
                    for (int bj = 0; bj < 2; ++bj)
#pragma unroll
                        for (int n = 0; n < 2; ++n) { const size_t o = (size_t)(row0 + ai * HALF + (2 * mp + mm) * 16) * ldc + col0 + bj * HALF + n * 16; xv[mm][bj][n] = *(const f32x4*)(X + o); pw[mm][bj][n] = *(const u32x2*)(PPB + o); }
#pragma unroll
                for (int mm = 0; mm < 2; ++mm) { const int m = 2 * mp + mm; const size_t off = (size_t)(row0 + ai * HALF + m * 16) * ldc + col0; q[mm] = 0.f;
#pragma unroll
                    for (int bj = 0; bj < 2; ++bj)
#pragma unroll
                        for (int n = 0; n < 2; ++n) { const f32x4 a = acc[ai][bj][m][n] * rn[ai][m]; f32x4 x = xv[mm][bj][n]; const u32x2 p2 = pw[mm][bj][n];
                            x[0] += bflo(p2.x) * sigmoidf_(a[0]); x[1] += bfhi(p2.x) * sigmoidf_(a[1]); x[2] += bflo(p2.y) * sigmoidf_(a[2]); x[3] += bfhi(p2.y) * sigmoidf_(a[3]); *(f32x4*)(X + off + bj * HALF + n * 16) = x;
                            u32x2 w; w.x = pk2(x[0], x[1]); w.y = pk2(x[2], x[3]); *(u32x2*)(XBo + off + bj * HALF + n * 16) = w; q[mm] += (x[0] * x[0] + x[1] * x[1]) + (x[2] * x[2] + x[3] * x[3]); } }
#pragma unroll
                for (int mm = 0; mm < 2; ++mm) { q[mm] += epi_shfl(q[mm], lane ^ 16); q[mm] += epi_shfl(q[mm], lane ^ 32); }
                if (fq == 0) {
#pragma unroll
                    for (int mm = 0; mm < 2; ++mm) ssq_add(ssq_out, row0 + ai * HALF + (2 * mp + mm) * 16, q[mm]); }
            }
    }
};

template <class Epi, class Sched, bool ALIGN_EPI>
__device__ __forceinline__ void gemm_phase(LAS unsigned char* lds, const Gemm g, const Sched& S, const Epi& E) {
    int tid_ = threadIdx.x; asm volatile("" : "+v"(tid_));
    const int tid = tid_, wid = __builtin_amdgcn_readfirstlane(tid >> 6), lane = tid & 63, wr = wid >> 2, wc = wid & 3, fr = lane & 15, fq = lane >> 4;
    const int K = g.K, nt = K / BK;
    unsigned voffA[2], voffB[2];
#pragma unroll
    for (int i = 0; i < 2; ++i) { int R, C; stage_rc(tid * 16 + i * 8192, R, C); const int Rb = Epi::PERM ? ((R & ~31) + perm32(R & 31)) : R;
        voffA[i] = (unsigned)(R * g.lda + C) * 2u; voffB[i] = (unsigned)(Rb * g.ldb + C) * 2u; }
    const size_t kstep = (size_t)(BK * 2);
    const size_t hstepA = (size_t)HALF * g.lda * 2, hstepB = (size_t)HALF * g.ldb * 2;
    const size_t tstepA = 2 * hstepA, tstepB = 2 * hstepB;
    const unsigned ldsw = (unsigned)wid * 1024u;
    const int aoff = lds_byte(wr * 64 + fr, fq * 8), boff = lds_byte(wc * 32 + fr, fq * 8);
#define PG8_SA(b, h) (((b) * 2 + (h)) * HTB)
#define PG8_SB(b, h) ((4 + (b) * 2 + (h)) * HTB)
#define PG8_STAGE(bufoff, gbase, voff) do { _Pragma("unroll") for (int _i = 0; _i < 2; ++_i) \
        __builtin_amdgcn_global_load_lds((const unsigned*)((const char*)(gbase) + (voff)[_i]), (LAS unsigned*)(lds + (bufoff) + ldsw + _i * 8192), 16, 0, 0); } while (0)
#define PG8_LDA(dst, b, h) do { _Pragma("unroll") for (int m = 0; m < 4; ++m) _Pragma("unroll") for (int k = 0; k < 2; ++k) dst[m][k] = *(const LAS bf16x8*)(lds + PG8_SA(b, h) + aoff + m * 2048 + k * 1024); } while (0)
#define PG8_LDB(dst, b, h) do { _Pragma("unroll") for (int n = 0; n < 2; ++n) _Pragma("unroll") for (int k = 0; k < 2; ++k) dst[n][k] = *(const LAS bf16x8*)(lds + PG8_SB(b, h) + boff + n * 2048 + k * 1024); } while (0)
#define PG8_MMA(ai, bj, At, Bt) do { __builtin_amdgcn_s_setprio(1); _Pragma("unroll") for (int m = 0; m < 4; ++m) _Pragma("unroll") for (int n = 0; n < 2; ++n) _Pragma("unroll") for (int k = 0; k < 2; ++k) \
        acc[ai][bj][m][n] = __builtin_amdgcn_mfma_f32_16x16x32_bf16(Bt[n][k], At[m][k], acc[ai][bj][m][n], 0, 0, 0); __builtin_amdgcn_s_setprio(0); } while (0)
#define PG8_WAIT_V(n) asm volatile("s_waitcnt vmcnt(" #n ")" ::: "memory")
#define PG8_WAIT_L(n) asm volatile("s_waitcnt lgkmcnt(" #n ")" ::: "memory")
#define PG8_BAR __builtin_amdgcn_s_barrier()
#define PG8_SCHED __builtin_amdgcn_sched_barrier(0)
    Unit cur, nxt; int ui = 0;
    if (!S.next(0, cur)) return;
    f32x4 acc[2][2][4][2];
#pragma unroll
    for (int a = 0; a < 2; ++a)
#pragma unroll
        for (int b = 0; b < 2; ++b)
#pragma unroll
            for (int m = 0; m < 4; ++m)
#pragma unroll
                for (int n = 0; n < 2; ++n) acc[a][b][m][n] = (f32x4){0.f, 0.f, 0.f, 0.f};
    bf16x8 At[4][2], B0[2][2], B1[2][2];
    const char* cA = (const char*)g.A + (size_t)cur.pm * tstepA; const char* cB = (const char*)(g.Bt + (size_t)cur.e * g.estride) + (size_t)cur.pn * tstepB;
    PG8_STAGE(PG8_SB(0, 0), cB, voffB); PG8_STAGE(PG8_SB(0, 1), cB + hstepB, voffB); PG8_STAGE(PG8_SA(0, 0), cA, voffA); PG8_STAGE(PG8_SA(0, 1), cA + hstepA, voffA);
    if (wr == 1) PG8_BAR;
    PG8_WAIT_V(2); PG8_BAR;
    PG8_STAGE(PG8_SB(1, 0), cB + kstep, voffB); PG8_STAGE(PG8_SA(1, 0), cA + kstep, voffA); PG8_STAGE(PG8_SB(1, 1), cB + hstepB + kstep, voffB);
    PG8_WAIT_V(6); PG8_BAR;
    for (;;) {
        const bool has_next = S.next(ui + 1, nxt);
        const char* nA = has_next ? (const char*)g.A + (size_t)nxt.pm * tstepA : cA; const char* nB = has_next ? (const char*)(g.Bt + (size_t)nxt.e * g.estride) + (size_t)nxt.pn * tstepB : cB;
        for (int t = 0; t < nt; t += 2) {
            const bool last = (t == nt - 2);
            const char* a1 = cA + (size_t)(t + 1) * kstep;
            const char* a2 = last ? nA : cA + (size_t)(t + 2) * kstep; const char* b2 = last ? nB : cB + (size_t)(t + 2) * kstep;
            const char* a3 = a2 + kstep; const char* b3 = b2 + kstep;
            PG8_LDB(B0, 0, 0); PG8_LDB(B1, 0, 1); PG8_SCHED; PG8_LDA(At, 0, 0); PG8_STAGE(PG8_SA(1, 1), a1 + hstepA, voffA);
            PG8_WAIT_V(8); PG8_WAIT_L(0); PG8_BAR; PG8_MMA(0, 0, At, B0); PG8_MMA(0, 1, At, B1); PG8_BAR; PG8_SCHED;
            PG8_LDA(At, 0, 1); PG8_STAGE(PG8_SB(0, 0), b2, voffB); PG8_STAGE(PG8_SB(0, 1), b2 + hstepB, voffB); PG8_STAGE(PG8_SA(0, 0), a2, voffA);
            PG8_WAIT_V(8); PG8_WAIT_L(0); PG8_BAR; PG8_MMA(1, 0, At, B0); PG8_MMA(1, 1, At, B1); PG8_BAR; PG8_SCHED;
            PG8_LDB(B0, 1, 0); PG8_LDB(B1, 1, 1); PG8_SCHED; PG8_LDA(At, 1, 0); PG8_STAGE(PG8_SA(0, 1), a2 + hstepA, voffA);
            PG8_WAIT_V(8); PG8_WAIT_L(0); PG8_BAR; PG8_MMA(0, 0, At, B0); PG8_MMA(0, 1, At, B1); PG8_BAR; PG8_SCHED;
            PG8_LDA(At, 1, 1); PG8_STAGE(PG8_SB(1, 0), b3, voffB); PG8_STAGE(PG8_SB(1, 1), b3 + hstepB, voffB); PG8_STAGE(PG8_SA(1, 0), a3, voffA);
            PG8_WAIT_V(8); PG8_WAIT_L(0); PG8_BAR; PG8_MMA(1, 0, At, B0); PG8_MMA(1, 1, At, B1); PG8_BAR; PG8_SCHED;
        }
        if constexpr (ALIGN_EPI) { if (wr == 0) PG8_BAR; }
        E(acc, cur, wr, wc, fr, fq);
        if (!has_next) break;
#pragma unroll
        for (int a = 0; a < 2; ++a)
#pragma unroll
            for (int b = 0; b < 2; ++b)
#pragma unroll
                for (int m = 0; m < 4; ++m)
#pragma unroll
                    for (int n = 0; n < 2; ++n) acc[a][b][m][n] = (f32x4){0.f, 0.f, 0.f, 0.f};
        cur = nxt; cA = nA; cB = nB; ++ui;
        if constexpr (ALIGN_EPI) { if (wr == 1) PG8_BAR; }
    }
    PG8_WAIT_V(0);
    if constexpr (!ALIGN_EPI) { if (wr == 0) PG8_BAR; }
    PG8_BAR;
#undef PG8_SA
#undef PG8_SB
#undef PG8_STAGE
#undef PG8_LDA
#undef PG8_LDB
#undef PG8_MMA
#undef PG8_WAIT_V
#undef PG8_WAIT_L
#undef PG8_BAR
#undef PG8_SCHED
}
}
constexpr int NB = 16, SEQ = 2048, T = NB * SEQ, D = 2048, DEPTH = 2;
constexpr int DPROJ_SRC = 6168, NU = 6400;
constexpr int DFF = 5632, NEXP = 8, DFFE = 7168, PLE = 256;
constexpr float EPS = 1e-6f;
constexpr int UQ = 0, UK = 512, UV = 1024, UO = 1536, UZ = 2048, UXBC = 3072, UAQ = 4608, UAK = 5120, UAV = 5632, UMI = 6144, UMF = 6148, UDT = 6152;
constexpr int MIXM = 0, MIXS = 512, MIXA = 1536;
constexpr int NWAVES = 8, NTHR = 512, NWG = 256;

constexpr size_t MiB = 1u << 20;
constexpr size_t WS_CTL = 0, CTL_ZERO_BYTES = 3 * MiB;
constexpr size_t WS_SSQ = 1 * MiB;
constexpr size_t WS_WIN = 4 * MiB;
constexpr size_t WS_WOUT = WS_WIN + 50 * MiB;
constexpr size_t WS_FGU = WS_WOUT + 16 * MiB;
constexpr size_t WS_FD = WS_FGU + 44 * MiB;
constexpr size_t WS_MGU = WS_FD + 22 * MiB;
constexpr size_t WS_MD = WS_MGU + 448 * MiB;
constexpr size_t WS_PG = WS_MD + 224 * MiB;
constexpr size_t WS_PP = WS_PG + 16 * MiB;
constexpr size_t WS_XN = WS_PP + 2 * MiB;
constexpr size_t WS_P16 = WS_XN + 128 * MiB;
constexpr size_t WS_R = WS_P16 + 32 * MiB;
constexpr size_t WS_U = WS_R;
constexpr size_t WS_MIX = WS_R + 400 * MiB;
constexpr size_t WS_CV = WS_R + 528 * MiB;
constexpr size_t WS_H = WS_R;
constexpr size_t WS_PPB0 = WS_R + 352 * MiB, WS_PPB1 = WS_R;
constexpr size_t WS_XG = WS_R;
constexpr size_t WS_HM = WS_R + 272 * MiB;
constexpr size_t WS_MISC = WS_R + 748 * MiB;
constexpr size_t WS_SSQM = WS_MISC;
constexpr size_t WS_SSQS = WS_SSQM + 4 * MiB;
constexpr size_t WS_KMEAN = WS_SSQS + 2 * MiB;
constexpr size_t WS_ROUTE = WS_KMEAN + 1 * MiB;
constexpr size_t WS_TOK = WS_ROUTE + 1 * MiB;
constexpr size_t WS_WGT = WS_TOK + 1 * MiB;
constexpr size_t WS_WGCNT = WS_WGT + 1 * MiB;
constexpr size_t WS_XBB = WS_WGCNT + 1 * MiB;
constexpr size_t WS_END = WS_XBB + 128 * MiB;
constexpr int MOE_ROWS = 69632, MOE_SLOT_ROWS = 34816;
constexpr int CW_TMO = 0, CW_BAR = 4096;

constexpr int RING_OFF = 0, RING_BYTES = 131072;
constexpr int LDSCTL_OFF = 139264;
constexpr int MISC_OFF = LDSCTL_OFF;
constexpr int LTAB_OFF = LDSCTL_OFF + 256;
constexpr int PTAB_OFF = LDSCTL_OFF + 6144;
constexpr int LDS_BYTES = 147456;

#define XB_TMO      128
#define XB_XCNT(j)  (256  + 64 * (j))
#define XB_XSUB(j)  (1280 + 64 * (j))
#define XB_XGEN(j)  (2304 + 64 * (j))
#define XB_TOP      3328
#define XB_TOPGEN   3392
#define XCD_BAR_WORDS 3456
#define XB_SPIN_CAP (1u << 18)

__device__ __forceinline__ unsigned xb_ld(unsigned* p)              { return __hip_atomic_load(p, __ATOMIC_RELAXED, __HIP_MEMORY_SCOPE_AGENT); }
__device__ __forceinline__ unsigned xb_add(unsigned* p, unsigned v) { return __hip_atomic_fetch_add(p, v, __ATOMIC_RELAXED, __HIP_MEMORY_SCOPE_AGENT); }
__device__ __forceinline__ unsigned xb_xcc_id() { return (unsigned)__builtin_amdgcn_s_getreg((3 << 11) | 20) & 0xFu; }
#define XB_SPIN(cond, bar) do { unsigned _sp = 0; while (cond) { __builtin_amdgcn_s_sleep(1); \
    if ((++_sp & 255u) == 0u) { if (xb_ld(&(bar)[XB_TMO])) break; if (_sp > XB_SPIN_CAP) { atomicAdd(&(bar)[XB_TMO], 1u); break; } } } } while (0)

struct XcdBarrier { unsigned* bar; unsigned x; volatile LAS unsigned* st; };

__device__ __forceinline__ XcdBarrier xcd_barrier_post(unsigned* bar, volatile LAS unsigned* st) {
    XcdBarrier b; b.bar = bar; b.x = xb_xcc_id(); b.st = st;
    if (threadIdx.x == 0) (void)xb_add(&bar[XB_XCNT(b.x)], 1u);
    return b;
}
__device__ __forceinline__ void xcd_barrier_complete(unsigned* bar, unsigned x, unsigned& nloc, unsigned& nx) {
    const unsigned G = NWG;
    unsigned sum, cnt, mine, sp = 0u;
    for (;;) {
        sum = 0u; cnt = 0u; mine = 0u;
#pragma unroll
        for (unsigned j = 0; j < 16; ++j) { const unsigned c = xb_ld(&bar[XB_XCNT(j)]); sum += c; cnt += (c > 0u) ? 1u : 0u; mine = (j == x) ? c : mine; }
        if (sum == G) break;
        __builtin_amdgcn_s_sleep(1);
        if ((++sp & 255u) == 0u) { if (xb_ld(&bar[XB_TMO])) break; if (sp > XB_SPIN_CAP) { atomicAdd(&bar[XB_TMO], 1u); break; } }
    }
    nloc = mine > 0u ? mine : 1u; nx = cnt > 0u ? cnt : 1u;
}
__device__ __forceinline__ void xcd_barrier(const XcdBarrier& b) {
    asm volatile("s_waitcnt vmcnt(0)" ::: "memory");
    __syncthreads();
    if (threadIdx.x == 0) {
        unsigned* bar = b.bar;
        __builtin_amdgcn_s_waitcnt(0);
        unsigned nloc = b.st[0], nx = b.st[1];
        if (nloc == 0u) { xcd_barrier_complete(bar, b.x, nloc, nx); b.st[0] = nloc; b.st[1] = nx; }
        const unsigned old = xb_add(&bar[XB_XSUB(b.x)], 1u);
        const unsigned gen = old / nloc;
        if (old + 1u == (gen + 1u) * nloc) {
            __builtin_amdgcn_fence(__ATOMIC_RELEASE, "agent");
            asm volatile("s_waitcnt vmcnt(0)" ::: "memory");
            const unsigned og = xb_add(&bar[XB_TOP], 1u);
            const unsigned tg = og / nx;
            if (og + 1u == (tg + 1u) * nx) xb_add(&bar[XB_TOPGEN], 1u);
            else XB_SPIN(xb_ld(&bar[XB_TOPGEN]) == tg, bar);
            __builtin_amdgcn_fence(__ATOMIC_ACQUIRE, "agent");
            xb_add(&bar[XB_XGEN(b.x)], 1u);
            asm volatile("s_waitcnt vmcnt(0)" ::: "memory");
        } else {
            XB_SPIN(xb_ld(&bar[XB_XGEN(b.x)]) == gen, bar);
            __builtin_amdgcn_fence(__ATOMIC_ACQUIRE, "agent");
            asm volatile("s_waitcnt vmcnt(0)" ::: "memory");
        }
    }
    __syncthreads();
}

struct Args {
    const float* in[27]; float* out; unsigned char* ws; int ph_lo, ph_hi;
};
struct Frame {
    LAS unsigned char* lds;
    int tid, lane, wave, vcu, bx;
};
__device__ __forceinline__ float lshfl(float v, int src) { return __builtin_bit_cast(float, __builtin_amdgcn_ds_bpermute(src << 2, __builtin_bit_cast(int, v))); }
#define SHFL_XOR(v, o) lshfl((v), F.lane ^ (o))
#define SHFL_UP(v, o) lshfl((v), F.lane - (o))
#define SHFL_IDX(v, i) lshfl((v), (i))
__device__ __forceinline__ float wave_sum_l(float v, int lane) {
#pragma unroll
    for (int o = 1; o < 64; o <<= 1) v += lshfl(v, lane ^ o);
    return v;
}
#define wave_sum(v) wave_sum_l((v), F.lane)
#define WG_BAR() __syncthreads()
__device__ __forceinline__ unsigned char* ld_ptr(LAS unsigned char* lds, int i) {
    const unsigned long long v = ((const LAS unsigned long long*)(lds + PTAB_OFF))[i];
    const unsigned lo = __builtin_amdgcn_readfirstlane((unsigned)v), hi = __builtin_amdgcn_readfirstlane((unsigned)(v >> 32));
    return (unsigned char*)(uintptr_t)(((unsigned long long)hi << 32) | lo);
}

constexpr int XP_SCR = 64 * 65 * 4;
__device__ __forceinline__ void xpose_item(const float* W, int ldsrc, int srccol4, int k0, bf16_t* WT, int K, int drow0, LAS float* scr, int lane, const float* gain) {
    f32x4 v[16];
    const int r = lane >> 4, c4 = 4 * (lane & 15);
#pragma unroll
    for (int i = 0; i < 16; ++i) v[i] = (srccol4 >= 0) ? *(const f32x4*)(W + (size_t)(k0 + 4 * i + r) * ldsrc + srccol4) : (f32x4){0.f, 0.f, 0.f, 0.f};
    if (gain) {
#pragma unroll
        for (int i = 0; i < 16; ++i) v[i] = v[i] * gain[k0 + 4 * i + r]; }
#pragma unroll
    for (int i = 0; i < 16; ++i) { LAS float* s = scr + (4 * i + r) * 65 + c4; s[0] = v[i].x; s[1] = v[i].y; s[2] = v[i].z; s[3] = v[i].w; }
    asm volatile("s_waitcnt lgkmcnt(0)" ::: "memory");
    const int c = lane & 7;
#pragma unroll
    for (int j = 0; j < 8; ++j) { const int n = (lane >> 3) + 8 * j; const LAS float* s = scr + (8 * c) * 65 + n;
        u32x4 o; o.x = pk2(s[0 * 65], s[1 * 65]); o.y = pk2(s[2 * 65], s[3 * 65]); o.z = pk2(s[4 * 65], s[5 * 65]); o.w = pk2(s[6 * 65], s[7 * 65]);
        *(u32x4*)(WT + (size_t)(drow0 + n) * K + k0 + 8 * c) = o; }
    asm volatile("s_waitcnt lgkmcnt(0)" ::: "memory");
}
__device__ __forceinline__ int win_srccol(int d) {
    if (d < 2048) return d;
    if (d < 3072) return 2056 + (d - 2048);
    if (d < 4608) return 3080 + (d - 3072);
    if (d < 6144) return 4632 + (d - 4608);
    if (d < 6152) return 2048 + (d - 6144);
    if (d < 6168) return 4616 + (d - 6152);
    return -1;
}
__device__ __forceinline__ void xpose_plain(Frame& F, const float* W, int K, int N, bf16_t* WT, LAS float* scr, int gw, int NGW, const float* gain) {
    const int nblk = N / 64, items = (K / 64) * nblk;
    for (int it = gw; it < items; it += NGW) { const int kb = it / nblk, nb = it % nblk; xpose_item(W, N, nb * 64 + 4 * (F.lane & 15), kb * 64, WT, K, nb * 64, scr, F.lane, gain); }
}
__device__ __forceinline__ void xpose_gu(Frame& F, const float* Wg, const float* Wu, int K, int N, bf16_t* WT, LAS float* scr, int gw, int NGW, const float* gain) {
    const int nblk = 2 * N / 64, items = (K / 64) * nblk;
    for (int it = gw; it < items; it += NGW) { const int kb = it / nblk, nb = it % nblk; const int drow0 = nb * 64, tile = drow0 >> 8, within = drow0 & 255;
        const float* W = within < 128 ? Wg : Wu; const int sc = tile * 128 + (within & 127) + 4 * (F.lane & 15);
        xpose_item(W, N, sc, kb * 64, WT, K, drow0, scr, F.lane, gain); }
}
__device__ __forceinline__ float load_row_ssq(Frame& F, const float* xrow, f32x4 (&v)[8]) {
    const f32x4* xr = (const f32x4*)xrow + F.lane; float s = 0.f;
#pragma unroll
    for (int j = 0; j < 8; ++j) { v[j] = xr[64 * j]; s += (v[j].x * v[j].x + v[j].y * v[j].y) + (v[j].z * v[j].z + v[j].w * v[j].w); }
    return wave_sum(s);
}
typedef short v4i16_t __attribute__((ext_vector_type(4)));
__device__ __forceinline__ f32x4 mfma16(bf16x8 a, bf16x8 b, f32x4 c) { return __builtin_amdgcn_mfma_f32_16x16x32_bf16(a, b, c, 0, 0, 0); }
__device__ __forceinline__ s16x4 tr_read(const LAS unsigned char* p) { return __builtin_bit_cast(s16x4, __builtin_amdgcn_ds_read_tr16_b64_v4i16((LAS v4i16_t*)p)); }
__device__ __forceinline__ bf16x8 cat4(s16x4 a, s16x4 b) { return (bf16x8){a[0], a[1], a[2], a[3], b[0], b[1], b[2], b[3]}; }
__device__ __forceinline__ bf16x8 pack8f(const float (&v)[8]) { u32x4 w; w.x = pk2(v[0], v[1]); w.y = pk2(v[2], v[3]); w.z = pk2(v[4], v[5]); w.w = pk2(v[6], v[7]); return __builtin_bit_cast(bf16x8, w); }
__device__ __forceinline__ float softplusf_(float x) { return x > 20.f ? x : __logf(1.0f + __expf(x)); }
__device__ __forceinline__ float logsigmoidf_(float x) { return fminf(x, 0.f) - __logf(1.0f + __expf(-fabsf(x))); }

constexpr int SLD = 272;

constexpr int NCV = 2560;
__device__ __forceinline__ void conv_phase(Frame& F, const bf16_t* __restrict__ U, bf16_t* __restrict__ CV, const float* __restrict__ mcw, const float* __restrict__ mcb, const float* __restrict__ scw, const float* __restrict__ scb) {
    const int gt = F.vcu * NTHR + F.tid;
    for (int it = gt; it < NB * 128 * 320; it += NWG * NTHR) {
        const int cg = it % 320, tb = (it / 320) & 127, b = it / (320 * 128);
        const int cvcol = 8 * cg; const bool isM = cg < 128;
        const int ucol = isM ? cvcol : UXBC + (cvcol - 1024), ch = isM ? cvcol : cvcol - 1024; const int nch = isM ? 1024 : 1536;
        const float* cwp = isM ? mcw : scw; const float* cbp = isM ? mcb : scb;
        float wt[4][8], bs[8];
#pragma unroll
        for (int j = 0; j < 4; ++j) { const f32x4 a = *(const f32x4*)(cwp + j * nch + ch), c2 = *(const f32x4*)(cwp + j * nch + ch + 4);
            wt[j][0] = a[0]; wt[j][1] = a[1]; wt[j][2] = a[2]; wt[j][3] = a[3]; wt[j][4] = c2[0]; wt[j][5] = c2[1]; wt[j][6] = c2[2]; wt[j][7] = c2[3]; }
        { const f32x4 a = *(const f32x4*)(cbp + ch), c2 = *(const f32x4*)(cbp + ch + 4); bs[0] = a[0]; bs[1] = a[1]; bs[2] = a[2]; bs[3] = a[3]; bs[4] = c2[0]; bs[5] = c2[1]; bs[6] = c2[2]; bs[7] = c2[3]; }
        const float sc = (isM && cg >= 64) ? 0.08838834764831845f : 1.0f;
        const int t0 = tb * 16; const bf16_t* up = U + ((size_t)b * SEQ + t0) * NU + ucol; bf16_t* op = CV + ((size_t)b * SEQ + t0) * NCV + cvcol;
        u32x4 r0 = (u32x4){0u, 0u, 0u, 0u}, r1 = r0, r2 = r0;
        if (t0 > 0) { r0 = *(const u32x4*)(up - 3 * (ptrdiff_t)NU); r1 = *(const u32x4*)(up - 2 * (ptrdiff_t)NU); r2 = *(const u32x4*)(up - (ptrdiff_t)NU); }
#pragma unroll 4
        for (int t = 0; t < 16; ++t) {
            const u32x4 r3 = *(const u32x4*)(up + (size_t)t * NU);
            float acc[8];
#pragma unroll
            for (int i = 0; i < 4; ++i) { const unsigned a0 = r0[i], a1 = r1[i], a2 = r2[i], a3 = r3[i];
                acc[2 * i] = bs[2 * i] + bflo(a0) * wt[0][2 * i] + bflo(a1) * wt[1][2 * i] + bflo(a2) * wt[2][2 * i] + bflo(a3) * wt[3][2 * i];
                acc[2 * i + 1] = bs[2 * i + 1] + bfhi(a0) * wt[0][2 * i + 1] + bfhi(a1) * wt[1][2 * i + 1] + bfhi(a2) * wt[2][2 * i + 1] + bfhi(a3) * wt[3][2 * i + 1]; }
#pragma unroll
            for (int i = 0; i < 8; ++i) acc[i] = siluf_(acc[i]) * sc;
            u32x4 o; o.x = pk2(acc[0], acc[1]); o.y = pk2(acc[2], acc[3]); o.z = pk2(acc[4], acc[5]); o.w = pk2(acc[6], acc[7]);
            *(u32x4*)(op + (size_t)t * NCV) = o;
            r0 = r1; r1 = r2; r2 = r3;
        }
    }
}

constexpr int XLD = 144;
constexpr int SS_CM = 0, SS_BM = 34816, SS_X = 69632, SS_HB = 88064, SS_F = 105472;
__device__ __forceinline__ void ssd_unit(Frame& F, int b, int hh, const bf16_t* __restrict__ U, const bf16_t* __restrict__ CV, bf16_t* __restrict__ MIX, float* __restrict__ SSQS,
                                         const float* __restrict__ dt_bias, const float* __restrict__ a_log, const float* __restrict__ d_skip) {
    LAS unsigned char* L = F.lds;
    const int tid = F.tid, lane = F.lane, w = F.wave, c16 = lane & 15, g4 = lane >> 4, grp = hh >> 3;
    WG_BAR();
    for (int i = tid; i < 64 * SLD / 4; i += NTHR) ((LAS unsigned*)(L + SS_HB))[i] = 0u;
    const float Aneg = -__expf(a_log[hh]), dtb = dt_bias[hh], Dsk = d_skip[hh];
    f32x4 hst[4];
#pragma unroll
    for (int i = 0; i < 4; ++i) hst[i] = (f32x4){0.f, 0.f, 0.f, 0.f};
    const bf16_t* cvb = CV + (size_t)b * SEQ * NCV + 1024;
    u32x4 pc[4], pb_[4], px[2]; unsigned graw0 = 0, graw1 = 0;
#define SSD_PREFETCH(cc) do { const size_t r0_ = (size_t)(cc) * 128; \
        _Pragma("unroll") for (int i = 0; i < 4; ++i) { const int q_ = tid + 512 * i; pc[i] = *(const u32x4*)(cvb + (r0_ + (q_ >> 4)) * NCV + 1280 + grp * 128 + 8 * (q_ & 15)); pb_[i] = *(const u32x4*)(cvb + (r0_ + (q_ >> 4)) * NCV + 1024 + grp * 128 + 8 * (q_ & 15)); } \
        _Pragma("unroll") for (int i = 0; i < 2; ++i) { const int q_ = tid + 512 * i; px[i] = *(const u32x4*)(cvb + (r0_ + (q_ >> 3)) * NCV + hh * 64 + 8 * (q_ & 7)); } \
        if (w == 0) { graw0 = U[((size_t)b * SEQ + r0_ + lane) * NU + UDT + hh]; graw1 = U[((size_t)b * SEQ + r0_ + 64 + lane) * NU + UDT + hh]; } } while (0)
#define SSD_GATES(buf) do { LAS float* fa_ = (LAS float*)(L + SS_F) + (buf) * 512; \
        const float dt0 = softplusf_(bf1((bf16_t)graw0) + dtb), dt1 = softplusf_(bf1((bf16_t)graw1) + dtb); float s0 = dt0 * Aneg, s1 = dt1 * Aneg; \
        _Pragma("unroll") for (int o = 1; o < 64; o <<= 1) { const float x0 = SHFL_UP(s0, o), x1 = SHFL_UP(s1, o); if (lane >= o) { s0 += x0; s1 += x1; } } \
        s1 += SHFL_IDX(s0, 63); const float tot = SHFL_IDX(s1, 63); \
        fa_[lane] = s0; fa_[64 + lane] = s1; fa_[128 + lane] = dt0; fa_[192 + lane] = dt1; fa_[256 + lane] = __expf(tot - s0) * dt0; fa_[320 + lane] = __expf(tot - s1) * dt1; fa_[384 + lane] = __expf(s0); fa_[448 + lane] = __expf(s1); } while (0)
    SSD_PREFETCH(0);
    if (w == 0) SSD_GATES(0);
    for (int c = 0; c < 16; ++c) {
        const size_t row0 = (size_t)b * SEQ + c * 128;
#pragma unroll
        for (int i = 0; i < 4; ++i) { const int q_ = tid + 512 * i; *(LAS u32x4*)(L + SS_CM + (q_ >> 4) * SLD + (q_ & 15) * 16) = pc[i]; *(LAS u32x4*)(L + SS_BM + (q_ >> 4) * SLD + (q_ & 15) * 16) = pb_[i]; }
#pragma unroll
        for (int i = 0; i < 2; ++i) { const int q_ = tid + 512 * i; *(LAS u32x4*)(L + SS_X + (q_ >> 3) * XLD + (q_ & 7) * 16) = px[i]; }
        WG_BAR();
        if (c + 1 < 16) SSD_PREFETCH(c + 1);
        {
            const LAS float* fa = (const LAS float*)(L + SS_F) + (c & 1) * 512; const LAS float* fdt = fa + 128; const LAS float* fwdt = fa + 256; const LAS float* feac = fa + 384;
            const int l = 16 * w + c16; const size_t row = row0 + l;
            u32x2 zr[4];
#pragma unroll
            for (int pb = 0; pb < 4; ++pb) zr[pb] = *(const u32x2*)(U + row * NU + UZ + hh * 64 + 16 * pb + 4 * g4);
            f32x4 accd[4], acco[4];
#pragma unroll
            for (int i = 0; i < 4; ++i) { accd[i] = (f32x4){0.f, 0.f, 0.f, 0.f}; acco[i] = (f32x4){0.f, 0.f, 0.f, 0.f}; }
            const float acl = fa[l]; const int q = c16 >> 2, pp = c16 & 3;
            for (int ks = 0; ks <= (w >> 1); ++ks) {
                float mv[8];
#pragma unroll
                for (int half = 0; half < 2; ++half) {
                    const int sb = 2 * ks + half;
                    if (sb <= w) {
                        f32x4 gt = (f32x4){0.f, 0.f, 0.f, 0.f};
#pragma unroll
                        for (int kn = 0; kn < 4; ++kn) { const bf16x8 a = *(const LAS bf16x8*)(L + SS_BM + (16 * sb + c16) * SLD + (32 * kn + 8 * g4) * 2);
                            const bf16x8 bb = *(const LAS bf16x8*)(L + SS_CM + (16 * w + c16) * SLD + (32 * kn + 8 * g4) * 2); gt = mfma16(a, bb, gt); }
#pragma unroll
                        for (int r = 0; r < 4; ++r) { const int s = 16 * sb + 4 * g4 + r; const float v = gt[r] * __expf(acl - fa[s]) * fdt[s]; mv[4 * half + r] = (s <= l) ? v : 0.f; }
                    } else {
#pragma unroll
                        for (int r = 0; r < 4; ++r) mv[4 * half + r] = 0.f;
                    }
                }
                const bf16x8 bfrag = pack8f(mv);
#pragma unroll
                for (int pb = 0; pb < 4; ++pb) { const s16x4 tA = tr_read(L + SS_X + (32 * ks + 4 * g4 + q) * XLD + (16 * pb + 4 * pp) * 2), tB = tr_read(L + SS_X + (32 * ks + 16 + 4 * g4 + q) * XLD + (16 * pb + 4 * pp) * 2);
                    accd[pb] = mfma16(cat4(tA, tB), bfrag, accd[pb]); }
            }
#pragma unroll
            for (int kn = 0; kn < 4; ++kn) { const bf16x8 bb = *(const LAS bf16x8*)(L + SS_CM + (16 * w + c16) * SLD + (32 * kn + 8 * g4) * 2);
#pragma unroll
                for (int pb = 0; pb < 4; ++pb) { const bf16x8 a = *(const LAS bf16x8*)(L + SS_HB + (16 * pb + c16) * SLD + (32 * kn + 8 * g4) * 2); acco[pb] = mfma16(a, bb, acco[pb]); } }
            const float el = feac[l]; float ssq = 0.f;
#pragma unroll
            for (int pb = 0; pb < 4; ++pb) { const int p0 = 16 * pb + 4 * g4;
                const float z[4] = {bflo(zr[pb].x), bfhi(zr[pb].x), bflo(zr[pb].y), bfhi(zr[pb].y)}; float o[4];
                const u32x2 xw = *(const LAS u32x2*)(L + SS_X + l * XLD + p0 * 2); const float xv[4] = {bflo(xw.x), bfhi(xw.x), bflo(xw.y), bfhi(xw.y)};
#pragma unroll
                for (int r = 0; r < 4; ++r) { const float y = accd[pb][r] + el * acco[pb][r] + Dsk * xv[r]; o[r] = y * siluf_(z[r]); ssq += o[r] * o[r]; }
                u32x2 ow; ow.x = pk2(o[0], o[1]); ow.y = pk2(o[2], o[3]); *(u32x2*)(MIX + row * 2048 + MIXS + hh * 64 + p0) = ow; }
            ssq += SHFL_XOR(ssq, 16); ssq += SHFL_XOR(ssq, 32);
            if (g4 == 0) SSQS[row * 16 + hh] = ssq;
            const float dec = feac[127];
#pragma unroll
            for (int pb = 0; pb < 4; ++pb) hst[pb] = hst[pb] * dec;
#pragma unroll
            for (int ks = 0; ks < 4; ++ks) {
                const s16x4 tA = tr_read(L + SS_BM + (32 * ks + 8 * g4 + q) * SLD + (16 * w + 4 * pp) * 2), tB = tr_read(L + SS_BM + (32 * ks + 8 * g4 + 4 + q) * SLD + (16 * w + 4 * pp) * 2);
                const bf16x8 bfrag = cat4(tA, tB);
                const f32x4 w0 = *(const LAS f32x4*)(fwdt + 32 * ks + 8 * g4), w1 = *(const LAS f32x4*)(fwdt + 32 * ks + 8 * g4 + 4);
#pragma unroll
                for (int pb = 0; pb < 4; ++pb) { const s16x4 xA = tr_read(L + SS_X + (32 * ks + 8 * g4 + q) * XLD + (16 * pb + 4 * pp) * 2), xB = tr_read(L + SS_X + (32 * ks + 8 * g4 + 4 + q) * XLD + (16 * pb + 4 * pp) * 2);
                    const float av[8] = {bf1((bf16_t)xA[0]) * w0[0], bf1((bf16_t)xA[1]) * w0[1], bf1((bf16_t)xA[2]) * w0[2], bf1((bf16_t)xA[3]) * w0[3], bf1((bf16_t)xB[0]) * w1[0], bf1((bf16_t)xB[1]) * w1[1], bf1((bf16_t)xB[2]) * w1[2], bf1((bf16_t)xB[3]) * w1[3]};
                    hst[pb] = mfma16(pack8f(av), bfrag, hst[pb]); }
            }
            if (w == 0 && c + 1 < 16) SSD_GATES((c + 1) & 1);
        }
        WG_BAR();
#pragma unroll
        for (int pb = 0; pb < 4; ++pb)
#pragma unroll
            for (int r = 0; r < 4; ++r) *(LAS bf16_t*)(L + SS_HB + (16 * pb + 4 * g4 + r) * SLD + (16 * w + c16) * 2) = f2bf(hst[pb][r]);
    }
#undef SSD_PREFETCH
#undef SSD_GATES
}

constexpr int VL2 = 80;
constexpr int ML_Q = 0, ML_K = 17408, ML_V = 34816, ML_CB = 39936, ML_F = 48640;
__device__ __forceinline__ void mlstm_unit(Frame& F, int b, int h, int vs, const bf16_t* __restrict__ U, const bf16_t* __restrict__ CV, bf16_t* __restrict__ MIX, float* __restrict__ SSQM, const float* __restrict__ gate_b) {
    LAS unsigned char* L = F.lds;
    const int tid = F.tid, lane = F.lane, w = F.wave, c16 = lane & 15, g4 = lane >> 4;
    LAS float* fbase = (LAS float*)(L + ML_F); LAS float* fnvec = fbase + 768;
    WG_BAR();
    for (int i = tid; i < 32 * SLD / 4; i += NTHR) ((LAS unsigned*)(L + ML_CB))[i] = 0u;
    if (tid < 128) fnvec[tid] = 0.f;
    const float bi = gate_b[h], bfg = gate_b[4 + h];
    float m_prev = 0.f, nreg = 0.f;
    f32x4 cst[2]; cst[0] = (f32x4){0.f, 0.f, 0.f, 0.f}; cst[1] = cst[0];
    const bf16_t* cvq = CV + (size_t)b * SEQ * NCV + h * 128; const bf16_t* uv = U + (size_t)b * SEQ * NU + UV + h * 128 + vs * 32;
    u32x4 pq[2], pkk[2], pvv; unsigned gri = 0, grf = 0;
#define ML_PREFETCH(cc) do { const size_t r0_ = (size_t)(cc) * 64; \
        _Pragma("unroll") for (int i = 0; i < 2; ++i) { const int q_ = tid + 512 * i; pq[i] = *(const u32x4*)(cvq + (r0_ + (q_ >> 4)) * NCV + 8 * (q_ & 15)); pkk[i] = *(const u32x4*)(cvq + (r0_ + (q_ >> 4)) * NCV + 512 + 8 * (q_ & 15)); } \
        if (tid < 256) pvv = *(const u32x4*)(uv + (r0_ + (tid >> 2)) * NU + 8 * (tid & 3)); \
        if (w == 0) { gri = U[((size_t)b * SEQ + r0_ + lane) * NU + UMI + h]; grf = U[((size_t)b * SEQ + r0_ + lane) * NU + UMF + h]; } } while (0)
#define ML_GATES(buf) do { LAS float* fg_ = fbase + (buf) * 384; \
        const float li = bf1((bf16_t)gri) + bi, lf = logsigmoidf_(bf1((bf16_t)grf) + bfg); float bc = lf; \
        _Pragma("unroll") for (int o = 1; o < 64; o <<= 1) { const float x = SHFL_UP(bc, o); if (lane >= o) bc += x; } \
        const float total = SHFL_IDX(bc, 63), ct = li - bc; float cm = ct; \
        _Pragma("unroll") for (int o = 1; o < 64; o <<= 1) { const float x = SHFL_UP(cm, o); if (lane >= o) cm = fmaxf(cm, x); } \
        const float mj = bc + fmaxf(m_prev, cm); \
        fg_[lane] = bc - mj; fg_[64 + lane] = ct; fg_[128 + lane] = __expf(bc + m_prev - mj); fg_[192 + lane] = __expf(-mj); \
        const float m_new = total + fmaxf(m_prev, SHFL_IDX(cm, 63)); \
        fg_[256 + lane] = __expf(total - m_new + ct); if (lane == 0) fg_[320] = __expf(total + m_prev - m_new); \
        m_prev = m_new; } while (0)
    ML_PREFETCH(0);
    if (w == 0) ML_GATES(0);
    for (int c = 0; c < 32; ++c) {
        const size_t row0 = (size_t)b * SEQ + c * 64;
#pragma unroll
        for (int i = 0; i < 2; ++i) { const int q_ = tid + 512 * i; *(LAS u32x4*)(L + ML_Q + (q_ >> 4) * SLD + (q_ & 15) * 16) = pq[i]; *(LAS u32x4*)(L + ML_K + (q_ >> 4) * SLD + (q_ & 15) * 16) = pkk[i]; }
        if (tid < 256) *(LAS u32x4*)(L + ML_V + (tid >> 2) * VL2 + (tid & 3) * 16) = pvv;
        WG_BAR();
        if (c + 1 < 32) ML_PREFETCH(c + 1);
        {
            const LAS float* frow = fbase + (c & 1) * 384; const LAS float* fcol = frow + 64; const LAS float* fsint = frow + 128; const LAS float* femj = frow + 192; const LAS float* favec = frow + 256;
            const int jb = w & 3, vb = w >> 2; const int j = 16 * jb + c16; const float rt = frow[j]; const int q = c16 >> 2, pp = c16 & 3;
            f32x4 accD = (f32x4){0.f, 0.f, 0.f, 0.f}, accI = accD; float dsum = 0.f;
            for (int ks = 0; ks <= (jb >> 1); ++ks) {
                float mv[8];
#pragma unroll
                for (int half = 0; half < 2; ++half) {
                    const int sb = 2 * ks + half;
                    if (sb <= jb) {
                        f32x4 st = (f32x4){0.f, 0.f, 0.f, 0.f};
#pragma unroll
                        for (int kk = 0; kk < 4; ++kk) { const bf16x8 a = *(const LAS bf16x8*)(L + ML_K + (16 * sb + c16) * SLD + (32 * kk + 8 * g4) * 2);
                            const bf16x8 bq = *(const LAS bf16x8*)(L + ML_Q + (16 * jb + c16) * SLD + (32 * kk + 8 * g4) * 2); st = mfma16(a, bq, st); }
#pragma unroll
                        for (int r = 0; r < 4; ++r) { const int s = 16 * sb + 4 * g4 + r; float v = st[r] * __expf(rt + fcol[s]); v = (s <= j) ? v : 0.f; mv[4 * half + r] = v; dsum += v; }
                    } else {
#pragma unroll
                        for (int r = 0; r < 4; ++r) mv[4 * half + r] = 0.f;
                    }
                }
                const bf16x8 bfrag = pack8f(mv);
                const s16x4 tA = tr_read(L + ML_V + (32 * ks + 4 * g4 + q) * VL2 + (16 * vb + 4 * pp) * 2), tB = tr_read(L + ML_V + (32 * ks + 16 + 4 * g4 + q) * VL2 + (16 * vb + 4 * pp) * 2);
                accD = mfma16(cat4(tA, tB), bfrag, accD);
            }
#pragma unroll
            for (int kk = 0; kk < 4; ++kk) { const bf16x8 a = *(const LAS bf16x8*)(L + ML_CB + (16 * vb + c16) * SLD + (32 * kk + 8 * g4) * 2);
                const bf16x8 bq = *(const LAS bf16x8*)(L + ML_Q + (16 * jb + c16) * SLD + (32 * kk + 8 * g4) * 2); accI = mfma16(a, bq, accI); }
            float nq = 0.f;
#pragma unroll
            for (int i = 0; i < 4; ++i) { const u32x4 qr = *(const LAS u32x4*)(L + ML_Q + (16 * jb + c16) * SLD + (32 * g4 + 8 * i) * 2);
                const f32x4 n0 = *(const LAS f32x4*)(fnvec + 32 * g4 + 8 * i), n1 = *(const LAS f32x4*)(fnvec + 32 * g4 + 8 * i + 4);
                nq += bflo(qr.x) * n0[0] + bfhi(qr.x) * n0[1] + bflo(qr.y) * n0[2] + bfhi(qr.y) * n0[3] + bflo(qr.z) * n1[0] + bfhi(qr.z) * n1[1] + bflo(qr.w) * n1[2] + bfhi(qr.w) * n1[3]; }
            nq += SHFL_XOR(nq, 16); nq += SHFL_XOR(nq, 32);
            dsum += SHFL_XOR(dsum, 16); dsum += SHFL_XOR(dsum, 32);
            const float si = fsint[j]; const float den = si * nq + dsum; const float inv = 1.0f / fmaxf(fabsf(den), femj[j]);
            const size_t row = row0 + j; float o[4], ssq = 0.f;
#pragma unroll
            for (int r = 0; r < 4; ++r) { o[r] = (si * accI[r] + accD[r]) * inv; ssq += o[r] * o[r]; }
            u32x2 ow; ow.x = pk2(o[0], o[1]); ow.y = pk2(o[2], o[3]); *(u32x2*)(MIX + row * 2048 + MIXM + h * 128 + vs * 32 + 16 * vb + 4 * g4) = ow;
            ssq += SHFL_XOR(ssq, 16); ssq += SHFL_XOR(ssq, 32);
            if (g4 == 0) SSQM[row * 32 + h * 8 + vs * 2 + vb] = ssq;
            const float dec = frow[320];
            cst[0] = cst[0] * dec; cst[1] = cst[1] * dec;
#pragma unroll
            for (int ks = 0; ks < 2; ++ks) {
                const s16x4 tA = tr_read(L + ML_K + (32 * ks + 8 * g4 + q) * SLD + (16 * w + 4 * pp) * 2), tB = tr_read(L + ML_K + (32 * ks + 8 * g4 + 4 + q) * SLD + (16 * w + 4 * pp) * 2);
                const bf16x8 bfrag = cat4(tA, tB);
                const f32x4 w0 = *(const LAS f32x4*)(favec + 32 * ks + 8 * g4), w1 = *(const LAS f32x4*)(favec + 32 * ks + 8 * g4 + 4);
#pragma unroll
                for (int vb2 = 0; vb2 < 2; ++vb2) { const s16x4 xA = tr_read(L + ML_V + (32 * ks + 8 * g4 + q) * VL2 + (16 * vb2 + 4 * pp) * 2), xB = tr_read(L + ML_V + (32 * ks + 8 * g4 + 4 + q) * VL2 + (16 * vb2 + 4 * pp) * 2);
                    const float av[8] = {bf1((bf16_t)xA[0]) * w0[0], bf1((bf16_t)xA[1]) * w0[1], bf1((bf16_t)xA[2]) * w0[2], bf1((bf16_t)xA[3]) * w0[3], bf1((bf16_t)xB[0]) * w1[0], bf1((bf16_t)xB[1]) * w1[1], bf1((bf16_t)xB[2]) * w1[2], bf1((bf16_t)xB[3]) * w1[3]};
                    cst[vb2] = mfma16(pack8f(av), bfrag, cst[vb2]); }
            }
            if (tid < 128) { float s = 0.f;
#pragma unroll 8
                for (int sI = 0; sI < 64; ++sI) s += favec[sI] * bf1(*(const LAS bf16_t*)(L + ML_K + sI * SLD + 2 * tid));
                nreg = dec * nreg + s; }
            if (w == 0 && c + 1 < 32) ML_GATES((c + 1) & 1);
        }
        WG_BAR();
#pragma unroll
        for (int vb2 = 0; vb2 < 2; ++vb2)
#pragma unroll
            for (int r = 0; r < 4; ++r) *(LAS bf16_t*)(L + ML_CB + (16 * vb2 + 4 * g4 + r) * SLD + (16 * w + c16) * 2) = f2bf(cst[vb2][r]);
        if (tid < 128) fnvec[tid] = nreg;
    }
#undef ML_PREFETCH
#undef ML_GATES
}

constexpr int MB_K0 = 0, MB_V0 = 17408, MB_K1 = 34816, MB_V1 = 52224, MB_KM = 69632, MB_SEL = 73216;
__device__ __forceinline__ void moba_unit(Frame& F, int b, int h, int qb, const bf16_t* __restrict__ U, bf16_t* __restrict__ MIX, const float* __restrict__ KMEAN) {
    LAS unsigned char* L = F.lds;
    const int tid = F.tid, lane = F.lane, w = F.wave, c16 = lane & 15, g4 = lane >> 4;
    LAS float* km = (LAS float*)(L + MB_KM); LAS int* sel = (LAS int*)(L + MB_SEL);
    const size_t row0 = (size_t)b * SEQ + 256 * qb;
    WG_BAR();
    for (int i = tid; i < qb * 128; i += NTHR) km[i] = KMEAN[((size_t)(b * 4 + h) * 8) * 128 + i];
    WG_BAR();
    if (tid < 256) {
        int mask = (1 << qb) - 1;
        if (qb > 3) {
            float sc[7];
#pragma unroll
            for (int j = 0; j < 7; ++j) sc[j] = 0.f;
            const bf16_t* qp = U + (row0 + tid) * NU + UAQ + h * 128;
            for (int d8 = 0; d8 < 16; ++d8) { const u32x4 qr = *(const u32x4*)(qp + 8 * d8); const float qv[8] = {bflo(qr.x), bfhi(qr.x), bflo(qr.y), bfhi(qr.y), bflo(qr.z), bfhi(qr.z), bflo(qr.w), bfhi(qr.w)};
#pragma unroll
                for (int j = 0; j < 7; ++j) if (j < qb) { const f32x4 k0 = *(const LAS f32x4*)(km + j * 128 + 8 * d8), k1 = *(const LAS f32x4*)(km + j * 128 + 8 * d8 + 4);
                    sc[j] += qv[0] * k0[0] + qv[1] * k0[1] + qv[2] * k0[2] + qv[3] * k0[3] + qv[4] * k1[0] + qv[5] * k1[1] + qv[6] * k1[2] + qv[7] * k1[3]; } }
            mask = 0;
#pragma unroll
            for (int it = 0; it < 3; ++it) { float best = -__builtin_inff(); int bi = 0;
#pragma unroll
                for (int j = 0; j < 7; ++j) if (j < qb && !((mask >> j) & 1) && sc[j] > best) { best = sc[j]; bi = j; }
                mask |= 1 << bi; }
        }
        sel[tid] = mask;
    }
    WG_BAR();
    bf16x8 Qf[2][4]; int msk[2]; float mrun[2], lsum[2]; f32x4 O[2][8];
#pragma unroll
    for (int qq = 0; qq < 2; ++qq) { const bf16_t* qp = U + (row0 + 32 * w + 16 * qq + c16) * NU + UAQ + h * 128 + 8 * g4;
#pragma unroll
        for (int ds = 0; ds < 4; ++ds) Qf[qq][ds] = *(const bf16x8*)(qp + 32 * ds);
        msk[qq] = sel[32 * w + 16 * qq + c16]; mrun[qq] = -1e30f; lsum[qq] = 0.f;
#pragma unroll
        for (int db = 0; db < 8; ++db) O[qq][db] = (f32x4){0.f, 0.f, 0.f, 0.f}; }
    const int ntiles = 4 * (qb + 1);
    const float SC = 0.08838834764831845f * 1.4426950408889634f;
    const int kr = tid >> 3, ch = tid & 7;
    u32x4 pk[2], pv[2];
    { const bf16_t* kp = U + ((size_t)b * SEQ + kr) * NU + UAK + h * 128; const bf16_t* vp = U + ((size_t)b * SEQ + kr) * NU + UAV + h * 128;
      pk[0] = *(const u32x4*)(kp + 8 * ch); pk[1] = *(const u32x4*)(kp + 8 * (ch + 8)); pv[0] = *(const u32x4*)(vp + 8 * ch); pv[1] = *(const u32x4*)(vp + 8 * (ch + 8)); }
    for (int tt = 0; tt < ntiles; ++tt) {
        const int kofs = (tt & 1) ? MB_K1 : MB_K0, vofs = (tt & 1) ? MB_V1 : MB_V0;
        *(LAS u32x4*)(L + kofs + kr * SLD + ch * 16) = pk[0]; *(LAS u32x4*)(L + kofs + kr * SLD + (ch + 8) * 16) = pk[1];
        *(LAS u32x4*)(L + vofs + kr * SLD + ch * 16) = pv[0]; *(LAS u32x4*)(L + vofs + kr * SLD + (ch + 8) * 16) = pv[1];
        WG_BAR();
        if (tt + 1 < ntiles) { const bf16_t* kp = U + ((size_t)b * SEQ + 64 * (tt + 1) + kr) * NU + UAK + h * 128; const bf16_t* vp = U + ((size_t)b * SEQ + 64 * (tt + 1) + kr) * NU + UAV + h * 128;
            pk[0] = *(const u32x4*)(kp + 8 * ch); pk[1] = *(const u32x4*)(kp + 8 * (ch + 8)); pv[0] = *(const u32x4*)(vp + 8 * ch); pv[1] = *(const u32x4*)(vp + 8 * (ch + 8)); }
        const int jblk = tt >> 2; const bool own = (jblk == qb);
        f32x4 st[4][2];
#pragma unroll
        for (int kb = 0; kb < 4; ++kb) { st[kb][0] = (f32x4){0.f, 0.f, 0.f, 0.f}; st[kb][1] = st[kb][0];
#pragma unroll
            for (int ds = 0; ds < 4; ++ds) { const bf16x8 a = *(const LAS bf16x8*)(L + kofs + (16 * kb + c16) * SLD + (32 * ds + 8 * g4) * 2);
                st[kb][0] = mfma16(a, Qf[0][ds], st[kb][0]); st[kb][1] = mfma16(a, Qf[1][ds], st[kb][1]); } }
        bf16x8 pf[2][2];
#pragma unroll
        for (int qq = 0; qq < 2; ++qq) {
            const float NEG = -__builtin_inff();
            if (own) { const int qi = 32 * w + 16 * qq + c16, kbase = 64 * (tt & 3) + 4 * g4;
#pragma unroll
                for (int kb = 0; kb < 4; ++kb)
#pragma unroll
                    for (int r = 0; r < 4; ++r) if (kbase + 16 * kb + r > qi) st[kb][qq][r] = NEG;
            } else if (!((msk[qq] >> jblk) & 1)) {
#pragma unroll
                for (int kb = 0; kb < 4; ++kb) st[kb][qq] = (f32x4){NEG, NEG, NEG, NEG};
            }
            float rm = st[0][qq][0];
#pragma unroll
            for (int kb = 0; kb < 4; ++kb)
#pragma unroll
                for (int r = 0; r < 4; ++r) rm = fmaxf(rm, st[kb][qq][r]);
            rm = fmaxf(rm, SHFL_XOR(rm, 16)); rm = fmaxf(rm, SHFL_XOR(rm, 32));
            const float mn = fmaxf(mrun[qq], rm), alpha = __builtin_amdgcn_exp2f((mrun[qq] - mn) * SC); mrun[qq] = mn;
            float ps = 0.f; float pvv[4][4];
#pragma unroll
            for (int kb = 0; kb < 4; ++kb)
#pragma unroll
                for (int r = 0; r < 4; ++r) { const float pe = __builtin_amdgcn_exp2f((st[kb][qq][r] - mn) * SC); pvv[kb][r] = pe; ps += pe; }
            lsum[qq] = lsum[qq] * alpha + ps;
#pragma unroll
            for (int db = 0; db < 8; ++db) O[qq][db] = O[qq][db] * alpha;
#pragma unroll
            for (int ks = 0; ks < 2; ++ks) { const float v8[8] = {pvv[2 * ks][0], pvv[2 * ks][1], pvv[2 * ks][2], pvv[2 * ks][3], pvv[2 * ks + 1][0], pvv[2 * ks + 1][1], pvv[2 * ks + 1][2], pvv[2 * ks + 1][3]}; pf[qq][ks] = pack8f(v8); }
        }
        const int q = c16 >> 2, p = c16 & 3;
#pragma unroll
        for (int ks = 0; ks < 2; ++ks)
#pragma unroll
            for (int db = 0; db < 8; ++db) {
                const s16x4 tA = tr_read(L + vofs + (32 * ks + 4 * g4 + q) * SLD + (16 * db + 4 * p) * 2), tB = tr_read(L + vofs + (32 * ks + 16 + 4 * g4 + q) * SLD + (16 * db + 4 * p) * 2);
                const bf16x8 a = cat4(tA, tB);
                O[0][db] = mfma16(a, pf[0][ks], O[0][db]); O[1][db] = mfma16(a, pf[1][ks], O[1][db]);
            }
    }
#pragma unroll
    for (int qq = 0; qq < 2; ++qq) { float ls = lsum[qq]; ls += SHFL_XOR(ls, 16); ls += SHFL_XOR(ls, 32); const float inv = 1.0f / ls;
        bf16_t* op = MIX + (row0 + 32 * w + 16 * qq + c16) * 2048 + MIXA + h * 128 + 4 * g4;
#pragma unroll
        for (int db = 0; db < 8; ++db) { u32x2 ow; ow.x = pk2(O[qq][db][0] * inv, O[qq][db][1] * inv); ow.y = pk2(O[qq][db][2] * inv, O[qq][db][3] * inv); *(u32x2*)(op + 16 * db) = ow; } }
}
__device__ __forceinline__ void kmean_items(Frame& F, const bf16_t* __restrict__ U, float* __restrict__ KMEAN) {
    const int gw = F.vcu * NWAVES + F.wave, NGW = NWG * NWAVES;
    for (int it = gw; it < NB * 4 * 8; it += NGW) {
        const int blk = it & 7, h = (it >> 3) & 3, b = it >> 5;
        const bf16_t* kp = U + ((size_t)b * SEQ + 256 * blk) * NU + UAK + h * 128 + 2 * F.lane;
        float s0 = 0.f, s1 = 0.f;
#pragma unroll 8
        for (int r = 0; r < 256; ++r) { const unsigned wv = *(const unsigned*)(kp + (size_t)r * NU); s0 += bflo(wv); s1 += bfhi(wv); }
        f32x2 o = {s0 * (1.f / 256.f), s1 * (1.f / 256.f)};
        *(f32x2*)(KMEAN + (size_t)it * 128 + 2 * F.lane) = o;
    }
}
__device__ __forceinline__ void mixnorm_rows(Frame& F, const bf16_t* __restrict__ U, bf16_t* __restrict__ MIX, const float* __restrict__ SSQM, const float* __restrict__ SSQS,
                                             const float* __restrict__ m_norm_g, const float* __restrict__ s_norm_g) {
    const int gw = F.vcu * NWAVES + F.wave, NGW = NWG * NWAVES, lane = F.lane;
    for (int row = gw; row < T; row += NGW) {
        {
            const int col0 = 8 * lane, hm = col0 >> 7;
            const f32x4 q0 = *(const f32x4*)(SSQM + (size_t)row * 32 + hm * 8), q1 = *(const f32x4*)(SSQM + (size_t)row * 32 + hm * 8 + 4);
            const float ssq = (q0[0] + q0[1]) + (q0[2] + q0[3]) + (q1[0] + q1[1]) + (q1[2] + q1[3]);
            const float r = 1.0f / sqrtf(ssq * (1.f / 128.f) + EPS);
            bf16_t* mp = MIX + (size_t)row * 2048 + MIXM + col0;
            const u32x4 hv = *(const u32x4*)mp, ov = *(const u32x4*)(U + (size_t)row * NU + UO + col0);
            const f32x4 g0 = *(const f32x4*)(m_norm_g + col0), g1 = *(const f32x4*)(m_norm_g + col0 + 4);
            u32x4 o;
            o.x = pk2(bflo(hv.x) * r * g0[0] * sigmoidf_(bflo(ov.x)), bfhi(hv.x) * r * g0[1] * sigmoidf_(bfhi(ov.x)));
            o.y = pk2(bflo(hv.y) * r * g0[2] * sigmoidf_(bflo(ov.y)), bfhi(hv.y) * r * g0[3] * sigmoidf_(bfhi(ov.y)));
            o.z = pk2(bflo(hv.z) * r * g1[0] * sigmoidf_(bflo(ov.z)), bfhi(hv.z) * r * g1[1] * sigmoidf_(bfhi(ov.z)));
            o.w = pk2(bflo(hv.w) * r * g1[2] * sigmoidf_(bflo(ov.w)), bfhi(hv.w) * r * g1[3] * sigmoidf_(bfhi(ov.w)));
            *(u32x4*)mp = o;
        }
#pragma unroll
        for (int i = 0; i < 2; ++i) {
            const int col0 = 512 * i + 8 * lane;
            const f32x4 q0 = *(const f32x4*)(SSQS + (size_t)row * 16 + 8 * i), q1 = *(const f32x4*)(SSQS + (size_t)row * 16 + 8 * i + 4);
            const float ssq = (q0[0] + q0[1]) + (q0[2] + q0[3]) + (q1[0] + q1[1]) + (q1[2] + q1[3]);
            const float r = 1.0f / sqrtf(ssq * (1.f / 512.f) + EPS);
            bf16_t* mp = MIX + (size_t)row * 2048 + MIXS + col0;
            const u32x4 hv = *(const u32x4*)mp;
            const f32x4 g0 = *(const f32x4*)(s_norm_g + col0), g1 = *(const f32x4*)(s_norm_g + col0 + 4);
            u32x4 o;
            o.x = pk2(bflo(hv.x) * r * g0[0], bfhi(hv.x) * r * g0[1]); o.y = pk2(bflo(hv.y) * r * g0[2], bfhi(hv.y) * r * g0[3]);
            o.z = pk2(bflo(hv.z) * r * g1[0], bfhi(hv.z) * r * g1[1]); o.w = pk2(bflo(hv.w) * r * g1[2], bfhi(hv.w) * r * g1[3]);
            *(u32x4*)mp = o;
        }
    }
}
constexpr int LT_TAB = 0, LT_CUMT = 320, LT_LCNT = 340, LT_BASE = 356, LT_TOT = 372, LT_GOFF = 388, LT_PART = 416, LT_PRE = 928;
__device__ __forceinline__ void moe_route(Frame& F, const float* X, const float* g, const float* Wr, int* ROUTE, int* WGCNT, int* TOK) {
    LAS unsigned char* L = F.lds; LAS int* lt = (LAS int*)(L + LTAB_OFF); const int lane = F.lane;
    WG_BAR();
    for (int i = F.tid; i < D * NEXP / 4; i += NTHR) { const float gk = g[i >> 1]; ((LAS f32x4*)L)[i] = ((const f32x4*)Wr)[i] * gk; }
    if (F.tid < 16) lt[LT_LCNT + F.tid] = 0;
    for (int i = F.bx * NTHR + F.tid; i < MOE_ROWS; i += NWG * NTHR) TOK[i] = -1;
    WG_BAR();
    f32x4 v[8];
    for (int i = 0; i < 16; ++i) {
        const int row = 128 * F.bx + 16 * F.wave + i;
        const float rstd = 1.0f / sqrtf(load_row_ssq(F, X + (size_t)row * D, v) * (1.f / D) + EPS);
        float lg[8];
#pragma unroll
        for (int e = 0; e < 8; ++e) lg[e] = 0.f;
#pragma unroll
        for (int j = 0; j < 8; ++j)
#pragma unroll
            for (int cc = 0; cc < 4; ++cc) { const int k = 4 * (lane + 64 * j) + cc; const f32x4 w0 = *(const LAS f32x4*)(L + (size_t)k * 32), w1 = *(const LAS f32x4*)(L + (size_t)k * 32 + 16); const float xv = v[j][cc];
                lg[0] += xv * w0[0]; lg[1] += xv * w0[1]; lg[2] += xv * w0[2]; lg[3] += xv * w0[3]; lg[4] += xv * w1[0]; lg[5] += xv * w1[1]; lg[6] += xv * w1[2]; lg[7] += xv * w1[3]; }
#pragma unroll
        for (int e = 0; e < 8; ++e) lg[e] = wave_sum(lg[e]) * rstd;
        if (lane == 0) {
            int e0 = 0; float b0 = lg[0];
#pragma unroll
            for (int e = 1; e < 8; ++e) if (lg[e] > b0) { b0 = lg[e]; e0 = e; }
            int e1 = -1; float b1 = -__builtin_inff();
#pragma unroll
            for (int e = 0; e < 8; ++e) if (e != e0 && lg[e] > b1) { b1 = lg[e]; e1 = e; }
            if (e1 < 0) e1 = (e0 == 0) ? 1 : 0;
            const float w1 = 1.0f / (1.0f + __expf(b0 - b1)), w0 = 1.0f - w1;
            const int r0 = __hip_atomic_fetch_add(lt + LT_LCNT + e0, 1, __ATOMIC_RELAXED, __HIP_MEMORY_SCOPE_WORKGROUP), r1 = __hip_atomic_fetch_add(lt + LT_LCNT + 8 + e1, 1, __ATOMIC_RELAXED, __HIP_MEMORY_SCOPE_WORKGROUP);
            ROUTE[row] = e0 | (e1 << 8); ROUTE[T + row] = r0; ROUTE[2 * T + row] = r1; ((float*)ROUTE)[3 * T + row] = w0; ((float*)ROUTE)[4 * T + row] = w1; ((float*)ROUTE)[5 * T + row] = rstd;
        }
    }
    WG_BAR();
    if (F.tid < 16) WGCNT[F.bx * 16 + F.tid] = lt[LT_LCNT + F.tid];
}
__device__ __forceinline__ void moe_tables(Frame& F, const int* WGCNT) {
    LAS unsigned char* L = F.lds; LAS int* lt = (LAS int*)(L + LTAB_OFF); const int tid = F.tid, c = F.bx;
    WG_BAR();
    { const int g = tid & 15, chn = tid >> 4; int s = 0;
#pragma unroll
      for (int i = 0; i < 8; ++i) s += WGCNT[(8 * chn + i) * 16 + g];
      lt[LT_PART + chn * 16 + g] = s; }
    WG_BAR();
    if (tid < 16) { int run = 0; for (int chn = 0; chn < 32; ++chn) { lt[LT_PRE + chn * 16 + tid] = run; run += lt[LT_PART + chn * 16 + tid]; } lt[LT_TOT + tid] = run; }
    WG_BAR();
    if (tid == 0) { int off = 0;
        for (int g = 0; g < 16; ++g) { const int nt = (lt[LT_TOT + g] + 255) >> 8; lt[LT_CUMT + g] = off >> 8; lt[LT_GOFF + g] = off; for (int t = 0; t < nt; ++t) lt[LT_TAB + (off >> 8) + t] = g & 7; off += nt << 8; }
        lt[LT_CUMT + 16] = off >> 8; }
    WG_BAR();
    if (tid < 16) { int bs = lt[LT_GOFF + tid] + lt[LT_PRE + (c >> 3) * 16 + tid]; for (int w2 = 8 * (c >> 3); w2 < c; ++w2) bs += WGCNT[w2 * 16 + tid]; lt[LT_BASE + tid] = bs; }
    WG_BAR();
}
__device__ __forceinline__ void moe_gather(Frame& F, const bf16_t* XN, const int* ROUTE, const int* WGCNT, bf16_t* XG, int* TOK, float* WGT, float* RS) {
    LAS unsigned char* L = F.lds; LAS int* lt = (LAS int*)(L + LTAB_OFF); const int lane = F.lane, c = F.bx;
    moe_tables(F, WGCNT);
    for (int i = 0; i < 16; ++i) {
        const int row = 128 * c + 16 * F.wave + i;
        const int ee = ROUTE[row], e0 = ee & 255, e1 = ee >> 8;
        const int pos0 = lt[LT_BASE + e0] + ROUTE[T + row], pos1 = lt[LT_BASE + 8 + e1] + ROUTE[2 * T + row];
        const u32x4* src = (const u32x4*)(XN + (size_t)row * D) + lane; u32x4* d0 = (u32x4*)(XG + (size_t)pos0 * D) + lane; u32x4* d1 = (u32x4*)(XG + (size_t)pos1 * D) + lane;
#pragma unroll
        for (int j = 0; j < 4; ++j) { const u32x4 x = src[64 * j]; d0[64 * j] = x; d1[64 * j] = x; }
        if (lane == 0) { TOK[pos0] = row; TOK[pos1] = row; WGT[pos0] = ((const float*)ROUTE)[3 * T + row]; WGT[pos1] = ((const float*)ROUTE)[4 * T + row]; const float rs = ((const float*)ROUTE)[5 * T + row]; RS[pos0] = rs; RS[pos1] = rs; }
    }
}

enum { I_X = 0, I_P, I_LNMIX, I_WIN, I_WOUT, I_MCW, I_MCB, I_MGB, I_MNG, I_SCW, I_SCB, I_SDTB, I_SALOG, I_SD, I_SNG, I_LNFFN, I_FWG, I_FWU, I_FWD, I_ROUTER, I_MWG, I_MWU, I_MWD, I_LNPLE, I_PPROJ, I_PGATE, I_LNFINAL };

__global__ void __launch_bounds__(NTHR, 2) hybrid_fwd(Args args) {
    extern __shared__ __attribute__((aligned(16))) unsigned char lds_raw[];
    Frame F;
    F.lds = (LAS unsigned char*)lds_raw;
    F.tid = threadIdx.x; F.lane = F.tid & 63; F.wave = __builtin_amdgcn_readfirstlane(F.tid >> 6);
    F.bx = blockIdx.x; F.vcu = (F.bx % 8) * (NWG / 8) + F.bx / 8;
    volatile LAS unsigned* MISC = (volatile LAS unsigned*)(F.lds + MISC_OFF);
    for (int u = F.tid; u < 64; u += NTHR) MISC[u] = 0u;
    __syncthreads();
    unsigned* ctl = (unsigned*)(args.ws + WS_CTL);
    XcdBarrier bar = xcd_barrier_post(ctl + CW_BAR, MISC + 8);
    const int lo = args.ph_lo, hi = args.ph_hi; int ph = 0;
#define PHASE_BEGIN if (ph >= lo && ph < hi) { { int t_ = threadIdx.x; asm volatile("" : "+v"(t_)); F.tid = t_; F.lane = t_ & 63; F.wave = __builtin_amdgcn_readfirstlane(t_ >> 6); LAS unsigned char* b_ = (LAS unsigned char*)lds_raw; asm volatile("" : "+s"(b_)); F.lds = b_; int x_ = blockIdx.x; asm volatile("" : "+s"(x_)); F.bx = x_; F.vcu = (x_ % 8) * (NWG / 8) + x_ / 8; }
#define PHASE_END(last) if (!(last) && ph + 1 < hi) xcd_barrier(bar); } ++ph;

    if (F.tid == 0) { LAS unsigned long long* pt = (LAS unsigned long long*)(F.lds + PTAB_OFF);
#pragma unroll
        for (int i = 0; i < 27; ++i) pt[i] = (unsigned long long)(uintptr_t)args.in[i];
        pt[27] = (unsigned long long)(uintptr_t)args.out; pt[28] = (unsigned long long)(uintptr_t)args.ws; }
    __syncthreads();
#define PTR_(i) ld_ptr(F.lds, (i))
#define IN_(i) ((const float*)PTR_(i))
#define X_ ((float*)PTR_(27))
#define WSB_(off) (PTR_(28) + (off))
#define WIN ((bf16_t*)WSB_(WS_WIN))
#define WOUT ((bf16_t*)WSB_(WS_WOUT))
#define FGU ((bf16_t*)WSB_(WS_FGU))
#define FD ((bf16_t*)WSB_(WS_FD))
#define MGU ((bf16_t*)WSB_(WS_MGU))
#define MD ((bf16_t*)WSB_(WS_MD))
#define PG ((bf16_t*)WSB_(WS_PG))
#define PP ((bf16_t*)WSB_(WS_PP))
#define XN ((bf16_t*)WSB_(WS_XN))
#define P16 ((bf16_t*)WSB_(WS_P16))
#define U ((bf16_t*)WSB_(WS_U))
#define MIX ((bf16_t*)WSB_(WS_MIX))
#define CVB ((bf16_t*)WSB_(WS_CV))
#define H ((bf16_t*)WSB_(WS_H))
#define XBB ((bf16_t*)WSB_(WS_XBB))
#define SSQ_(i) ((pg8::ssq_t*)WSB_(WS_SSQ) + (size_t)(i) * T)
#define RS ((float*)WSB_(WS_WGT + 512 * 1024))
#define XG ((bf16_t*)WSB_(WS_XG))
#define HM ((bf16_t*)WSB_(WS_HM))
#define SSQM ((float*)WSB_(WS_SSQM))
#define SSQS ((float*)WSB_(WS_SSQS))
#define KMEAN ((float*)WSB_(WS_KMEAN))
#define ROUTE ((int*)WSB_(WS_ROUTE))
#define TOK ((int*)WSB_(WS_TOK))
#define WGT ((float*)WSB_(WS_WGT))
#define WGCNT ((int*)WSB_(WS_WGCNT))
    PHASE_BEGIN
#ifdef PROBE_P02
    for (int rp_ = 0; rp_ < 2; ++rp_)
#endif
    {
        LAS float* scr = (LAS float*)(F.lds + RING_OFF + F.wave * XP_SCR); const int gw = F.vcu * NWAVES + F.wave, NGW = NWG * NWAVES;
        for (int l = 0; l < DEPTH; ++l) {
            {
                const float* W = IN_(I_WIN) + (size_t)l * D * DPROJ_SRC; bf16_t* WT = WIN + (size_t)l * NU * D;
                const int nblk = NU / 64, items = (D / 64) * nblk;
                for (int it = gw; it < items; it += NGW) { const int kb = it / nblk, nb = it % nblk; xpose_item(W, DPROJ_SRC, win_srccol(nb * 64 + 4 * (F.lane & 15)), kb * 64, WT, D, nb * 64, scr, F.lane, IN_(I_LNMIX) + (size_t)l * D); }
            }
            xpose_plain(F, IN_(I_WOUT) + (size_t)l * D * D, D, D, WOUT + (size_t)l * D * D, scr, gw, NGW, nullptr);
            xpose_plain(F, IN_(I_PGATE) + (size_t)l * D * D, D, D, PG + (size_t)l * D * D, scr, gw, NGW, IN_(I_LNPLE) + (size_t)l * D);
            xpose_plain(F, IN_(I_PPROJ) + (size_t)l * PLE * D, PLE, D, PP + (size_t)l * D * PLE, scr, gw, NGW, nullptr);
        }
        xpose_gu(F, IN_(I_FWG), IN_(I_FWU), D, DFF, FGU, scr, gw, NGW, IN_(I_LNFFN));
        xpose_plain(F, IN_(I_FWD), DFF, D, FD, scr, gw, NGW, nullptr);
        for (int e = 0; e < NEXP; ++e) {
            xpose_gu(F, IN_(I_MWG) + (size_t)e * D * DFFE, IN_(I_MWU) + (size_t)e * D * DFFE, D, DFFE, MGU + (size_t)e * 2 * DFFE * D, scr, gw, NGW, IN_(I_LNFFN) + D);
            xpose_plain(F, IN_(I_MWD) + (size_t)e * DFFE * D, DFFE, D, MD + (size_t)e * D * DFFE, scr, gw, NGW, nullptr);
        }
        {
            const f32x4* ps = (const f32x4*)IN_(I_P); u32x2* pd = (u32x2*)P16; const size_t n4 = (size_t)DEPTH * T * PLE / 4;
            for (size_t i = (size_t)F.bx * NTHR + F.tid; i < n4; i += (size_t)NWG * NTHR) { const f32x4 v = ps[i]; u32x2 o; o.x = pk2(v.x, v.y); o.y = pk2(v.z, v.w); pd[i] = o; }
        }
        {
            const float* xs = IN_(I_X); float* X = X_; bf16_t* xb = XBB; pg8::ssq_t* sq = SSQ_(0); f32x4 v[8];
            for (int m = gw; m < T; m += NGW) { const float s = load_row_ssq(F, xs + (size_t)m * D, v);
#pragma unroll
                for (int j = 0; j < 8; ++j) { ((f32x4*)(X + (size_t)m * D) + F.lane)[64 * j] = v[j]; u32x2 w; w.x = pk2(v[j].x, v[j].y); w.y = pk2(v[j].z, v[j].w); ((u32x2*)(xb + (size_t)m * D) + F.lane)[64 * j] = w; }
                if (F.lane == 0) sq[m] = (pg8::ssq_t)(s * pg8::SSQ_SCALE + 0.5f); }
        }
    }
    PHASE_END(false)

    for (int l = 0; l < DEPTH; ++l) {
        PHASE_BEGIN
        { pg8::Gemm g{XBB, WIN + (size_t)l * NU * D, D, D, D, 0}; pg8::StaticOrder S; S.init(T, NU, NWG, F.bx); pg8::EpiBf16 E{U, NU, SSQ_(3 * l)};
          pg8::gemm_phase<pg8::EpiBf16, pg8::StaticOrder, true>(F.lds + RING_OFF, g, S, E); }
        PHASE_END(false)
        PHASE_BEGIN
        {
            conv_phase(F, U, CVB, IN_(I_MCW) + (size_t)l * 4 * 1024, IN_(I_MCB) + (size_t)l * 1024, IN_(I_SCW) + (size_t)l * 4 * 1536, IN_(I_SCB) + (size_t)l * 1536);
            kmean_items(F, U, KMEAN);
        }
        PHASE_END(false)
        PHASE_BEGIN
        {
            for (int u = F.vcu; u < NB * 16; u += NWG)
                ssd_unit(F, u >> 4, u & 15, U, CVB, MIX, SSQS, IN_(I_SDTB) + l * 16, IN_(I_SALOG) + l * 16, IN_(I_SD) + l * 16);
            for (int u = F.vcu; u < NB * 16; u += NWG)
                mlstm_unit(F, u >> 4, (u >> 2) & 3, u & 3, U, CVB, MIX, SSQM, IN_(I_MGB) + l * 8);
        }
        PHASE_END(false)
        PHASE_BEGIN
        {
            for (int u = F.vcu; u < NB * 4 * 4; u += NWG) { const int bh = u >> 2, s = u & 3;
                moba_unit(F, bh >> 2, bh & 3, 7 - s, U, MIX, KMEAN); moba_unit(F, bh >> 2, bh & 3, s, U, MIX, KMEAN); }
            mixnorm_rows(F, U, MIX, SSQM, SSQS, IN_(I_MNG) + (size_t)l * 512, IN_(I_SNG) + (size_t)l * 1024);
        }
        PHASE_END(false)
        PHASE_BEGIN
        { pg8::Gemm g{MIX, WOUT + (size_t)l * D * D, D, D, D, 0}; pg8::StaticOrder S; S.init(T, D, NWG, F.bx); pg8::EpiResidualStat E{X_, XN, SSQ_(3 * l + 1), D};
          pg8::gemm_phase<pg8::EpiResidualStat, pg8::StaticOrder, true>(F.lds + RING_OFF, g, S, E); }
        PHASE_END(false)
        if (l == 0) {
            PHASE_BEGIN
            { pg8::Gemm g{XN, FGU, D, D, D, 0}; pg8::StaticOrder S; S.init(T, 2 * DFF, NWG, F.bx); pg8::EpiSwiGLU E{H, DFF, nullptr, 0, SSQ_(3 * l + 1), nullptr};
              pg8::gemm_phase<pg8::EpiSwiGLU, pg8::StaticOrder, true>(F.lds + RING_OFF, g, S, E); }
            PHASE_END(false)
            PHASE_BEGIN
            { pg8::Gemm g{H, FD, DFF, DFF, DFF, 0}; pg8::StaticOrder S; S.init(T, D, NWG, F.bx); pg8::EpiResidualStat E{X_, XN, SSQ_(3 * l + 2), D};
              pg8::gemm_phase<pg8::EpiResidualStat, pg8::StaticOrder, true>(F.lds + RING_OFF, g, S, E); }
            { pg8::Gemm g{P16 + (size_t)l * T * PLE, PP + (size_t)l * D * PLE, PLE, PLE, PLE, 0}; pg8::StaticOrder S; S.init(T, D, NWG, F.bx); pg8::EpiBf16 E{(bf16_t*)WSB_(WS_PPB0), D, nullptr};
              pg8::gemm_phase<pg8::EpiBf16, pg8::StaticOrder, true>(F.lds + RING_OFF, g, S, E); }
            PHASE_END(false)
        } else {
            PHASE_BEGIN
            moe_route(F, X_, IN_(I_LNFFN) + (size_t)l * D, IN_(I_ROUTER), ROUTE, WGCNT, TOK);
            PHASE_END(false)
            PHASE_BEGIN
            moe_gather(F, XN, ROUTE, WGCNT, XG, TOK, WGT, RS);
            PHASE_END(false)
            for (int slot = 0; slot < 2; ++slot) {
                const LAS int* lt = (const LAS int*)(F.lds + LTAB_OFF);
                PHASE_BEGIN
                { moe_tables(F, WGCNT); const int rt0 = lt[LT_CUMT + 8 * slot], rt1 = lt[LT_CUMT + 8 * slot + 8];
                  pg8::Gemm g{XG, MGU, D, D, D, (size_t)2 * DFFE * D}; pg8::MoeOrder S{rt0, rt1 - rt0, 2 * DFFE / 256, NWG, F.bx, lt + LT_TAB}; pg8::EpiSwiGLU E{HM, DFFE, WGT, rt0, nullptr, RS};
                  pg8::gemm_phase<pg8::EpiSwiGLU, pg8::MoeOrder, true>(F.lds + RING_OFF, g, S, E); }
                PHASE_END(false)
                PHASE_BEGIN
                { moe_tables(F, WGCNT); const int rt0 = lt[LT_CUMT + 8 * slot], rt1 = lt[LT_CUMT + 8 * slot + 8];
                  pg8::Gemm g{HM - (size_t)rt0 * 256 * DFFE, MD, DFFE, DFFE, DFFE, (size_t)D * DFFE}; pg8::MoeOrder S{rt0, rt1 - rt0, D / 256, NWG, F.bx, lt + LT_TAB};
                  if (slot == 0) { pg8::EpiScatter<false> E{X_, D, TOK, nullptr, nullptr}; pg8::gemm_phase<pg8::EpiScatter<false>, pg8::MoeOrder, true>(F.lds + RING_OFF, g, S, E); }
                  else { pg8::EpiScatter<true> E{X_, D, TOK, XN, SSQ_(3 * l + 2)}; pg8::gemm_phase<pg8::EpiScatter<true>, pg8::MoeOrder, true>(F.lds + RING_OFF, g, S, E);
                    pg8::Gemm g2{P16 + (size_t)l * T * PLE, PP + (size_t)l * D * PLE, PLE, PLE, PLE, 0}; pg8::StaticOrder S2; S2.init(T, D, NWG, F.bx); pg8::EpiBf16 E2{(bf16_t*)WSB_(WS_PPB1), D, nullptr};
                    pg8::gemm_phase<pg8::EpiBf16, pg8::StaticOrder, true>(F.lds + RING_OFF, g2, S2, E2); } }
                PHASE_END(false)
            }
        }
        PHASE_BEGIN
        { pg8::Gemm g{XN, PG + (size_t)l * D * D, D, D, D, 0}; pg8::StaticOrder S; S.init(T, D, NWG, F.bx); pg8::EpiPleGate E{X_, (const bf16_t*)WSB_(l == 0 ? WS_PPB0 : WS_PPB1), D, SSQ_(3 * l + 2), XBB, SSQ_(3 * l + 3)};
          pg8::gemm_phase<pg8::EpiPleGate, pg8::StaticOrder, true>(F.lds + RING_OFF, g, S, E); }
        PHASE_END(false)
    }
    PHASE_BEGIN
    {
        const float* g = IN_(I_LNFINAL); float* X = X_; const pg8::ssq_t* sq = SSQ_(6); const int gw = F.vcu * NWAVES + F.wave, NGW = NWG * NWAVES;
        for (int m = gw; m < T; m += NGW) {
            f32x4* xr = (f32x4*)(X + (size_t)m * D) + F.lane; const float rstd = pg8::ssq_rstd(sq, m);
#pragma unroll
            for (int j = 0; j < 8; ++j) { const f32x4 gg = ((const f32x4*)g + F.lane)[64 * j]; xr[64 * j] = xr[64 * j] * rstd * gg; }
        }
    }
    PHASE_END(true)
#undef PHASE_BEGIN
#undef PHASE_END
}

extern "C" void kernel_launch(void* const* d_in, const int* in_sizes, int n_in, void* d_out, int out_size, void* d_ws, size_t ws_size, hipStream_t stream) {
    static int grid = 0;
    if (grid == 0) {
        if (n_in != 27 || out_size != T * D || ws_size < WS_END) { fprintf(stderr, "kernel_launch: unexpected shapes (n_in %d, out %d, ws %zu < %zu)\n", n_in, out_size, ws_size, (size_t)WS_END); grid = -1; return; }
        int dev = 0, cus = 0, per_cu = 0;
        if (hipGetDevice(&dev) != hipSuccess || hipDeviceGetAttribute(&cus, hipDeviceAttributeMultiprocessorCount, dev) != hipSuccess) { grid = -1; return; }
        if (hipFuncSetAttribute((const void*)hybrid_fwd, hipFuncAttributeMaxDynamicSharedMemorySize, LDS_BYTES) != hipSuccess) { fprintf(stderr, "kernel_launch: hipFuncSetAttribute failed\n"); grid = -1; return; }
        if (hipOccupancyMaxActiveBlocksPerMultiprocessor(&per_cu, (const void*)hybrid_fwd, NTHR, LDS_BYTES) != hipSuccess || per_cu < 1) fprintf(stderr, "kernel_launch: occupancy query reports %d\n", per_cu);
        (void)hipGetLastError();
        if (cus != 256) { fprintf(stderr, "kernel_launch: built for 256 CUs, device has %d\n", cus); grid = -1; return; }
        grid = cus;
    }
    if (grid < 0) return;
    if (hipMemsetAsync((char*)d_ws + WS_CTL, 0, CTL_ZERO_BYTES, stream) != hipSuccess) return;
    Args a{};
    for (int i = 0; i < 27; ++i) a.in[i] = (const float*)d_in[i];
    a.out = (float*)d_out; a.ws = (unsigned char*)d_ws;
#ifndef MK_SPLIT
    a.ph_lo = 0; a.ph_hi = 1000;
    hipLaunchKernelGGL(hybrid_fwd, dim3(NWG), dim3(NTHR), LDS_BYTES, stream, a);
#else
    for (int p = 0; p < 40; ++p) { a.ph_lo = p; a.ph_hi = p + 1; hipLaunchKernelGGL(hybrid_fwd, dim3(NWG), dim3(NTHR), LDS_BYTES, stream, a); }
#endif
}
```

```cpp
#include <hip/hip_runtime.h>
#include <cstdio>
#include <cstdint>

#define GAS __attribute__((address_space(1)))
#define LAS __attribute__((address_space(3)))
typedef unsigned short bf16_t;
typedef short bf16x8 __attribute__((ext_vector_type(8)));
typedef short s16x4 __attribute__((ext_vector_type(4)));
typedef float f32x4 __attribute__((ext_vector_type(4)));
typedef float f32x2 __attribute__((ext_vector_type(2)));
typedef unsigned u32x4 __attribute__((ext_vector_type(4)));
typedef unsigned u32x2 __attribute__((ext_vector_type(2)));
typedef __bf16 bf16x2_t __attribute__((ext_vector_type(2)));

__device__ __forceinline__ unsigned pk2(float lo, float hi) { f32x2 v = {lo, hi}; bf16x2_t b = __builtin_convertvector(v, bf16x2_t); return __builtin_bit_cast(unsigned, b); }
__device__ __forceinline__ float bflo(unsigned w) { return __builtin_bit_cast(float, w << 16); }
__device__ __forceinline__ float bfhi(unsigned w) { return __builtin_bit_cast(float, w & 0xffff0000u); }
__device__ __forceinline__ float bf1(bf16_t h) { return __builtin_bit_cast(float, ((unsigned)h) << 16); }
__device__ __forceinline__ bf16_t f2bf(float f) { return (bf16_t)(pk2(f, 0.f) & 0xffffu); }
__device__ __forceinline__ float fast_exp(float x) { return __builtin_amdgcn_exp2f(x * 1.4426950408889634f); }
__device__ __forceinline__ float sigmoidf_(float x) { return __builtin_amdgcn_rcpf(1.0f + fast_exp(-x)); }
__device__ __forceinline__ float siluf_(float x) { return x * sigmoidf_(x); }

namespace pg8 {
constexpr int BM = 256, BK = 64, HALF = 128, HTB = HALF * BK * 2  , STAGE_BYTES = 8 * HTB, NXCD = 8, WGM = 8;

__host__ __device__ __forceinline__ int lds_byte(int r, int c) { const int st = (r >> 4) * 2 + (c >> 5), rr = r & 15, cc = c & 31, ob = rr * 64 + cc * 2; return st * 1024 + (ob ^ (((ob >> 9) & 1) << 5)); }
__host__ __device__ __forceinline__ void stage_rc(int b, int& R, int& C) { const int st = b / 1024, sb = b % 1024, swz = sb ^ (((sb >> 9) & 1) << 5); R = (st >> 1) * 16 + swz / 64; C = (st & 1) * 32 + (swz % 64) / 2; }
__host__ __device__ __forceinline__ int perm32(int rho) { const int n = rho >> 4, i = rho & 15; return 8 * (i >> 2) + 4 * n + (i & 3); }

struct Unit { int pm, pn, e; };
struct Gemm { const bf16_t* A; const bf16_t* Bt; int lda, ldb, K; size_t estride; };

struct StaticOrder {
    int nM, nN, nwg, G, c;
    __device__ void init(int M, int N, int G_, int c_) { nM = M / BM; nN = N / BM; nwg = nM * nN; G = G_; c = c_; }
    __device__ bool next(int i, Unit& u) const {
        const long L = (long)i * G + c; if (L >= nwg) return false;
        int wgid = (int)L; { const int q = nwg / NXCD, r = nwg % NXCD, xcd = wgid % NXCD, off = wgid / NXCD; wgid = (xcd < r ? xcd * (q + 1) : r * (q + 1) + (xcd - r) * q) + off; }
        const int nig = WGM * nN, gid = wgid / nig, fm = gid * WGM, gsz = (nM - fm) < WGM ? (nM - fm) : WGM;
        u.pm = fm + ((wgid % nig) % gsz); u.pn = (wgid % nig) / gsz; u.e = 0; return true;
    }
};
struct MoeOrder {
    int rt0, nrt, nN, G, c; const LAS int* tab;
    __device__ bool next(int i, Unit& u) const {
        const int nwg = nrt * nN; const long L = (long)i * G + c; if (L >= nwg) return false;
        int wgid = (int)L; { const int q = nwg / NXCD, r = nwg % NXCD, xcd = wgid % NXCD, off = wgid / NXCD; wgid = (xcd < r ? xcd * (q + 1) : r * (q + 1) + (xcd - r) * q) + off; }
        const int nig = WGM * nN, gid = wgid / nig, fm = gid * WGM, gsz = (nrt - fm) < WGM ? (nrt - fm) : WGM;
        u.pm = rt0 + fm + ((wgid % nig) % gsz); u.pn = (wgid % nig) / gsz; u.e = tab[u.pm]; return true;
    }
};


__device__ __forceinline__ float epi_shfl(float v, int src) { return __builtin_bit_cast(float, __builtin_amdgcn_ds_bpermute(src << 2, __builtin_bit_cast(int, v))); }
constexpr float RMS_EPS = 1e-6f, INV_D = 1.0f / 2048.0f, SSQ_SCALE = 16777216.0f, SSQ_INV = INV_D / 16777216.0f;
typedef unsigned long long ssq_t;
__device__ __forceinline__ float ssq_rstd(const ssq_t* p, int row) { return __builtin_amdgcn_rsqf((float)p[row] * SSQ_INV + RMS_EPS); }
__device__ __forceinline__ void ssq_add(ssq_t* p, int row, float q) { __hip_atomic_fetch_add(p + row, (ssq_t)(q * SSQ_SCALE + 0.5f), __ATOMIC_RELAXED, __HIP_MEMORY_SCOPE_AGENT); }
struct EpiBf16 {
    static constexpr bool PERM = true;
    bf16_t* O; int ldc; const ssq_t* ssq;
    __device__ __forceinline__ void operator()(const f32x4 (&acc)[2][2][4][2], const Unit& u, int wr, int wc, int fr, int fq) const {
        const int row0 = u.pm * BM + wr * 64 + fr, col0 = u.pn * BM + wc * 32 + 8 * fq;
#pragma unroll
        for (int ai = 0; ai < 2; ++ai)
#pragma unroll
            for (int m = 0; m < 4; ++m) { const int row = row0 + ai * HALF + m * 16; const float s = ssq ? ssq_rstd(ssq, row) : 1.0f;
                bf16_t* rowp = O + (size_t)row * ldc + col0;
#pragma unroll
                for (int bj = 0; bj < 2; ++bj) { const f32x4 v0 = acc[ai][bj][m][0] * s, v1 = acc[ai][bj][m][1] * s;
                    u32x4 w; w.x = pk2(v0[0], v0[1]); w.y = pk2(v0[2], v0[3]); w.z = pk2(v1[0], v1[1]); w.w = pk2(v1[2], v1[3]);
                    *(u32x4*)(rowp + bj * HALF) = w; } }
    }
};
struct EpiSwiGLU {
    static constexpr bool PERM = true;
    bf16_t* H; int ldc; const float* wgt; int rt0; const ssq_t* ssq; const float* rs;
    __device__ __forceinline__ void operator()(const f32x4 (&acc)[2][2][4][2], const Unit& u, int wr, int wc, int fr, int fq) const {
        const int row0 = u.pm * BM + wr * 64 + fr, col0 = u.pn * HALF + wc * 32 + 8 * fq;
#pragma unroll
        for (int ai = 0; ai < 2; ++ai)
#pragma unroll
            for (int m = 0; m < 4; ++m) { const int row = row0 + ai * HALF + m * 16; const float s = wgt ? wgt[row] : 1.0f; const float rn = rs ? rs[row] : ssq_rstd(ssq, row);
                bf16_t* rowp = H + (size_t)(row - rt0 * BM) * ldc + col0;
                f32x4 o0, o1;
#pragma unroll
                for (int j = 0; j < 4; ++j) { o0[j] = siluf_(acc[ai][0][m][0][j] * rn) * (acc[ai][1][m][0][j] * rn) * s; o1[j] = siluf_(acc[ai][0][m][1][j] * rn) * (acc[ai][1][m][1][j] * rn) * s; }
                u32x4 w; w.x = pk2(o0[0], o0[1]); w.y = pk2(o0[2], o0[3]); w.z = pk2(o1[0], o1[1]); w.w = pk2(o1[2], o1[3]);
                *(u32x4*)rowp = w; }
    }
};
struct EpiResidualStat {
    static constexpr bool PERM = false;
    float* X; bf16_t* XB; ssq_t* ssq; int ldc; float alpha;
    __device__ __forceinline__ void operator()(const f32x4 (&acc)[2][2][4][2], const Unit& u, int wr, int wc, int fr, int fq) const {
        const int row0 = u.pm * BM + wr * 64 + fr, col0 = u.pn * BM + wc * 32 + 4 * fq, lane = fq * 16 + fr;
#pragma unroll
        for (int ai = 0; ai < 2; ++ai) {
            f32x4 xv[4][2][2]; float q[4];
#pragma unroll
            for (int m = 0; m < 4; ++m)
#pragma unroll
                for (int bj = 0; bj < 2; ++bj)
#pragma unroll
                    for (int n = 0; n < 2; ++n) xv[m][bj][n] = *(const f32x4*)(X + (size_t)(row0 + ai * HALF + m * 16) * ldc + col0 + bj * HALF + n * 16);
#pragma unroll
            for (int m = 0; m < 4; ++m) { const size_t off = (size_t)(row0 + ai * HALF + m * 16) * ldc + col0; q[m] = 0.f;
#pragma unroll
                for (int bj = 0; bj < 2; ++bj)
#pragma unroll
                    for (int n = 0; n < 2; ++n) { const f32x4 x = xv[m][bj][n] + acc[ai][bj][m][n] * alpha; *(f32x4*)(X + off + bj * HALF + n * 16) = x;
                        u32x2 w; w.x = pk2(x[0], x[1]); w.y = pk2(x[2], x[3]); *(u32x2*)(XB + off + bj * HALF + n * 16) = w; q[m] += (x[0] * x[0] + x[1] * x[1]) + (x[2] * x[2] + x[3] * x[3]); } }
#pragma unroll
            for (int m = 0; m < 4; ++m) { q[m] += epi_shfl(q[m], lane ^ 16); q[m] += epi_shfl(q[m], lane ^ 32); }
            if (fq == 0) {
#pragma unroll
                for (int m = 0; m < 4; ++m) ssq_add(ssq, row0 + ai * HALF + m * 16, q[m]); }
        }
    }
};
template <bool STAT> struct EpiScatter {
    static constexpr bool PERM = false;
    float* X; int ldc; const int* tok; bf16_t* XB; ssq_t* ssq;
    __device__ __forceinline__ void operator()(const f32x4 (&acc)[2][2][4][2], const Unit& u, int wr, int wc, int fr, int fq) const {
        const int row0 = u.pm * BM + wr * 64 + fr, col0 = u.pn * BM + wc * 32 + 4 * fq, lane = fq * 16 + fr;
        int tk[2][4];
#pragma unroll
        for (int ai = 0; ai < 2; ++ai)
#pragma unroll
            for (int m = 0; m < 4; ++m) tk[ai][m] = tok[row0 + ai * HALF + m * 16];
#pragma unroll
        for (int ai = 0; ai < 2; ++ai) {
            f32x4 xv[4][2][2]; float q[4];
#pragma unroll
            for (int m = 0; m < 4; ++m) { const int t = tk[ai][m] >= 0 ? tk[ai][m] : 0;
#pragma unroll
                for (int bj = 0; bj < 2; ++bj)
#pragma unroll
                    for (int n = 0; n < 2; ++n) xv[m][bj][n] = *(const f32x4*)(X + (size_t)t * ldc + col0 + bj * HALF + n * 16); }
#pragma unroll
            for (int m = 0; m < 4; ++m) { const int t = tk[ai][m]; q[m] = 0.f;
                if (t >= 0) { const size_t off = (size_t)t * ldc + col0;
#pragma unroll
                    for (int bj = 0; bj < 2; ++bj)
#pragma unroll
                        for (int n = 0; n < 2; ++n) { const f32x4 x = xv[m][bj][n] + acc[ai][bj][m][n]; *(f32x4*)(X + off + bj * HALF + n * 16) = x;
                            if (STAT) { u32x2 w; w.x = pk2(x[0], x[1]); w.y = pk2(x[2], x[3]); *(u32x2*)(XB + off + bj * HALF + n * 16) = w; q[m] += (x[0] * x[0] + x[1] * x[1]) + (x[2] * x[2] + x[3] * x[3]); } } } }
            if (STAT) {
#pragma unroll
                for (int m = 0; m < 4; ++m) { q[m] += epi_shfl(q[m], lane ^ 16); q[m] += epi_shfl(q[m], lane ^ 32); }
                if (fq == 0) {
#pragma unroll
                    for (int m = 0; m < 4; ++m) if (tk[ai][m] >= 0) ssq_add(ssq, tk[ai][m], q[m]); } }
        }
    }
};
struct EpiPleGate {
    static constexpr bool PERM = false;
    float* X; const bf16_t* PPB; int ldc; const ssq_t* ssq_in; bf16_t* XBo; ssq_t* ssq_out;
    __device__ __forceinline__ void operator()(const f32x4 (&acc)[2][2][4][2], const Unit& u, int wr, int wc, int fr, int fq) const {
        const int row0 = u.pm * BM + wr * 64 + fr, col0 = u.pn * BM + wc * 32 + 4 * fq, lane = fq * 16 + fr;
        float rn[2][4];
#pragma unroll
        for (int ai = 0; ai < 2; ++ai)
#pragma unroll
            for (int m = 0; m < 4; ++m) rn[ai][m] = ssq_rstd(ssq_in, row0 + ai * HALF + m * 16);
#pragma unroll
        for (int ai = 0; ai < 2; ++ai)
#pragma unroll
            for (int mp = 0; mp < 2; ++mp) {
                f32x4 xv[2][2][2]; u32x2 pw[2][2][2]; float q[2];
#pragma unroll
                for (int mm = 0; mm < 2; ++mm)
#pragma unroll
                    for (int bj = 0; bj < 2; ++bj)
#pragma unroll
                        for (int n = 0; n < 2; ++n) { const size_t o = (size_t)(row0 + ai * HALF + (2 * mp + mm) * 16) * ldc + col0 + bj * HALF + n * 16; xv[mm][bj][n] = *(const f32x4*)(X + o); pw[mm][bj][n] = *(const u32x2*)(PPB + o); }
#pragma unroll
                for (int mm = 0; mm < 2; ++mm) { const int m = 2 * mp + mm; const size_t off = (size_t)(row0 + ai * HALF + m * 16) * ldc + col0; q[mm] = 0.f;
#pragma unroll
                    for (int bj = 0; bj < 2; ++bj)
#pragma unroll
                        for (int n = 0; n < 2; ++n) { const f32x4 a = acc[ai][bj][m][n] * rn[ai][m]; f32x4 x = xv[mm][bj][n]; const u32x2 p2 = pw[mm][bj][n];
                            x[0] += bflo(p2.x) * sigmoidf_(a[0]); x[1] += bfhi(p2.x) * sigmoidf_(a[1]); x[2] += bflo(p2.y) * sigmoidf_(a[2]); x[3] += bfhi(p2.y) * sigmoidf_(a[3]); *(f32x4*)(X + off + bj * HALF + n * 16) = x;
                            u32x2 w; w.x = pk2(x[0], x[1]); w.y = pk2(x[2], x[3]); *(u32x2*)(XBo + off + bj * HALF + n * 16) = w; q[mm] += (x[0] * x[0] + x[1] * x[1]) + (x[2] * x[2] + x[3] * x[3]); } }
#pragma unroll
                for (int mm = 0; mm < 2; ++mm) { q[mm] += epi_shfl(q[mm], lane ^ 16); q[mm] += epi_shfl(q[mm], lane ^ 32); }
                if (fq == 0) {
#pragma unroll
                    for (int mm = 0; mm < 2; ++mm) ssq_add(ssq_out, row0 + ai * HALF + (2 * mp + mm) * 16, q[mm]); }
            }
    }
};

template <class Epi, class Sched, bool ALIGN_EPI>
__device__ __forceinline__ void gemm_phase(LAS unsigned char* lds, const Gemm g, const Sched& S, const Epi& E) {
    int tid_ = threadIdx.x; asm volatile("" : "+v"(tid_));
    const int tid = tid_, wid = __builtin_amdgcn_readfirstlane(tid >> 6), lane = tid & 63, wr = wid >> 2, wc = wid & 3, fr = lane & 15, fq = lane >> 4;
    const int K = g.K, nt = K / BK;
    unsigned voffA[2], voffB[2];
#pragma unroll
    for (int i = 0; i < 2; ++i) { int R, C; stage_rc(tid * 16 + i * 8192, R, C); const int Rb = Epi::PERM ? ((R & ~31) + perm32(R & 31)) : R;
        voffA[i] = (unsigned)(R * g.lda + C) * 2u; voffB[i] = (unsigned)(Rb * g.ldb + C) * 2u; }
    const size_t kstep = (size_t)(BK * 2);
    const size_t hstepA = (size_t)HALF * g.lda * 2, hstepB = (size_t)HALF * g.ldb * 2;
    const size_t tstepA = 2 * hstepA, tstepB = 2 * hstepB;
    const unsigned ldsw = (unsigned)wid * 1024u;
    const int aoff = lds_byte(wr * 64 + fr, fq * 8), boff = lds_byte(wc * 32 + fr, fq * 8);
#define PG8_SA(b, h) (((b) * 2 + (h)) * HTB)
#define PG8_SB(b, h) ((4 + (b) * 2 + (h)) * HTB)
#define PG8_STAGE(bufoff, gbase, voff) do { _Pragma("unroll") for (int _i = 0; _i < 2; ++_i) \
        __builtin_amdgcn_global_load_lds((const unsigned*)((const char*)(gbase) + (voff)[_i]), (LAS unsigned*)(lds + (bufoff) + ldsw + _i * 8192), 16, 0, 0); } while (0)
#define PG8_LDA(dst, b, h) do { _Pragma("unroll") for (int m = 0; m < 4; ++m) _Pragma("unroll") for (int k = 0; k < 2; ++k) dst[m][k] = *(const LAS bf16x8*)(lds + PG8_SA(b, h) + aoff + m * 2048 + k * 1024); } while (0)
#define PG8_LDB(dst, b, h) do { _Pragma("unroll") for (int n = 0; n < 2; ++n) _Pragma("unroll") for (int k = 0; k < 2; ++k) dst[n][k] = *(const LAS bf16x8*)(lds + PG8_SB(b, h) + boff + n * 2048 + k * 1024); } while (0)
#define PG8_MMA(ai, bj, At, Bt) do { __builtin_amdgcn_s_setprio(1); _Pragma("unroll") for (int m = 0; m < 4; ++m) _Pragma("unroll") for (int n = 0; n < 2; ++n) _Pragma("unroll") for (int k = 0; k < 2; ++k) \
        acc[ai][bj][m][n] = __builtin_amdgcn_mfma_f32_16x16x32_bf16(Bt[n][k], At[m][k], acc[ai][bj][m][n], 0, 0, 0); __builtin_amdgcn_s_setprio(0); } while (0)
#define PG8_WAIT_V(n) asm volatile("s_waitcnt vmcnt(" #n ")" ::: "memory")
#define PG8_WAIT_L(n) asm volatile("s_waitcnt lgkmcnt(" #n ")" ::: "memory")
#define PG8_BAR __builtin_amdgcn_s_barrier()
#define PG8_SCHED __builtin_amdgcn_sched_barrier(0)
    Unit cur, nxt; int ui = 0;
    if (!S.next(0, cur)) return;
    f32x4 acc[2][2][4][2];
#pragma unroll
    for (int a = 0; a < 2; ++a)
#pragma unroll
        for (int b = 0; b < 2; ++b)
#pragma unroll
            for (int m = 0; m < 4; ++m)
#pragma unroll
                for (int n = 0; n < 2; ++n) acc[a][b][m][n] = (f32x4){0.f, 0.f, 0.f, 0.f};
    bf16x8 At[4][2], B0[2][2], B1[2][2];
    const char* cA = (const char*)g.A + (size_t)cur.pm * tstepA; const char* cB = (const char*)(g.Bt + (size_t)cur.e * g.estride) + (size_t)cur.pn * tstepB;
    PG8_STAGE(PG8_SB(0, 0), cB, voffB); PG8_STAGE(PG8_SB(0, 1), cB + hstepB, voffB); PG8_STAGE(PG8_SA(0, 0), cA, voffA); PG8_STAGE(PG8_SA(0, 1), cA + hstepA, voffA);
    if (wr == 1) PG8_BAR;
    PG8_WAIT_V(2); PG8_BAR;
    PG8_STAGE(PG8_SB(1, 0), cB + kstep, voffB); PG8_STAGE(PG8_SA(1, 0), cA + kstep, voffA); PG8_STAGE(PG8_SB(1, 1), cB + hstepB + kstep, voffB);
    PG8_WAIT_V(6); PG8_BAR;
    for (;;) {
        const bool has_next = S.next(ui + 1, nxt);
        const char* nA = has_next ? (const char*)g.A + (size_t)nxt.pm * tstepA : cA; const char* nB = has_next ? (const char*)(g.Bt + (size_t)nxt.e * g.estride) + (size_t)nxt.pn * tstepB : cB;
        for (int t = 0; t < nt; t += 2) {
            const bool last = (t == nt - 2);
            const char* a1 = cA + (size_t)(t + 1) * kstep;
            const char* a2 = last ? nA : cA + (size_t)(t + 2) * kstep; const char* b2 = last ? nB : cB + (size_t)(t + 2) * kstep;
            const char* a3 = a2 + kstep; const char* b3 = b2 + kstep;
            PG8_LDB(B0, 0, 0); PG8_LDB(B1, 0, 1); PG8_SCHED; PG8_LDA(At, 0, 0); PG8_STAGE(PG8_SA(1, 1), a1 + hstepA, voffA);
            PG8_WAIT_V(8); PG8_WAIT_L(0); PG8_BAR; PG8_MMA(0, 0, At, B0); PG8_MMA(0, 1, At, B1); PG8_BAR; PG8_SCHED;
            PG8_LDA(At, 0, 1); PG8_STAGE(PG8_SB(0, 0), b2, voffB); PG8_STAGE(PG8_SB(0, 1), b2 + hstepB, voffB); PG8_STAGE(PG8_SA(0, 0), a2, voffA);
            PG8_WAIT_V(8); PG8_WAIT_L(0); PG8_BAR; PG8_MMA(1, 0, At, B0); PG8_MMA(1, 1, At, B1); PG8_BAR; PG8_SCHED;
            PG8_LDB(B0, 1, 0); PG8_LDB(B1, 1, 1); PG8_SCHED; PG8_LDA(At, 1, 0); PG8_STAGE(PG8_SA(0, 1), a2 + hstepA, voffA);
            PG8_WAIT_V(8); PG8_WAIT_L(0); PG8_BAR; PG8_MMA(0, 0, At, B0); PG8_MMA(0, 1, At, B1); PG8_BAR; PG8_SCHED;
            PG8_LDA(At, 1, 1); PG8_STAGE(PG8_SB(1, 0), b3, voffB); PG8_STAGE(PG8_SB(1, 1), b3 + hstepB, voffB); PG8_STAGE(PG8_SA(1, 0), a3, voffA);
            PG8_WAIT_V(8); PG8_WAIT_L(0); PG8_BAR; PG8_MMA(1, 0, At, B0); PG8_MMA(1, 1, At, B1); PG8_BAR; PG8_SCHED;
        }
        if constexpr (ALIGN_EPI) { if (wr == 0) PG8_BAR; }
        E(acc, cur, wr, wc, fr, fq);
        if (!has_next) break;
#pragma unroll
        for (int a = 0; a < 2; ++a)
#pragma unroll
            for (int b = 0; b < 2; ++b)
#pragma unroll
                for (int m = 0; m < 4; ++m)
#pragma unroll
                    for (int n = 0; n < 2; ++n) acc[a][b][m][n] = (f32x4){0.f, 0.f, 0.f, 0.f};
        cur = nxt; cA = nA; cB = nB; ++ui;
        if constexpr (ALIGN_EPI) { if (wr == 1) PG8_BAR; }
    }
    PG8_WAIT_V(0);
    if constexpr (!ALIGN_EPI) { if (wr == 0) PG8_BAR; }
    PG8_BAR;
#undef PG8_SA
#undef PG8_SB
#undef PG8_STAGE
#undef PG8_LDA
#undef PG8_LDB
#undef PG8_MMA
#undef PG8_WAIT_V
#undef PG8_WAIT_L
#undef PG8_BAR
#undef PG8_SCHED
}
}
constexpr int NB = 16, SEQ = 2048, T = NB * SEQ, D = 2048, DEPTH = 2;
constexpr int DPROJ_SRC = 6168, NU = 6400;
constexpr int DFF = 5632, NEXP = 8, DFFE = 7168, PLE = 256;
constexpr float EPS = 1e-6f;
constexpr int UQ = 0, UK = 512, UV = 1024, UO = 1536, UZ = 2048, UXBC = 3072, UAQ = 4608, UAK = 5120, UAV = 5632, UMI = 6144, UMF = 6148, UDT = 6152;
constexpr int MIXM = 0, MIXS = 512, MIXA = 1536;
constexpr int NWAVES = 8, NTHR = 512, NWG = 256;

constexpr size_t MiB = 1u << 20;
constexpr size_t WS_CTL = 0, CTL_ZERO_BYTES = 3 * MiB;
constexpr size_t WS_SSQ = 1 * MiB;
constexpr size_t WS_WIN = 4 * MiB;
constexpr size_t WS_WOUT = WS_WIN + 50 * MiB;
constexpr size_t WS_FGU = WS_WOUT + 16 * MiB;
constexpr size_t WS_FD = WS_FGU + 44 * MiB;
constexpr size_t WS_MGU = WS_FD + 22 * MiB;
constexpr size_t WS_MD = WS_MGU + 448 * MiB;
constexpr size_t WS_PG = WS_MD + 224 * MiB;
constexpr size_t WS_PP = WS_PG + 16 * MiB;
constexpr size_t WS_XN = WS_PP + 2 * MiB;
constexpr size_t WS_P16 = WS_XN + 128 * MiB;
constexpr size_t WS_R = WS_P16 + 32 * MiB;
constexpr size_t WS_U = WS_R;
constexpr size_t WS_MIX = WS_R + 400 * MiB;
constexpr size_t WS_CV = WS_R + 528 * MiB;
constexpr size_t WS_H = WS_R;
constexpr size_t WS_PPB0 = WS_R + 352 * MiB, WS_PPB1 = WS_R;
constexpr size_t WS_XG = WS_R;
constexpr size_t WS_HM = WS_R + 272 * MiB;
constexpr size_t WS_MISC = WS_R + 748 * MiB;
constexpr size_t WS_SSQM = WS_MISC;
constexpr size_t WS_SSQS = WS_SSQM + 4 * MiB;
constexpr size_t WS_KMEAN = WS_SSQS + 2 * MiB;
constexpr size_t WS_ROUTE = WS_KMEAN + 1 * MiB;
constexpr size_t WS_TOK = WS_ROUTE + 1 * MiB;
constexpr size_t WS_WGT = WS_TOK + 1 * MiB;
constexpr size_t WS_WGCNT = WS_WGT + 1 * MiB;
constexpr size_t WS_XBB = WS_WGCNT + 1 * MiB;
constexpr size_t WS_END = WS_XBB + 128 * MiB;
constexpr int MOE_ROWS = 69632, MOE_SLOT_ROWS = 34816;
constexpr int CW_TMO = 0, CW_BAR = 4096;

constexpr int RING_OFF = 0, RING_BYTES = 131072;
constexpr int LDSCTL_OFF = 139264;
constexpr int MISC_OFF = LDSCTL_OFF;
constexpr int LTAB_OFF = LDSCTL_OFF + 256;
constexpr int PTAB_OFF = LDSCTL_OFF + 6144;
constexpr int LDS_BYTES = 147456;

#define XB_TMO      128
#define XB_XCNT(j)  (256  + 64 * (j))
#define XB_XSUB(j)  (1280 + 64 * (j))
#define XB_XGEN(j)  (2304 + 64 * (j))
#define XB_TOP      3328
#define XB_TOPGEN   3392
#define XCD_BAR_WORDS 3456
#define XB_SPIN_CAP (1u << 18)

__device__ __forceinline__ unsigned xb_ld(unsigned* p)              { return __hip_atomic_load(p, __ATOMIC_RELAXED, __HIP_MEMORY_SCOPE_AGENT); }
__device__ __forceinline__ unsigned xb_add(unsigned* p, unsigned v) { return __hip_atomic_fetch_add(p, v, __ATOMIC_RELAXED, __HIP_MEMORY_SCOPE_AGENT); }
__device__ __forceinline__ unsigned xb_xcc_id() { return (unsigned)__builtin_amdgcn_s_getreg((3 << 11) | 20) & 0xFu; }
#define XB_SPIN(cond, bar) do { unsigned _sp = 0; while (cond) { __builtin_amdgcn_s_sleep(1); \
    if ((++_sp & 255u) == 0u) { if (xb_ld(&(bar)[XB_TMO])) break; if (_sp > XB_SPIN_CAP) { atomicAdd(&(bar)[XB_TMO], 1u); break; } } } } while (0)

struct XcdBarrier { unsigned* bar; unsigned x; volatile LAS unsigned* st; };

__device__ __forceinline__ XcdBarrier xcd_barrier_post(unsigned* bar, volatile LAS unsigned* st) {
    XcdBarrier b; b.bar = bar; b.x = xb_xcc_id(); b.st = st;
    if (threadIdx.x == 0) (void)xb_add(&bar[XB_XCNT(b.x)], 1u);
    return b;
}
__device__ __forceinline__ void xcd_barrier_complete(unsigned* bar, unsigned x, unsigned& nloc, unsigned& nx) {
    const unsigned G = NWG;
    unsigned sum, cnt, mine, sp = 0u;
    for (;;) {
        sum = 0u; cnt = 0u; mine = 0u;
#pragma unroll
        for (unsigned j = 0; j < 16; ++j) { const unsigned c = xb_ld(&bar[XB_XCNT(j)]); sum += c; cnt += (c > 0u) ? 1u : 0u; mine = (j == x) ? c : mine; }
        if (sum == G) break;
        __builtin_amdgcn_s_sleep(1);
        if ((++sp & 255u) == 0u) { if (xb_ld(&bar[XB_TMO])) break; if (sp > XB_SPIN_CAP) { atomicAdd(&bar[XB_TMO], 1u); break; } }
    }
    nloc = mine > 0u ? mine : 1u; nx = cnt > 0u ? cnt : 1u;
}
__device__ __forceinline__ void xcd_barrier(const XcdBarrier& b) {
    asm volatile("s_waitcnt vmcnt(0)" ::: "memory");
    __syncthreads();
    if (threadIdx.x == 0) {
        unsigned* bar = b.bar;
        __builtin_amdgcn_s_waitcnt(0);
        unsigned nloc = b.st[0], nx = b.st[1];
        if (nloc == 0u) { xcd_barrier_complete(bar, b.x, nloc, nx); b.st[0] = nloc; b.st[1] = nx; }
        const unsigned old = xb_add(&bar[XB_XSUB(b.x)], 1u);
        const unsigned gen = old / nloc;
        if (old + 1u == (gen + 1u) * nloc) {
            __builtin_amdgcn_fence(__ATOMIC_RELEASE, "agent");
            asm volatile("s_waitcnt vmcnt(0)" ::: "memory");
            const unsigned og = xb_add(&bar[XB_TOP], 1u);
            const unsigned tg = og / nx;
            if (og + 1u == (tg + 1u) * nx) xb_add(&bar[XB_TOPGEN], 1u);
            else XB_SPIN(xb_ld(&bar[XB_TOPGEN]) == tg, bar);
            __builtin_amdgcn_fence(__ATOMIC_ACQUIRE, "agent");
            xb_add(&bar[XB_XGEN(b.x)], 1u);
            asm volatile("s_waitcnt vmcnt(0)" ::: "memory");
        } else {
            XB_SPIN(xb_ld(&bar[XB_XGEN(b.x)]) == gen, bar);
            __builtin_amdgcn_fence(__ATOMIC_ACQUIRE, "agent");
            asm volatile("s_waitcnt vmcnt(0)" ::: "memory");
        }
    }
    __syncthreads();
}

struct Args {
    const float* in[27]; float* out; unsigned char* ws; int ph_lo, ph_hi;
};
struct Frame {
    LAS unsigned char* lds;
    int tid, lane, wave, vcu, bx;
};
__device__ __forceinline__ float lshfl(float v, int src) { return __builtin_bit_cast(float, __builtin_amdgcn_ds_bpermute(src << 2, __builtin_bit_cast(int, v))); }
#define SHFL_XOR(v, o) lshfl((v), F.lane ^ (o))
#define SHFL_UP(v, o) lshfl((v), F.lane - (o))
#define SHFL_IDX(v, i) lshfl((v), (i))
__device__ __forceinline__ float wave_sum_l(float v, int lane) {
#pragma unroll
    for (int o = 1; o < 64; o <<= 1) v += lshfl(v, lane ^ o);
    return v;
}
#define wave_sum(v) wave_sum_l((v), F.lane)
#define WG_BAR() __syncthreads()
__device__ __forceinline__ unsigned char* ld_ptr(LAS unsigned char* lds, int i) {
    const unsigned long long v = ((const LAS unsigned long long*)(lds + PTAB_OFF))[i];
    const unsigned lo = __builtin_amdgcn_readfirstlane((unsigned)v), hi = __builtin_amdgcn_readfirstlane((unsigned)(v >> 32));
    return (unsigned char*)(uintptr_t)(((unsigned long long)hi << 32) | lo);
}

constexpr int XP_SCR = 64 * 65 * 4;
__device__ __forceinline__ void xpose_item(const float* W, int ldsrc, int srccol4, int k0, bf16_t* WT, int K, int drow0, LAS float* scr, int lane, const float* gain) {
    f32x4 v[16];
    const int r = lane >> 4, c4 = 4 * (lane & 15);
#pragma unroll
    for (int i = 0; i < 16; ++i) v[i] = (srccol4 >= 0) ? *(const f32x4*)(W + (size_t)(k0 + 4 * i + r) * ldsrc + srccol4) : (f32x4){0.f, 0.f, 0.f, 0.f};
    if (gain) {
#pragma unroll
        for (int i = 0; i < 16; ++i) v[i] = v[i] * gain[k0 + 4 * i + r]; }
#pragma unroll
    for (int i = 0; i < 16; ++i) { LAS float* s = scr + (4 * i + r) * 65 + c4; s[0] = v[i].x; s[1] = v[i].y; s[2] = v[i].z; s[3] = v[i].w; }
    asm volatile("s_waitcnt lgkmcnt(0)" ::: "memory");
    const int c = lane & 7;
#pragma unroll
    for (int j = 0; j < 8; ++j) { const int n = (lane >> 3) + 8 * j; const LAS float* s = scr + (8 * c) * 65 + n;
        u32x4 o; o.x = pk2(s[0 * 65], s[1 * 65]); o.y = pk2(s[2 * 65], s[3 * 65]); o.z = pk2(s[4 * 65], s[5 * 65]); o.w = pk2(s[6 * 65], s[7 * 65]);
        *(u32x4*)(WT + (size_t)(drow0 + n) * K + k0 + 8 * c) = o; }
    asm volatile("s_waitcnt lgkmcnt(0)" ::: "memory");
}
__device__ __forceinline__ int win_srccol(int d) {
    if (d < 2048) return d;
    if (d < 3072) return 2056 + (d - 2048);
    if (d < 4608) return 3080 + (d - 3072);
    if (d < 6144) return 4632 + (d - 4608);
    if (d < 6152) return 2048 + (d - 6144);
    if (d < 6168) return 4616 + (d - 6152);
    return -1;
}
__device__ __forceinline__ void xpose_plain(Frame& F, const float* W, int K, int N, bf16_t* WT, LAS float* scr, int gw, int NGW, const float* gain) {
    const int nblk = N / 64, items = (K / 64) * nblk;
    for (int it = gw; it < items; it += NGW) { const int kb = it / nblk, nb = it % nblk; xpose_item(W, N, nb * 64 + 4 * (F.lane & 15), kb * 64, WT, K, nb * 64, scr, F.lane, gain); }
}
__device__ __forceinline__ void xpose_gu(Frame& F, const float* Wg, const float* Wu, int K, int N, bf16_t* WT, LAS float* scr, int gw, int NGW, const float* gain) {
    const int nblk = 2 * N / 64, items = (K / 64) * nblk;
    for (int it = gw; it < items; it += NGW) { const int kb = it / nblk, nb = it % nblk; const int drow0 = nb * 64, tile = drow0 >> 8, within = drow0 & 255;
        const float* W = within < 128 ? Wg : Wu; const int sc = tile * 128 + (within & 127) + 4 * (F.lane & 15);
        xpose_item(W, N, sc, kb * 64, WT, K, drow0, scr, F.lane, gain); }
}
__device__ __forceinline__ float load_row_ssq(Frame& F, const float* xrow, f32x4 (&v)[8]) {
    const f32x4* xr = (const f32x4*)xrow + F.lane; float s = 0.f;
#pragma unroll
    for (int j = 0; j < 8; ++j) { v[j] = xr[64 * j]; s += (v[j].x * v[j].x + v[j].y * v[j].y) + (v[j].z * v[j].z + v[j].w * v[j].w); }
    return wave_sum(s);
}
typedef short v4i16_t __attribute__((ext_vector_type(4)));
__device__ __forceinline__ f32x4 mfma16(bf16x8 a, bf16x8 b, f32x4 c) { return __builtin_amdgcn_mfma_f32_16x16x32_bf16(a, b, c, 0, 0, 0); }
__device__ __forceinline__ s16x4 tr_read(const LAS unsigned char* p) { return __builtin_bit_cast(s16x4, __builtin_amdgcn_ds_read_tr16_b64_v4i16((LAS v4i16_t*)p)); }
__device__ __forceinline__ bf16x8 cat4(s16x4 a, s16x4 b) { return (bf16x8){a[0], a[1], a[2], a[3], b[0], b[1], b[2], b[3]}; }
__device__ __forceinline__ bf16x8 pack8f(const float (&v)[8]) { u32x4 w; w.x = pk2(v[0], v[1]); w.y = pk2(v[2], v[3]); w.z = pk2(v[4], v[5]); w.w = pk2(v[6], v[7]); return __builtin_bit_cast(bf16x8, w); }
__device__ __forceinline__ float softplusf_(float x) { return x > 20.f ? x : __logf(1.0f + __expf(x)); }
__device__ __forceinline__ float logsigmoidf_(float x) { return fminf(x, 0.f) - __logf(1.0f + __expf(-fabsf(x))); }

constexpr int SLD = 272;

constexpr int NCV = 2560;
__device__ __forceinline__ void conv_phase(Frame& F, const bf16_t* __restrict__ U, bf16_t* __restrict__ CV, const float* __restrict__ mcw, const float* __restrict__ mcb, const float* __restrict__ scw, const float* __restrict__ scb) {
    const int gt = F.vcu * NTHR + F.tid;
    for (int it = gt; it < NB * 128 * 320; it += NWG * NTHR) {
        const int cg = it % 320, tb = (it / 320) & 127, b = it / (320 * 128);
        const int cvcol = 8 * cg; const bool isM = cg < 128;
        const int ucol = isM ? cvcol : UXBC + (cvcol - 1024), ch = isM ? cvcol : cvcol - 1024; const int nch = isM ? 1024 : 1536;
        const float* cwp = isM ? mcw : scw; const float* cbp = isM ? mcb : scb;
        float wt[4][8], bs[8];
#pragma unroll
        for (int j = 0; j < 4; ++j) { const f32x4 a = *(const f32x4*)(cwp + j * nch + ch), c2 = *(const f32x4*)(cwp + j * nch + ch + 4);
            wt[j][0] = a[0]; wt[j][1] = a[1]; wt[j][2] = a[2]; wt[j][3] = a[3]; wt[j][4] = c2[0]; wt[j][5] = c2[1]; wt[j][6] = c2[2]; wt[j][7] = c2[3]; }
        { const f32x4 a = *(const f32x4*)(cbp + ch), c2 = *(const f32x4*)(cbp + ch + 4); bs[0] = a[0]; bs[1] = a[1]; bs[2] = a[2]; bs[3] = a[3]; bs[4] = c2[0]; bs[5] = c2[1]; bs[6] = c2[2]; bs[7] = c2[3]; }
        const float sc = (isM && cg >= 64) ? 0.08838834764831845f : 1.0f;
        const int t0 = tb * 16; const bf16_t* up = U + ((size_t)b * SEQ + t0) * NU + ucol; bf16_t* op = CV + ((size_t)b * SEQ + t0) * NCV + cvcol;
        u32x4 r0 = (u32x4){0u, 0u, 0u, 0u}, r1 = r0, r2 = r0;
        if (t0 > 0) { r0 = *(const u32x4*)(up - 3 * (ptrdiff_t)NU); r1 = *(const u32x4*)(up - 2 * (ptrdiff_t)NU); r2 = *(const u32x4*)(up - (ptrdiff_t)NU); }
#pragma unroll 4
        for (int t = 0; t < 16; ++t) {
            const u32x4 r3 = *(const u32x4*)(up + (size_t)t * NU);
            float acc[8];
#pragma unroll
            for (int i = 0; i < 4; ++i) { const unsigned a0 = r0[i], a1 = r1[i], a2 = r2[i], a3 = r3[i];
                acc[2 * i] = bs[2 * i] + bflo(a0) * wt[0][2 * i] + bflo(a1) * wt[1][2 * i] + bflo(a2) * wt[2][2 * i] + bflo(a3) * wt[3][2 * i];
                acc[2 * i + 1] = bs[2 * i + 1] + bfhi(a0) * wt[0][2 * i + 1] + bfhi(a1) * wt[1][2 * i + 1] + bfhi(a2) * wt[2][2 * i + 1] + bfhi(a3) * wt[3][2 * i + 1]; }
#pragma unroll
            for (int i = 0; i < 8; ++i) acc[i] = siluf_(acc[i]) * sc;
            u32x4 o; o.x = pk2(acc[0], acc[1]); o.y = pk2(acc[2], acc[3]); o.z = pk2(acc[4], acc[5]); o.w = pk2(acc[6], acc[7]);
            *(u32x4*)(op + (size_t)t * NCV) = o;
            r0 = r1; r1 = r2; r2 = r3;
        }
    }
}

constexpr int XLD = 144;
constexpr int SS_CM = 0, SS_BM = 34816, SS_X = 69632, SS_HB = 88064, SS_F = 105472;
__device__ __forceinline__ void ssd_unit(Frame& F, int b, int hh, const bf16_t* __restrict__ U, const bf16_t* __restrict__ CV, bf16_t* __restrict__ MIX, float* __restrict__ SSQS,
                                         const float* __restrict__ dt_bias, const float* __restrict__ a_log, const float* __restrict__ d_skip) {
    LAS unsigned char* L = F.lds;
    const int tid = F.tid, lane = F.lane, w = F.wave, c16 = lane & 15, g4 = lane >> 4, grp = hh >> 3;
    WG_BAR();
    for (int i = tid; i < 64 * SLD / 4; i += NTHR) ((LAS unsigned*)(L + SS_HB))[i] = 0u;
    const float Aneg = -__expf(a_log[hh]), dtb = dt_bias[hh], Dsk = d_skip[hh];
    f32x4 hst[4];
#pragma unroll
    for (int i = 0; i < 4; ++i) hst[i] = (f32x4){0.f, 0.f, 0.f, 0.f};
    const bf16_t* cvb = CV + (size_t)b * SEQ * NCV + 1024;
    u32x4 pc[4], pb_[4], px[2]; unsigned graw0 = 0, graw1 = 0;
#define SSD_PREFETCH(cc) do { const size_t r0_ = (size_t)(cc) * 128; \
        _Pragma("unroll") for (int i = 0; i < 4; ++i) { const int q_ = tid + 512 * i; pc[i] = *(const u32x4*)(cvb + (r0_ + (q_ >> 4)) * NCV + 1280 + grp * 128 + 8 * (q_ & 15)); pb_[i] = *(const u32x4*)(cvb + (r0_ + (q_ >> 4)) * NCV + 1024 + grp * 128 + 8 * (q_ & 15)); } \
        _Pragma("unroll") for (int i = 0; i < 2; ++i) { const int q_ = tid + 512 * i; px[i] = *(const u32x4*)(cvb + (r0_ + (q_ >> 3)) * NCV + hh * 64 + 8 * (q_ & 7)); } \
        if (w == 0) { graw0 = U[((size_t)b * SEQ + r0_ + lane) * NU + UDT + hh]; graw1 = U[((size_t)b * SEQ + r0_ + 64 + lane) * NU + UDT + hh]; } } while (0)
#define SSD_GATES(buf) do { LAS float* fa_ = (LAS float*)(L + SS_F) + (buf) * 512; \
        const float dt0 = softplusf_(bf1((bf16_t)graw0) + dtb), dt1 = softplusf_(bf1((bf16_t)graw1) + dtb); float s0 = dt0 * Aneg, s1 = dt1 * Aneg; \
        _Pragma("unroll") for (int o = 1; o < 64; o <<= 1) { const float x0 = SHFL_UP(s0, o), x1 = SHFL_UP(s1, o); if (lane >= o) { s0 += x0; s1 += x1; } } \
        s1 += SHFL_IDX(s0, 63); const float tot = SHFL_IDX(s1, 63); \
        fa_[lane] = s0; fa_[64 + lane] = s1; fa_[128 + lane] = dt0; fa_[192 + lane] = dt1; fa_[256 + lane] = __expf(tot - s0) * dt0; fa_[320 + lane] = __expf(tot - s1) * dt1; fa_[384 + lane] = __expf(s0); fa_[448 + lane] = __expf(s1); } while (0)
    SSD_PREFETCH(0);
    if (w == 0) SSD_GATES(0);
    for (int c = 0; c < 16; ++c) {
        const size_t row0 = (size_t)b * SEQ + c * 128;
#pragma unroll
        for (int i = 0; i < 4; ++i) { const int q_ = tid + 512 * i; *(LAS u32x4*)(L + SS_CM + (q_ >> 4) * SLD + (q_ & 15) * 16) = pc[i]; *(LAS u32x4*)(L + SS_BM + (q_ >> 4) * SLD + (q_ & 15) * 16) = pb_[i]; }
#pragma unroll
        for (int i = 0; i < 2; ++i) { const int q_ = tid + 512 * i; *(LAS u32x4*)(L + SS_X + (q_ >> 3) * XLD + (q_ & 7) * 16) = px[i]; }
        WG_BAR();
        if (c + 1 < 16) SSD_PREFETCH(c + 1);
        {
            const LAS float* fa = (const LAS float*)(L + SS_F) + (c & 1) * 512; const LAS float* fdt = fa + 128; const LAS float* fwdt = fa + 256; const LAS float* feac = fa + 384;
            const int l = 16 * w + c16; const size_t row = row0 + l;
            u32x2 zr[4];
#pragma unroll
            for (int pb = 0; pb < 4; ++pb) zr[pb] = *(const u32x2*)(U + row * NU + UZ + hh * 64 + 16 * pb + 4 * g4);
            f32x4 accd[4], acco[4];
#pragma unroll
            for (int i = 0; i < 4; ++i) { accd[i] = (f32x4){0.f, 0.f, 0.f, 0.f}; acco[i] = (f32x4){0.f, 0.f, 0.f, 0.f}; }
            const float acl = fa[l]; const int q = c16 >> 2, pp = c16 & 3;
            for (int ks = 0; ks <= (w >> 1); ++ks) {
                float mv[8];
#pragma unroll
                for (int half = 0; half < 2; ++half) {
                    const int sb = 2 * ks + half;
                    if (sb <= w) {
                        f32x4 gt = (f32x4){0.f, 0.f, 0.f, 0.f};
#pragma unroll
                        for (int kn = 0; kn < 4; ++kn) { const bf16x8 a = *(const LAS bf16x8*)(L + SS_BM + (16 * sb + c16) * SLD + (32 * kn + 8 * g4) * 2);
                            const bf16x8 bb = *(const LAS bf16x8*)(L + SS_CM + (16 * w + c16) * SLD + (32 * kn + 8 * g4) * 2); gt = mfma16(a, bb, gt); }
#pragma unroll
                        for (int r = 0; r < 4; ++r) { const int s = 16 * sb + 4 * g4 + r; const float v = gt[r] * __expf(acl - fa[s]) * fdt[s]; mv[4 * half + r] = (s <= l) ? v : 0.f; }
                    } else {
#pragma unroll
                        for (int r = 0; r < 4; ++r) mv[4 * half + r] = 0.f;
                    }
                }
                const bf16x8 bfrag = pack8f(mv);
#pragma unroll
                for (int pb = 0; pb < 4; ++pb) { const s16x4 tA = tr_read(L + SS_X + (32 * ks + 4 * g4 + q) * XLD + (16 * pb + 4 * pp) * 2), tB = tr_read(L + SS_X + (32 * ks + 16 + 4 * g4 + q) * XLD + (16 * pb + 4 * pp) * 2);
                    accd[pb] = mfma16(cat4(tA, tB), bfrag, accd[pb]); }
            }
#pragma unroll
            for (int kn = 0; kn < 4; ++kn) { const bf16x8 bb = *(const LAS bf16x8*)(L + SS_CM + (16 * w + c16) * SLD + (32 * kn + 8 * g4) * 2);
#pragma unroll
                for (int pb = 0; pb < 4; ++pb) { const bf16x8 a = *(const LAS bf16x8*)(L + SS_HB + (16 * pb + c16) * SLD + (32 * kn + 8 * g4) * 2); acco[pb] = mfma16(a, bb, acco[pb]); } }
            const float el = feac[l]; float ssq = 0.f;
#pragma unroll
            for (int pb = 0; pb < 4; ++pb) { const int p0 = 16 * pb + 4 * g4;
                const float z[4] = {bflo(zr[pb].x), bfhi(zr[pb].x), bflo(zr[pb].y), bfhi(zr[pb].y)}; float o[4];
                const u32x2 xw = *(const LAS u32x2*)(L + SS_X + l * XLD + p0 * 2); const float xv[4] = {bflo(xw.x), bfhi(xw.x), bflo(xw.y), bfhi(xw.y)};
#pragma unroll
                for (int r = 0; r < 4; ++r) { const float y = accd[pb][r] + el * acco[pb][r] + Dsk * xv[r]; o[r] = y * siluf_(z[r]); ssq += o[r] * o[r]; }
                u32x2 ow; ow.x = pk2(o[0], o[1]); ow.y = pk2(o[2], o[3]); *(u32x2*)(MIX + row * 2048 + MIXS + hh * 64 + p0) = ow; }
            ssq += SHFL_XOR(ssq, 16); ssq += SHFL_XOR(ssq, 32);
            if (g4 == 0) SSQS[row * 16 + hh] = ssq;
            const float dec = feac[127];
#pragma unroll
            for (int pb = 0; pb < 4; ++pb) hst[pb] = hst[pb] * dec;
#pragma unroll
            for (int ks = 0; ks < 4; ++ks) {
                const s16x4 tA = tr_read(L + SS_BM + (32 * ks + 8 * g4 + q) * SLD + (16 * w + 4 * pp) * 2), tB = tr_read(L + SS_BM + (32 * ks + 8 * g4 + 4 + q) * SLD + (16 * w + 4 * pp) * 2);
                const bf16x8 bfrag = cat4(tA, tB);
                const f32x4 w0 = *(const LAS f32x4*)(fwdt + 32 * ks + 8 * g4), w1 = *(const LAS f32x4*)(fwdt + 32 * ks + 8 * g4 + 4);
#pragma unroll
                for (int pb = 0; pb < 4; ++pb) { const s16x4 xA = tr_read(L + SS_X + (32 * ks + 8 * g4 + q) * XLD + (16 * pb + 4 * pp) * 2), xB = tr_read(L + SS_X + (32 * ks + 8 * g4 + 4 + q) * XLD + (16 * pb + 4 * pp) * 2);
                    const float av[8] = {bf1((bf16_t)xA[0]) * w0[0], bf1((bf16_t)xA[1]) * w0[1], bf1((bf16_t)xA[2]) * w0[2], bf1((bf16_t)xA[3]) * w0[3], bf1((bf16_t)xB[0]) * w1[0], bf1((bf16_t)xB[1]) * w1[1], bf1((bf16_t)xB[2]) * w1[2], bf1((bf16_t)xB[3]) * w1[3]};
                    hst[pb] = mfma16(pack8f(av), bfrag, hst[pb]); }
            }
            if (w == 0 && c + 1 < 16) SSD_GATES((c + 1) & 1);
        }
        WG_BAR();
#pragma unroll
        for (int pb = 0; pb < 4; ++pb)
#pragma unroll
            for (int r = 0; r < 4; ++r) *(LAS bf16_t*)(L + SS_HB + (16 * pb + 4 * g4 + r) * SLD + (16 * w + c16) * 2) = f2bf(hst[pb][r]);
    }
#undef SSD_PREFETCH
#undef SSD_GATES
}

constexpr int VL2 = 80;
constexpr int ML_Q = 0, ML_K = 17408, ML_V = 34816, ML_CB = 39936, ML_F = 48640;
__device__ __forceinline__ void mlstm_unit(Frame& F, int b, int h, int vs, const bf16_t* __restrict__ U, const bf16_t* __restrict__ CV, bf16_t* __restrict__ MIX, float* __restrict__ SSQM, const float* __restrict__ gate_b) {
    LAS unsigned char* L = F.lds;
    const int tid = F.tid, lane = F.lane, w = F.wave, c16 = lane & 15, g4 = lane >> 4;
    LAS float* fbase = (LAS float*)(L + ML_F); LAS float* fnvec = fbase + 768;
    WG_BAR();
    for (int i = tid; i < 32 * SLD / 4; i += NTHR) ((LAS unsigned*)(L + ML_CB))[i] = 0u;
    if (tid < 128) fnvec[tid] = 0.f;
    const float bi = gate_b[h], bfg = gate_b[4 + h];
    float m_prev = 0.f, nreg = 0.f;
    f32x4 cst[2]; cst[0] = (f32x4){0.f, 0.f, 0.f, 0.f}; cst[1] = cst[0];
    const bf16_t* cvq = CV + (size_t)b * SEQ * NCV + h * 128; const bf16_t* uv = U + (size_t)b * SEQ * NU + UV + h * 128 + vs * 32;
    u32x4 pq[2], pkk[2], pvv; unsigned gri = 0, grf = 0;
#define ML_PREFETCH(cc) do { const size_t r0_ = (size_t)(cc) * 64; \
        _Pragma("unroll") for (int i = 0; i < 2; ++i) { const int q_ = tid + 512 * i; pq[i] = *(const u32x4*)(cvq + (r0_ + (q_ >> 4)) * NCV + 8 * (q_ & 15)); pkk[i] = *(const u32x4*)(cvq + (r0_ + (q_ >> 4)) * NCV + 512 + 8 * (q_ & 15)); } \
        if (tid < 256) pvv = *(const u32x4*)(uv + (r0_ + (tid >> 2)) * NU + 8 * (tid & 3)); \
        if (w == 0) { gri = U[((size_t)b * SEQ + r0_ + lane) * NU + UMI + h]; grf = U[((size_t)b * SEQ + r0_ + lane) * NU + UMF + h]; } } while (0)
#define ML_GATES(buf) do { LAS float* fg_ = fbase + (buf) * 384; \
        const float li = bf1((bf16_t)gri) + bi, lf = logsigmoidf_(bf1((bf16_t)grf) + bfg); float bc = lf; \
        _Pragma("unroll") for (int o = 1; o < 64; o <<= 1) { const float x = SHFL_UP(bc, o); if (lane >= o) bc += x; } \
        const float total = SHFL_IDX(bc, 63), ct = li - bc; float cm = ct; \
        _Pragma("unroll") for (int o = 1; o < 64; o <<= 1) { const float x = SHFL_UP(cm, o); if (lane >= o) cm = fmaxf(cm, x); } \
        const float mj = bc + fmaxf(m_prev, cm); \
        fg_[lane] = bc - mj; fg_[64 + lane] = ct; fg_[128 + lane] = __expf(bc + m_prev - mj); fg_[192 + lane] = __expf(-mj); \
        const float m_new = total + fmaxf(m_prev, SHFL_IDX(cm, 63)); \
        fg_[256 + lane] = __expf(total - m_new + ct); if (lane == 0) fg_[320] = __expf(total + m_prev - m_new); \
        m_prev = m_new; } while (0)
    ML_PREFETCH(0);
    if (w == 0) ML_GATES(0);
    for (int c = 0; c < 32; ++c) {
        const size_t row0 = (size_t)b * SEQ + c * 64;
#pragma unroll
        for (int i = 0; i < 2; ++i) { const int q_ = tid + 512 * i; *(LAS u32x4*)(L + ML_Q + (q_ >> 4) * SLD + (q_ & 15) * 16) = pq[i]; *(LAS u32x4*)(L + ML_K + (q_ >> 4) * SLD + (q_ & 15) * 16) = pkk[i]; }
        if (tid < 256) *(LAS u32x4*)(L + ML_V + (tid >> 2) * VL2 + (tid & 3) * 16) = pvv;
        WG_BAR();
        if (c + 1 < 32) ML_PREFETCH(c + 1);
        {
            const LAS float* frow = fbase + (c & 1) * 384; const LAS float* fcol = frow + 64; const LAS float* fsint = frow + 128; const LAS float* femj = frow + 192; const LAS float* favec = frow + 256;
            const int jb = w & 3, vb = w >> 2; const int j = 16 * jb + c16; const float rt = frow[j]; const int q = c16 >> 2, pp = c16 & 3;
            f32x4 accD = (f32x4){0.f, 0.f, 0.f, 0.f}, accI = accD; float dsum = 0.f;
            for (int ks = 0; ks <= (jb >> 1); ++ks) {
                float mv[8];
#pragma unroll
                for (int half = 0; half < 2; ++half) {
                    const int sb = 2 * ks + half;
                    if (sb <= jb) {
                        f32x4 st = (f32x4){0.f, 0.f, 0.f, 0.f};
#pragma unroll
                        for (int kk = 0; kk < 4; ++kk) { const bf16x8 a = *(const LAS bf16x8*)(L + ML_K + (16 * sb + c16) * SLD + (32 * kk + 8 * g4) * 2);
                            const bf16x8 bq = *(const LAS bf16x8*)(L + ML_Q + (16 * jb + c16) * SLD + (32 * kk + 8 * g4) * 2); st = mfma16(a, bq, st); }
#pragma unroll
                        for (int r = 0; r < 4; ++r) { const int s = 16 * sb + 4 * g4 + r; float v = st[r] * __expf(rt + fcol[s]); v = (s <= j) ? v : 0.f; mv[4 * half + r] = v; dsum += v; }
                    } else {
#pragma unroll
                        for (int r = 0; r < 4; ++r) mv[4 * half + r] = 0.f;
                    }
                }
                const bf16x8 bfrag = pack8f(mv);
                const s16x4 tA = tr_read(L + ML_V + (32 * ks + 4 * g4 + q) * VL2 + (16 * vb + 4 * pp) * 2), tB = tr_read(L + ML_V + (32 * ks + 16 + 4 * g4 + q) * VL2 + (16 * vb + 4 * pp) * 2);
                accD = mfma16(cat4(tA, tB), bfrag, accD);
            }
#pragma unroll
            for (int kk = 0; kk < 4; ++kk) { const bf16x8 a = *(const LAS bf16x8*)(L + ML_CB + (16 * vb + c16) * SLD + (32 * kk + 8 * g4) * 2);
                const bf16x8 bq = *(const LAS bf16x8*)(L + ML_Q + (16 * jb + c16) * SLD + (32 * kk + 8 * g4) * 2); accI = mfma16(a, bq, accI); }
            float nq = 0.f;
#pragma unroll
            for (int i = 0; i < 4; ++i) { const u32x4 qr = *(const LAS u32x4*)(L + ML_Q + (16 * jb + c16) * SLD + (32 * g4 + 8 * i) * 2);
                const f32x4 n0 = *(const LAS f32x4*)(fnvec + 32 * g4 + 8 * i), n1 = *(const LAS f32x4*)(fnvec + 32 * g4 + 8 * i + 4);
                nq += bflo(qr.x) * n0[0] + bfhi(qr.x) * n0[1] + bflo(qr.y) * n0[2] + bfhi(qr.y) * n0[3] + bflo(qr.z) * n1[0] + bfhi(qr.z) * n1[1] + bflo(qr.w) * n1[2] + bfhi(qr.w) * n1[3]; }
            nq += SHFL_XOR(nq, 16); nq += SHFL_XOR(nq, 32);
            dsum += SHFL_XOR(dsum, 16); dsum += SHFL_XOR(dsum, 32);
            const float si = fsint[j]; const float den = si * nq + dsum; const float inv = 1.0f / fmaxf(fabsf(den), femj[j]);
            const size_t row = row0 + j; float o[4], ssq = 0.f;
#pragma unroll
            for (int r = 0; r < 4; ++r) { o[r] = (si * accI[r] + accD[r]) * inv; ssq += o[r] * o[r]; }
            u32x2 ow; ow.x = pk2(o[0], o[1]); ow.y = pk2(o[2], o[3]); *(u32x2*)(MIX + row * 2048 + MIXM + h * 128 + vs * 32 + 16 * vb + 4 * g4) = ow;
            ssq += SHFL_XOR(ssq, 16); ssq += SHFL_XOR(ssq, 32);
            if (g4 == 0) SSQM[row * 32 + h * 8 + vs * 2 + vb] = ssq;
            const float dec = frow[320];
            cst[0] = cst[0] * dec; cst[1] = cst[1] * dec;
#pragma unroll
            for (int ks = 0; ks < 2; ++ks) {
                const s16x4 tA = tr_read(L + ML_K + (32 * ks + 8 * g4 + q) * SLD + (16 * w + 4 * pp) * 2), tB = tr_read(L + ML_K + (32 * ks + 8 * g4 + 4 + q) * SLD + (16 * w + 4 * pp) * 2);
                const bf16x8 bfrag = cat4(tA, tB);
                const f32x4 w0 = *(const LAS f32x4*)(favec + 32 * ks + 8 * g4), w1 = *(const LAS f32x4*)(favec + 32 * ks + 8 * g4 + 4);
#pragma unroll
                for (int vb2 = 0; vb2 < 2; ++vb2) { const s16x4 xA = tr_read(L + ML_V + (32 * ks + 8 * g4 + q) * VL2 + (16 * vb2 + 4 * pp) * 2), xB = tr_read(L + ML_V + (32 * ks + 8 * g4 + 4 + q) * VL2 + (16 * vb2 + 4 * pp) * 2);
                    const float av[8] = {bf1((bf16_t)xA[0]) * w0[0], bf1((bf16_t)xA[1]) * w0[1], bf1((bf16_t)xA[2]) * w0[2], bf1((bf16_t)xA[3]) * w0[3], bf1((bf16_t)xB[0]) * w1[0], bf1((bf16_t)xB[1]) * w1[1], bf1((bf16_t)xB[2]) * w1[2], bf1((bf16_t)xB[3]) * w1[3]};
                    cst[vb2] = mfma16(pack8f(av), bfrag, cst[vb2]); }
            }
            if (tid < 128) { float s = 0.f;
#pragma unroll 8
                for (int sI = 0; sI < 64; ++sI) s += favec[sI] * bf1(*(const LAS bf16_t*)(L + ML_K + sI * SLD + 2 * tid));
                nreg = dec * nreg + s; }
            if (w == 0 && c + 1 < 32) ML_GATES((c + 1) & 1);
        }
        WG_BAR();
#pragma unroll
        for (int vb2 = 0; vb2 < 2; ++vb2)
#pragma unroll
            for (int r = 0; r < 4; ++r) *(LAS bf16_t*)(L + ML_CB + (16 * vb2 + 4 * g4 + r) * SLD + (16 * w + c16) * 2) = f2bf(cst[vb2][r]);
        if (tid < 128) fnvec[tid] = nreg;
    }
#undef ML_PREFETCH
#undef ML_GATES
}

constexpr int MB_K0 = 0, MB_V0 = 17408, MB_K1 = 34816, MB_V1 = 52224, MB_KM = 69632, MB_SEL = 73216;
__device__ __forceinline__ void moba_unit(Frame& F, int b, int h, int qb, const bf16_t* __restrict__ U, bf16_t* __restrict__ MIX, const float* __restrict__ KMEAN) {
    LAS unsigned char* L = F.lds;
    const int tid = F.tid, lane = F.lane, w = F.wave, c16 = lane & 15, g4 = lane >> 4;
    LAS float* km = (LAS float*)(L + MB_KM); LAS int* sel = (LAS int*)(L + MB_SEL);
    const size_t row0 = (size_t)b * SEQ + 256 * qb;
    WG_BAR();
    for (int i = tid; i < qb * 128; i += NTHR) km[i] = KMEAN[((size_t)(b * 4 + h) * 8) * 128 + i];
    WG_BAR();
    if (tid < 256) {
        int mask = (1 << qb) - 1;
        if (qb > 3) {
            float sc[7];
#pragma unroll
            for (int j = 0; j < 7; ++j) sc[j] = 0.f;
            const bf16_t* qp = U + (row0 + tid) * NU + UAQ + h * 128;
            for (int d8 = 0; d8 < 16; ++d8) { const u32x4 qr = *(const u32x4*)(qp + 8 * d8); const float qv[8] = {bflo(qr.x), bfhi(qr.x), bflo(qr.y), bfhi(qr.y), bflo(qr.z), bfhi(qr.z), bflo(qr.w), bfhi(qr.w)};
#pragma unroll
                for (int j = 0; j < 7; ++j) if (j < qb) { const f32x4 k0 = *(const LAS f32x4*)(km + j * 128 + 8 * d8), k1 = *(const LAS f32x4*)(km + j * 128 + 8 * d8 + 4);
                    sc[j] += qv[0] * k0[0] + qv[1] * k0[1] + qv[2] * k0[2] + qv[3] * k0[3] + qv[4] * k1[0] + qv[5] * k1[1] + qv[6] * k1[2] + qv[7] * k1[3]; } }
            mask = 0;
#pragma unroll
            for (int it = 0; it < 3; ++it) { float best = -__builtin_inff(); int bi = 0;
#pragma unroll
                for (int j = 0; j < 7; ++j) if (j < qb && !((mask >> j) & 1) && sc[j] > best) { best = sc[j]; bi = j; }
                mask |= 1 << bi; }
        }
        sel[tid] = mask;
    }
    WG_BAR();
    bf16x8 Qf[2][4]; int msk[2]; float mrun[2], lsum[2]; f32x4 O[2][8];
#pragma unroll
    for (int qq = 0; qq < 2; ++qq) { const bf16_t* qp = U + (row0 + 32 * w + 16 * qq + c16) * NU + UAQ + h * 128 + 8 * g4;
#pragma unroll
        for (int ds = 0; ds < 4; ++ds) Qf[qq][ds] = *(const bf16x8*)(qp + 32 * ds);
        msk[qq] = sel[32 * w + 16 * qq + c16]; mrun[qq] = -1e30f; lsum[qq] = 0.f;
#pragma unroll
        for (int db = 0; db < 8; ++db) O[qq][db] = (f32x4){0.f, 0.f, 0.f, 0.f}; }
    const int ntiles = 4 * (qb + 1);
    const float SC = 0.08838834764831845f * 1.4426950408889634f;
    const int kr = tid >> 3, ch = tid & 7;
    u32x4 pk[2], pv[2];
    { const bf16_t* kp = U + ((size_t)b * SEQ + kr) * NU + UAK + h * 128; const bf16_t* vp = U + ((size_t)b * SEQ + kr) * NU + UAV + h * 128;
      pk[0] = *(const u32x4*)(kp + 8 * ch); pk[1] = *(const u32x4*)(kp + 8 * (ch + 8)); pv[0] = *(const u32x4*)(vp + 8 * ch); pv[1] = *(const u32x4*)(vp + 8 * (ch + 8)); }
    for (int tt = 0; tt < ntiles; ++tt) {
        const int kofs = (tt & 1) ? MB_K1 : MB_K0, vofs = (tt & 1) ? MB_V1 : MB_V0;
        *(LAS u32x4*)(L + kofs + kr * SLD + ch * 16) = pk[0]; *(LAS u32x4*)(L + kofs + kr * SLD + (ch + 8) * 16) = pk[1];
        *(LAS u32x4*)(L + vofs + kr * SLD + ch * 16) = pv[0]; *(LAS u32x4*)(L + vofs + kr * SLD + (ch + 8) * 16) = pv[1];
        WG_BAR();
        if (tt + 1 < ntiles) { const bf16_t* kp = U + ((size_t)b * SEQ + 64 * (tt + 1) + kr) * NU + UAK + h * 128; const bf16_t* vp = U + ((size_t)b * SEQ + 64 * (tt + 1) + kr) * NU + UAV + h * 128;
            pk[0] = *(const u32x4*)(kp + 8 * ch); pk[1] = *(const u32x4*)(kp + 8 * (ch + 8)); pv[0] = *(const u32x4*)(vp + 8 * ch); pv[1] = *(const u32x4*)(vp + 8 * (ch + 8)); }
        const int jblk = tt >> 2; const bool own = (jblk == qb);
        f32x4 st[4][2];
#pragma unroll
        for (int kb = 0; kb < 4; ++kb) { st[kb][0] = (f32x4){0.f, 0.f, 0.f, 0.f}; st[kb][1] = st[kb][0];
#pragma unroll
            for (int ds = 0; ds < 4; ++ds) { const bf16x8 a = *(const LAS bf16x8*)(L + kofs + (16 * kb + c16) * SLD + (32 * ds + 8 * g4) * 2);
                st[kb][0] = mfma16(a, Qf[0][ds], st[kb][0]); st[kb][1] = mfma16(a, Qf[1][ds], st[kb][1]); } }
        bf16x8 pf[2][2];
#pragma unroll
        for (int qq = 0; qq < 2; ++qq) {
            const float NEG = -__builtin_inff();
            if (own) { const int qi = 32 * w + 16 * qq + c16, kbase = 64 * (tt & 3) + 4 * g4;
#pragma unroll
                for (int kb = 0; kb < 4; ++kb)
#pragma unroll
                    for (int r = 0; r < 4; ++r) if (kbase + 16 * kb + r > qi) st[kb][qq][r] = NEG;
            } else if (!((msk[qq] >> jblk) & 1)) {
#pragma unroll
                for (int kb = 0; kb < 4; ++kb) st[kb][qq] = (f32x4){NEG, NEG, NEG, NEG};
            }
            float rm = st[0][qq][0];
#pragma unroll
            for (int kb = 0; kb < 4; ++kb)
#pragma unroll
                for (int r = 0; r < 4; ++r) rm = fmaxf(rm, st[kb][qq][r]);
            rm = fmaxf(rm, SHFL_XOR(rm, 16)); rm = fmaxf(rm, SHFL_XOR(rm, 32));
            const float mn = fmaxf(mrun[qq], rm), alpha = __builtin_amdgcn_exp2f((mrun[qq] - mn) * SC); mrun[qq] = mn;
            float ps = 0.f; float pvv[4][4];
#pragma unroll
            for (int kb = 0; kb < 4; ++kb)
#pragma unroll
                for (int r = 0; r < 4; ++r) { const float pe = __builtin_amdgcn_exp2f((st[kb][qq][r] - mn) * SC); pvv[kb][r] = pe; ps += pe; }
            lsum[qq] = lsum[qq] * alpha + ps;
#pragma unroll
            for (int db = 0; db < 8; ++db) O[qq][db] = O[qq][db] * alpha;
#pragma unroll
            for (int ks = 0; ks < 2; ++ks) { const float v8[8] = {pvv[2 * ks][0], pvv[2 * ks][1], pvv[2 * ks][2], pvv[2 * ks][3], pvv[2 * ks + 1][0], pvv[2 * ks + 1][1], pvv[2 * ks + 1][2], pvv[2 * ks + 1][3]}; pf[qq][ks] = pack8f(v8); }
        }
        const int q = c16 >> 2, p = c16 & 3;
#pragma unroll
        for (int ks = 0; ks < 2; ++ks)
#pragma unroll
            for (int db = 0; db < 8; ++db) {
                const s16x4 tA = tr_read(L + vofs + (32 * ks + 4 * g4 + q) * SLD + (16 * db + 4 * p) * 2), tB = tr_read(L + vofs + (32 * ks + 16 + 4 * g4 + q) * SLD + (16 * db + 4 * p) * 2);
                const bf16x8 a = cat4(tA, tB);
                O[0][db] = mfma16(a, pf[0][ks], O[0][db]); O[1][db] = mfma16(a, pf[1][ks], O[1][db]);
            }
    }
#pragma unroll
    for (int qq = 0; qq < 2; ++qq) { float ls = lsum[qq]; ls += SHFL_XOR(ls, 16); ls += SHFL_XOR(ls, 32); const float inv = 1.0f / ls;
        bf16_t* op = MIX + (row0 + 32 * w + 16 * qq + c16) * 2048 + MIXA + h * 128 + 4 * g4;
#pragma unroll
        for (int db = 0; db < 8; ++db) { u32x2 ow; ow.x = pk2(O[qq][db][0] * inv, O[qq][db][1] * inv); ow.y = pk2(O[qq][db][2] * inv, O[qq][db][3] * inv); *(u32x2*)(op + 16 * db) = ow; } }
}
__device__ __forceinline__ void kmean_items(Frame& F, const bf16_t* __restrict__ U, float* __restrict__ KMEAN) {
    const int gw = F.vcu * NWAVES + F.wave, NGW = NWG * NWAVES;
    for (int it = gw; it < NB * 4 * 8; it += NGW) {
        const int blk = it & 7, h = (it >> 3) & 3, b = it >> 5;
        const bf16_t* kp = U + ((size_t)b * SEQ + 256 * blk) * NU + UAK + h * 128 + 2 * F.lane;
        float s0 = 0.f, s1 = 0.f;
#pragma unroll 8
        for (int r = 0; r < 256; ++r) { const unsigned wv = *(const unsigned*)(kp + (size_t)r * NU); s0 += bflo(wv); s1 += bfhi(wv); }
        f32x2 o = {s0 * (1.f / 256.f), s1 * (1.f / 256.f)};
        *(f32x2*)(KMEAN + (size_t)it * 128 + 2 * F.lane) = o;
    }
}
__device__ __forceinline__ void mixnorm_rows(Frame& F, const bf16_t* __restrict__ U, bf16_t* __restrict__ MIX, const float* __restrict__ SSQM, const float* __restrict__ SSQS,
                                             const float* __restrict__ m_norm_g, const float* __restrict__ s_norm_g) {
    const int gw = F.vcu * NWAVES + F.wave, NGW = NWG * NWAVES, lane = F.lane;
    for (int row = gw; row < T; row += NGW) {
        {
            const int col0 = 8 * lane, hm = col0 >> 7;
            const f32x4 q0 = *(const f32x4*)(SSQM + (size_t)row * 32 + hm * 8), q1 = *(const f32x4*)(SSQM + (size_t)row * 32 + hm * 8 + 4);
            const float ssq = (q0[0] + q0[1]) + (q0[2] + q0[3]) + (q1[0] + q1[1]) + (q1[2] + q1[3]);
            const float r = 1.0f / sqrtf(ssq * (1.f / 128.f) + EPS);
            bf16_t* mp = MIX + (size_t)row * 2048 + MIXM + col0;
            const u32x4 hv = *(const u32x4*)mp, ov = *(const u32x4*)(U + (size_t)row * NU + UO + col0);
            const f32x4 g0 = *(const f32x4*)(m_norm_g + col0), g1 = *(const f32x4*)(m_norm_g + col0 + 4);
            u32x4 o;
            o.x = pk2(bflo(hv.x) * r * g0[0] * sigmoidf_(bflo(ov.x)), bfhi(hv.x) * r * g0[1] * sigmoidf_(bfhi(ov.x)));
            o.y = pk2(bflo(hv.y) * r * g0[2] * sigmoidf_(bflo(ov.y)), bfhi(hv.y) * r * g0[3] * sigmoidf_(bfhi(ov.y)));
            o.z = pk2(bflo(hv.z) * r * g1[0] * sigmoidf_(bflo(ov.z)), bfhi(hv.z) * r * g1[1] * sigmoidf_(bfhi(ov.z)));
            o.w = pk2(bflo(hv.w) * r * g1[2] * sigmoidf_(bflo(ov.w)), bfhi(hv.w) * r * g1[3] * sigmoidf_(bfhi(ov.w)));
            *(u32x4*)mp = o;
        }
#pragma unroll
        for (int i = 0; i < 2; ++i) {
            const int col0 = 512 * i + 8 * lane;
            const f32x4 q0 = *(const f32x4*)(SSQS + (size_t)row * 16 + 8 * i), q1 = *(const f32x4*)(SSQS + (size_t)row * 16 + 8 * i + 4);
            const float ssq = (q0[0] + q0[1]) + (q0[2] + q0[3]) + (q1[0] + q1[1]) + (q1[2] + q1[3]);
            const float r = 1.0f / sqrtf(ssq * (1.f / 512.f) + EPS);
            bf16_t* mp = MIX + (size_t)row * 2048 + MIXS + col0;
            const u32x4 hv = *(const u32x4*)mp;
            const f32x4 g0 = *(const f32x4*)(s_norm_g + col0), g1 = *(const f32x4*)(s_norm_g + col0 + 4);
            u32x4 o;
            o.x = pk2(bflo(hv.x) * r * g0[0], bfhi(hv.x) * r * g0[1]); o.y = pk2(bflo(hv.y) * r * g0[2], bfhi(hv.y) * r * g0[3]);
            o.z = pk2(bflo(hv.z) * r * g1[0], bfhi(hv.z) * r * g1[1]); o.w = pk2(bflo(hv.w) * r * g1[2], bfhi(hv.w) * r * g1[3]);
            *(u32x4*)mp = o;
        }
    }
}
constexpr int LT_TAB = 0, LT_CUMT = 320, LT_LCNT = 340, LT_BASE = 356, LT_TOT = 372, LT_GOFF = 388, LT_PART = 416, LT_PRE = 928;
__device__ __forceinline__ void moe_route(Frame& F, const float* X, const float* g, const float* Wr, int* ROUTE, int* WGCNT, int* TOK) {
    LAS unsigned char* L = F.lds; LAS int* lt = (LAS int*)(L + LTAB_OFF); const int lane = F.lane;
    WG_BAR();
    for (int i = F.tid; i < D * NEXP / 4; i += NTHR) { const float gk = g[i >> 1]; ((LAS f32x4*)L)[i] = ((const f32x4*)Wr)[i] * gk; }
    if (F.tid < 16) lt[LT_LCNT + F.tid] = 0;
    for (int i = F.bx * NTHR + F.tid; i < MOE_ROWS; i += NWG * NTHR) TOK[i] = -1;
    WG_BAR();
    f32x4 v[8];
    for (int i = 0; i < 16; ++i) {
        const int row = 128 * F.bx + 16 * F.wave + i;
        const float rstd = 1.0f / sqrtf(load_row_ssq(F, X + (size_t)row * D, v) * (1.f / D) + EPS);
        float lg[8];
#pragma unroll
        for (int e = 0; e < 8; ++e) lg[e] = 0.f;
#pragma unroll
        for (int j = 0; j < 8; ++j)
#pragma unroll
            for (int cc = 0; cc < 4; ++cc) { const int k = 4 * (lane + 64 * j) + cc; const f32x4 w0 = *(const LAS f32x4*)(L + (size_t)k * 32), w1 = *(const LAS f32x4*)(L + (size_t)k * 32 + 16); const float xv = v[j][cc];
                lg[0] += xv * w0[0]; lg[1] += xv * w0[1]; lg[2] += xv * w0[2]; lg[3] += xv * w0[3]; lg[4] += xv * w1[0]; lg[5] += xv * w1[1]; lg[6] += xv * w1[2]; lg[7] += xv * w1[3]; }
#pragma unroll
        for (int e = 0; e < 8; ++e) lg[e] = wave_sum(lg[e]) * rstd;
        if (lane == 0) {
            int e0 = 0; float b0 = lg[0];
#pragma unroll
            for (int e = 1; e < 8; ++e) if (lg[e] > b0) { b0 = lg[e]; e0 = e; }
            int e1 = -1; float b1 = -__builtin_inff();
#pragma unroll
            for (int e = 0; e < 8; ++e) if (e != e0 && lg[e] > b1) { b1 = lg[e]; e1 = e; }
            if (e1 < 0) e1 = (e0 == 0) ? 1 : 0;
            const float w1 = 1.0f / (1.0f + __expf(b0 - b1)), w0 = 1.0f - w1;
            const int r0 = __hip_atomic_fetch_add(lt + LT_LCNT + e0, 1, __ATOMIC_RELAXED, __HIP_MEMORY_SCOPE_WORKGROUP), r1 = __hip_atomic_fetch_add(lt + LT_LCNT + 8 + e1, 1, __ATOMIC_RELAXED, __HIP_MEMORY_SCOPE_WORKGROUP);
            ROUTE[row] = e0 | (e1 << 8); ROUTE[T + row] = r0; ROUTE[2 * T + row] = r1; ((float*)ROUTE)[3 * T + row] = w0; ((float*)ROUTE)[4 * T + row] = w1; ((float*)ROUTE)[5 * T + row] = rstd;
        }
    }
    WG_BAR();
    if (F.tid < 16) WGCNT[F.bx * 16 + F.tid] = lt[LT_LCNT + F.tid];
}
__device__ __forceinline__ void moe_tables(Frame& F, const int* WGCNT) {
    LAS unsigned char* L = F.lds; LAS int* lt = (LAS int*)(L + LTAB_OFF); const int tid = F.tid, c = F.bx;
    WG_BAR();
    { const int g = tid & 15, chn = tid >> 4; int s = 0;
#pragma unroll
      for (int i = 0; i < 8; ++i) s += WGCNT[(8 * chn + i) * 16 + g];
      lt[LT_PART + chn * 16 + g] = s; }
    WG_BAR();
    if (tid < 16) { int run = 0; for (int chn = 0; chn < 32; ++chn) { lt[LT_PRE + chn * 16 + tid] = run; run += lt[LT_PART + chn * 16 + tid]; } lt[LT_TOT + tid] = run; }
    WG_BAR();
    if (tid == 0) { int off = 0;
        for (int g = 0; g < 16; ++g) { const int nt = (lt[LT_TOT + g] + 255) >> 8; lt[LT_CUMT + g] = off >> 8; lt[LT_GOFF + g] = off; for (int t = 0; t < nt; ++t) lt[LT_TAB + (off >> 8) + t] = g & 7; off += nt << 8; }
        lt[LT_CUMT + 16] = off >> 8; }
    WG_BAR();
    if (tid < 16) { int bs = lt[LT_GOFF + tid] + lt[LT_PRE + (c >> 3) * 16 + tid]; for (int w2 = 8 * (c >> 3); w2 < c; ++w2) bs += WGCNT[w2 * 16 + tid]; lt[LT_BASE + tid] = bs; }
    WG_BAR();
}
__device__ __forceinline__ void moe_gather(Frame& F, const bf16_t* XN, const int* ROUTE, const int* WGCNT, bf16_t* XG, int* TOK, float* WGT, float* RS) {
    LAS unsigned char* L = F.lds; LAS int* lt = (LAS int*)(L + LTAB_OFF); const int lane = F.lane, c = F.bx;
    moe_tables(F, WGCNT);
    for (int i = 0; i < 16; ++i) {
        const int row = 128 * c + 16 * F.wave + i;
        const int ee = ROUTE[row], e0 = ee & 255, e1 = ee >> 8;
        const int pos0 = lt[LT_BASE + e0] + ROUTE[T + row], pos1 = lt[LT_BASE + 8 + e1] + ROUTE[2 * T + row];
        const u32x4* src = (const u32x4*)(XN + (size_t)row * D) + lane; u32x4* d0 = (u32x4*)(XG + (size_t)pos0 * D) + lane; u32x4* d1 = (u32x4*)(XG + (size_t)pos1 * D) + lane;
#pragma unroll
        for (int j = 0; j < 4; ++j) { const u32x4 x = src[64 * j]; d0[64 * j] = x; d1[64 * j] = x; }
        if (lane == 0) { TOK[pos0] = row; TOK[pos1] = row; WGT[pos0] = ((const float*)ROUTE)[3 * T + row]; WGT[pos1] = ((const float*)ROUTE)[4 * T + row]; const float rs = ((const float*)ROUTE)[5 * T + row]; RS[pos0] = rs; RS[pos1] = rs; }
    }
}

#ifndef RES_ALIGN
#define RES_ALIGN false
#endif
enum { I_X = 0, I_P, I_LNMIX, I_WIN, I_WOUT, I_MCW, I_MCB, I_MGB, I_MNG, I_SCW, I_SCB, I_SDTB, I_SALOG, I_SD, I_SNG, I_LNFFN, I_FWG, I_FWU, I_FWD, I_ROUTER, I_MWG, I_MWU, I_MWD, I_LNPLE, I_PPROJ, I_PGATE, I_LNFINAL };

__global__ void __launch_bounds__(NTHR, 2) hybrid_fwd(Args args) {
    extern __shared__ __attribute__((aligned(16))) unsigned char lds_raw[];
    Frame F;
    F.lds = (LAS unsigned char*)lds_raw;
    F.tid = threadIdx.x; F.lane = F.tid & 63; F.wave = __builtin_amdgcn_readfirstlane(F.tid >> 6);
    F.bx = blockIdx.x; F.vcu = (F.bx % 8) * (NWG / 8) + F.bx / 8;
    volatile LAS unsigned* MISC = (volatile LAS unsigned*)(F.lds + MISC_OFF);
    for (int u = F.tid; u < 64; u += NTHR) MISC[u] = 0u;
    __syncthreads();
    unsigned* ctl = (unsigned*)(args.ws + WS_CTL);
    XcdBarrier bar = xcd_barrier_post(ctl + CW_BAR, MISC + 8);
    const int lo = args.ph_lo, hi = args.ph_hi; int ph = 0;
#define PHASE_BEGIN if (ph >= lo && ph < hi) { { int t_ = threadIdx.x; asm volatile("" : "+v"(t_)); F.tid = t_; F.lane = t_ & 63; F.wave = __builtin_amdgcn_readfirstlane(t_ >> 6); LAS unsigned char* b_ = (LAS unsigned char*)lds_raw; asm volatile("" : "+s"(b_)); F.lds = b_; int x_ = blockIdx.x; asm volatile("" : "+s"(x_)); F.bx = x_; F.vcu = (x_ % 8) * (NWG / 8) + x_ / 8; }
#define PHASE_END(last) if (!(last) && ph + 1 < hi) xcd_barrier(bar); } ++ph;

    if (F.tid == 0) { LAS unsigned long long* pt = (LAS unsigned long long*)(F.lds + PTAB_OFF);
#pragma unroll
        for (int i = 0; i < 27; ++i) pt[i] = (unsigned long long)(uintptr_t)args.in[i];
        pt[27] = (unsigned long long)(uintptr_t)args.out; pt[28] = (unsigned long long)(uintptr_t)args.ws; }
    __syncthreads();
#define PTR_(i) ld_ptr(F.lds, (i))
#define IN_(i) ((const float*)PTR_(i))
#define X_ ((float*)PTR_(27))
#define WSB_(off) (PTR_(28) + (off))
#define WIN ((bf16_t*)WSB_(WS_WIN))
#define WOUT ((bf16_t*)WSB_(WS_WOUT))
#define FGU ((bf16_t*)WSB_(WS_FGU))
#define FD ((bf16_t*)WSB_(WS_FD))
#define MGU ((bf16_t*)WSB_(WS_MGU))
#define MD ((bf16_t*)WSB_(WS_MD))
#define PG ((bf16_t*)WSB_(WS_PG))
#define PP ((bf16_t*)WSB_(WS_PP))
#define XN ((bf16_t*)WSB_(WS_XN))
#define P16 ((bf16_t*)WSB_(WS_P16))
#define U ((bf16_t*)WSB_(WS_U))
#define MIX ((bf16_t*)WSB_(WS_MIX))
#define CVB ((bf16_t*)WSB_(WS_CV))
#define H ((bf16_t*)WSB_(WS_H))
#define XBB ((bf16_t*)WSB_(WS_XBB))
#define SSQ_(i) ((pg8::ssq_t*)WSB_(WS_SSQ) + (size_t)(i) * T)
#define RS ((float*)WSB_(WS_WGT + 512 * 1024))
#define XG ((bf16_t*)WSB_(WS_XG))
#define HM ((bf16_t*)WSB_(WS_HM))
#define SSQM ((float*)WSB_(WS_SSQM))
#define SSQS ((float*)WSB_(WS_SSQS))
#define KMEAN ((float*)WSB_(WS_KMEAN))
#define ROUTE ((int*)WSB_(WS_ROUTE))
#define TOK ((int*)WSB_(WS_TOK))
#define WGT ((float*)WSB_(WS_WGT))
#define WGCNT ((int*)WSB_(WS_WGCNT))
    PHASE_BEGIN
#ifdef PROBE_P02
    for (int rp_ = 0; rp_ < 2; ++rp_)
#endif
    {
        LAS float* scr = (LAS float*)(F.lds + RING_OFF + F.wave * XP_SCR); const int gw = F.vcu * NWAVES + F.wave, NGW = NWG * NWAVES;
        for (int l = 0; l < DEPTH; ++l) {
            {
                const float* W = IN_(I_WIN) + (size_t)l * D * DPROJ_SRC; bf16_t* WT = WIN + (size_t)l * NU * D;
                const int nblk = NU / 64, items = (D / 64) * nblk;
                for (int it = gw; it < items; it += NGW) { const int kb = it / nblk, nb = it % nblk; xpose_item(W, DPROJ_SRC, win_srccol(nb * 64 + 4 * (F.lane & 15)), kb * 64, WT, D, nb * 64, scr, F.lane, IN_(I_LNMIX) + (size_t)l * D); }
            }
            xpose_plain(F, IN_(I_WOUT) + (size_t)l * D * D, D, D, WOUT + (size_t)l * D * D, scr, gw, NGW, nullptr);
            xpose_plain(F, IN_(I_PGATE) + (size_t)l * D * D, D, D, PG + (size_t)l * D * D, scr, gw, NGW, IN_(I_LNPLE) + (size_t)l * D);
            xpose_plain(F, IN_(I_PPROJ) + (size_t)l * PLE * D, PLE, D, PP + (size_t)l * D * PLE, scr, gw, NGW, nullptr);
        }
        xpose_gu(F, IN_(I_FWG), IN_(I_FWU), D, DFF, FGU, scr, gw, NGW, IN_(I_LNFFN));
        xpose_plain(F, IN_(I_FWD), DFF, D, FD, scr, gw, NGW, nullptr);
        for (int e = 0; e < NEXP; ++e) {
            xpose_gu(F, IN_(I_MWG) + (size_t)e * D * DFFE, IN_(I_MWU) + (size_t)e * D * DFFE, D, DFFE, MGU + (size_t)e * 2 * DFFE * D, scr, gw, NGW, IN_(I_LNFFN) + D);
            xpose_plain(F, IN_(I_MWD) + (size_t)e * DFFE * D, DFFE, D, MD + (size_t)e * D * DFFE, scr, gw, NGW, nullptr);
        }
        {
            const f32x4* ps = (const f32x4*)IN_(I_P); u32x2* pd = (u32x2*)P16; const size_t n4 = (size_t)DEPTH * T * PLE / 4;
            for (size_t i = (size_t)F.bx * NTHR + F.tid; i < n4; i += (size_t)NWG * NTHR) { const f32x4 v = ps[i]; u32x2 o; o.x = pk2(v.x, v.y); o.y = pk2(v.z, v.w); pd[i] = o; }
        }
        {
            const float* xs = IN_(I_X); float* X = X_; bf16_t* xb = XBB; pg8::ssq_t* sq = SSQ_(0); f32x4 v[8];
            for (int m = gw; m < T; m += NGW) { const float s = load_row_ssq(F, xs + (size_t)m * D, v);
#pragma unroll
                for (int j = 0; j < 8; ++j) { ((f32x4*)(X + (size_t)m * D) + F.lane)[64 * j] = v[j]; u32x2 w; w.x = pk2(v[j].x, v[j].y); w.y = pk2(v[j].z, v[j].w); ((u32x2*)(xb + (size_t)m * D) + F.lane)[64 * j] = w; }
                if (F.lane == 0) sq[m] = (pg8::ssq_t)(s * pg8::SSQ_SCALE + 0.5f); }
        }
    }
    PHASE_END(false)

    for (int l = 0; l < DEPTH; ++l) {
        PHASE_BEGIN
        { pg8::Gemm g{XBB, WIN + (size_t)l * NU * D, D, D, D, 0}; pg8::StaticOrder S; S.init(T, NU, NWG, F.bx); pg8::EpiBf16 E{U, NU, SSQ_(3 * l)};
          pg8::gemm_phase<pg8::EpiBf16, pg8::StaticOrder, true>(F.lds + RING_OFF, g, S, E); }
        PHASE_END(false)
        PHASE_BEGIN
        {
            conv_phase(F, U, CVB, IN_(I_MCW) + (size_t)l * 4 * 1024, IN_(I_MCB) + (size_t)l * 1024, IN_(I_SCW) + (size_t)l * 4 * 1536, IN_(I_SCB) + (size_t)l * 1536);
            kmean_items(F, U, KMEAN);
        }
        PHASE_END(false)
        PHASE_BEGIN
        {
            for (int u = F.vcu; u < NB * 16; u += NWG)
                ssd_unit(F, u >> 4, u & 15, U, CVB, MIX, SSQS, IN_(I_SDTB) + l * 16, IN_(I_SALOG) + l * 16, IN_(I_SD) + l * 16);
            for (int u = F.vcu; u < NB * 16; u += NWG)
                mlstm_unit(F, u >> 4, (u >> 2) & 3, u & 3, U, CVB, MIX, SSQM, IN_(I_MGB) + l * 8);
        }
        PHASE_END(false)
        PHASE_BEGIN
        {
            for (int u = F.vcu; u < NB * 4 * 4; u += NWG) { const int bh = u >> 2, s = u & 3;
                moba_unit(F, bh >> 2, bh & 3, 7 - s, U, MIX, KMEAN); moba_unit(F, bh >> 2, bh & 3, s, U, MIX, KMEAN); }
            mixnorm_rows(F, U, MIX, SSQM, SSQS, IN_(I_MNG) + (size_t)l * 512, IN_(I_SNG) + (size_t)l * 1024);
        }
        PHASE_END(false)
        PHASE_BEGIN
        { pg8::Gemm g{MIX, WOUT + (size_t)l * D * D, D, D, D, 0}; pg8::StaticOrder S; S.init(T, D, NWG, F.bx);
#ifdef PROBE_OUT2
          { pg8::EpiResidualStat E0{X_, XN, SSQ_(7), D, 0.5f}; pg8::gemm_phase<pg8::EpiResidualStat, pg8::StaticOrder, RES_ALIGN>(F.lds + RING_OFF, g, S, E0); }
          xcd_barrier(bar);
          pg8::EpiResidualStat E{X_, XN, SSQ_(3 * l + 1), D, 0.5f};
#else
          pg8::EpiResidualStat E{X_, XN, SSQ_(3 * l + 1), D, 1.0f};
#endif
          pg8::gemm_phase<pg8::EpiResidualStat, pg8::StaticOrder, RES_ALIGN>(F.lds + RING_OFF, g, S, E); }
        PHASE_END(false)
        if (l == 0) {
            PHASE_BEGIN
            { pg8::Gemm g{XN, FGU, D, D, D, 0}; pg8::StaticOrder S; S.init(T, 2 * DFF, NWG, F.bx); pg8::EpiSwiGLU E{H, DFF, nullptr, 0, SSQ_(3 * l + 1), nullptr};
              pg8::gemm_phase<pg8::EpiSwiGLU, pg8::StaticOrder, true>(F.lds + RING_OFF, g, S, E); }
            PHASE_END(false)
            PHASE_BEGIN
            { pg8::Gemm g{H, FD, DFF, DFF, DFF, 0}; pg8::StaticOrder S; S.init(T, D, NWG, F.bx); pg8::EpiResidualStat E{X_, XN, SSQ_(3 * l + 2), D, 1.0f};
              pg8::gemm_phase<pg8::EpiResidualStat, pg8::StaticOrder, RES_ALIGN>(F.lds + RING_OFF, g, S, E); }
            { pg8::Gemm g{P16 + (size_t)l * T * PLE, PP + (size_t)l * D * PLE, PLE, PLE, PLE, 0}; pg8::StaticOrder S; S.init(T, D, NWG, F.bx); pg8::EpiBf16 E{(bf16_t*)WSB_(WS_PPB0), D, nullptr};
              pg8::gemm_phase<pg8::EpiBf16, pg8::StaticOrder, true>(F.lds + RING_OFF, g, S, E); }
            PHASE_END(false)
        } else {
            PHASE_BEGIN
            moe_route(F, X_, IN_(I_LNFFN) + (size_t)l * D, IN_(I_ROUTER), ROUTE, WGCNT, TOK);
            PHASE_END(false)
            PHASE_BEGIN
            moe_gather(F, XN, ROUTE, WGCNT, XG, TOK, WGT, RS);
            PHASE_END(false)
            for (int slot = 0; slot < 2; ++slot) {
                const LAS int* lt = (const LAS int*)(F.lds + LTAB_OFF);
                PHASE_BEGIN
                { moe_tables(F, WGCNT); const int rt0 = lt[LT_CUMT + 8 * slot], rt1 = lt[LT_CUMT + 8 * slot + 8];
                  pg8::Gemm g{XG, MGU, D, D, D, (size_t)2 * DFFE * D}; pg8::MoeOrder S{rt0, rt1 - rt0, 2 * DFFE / 256, NWG, F.bx, lt + LT_TAB}; pg8::EpiSwiGLU E{HM, DFFE, WGT, rt0, nullptr, RS};
                  pg8::gemm_phase<pg8::EpiSwiGLU, pg8::MoeOrder, true>(F.lds + RING_OFF, g, S, E); }
                PHASE_END(false)
                PHASE_BEGIN
                { moe_tables(F, WGCNT); const int rt0 = lt[LT_CUMT + 8 * slot], rt1 = lt[LT_CUMT + 8 * slot + 8];
                  pg8::Gemm g{HM - (size_t)rt0 * 256 * DFFE, MD, DFFE, DFFE, DFFE, (size_t)D * DFFE}; pg8::MoeOrder S{rt0, rt1 - rt0, D / 256, NWG, F.bx, lt + LT_TAB};
                  if (slot == 0) { pg8::EpiScatter<false> E{X_, D, TOK, nullptr, nullptr}; pg8::gemm_phase<pg8::EpiScatter<false>, pg8::MoeOrder, RES_ALIGN>(F.lds + RING_OFF, g, S, E); }
                  else { pg8::EpiScatter<true> E{X_, D, TOK, XN, SSQ_(3 * l + 2)}; pg8::gemm_phase<pg8::EpiScatter<true>, pg8::MoeOrder, RES_ALIGN>(F.lds + RING_OFF, g, S, E);
                    pg8::Gemm g2{P16 + (size_t)l * T * PLE, PP + (size_t)l * D * PLE, PLE, PLE, PLE, 0}; pg8::StaticOrder S2; S2.init(T, D, NWG, F.bx); pg8::EpiBf16 E2{(bf16_t*)WSB_(WS_PPB1), D, nullptr};
                    pg8::gemm_phase<pg8::EpiBf16, pg8::StaticOrder, true>(F.lds + RING_OFF, g2, S2, E2); } }
                PHASE_END(false)
            }
        }
        PHASE_BEGIN
        { pg8::Gemm g{XN, PG + (size_t)l * D * D, D, D, D, 0}; pg8::StaticOrder S; S.init(T, D, NWG, F.bx); pg8::EpiPleGate E{X_, (const bf16_t*)WSB_(l == 0 ? WS_PPB0 : WS_PPB1), D, SSQ_(3 * l + 2), XBB, SSQ_(3 * l + 3)};
          pg8::gemm_phase<pg8::EpiPleGate, pg8::StaticOrder, RES_ALIGN>(F.lds + RING_OFF, g, S, E); }
        PHASE_END(false)
    }
    PHASE_BEGIN
    {
        const float* g = IN_(I_LNFINAL); float* X = X_; const pg8::ssq_t* sq = SSQ_(6); const int gw = F.vcu * NWAVES + F.wave, NGW = NWG * NWAVES;
        for (int m = gw; m < T; m += NGW) {
            f32x4* xr = (f32x4*)(X + (size_t)m * D) + F.lane; const float rstd = pg8::ssq_rstd(sq, m);
#pragma unroll
            for (int j = 0; j < 8; ++j) { const f32x4 gg = ((const f32x4*)g + F.lane)[64 * j]; xr[64 * j] = xr[64 * j] * rstd * gg; }
        }
    }
    PHASE_END(true)
#undef PHASE_BEGIN
#undef PHASE_END
}

extern "C" void kernel_launch(void* const* d_in, const int* in_sizes, int n_in, void* d_out, int out_size, void* d_ws, size_t ws_size, hipStream_t stream) {
    static int grid = 0;
    if (grid == 0) {
        if (n_in != 27 || out_size != T * D || ws_size < WS_END) { fprintf(stderr, "kernel_launch: unexpected shapes (n_in %d, out %d, ws %zu < %zu)\n", n_in, out_size, ws_size, (size_t)WS_END); grid = -1; return; }
        int dev = 0, cus = 0, per_cu = 0;
        if (hipGetDevice(&dev) != hipSuccess || hipDeviceGetAttribute(&cus, hipDeviceAttributeMultiprocessorCount, dev) != hipSuccess) { grid = -1; return; }
        if (hipFuncSetAttribute((const void*)hybrid_fwd, hipFuncAttributeMaxDynamicSharedMemorySize, LDS_BYTES) != hipSuccess) { fprintf(stderr, "kernel_launch: hipFuncSetAttribute failed\n"); grid = -1; return; }
        if (hipOccupancyMaxActiveBlocksPerMultiprocessor(&per_cu, (const void*)hybrid_fwd, NTHR, LDS_BYTES) != hipSuccess || per_cu < 1) fprintf(stderr, "kernel_launch: occupancy query reports %d\n", per_cu);
        (void)hipGetLastError();
        if (cus != 256) { fprintf(stderr, "kernel_launch: built for 256 CUs, device has %d\n", cus); grid = -1; return; }
        grid = cus;
    }
    if (grid < 0) return;
    if (hipMemsetAsync((char*)d_ws + WS_CTL, 0, CTL_ZERO_BYTES, stream) != hipSuccess) return;
    Args a{};
    for (int i = 0; i < 27; ++i) a.in[i] = (const float*)d_in[i];
    a.out = (float*)d_out; a.ws = (unsigned char*)d_ws;
#ifndef MK_SPLIT
    a.ph_lo = 0; a.ph_hi = 1000;
    hipLaunchKernelGGL(hybrid_fwd, dim3(NWG), dim3(NTHR), LDS_BYTES, stream, a);
#else
    for (int p = 0; p < 40; ++p) { a.ph_lo = p; a.ph_hi = p + 1; hipLaunchKernelGGL(hybrid_fwd, dim3(NWG), dim3(NTHR), LDS_BYTES, stream, a); }
#endif
}
```

```cpp
#include <hip/hip_runtime.h>
#include <cstdio>
#include <cstdint>

#define GAS __attribute__((address_space(1)))
#define LAS __attribute__((address_space(3)))
typedef unsigned short bf16_t;
typedef short bf16x8 __attribute__((ext_vector_type(8)));
typedef short s16x4 __attribute__((ext_vector_type(4)));
typedef float f32x4 __attribute__((ext_vector_type(4)));
typedef float f32x2 __attribute__((ext_vector_type(2)));
typedef unsigned u32x4 __attribute__((ext_vector_type(4)));
typedef unsigned u32x2 __attribute__((ext_vector_type(2)));
typedef __bf16 bf16x2_t __attribute__((ext_vector_type(2)));

__device__ __forceinline__ unsigned pk2(float lo, float hi) { f32x2 v = {lo, hi}; bf16x2_t b = __builtin_convertvector(v, bf16x2_t); return __builtin_bit_cast(unsigned, b); }
__device__ __forceinline__ float bflo(unsigned w) { return __builtin_bit_cast(float, w << 16); }
__device__ __forceinline__ float bfhi(unsigned w) { return __builtin_bit_cast(float, w & 0xffff0000u); }
__device__ __forceinline__ float bf1(bf16_t h) { return __builtin_bit_cast(float, ((unsigned)h) << 16); }
__device__ __forceinline__ bf16_t f2bf(float f) { return (bf16_t)(pk2(f, 0.f) & 0xffffu); }
__device__ __forceinline__ float fast_exp(float x) { return __builtin_amdgcn_exp2f(x * 1.4426950408889634f); }
__device__ __forceinline__ float sigmoidf_(float x) { return __builtin_amdgcn_rcpf(1.0f + fast_exp(-x)); }
__device__ __forceinline__ float siluf_(float x) { return x * sigmoidf_(x); }
typedef int i32x8 __attribute__((ext_vector_type(8)));
__device__ __forceinline__ unsigned pk4_fp8(float a, float b, float c, float d) { int w; asm("" : "=v"(w)); w = __builtin_amdgcn_cvt_pk_fp8_f32(a, b, w, false); w = __builtin_amdgcn_cvt_pk_fp8_f32(c, d, w, true); return (unsigned)w; }
constexpr float W8_SCALE = 32.0f, W8_INV = 1.0f / 32.0f, H8_SCALE = 4.0f, H8_INV = 0.25f;

namespace pg8 {
constexpr int BM = 256, BK = 64, HALF = 128, HTB = HALF * BK * 2  , STAGE_BYTES = 8 * HTB, NXCD = 8, WGM = 8;

__host__ __device__ __forceinline__ int lds_byte(int r, int c) { const int st = (r >> 4) * 2 + (c >> 5), rr = r & 15, cc = c & 31, ob = rr * 64 + cc * 2; return st * 1024 + (ob ^ (((ob >> 9) & 1) << 5)); }
__host__ __device__ __forceinline__ void stage_rc(int b, int& R, int& C) { const int st = b / 1024, sb = b % 1024, swz = sb ^ (((sb >> 9) & 1) << 5); R = (st >> 1) * 16 + swz / 64; C = (st & 1) * 32 + (swz % 64) / 2; }
__host__ __device__ __forceinline__ int perm32(int rho) { const int n = rho >> 4, i = rho & 15; return 8 * (i >> 2) + 4 * n + (i & 3); }

struct Unit { int pm, pn, e; };
struct Gemm { const bf16_t* A; const bf16_t* Bt; int lda, ldb, K; size_t estride; };

struct StaticOrder {
    int nM, nN, nwg, G, c;
    __device__ void init(int M, int N, int G_, int c_) { nM = M / BM; nN = N / BM; nwg = nM * nN; G = G_; c = c_; }
    __device__ bool next(int i, Unit& u) const {
        const long L = (long)i * G + c; if (L >= nwg) return false;
        int wgid = (int)L; { const int q = nwg / NXCD, r = nwg % NXCD, xcd = wgid % NXCD, off = wgid / NXCD; wgid = (xcd < r ? xcd * (q + 1) : r * (q + 1) + (xcd - r) * q) + off; }
        const int nig = WGM * nN, gid = wgid / nig, fm = gid * WGM, gsz = (nM - fm) < WGM ? (nM - fm) : WGM;
        u.pm = fm + ((wgid % nig) % gsz); u.pn = (wgid % nig) / gsz; u.e = 0; return true;
    }
};
struct MoeOrder {
    int rt0, nrt, nN, G, c; const LAS int* tab;
    __device__ bool next(int i, Unit& u) const {
        const int nwg = nrt * nN; const long L = (long)i * G + c; if (L >= nwg) return false;
        int wgid = (int)L; { const int q = nwg / NXCD, r = nwg % NXCD, xcd = wgid % NXCD, off = wgid / NXCD; wgid = (xcd < r ? xcd * (q + 1) : r * (q + 1) + (xcd - r) * q) + off; }
        const int nig = WGM * nN, gid = wgid / nig, fm = gid * WGM, gsz = (nrt - fm) < WGM ? (nrt - fm) : WGM;
        u.pm = rt0 + fm + ((wgid % nig) % gsz); u.pn = (wgid % nig) / gsz; u.e = tab[u.pm]; return true;
    }
};

struct MoeOrderGU {
    int rtb, rtc, nN, G, c, L0, Lend; const LAS int* tab;
    __device__ bool next(int i, Unit& u) const {
        const int L = L0 + i * G + c; if (L >= Lend || c < 0) return false;
        const int n0 = rtb * nN; int j, nrt, rt0; if (L < n0) { j = L; nrt = rtb; rt0 = 0; } else { j = L - n0; nrt = rtc - rtb; rt0 = rtb; }
        const int nwg = nrt * nN; { const int q = nwg / NXCD, r = nwg % NXCD, xcd = j % NXCD, off = j / NXCD; j = (xcd < r ? xcd * (q + 1) : r * (q + 1) + (xcd - r) * q) + off; }
        const int nig = WGM * nN, gid = j / nig, fm = gid * WGM, gsz = (nrt - fm) < WGM ? (nrt - fm) : WGM;
        u.pm = rt0 + fm + ((j % nig) % gsz); u.pn = (j % nig) / gsz; u.e = tab[u.pm]; return true;
    }
};


__device__ __forceinline__ float epi_shfl(float v, int src) { return __builtin_bit_cast(float, __builtin_amdgcn_ds_bpermute(src << 2, __builtin_bit_cast(int, v))); }
constexpr float RMS_EPS = 1e-6f, INV_D = 1.0f / 2048.0f, SSQ_SCALE = 16777216.0f, SSQ_INV = INV_D / 16777216.0f;
typedef unsigned long long ssq_t;
__device__ __forceinline__ float ssq_rstd(const ssq_t* p, int row) { return __builtin_amdgcn_rsqf((float)p[row] * SSQ_INV + RMS_EPS); }
__device__ __forceinline__ void ssq_add(ssq_t* p, int row, float q) { __hip_atomic_fetch_add(p + row, (ssq_t)(q * SSQ_SCALE + 0.5f), __ATOMIC_RELAXED, __HIP_MEMORY_SCOPE_AGENT); }
struct EpiBf16 {
    static constexpr bool PERM = true;
    bf16_t* O; int ldc; const ssq_t* ssq; float wscale;
    __device__ __forceinline__ void operator()(const f32x4 (&acc)[2][2][4][2], const Unit& u, int wr, int wc, int fr, int fq) const {
        const int row0 = u.pm * BM + wr * 64 + fr, col0 = u.pn * BM + wc * 32 + 8 * fq;
#pragma unroll
        for (int ai = 0; ai < 2; ++ai)
#pragma unroll
            for (int m = 0; m < 4; ++m) { const int row = row0 + ai * HALF + m * 16; const float s = (ssq ? ssq_rstd(ssq, row) : 1.0f) * wscale;
                bf16_t* rowp = O + (size_t)row * ldc + col0;
#pragma unroll
                for (int bj = 0; bj < 2; ++bj) { const f32x4 v0 = acc[ai][bj][m][0] * s, v1 = acc[ai][bj][m][1] * s;
                    u32x4 w; w.x = pk2(v0[0], v0[1]); w.y = pk2(v0[2], v0[3]); w.z = pk2(v1[0], v1[1]); w.w = pk2(v1[2], v1[3]);
                    *(u32x4*)(rowp + bj * HALF) = w; } }
    }
};
template <bool OUT8> struct EpiSwiGLU {
    static constexpr bool PERM = true;
    bf16_t* H; int ldc; const float* wgt; int rt0; const ssq_t* ssq; const float* rs; float wscale;
    __device__ __forceinline__ void operator()(const f32x4 (&acc)[2][2][4][2], const Unit& u, int wr, int wc, int fr, int fq) const {
        const int row0 = u.pm * BM + wr * 64 + fr, col0 = u.pn * HALF + wc * 32 + 8 * fq;
#pragma unroll
        for (int ai = 0; ai < 2; ++ai)
#pragma unroll
            for (int m = 0; m < 4; ++m) { const int row = row0 + ai * HALF + m * 16; const float s = wgt ? wgt[row] : 1.0f; const float rn = (rs ? rs[row] : ssq_rstd(ssq, row)) * wscale;
                const float kn = rn * -1.4426950408889634f, ku = rn * s * (OUT8 ? H8_SCALE : 1.0f);
                const f32x2 rn2 = {rn, rn}, kn2 = {kn, kn}, ku2 = {ku, ku};
                f32x2 o[4];
#pragma unroll
                for (int n = 0; n < 2; ++n)
#pragma unroll
                    for (int h = 0; h < 2; ++h) { const f32x2 g = {acc[ai][0][m][n][2 * h], acc[ai][0][m][n][2 * h + 1]}, uu = {acc[ai][1][m][n][2 * h], acc[ai][1][m][n][2 * h + 1]};
                        const f32x2 t = g * kn2; f32x2 e; e.x = __builtin_amdgcn_exp2f(t.x); e.y = __builtin_amdgcn_exp2f(t.y);
                        const f32x2 d = e + 1.0f; f32x2 r; r.x = __builtin_amdgcn_rcpf(d.x); r.y = __builtin_amdgcn_rcpf(d.y);
                        o[2 * n + h] = ((g * rn2) * r) * (uu * ku2); }
                if constexpr (OUT8) { u32x2 b; b.x = pk4_fp8(o[0].x, o[0].y, o[1].x, o[1].y); b.y = pk4_fp8(o[2].x, o[2].y, o[3].x, o[3].y);
                    *(u32x2*)((unsigned char*)H + (size_t)(row - rt0 * BM) * ldc + col0) = b; }
                else { u32x4 w; w.x = pk2(o[0].x, o[0].y); w.y = pk2(o[1].x, o[1].y); w.z = pk2(o[2].x, o[2].y); w.w = pk2(o[3].x, o[3].y);
                    *(u32x4*)(H + (size_t)(row - rt0 * BM) * ldc + col0) = w; } }
    }
};
__device__ __forceinline__ void unpack8(const u32x4 w, float (&f)[8]) { f[0] = bflo(w.x); f[1] = bfhi(w.x); f[2] = bflo(w.y); f[3] = bfhi(w.y); f[4] = bflo(w.z); f[5] = bfhi(w.z); f[6] = bflo(w.w); f[7] = bfhi(w.w); }
__device__ __forceinline__ float store_row8(bf16_t* XSo, unsigned char* X8, size_t off, const float (&x)[8]) {
    u32x4 w; w.x = pk2(x[0], x[1]); w.y = pk2(x[2], x[3]); w.z = pk2(x[4], x[5]); w.w = pk2(x[6], x[7]); *(u32x4*)(XSo + off) = w;
    if (X8) { u32x2 b; b.x = pk4_fp8(x[0], x[1], x[2], x[3]); b.y = pk4_fp8(x[4], x[5], x[6], x[7]); *(u32x2*)(X8 + off) = b; }
    float r[8]; unpack8(w, r); return ((r[0] * r[0] + r[1] * r[1]) + (r[2] * r[2] + r[3] * r[3])) + ((r[4] * r[4] + r[5] * r[5]) + (r[6] * r[6] + r[7] * r[7]));
}
struct EpiResidualStat {
    static constexpr bool PERM = true;
    const bf16_t* XSi; bf16_t* XSo; unsigned char* X8; ssq_t* ssq; int ldc; float alpha;
    __device__ __forceinline__ void operator()(const f32x4 (&acc)[2][2][4][2], const Unit& u, int wr, int wc, int fr, int fq) const {
        const int row0 = u.pm * BM + wr * 64 + fr, col0 = u.pn * BM + wc * 32 + 8 * fq, lane = fq * 16 + fr;
#pragma unroll
        for (int ai = 0; ai < 2; ++ai) {
            u32x4 xi[4][2]; float q[4];
#pragma unroll
            for (int m = 0; m < 4; ++m)
#pragma unroll
                for (int bj = 0; bj < 2; ++bj) xi[m][bj] = *(const u32x4*)(XSi + (size_t)(row0 + ai * HALF + m * 16) * ldc + col0 + bj * HALF);
#pragma unroll
            for (int m = 0; m < 4; ++m) { const size_t off = (size_t)(row0 + ai * HALF + m * 16) * ldc + col0; q[m] = 0.f;
#pragma unroll
                for (int bj = 0; bj < 2; ++bj) { float x[8]; unpack8(xi[m][bj], x);
#pragma unroll
                    for (int j = 0; j < 4; ++j) { x[j] += acc[ai][bj][m][0][j] * alpha; x[4 + j] += acc[ai][bj][m][1][j] * alpha; }
                    q[m] += store_row8(XSo, X8, off + bj * HALF, x); } }
#pragma unroll
            for (int m = 0; m < 4; ++m) { q[m] += epi_shfl(q[m], lane ^ 16); q[m] += epi_shfl(q[m], lane ^ 32); }
            if (fq == 0 && ssq) {
#pragma unroll
                for (int m = 0; m < 4; ++m) ssq_add(ssq, row0 + ai * HALF + m * 16, q[m]); }
        }
    }
};
template <bool STAT> struct EpiScatter {
    static constexpr bool PERM = true;
    bf16_t* XS; int ldc; const int* tok; unsigned char* X8; ssq_t* ssq; float alpha;
    __device__ __forceinline__ void operator()(const f32x4 (&acc)[2][2][4][2], const Unit& u, int wr, int wc, int fr, int fq) const {
        const int row0 = u.pm * BM + wr * 64 + fr, col0 = u.pn * BM + wc * 32 + 8 * fq, lane = fq * 16 + fr;
        int tk[2][4];
#pragma unroll
        for (int ai = 0; ai < 2; ++ai)
#pragma unroll
            for (int m = 0; m < 4; ++m) tk[ai][m] = tok[row0 + ai * HALF + m * 16];
#pragma unroll
        for (int ai = 0; ai < 2; ++ai) {
            u32x4 xi[4][2]; float q[4];
#pragma unroll
            for (int m = 0; m < 4; ++m) { const int t = tk[ai][m] >= 0 ? tk[ai][m] : 0;
#pragma unroll
                for (int bj = 0; bj < 2; ++bj) xi[m][bj] = *(const u32x4*)(XS + (size_t)t * ldc + col0 + bj * HALF); }
#pragma unroll
            for (int m = 0; m < 4; ++m) { const int t = tk[ai][m]; q[m] = 0.f;
                if (t >= 0) { const size_t off = (size_t)t * ldc + col0;
#pragma unroll
                    for (int bj = 0; bj < 2; ++bj) { float x[8]; unpack8(xi[m][bj], x);
#pragma unroll
                        for (int j = 0; j < 4; ++j) { x[j] += acc[ai][bj][m][0][j] * alpha; x[4 + j] += acc[ai][bj][m][1][j] * alpha; }
                        q[m] += store_row8(XS, STAT ? X8 : nullptr, off + bj * HALF, x); } } }
            if (STAT) {
#pragma unroll
                for (int m = 0; m < 4; ++m) { q[m] += epi_shfl(q[m], lane ^ 16); q[m] += epi_shfl(q[m], lane ^ 32); }
                if (fq == 0) {
#pragma unroll
                    for (int m = 0; m < 4; ++m) if (tk[ai][m] >= 0) ssq_add(ssq, tk[ai][m], q[m]); } }
        }
    }
};
struct EpiPleGate {
    static constexpr bool PERM = true;
    const bf16_t* XSi; bf16_t* XSo; const bf16_t* PPB; int ldc; const ssq_t* ssq_in; ssq_t* ssq_out; float wscale; unsigned char* X8o;
    __device__ __forceinline__ void operator()(const f32x4 (&acc)[2][2][4][2], const Unit& u, int wr, int wc, int fr, int fq) const {
        const int row0 = u.pm * BM + wr * 64 + fr, col0 = u.pn * BM + wc * 32 + 8 * fq, lane = fq * 16 + fr;
#pragma unroll
        for (int ai = 0; ai < 2; ++ai) {
            u32x4 xi[4][2], pp[4][2]; float q[4], rn[4];
#pragma unroll
            for (int m = 0; m < 4; ++m) { rn[m] = ssq_rstd(ssq_in, row0 + ai * HALF + m * 16) * wscale;
#pragma unroll
                for (int bj = 0; bj < 2; ++bj) { const size_t o = (size_t)(row0 + ai * HALF + m * 16) * ldc + col0 + bj * HALF; xi[m][bj] = *(const u32x4*)(XSi + o); pp[m][bj] = *(const u32x4*)(PPB + o); } }
#pragma unroll
            for (int m = 0; m < 4; ++m) { const size_t off = (size_t)(row0 + ai * HALF + m * 16) * ldc + col0; q[m] = 0.f;
#pragma unroll
                for (int bj = 0; bj < 2; ++bj) { float x[8], p[8]; unpack8(xi[m][bj], x); unpack8(pp[m][bj], p);
                    const float kn = rn[m] * -1.4426950408889634f; const f32x2 kn2 = {kn, kn};
#pragma unroll
                    for (int n = 0; n < 2; ++n)
#pragma unroll
                        for (int h = 0; h < 2; ++h) { const f32x2 a = {acc[ai][bj][m][n][2 * h], acc[ai][bj][m][n][2 * h + 1]}; const f32x2 t = a * kn2;
                            f32x2 e; e.x = __builtin_amdgcn_exp2f(t.x); e.y = __builtin_amdgcn_exp2f(t.y); const f32x2 d = e + 1.0f; f32x2 r; r.x = __builtin_amdgcn_rcpf(d.x); r.y = __builtin_amdgcn_rcpf(d.y);
                            const f32x2 pv = {p[4 * n + 2 * h], p[4 * n + 2 * h + 1]}, xv = {x[4 * n + 2 * h], x[4 * n + 2 * h + 1]}; const f32x2 o = pv * r + xv; x[4 * n + 2 * h] = o.x; x[4 * n + 2 * h + 1] = o.y; }
                    q[m] += store_row8(XSo, X8o, off + bj * HALF, x); } }
#pragma unroll
            for (int m = 0; m < 4; ++m) { q[m] += epi_shfl(q[m], lane ^ 16); q[m] += epi_shfl(q[m], lane ^ 32); }
            if (fq == 0) {
#pragma unroll
                for (int m = 0; m < 4; ++m) ssq_add(ssq_out, row0 + ai * HALF + m * 16, q[m]); }
        }
    }
};

template <class Epi, class Sched, bool ALIGN_EPI, bool FP8 = false>
__device__ __forceinline__ void gemm_phase(LAS unsigned char* lds, const Gemm g, const Sched& S, const Epi& E, int tid_in) {
    int tid_ = tid_in; asm volatile("" : "+v"(tid_));
    const int tid = tid_, wid = __builtin_amdgcn_readfirstlane(tid >> 6), lane = tid & 63, wr = wid >> 2, wc = wid & 3, fr = lane & 15, fq = lane >> 4;
    const int K = g.K, nt = K / BK;
    unsigned voffA[2], voffB[2];
#pragma unroll
    for (int i = 0; i < 2; ++i) { int R, C; stage_rc(tid * 16 + i * 8192, R, C); const int Rb = Epi::PERM ? ((R & ~31) + perm32(R & 31)) : R;
        voffA[i] = (unsigned)(R * g.lda + C) * 2u; voffB[i] = (unsigned)(Rb * g.ldb + C) * 2u; }
    const __amdgpu_buffer_rsrc_t rA = __builtin_amdgcn_make_buffer_rsrc((void*)g.A, 0, 0xffffffff, 0x00020000), rB = __builtin_amdgcn_make_buffer_rsrc((void*)g.Bt, 0, 0xffffffff, 0x00020000);
    const unsigned kstep = (unsigned)(BK * 2);
    const unsigned hstepA = (unsigned)HALF * g.lda * 2u, hstepB = (unsigned)HALF * g.ldb * 2u;
    const unsigned tstepA = 2u * hstepA, tstepB = 2u * hstepB, estepB = (unsigned)(g.estride * 2);
    const unsigned ldsw = (unsigned)wid * 1024u;
    const int aoff = lds_byte(wr * 64 + fr, fq * 8), boff = lds_byte(wc * 32 + fr, fq * 8);
#define PG8_SA(b, h) (((b) * 2 + (h)) * HTB)
#define PG8_SB(b, h) ((4 + (b) * 2 + (h)) * HTB)
#define PG8_STAGE(bufoff, rs, soff, voff) do { _Pragma("unroll") for (int _i = 0; _i < 2; ++_i) \
        __builtin_amdgcn_raw_ptr_buffer_load_lds((rs), (LAS unsigned*)(lds + (bufoff) + ldsw + _i * 8192), 16, (voff)[_i], (soff), 0, 0); } while (0)
#define PG8_LD8(base) __builtin_bit_cast(i32x8, __builtin_shufflevector(*(const LAS u32x4*)(base), *(const LAS u32x4*)((base) + 1024), 0, 1, 2, 3, 4, 5, 6, 7))
#define PG8_LDA(dst, b, h) do { if constexpr (FP8) { _Pragma("unroll") for (int m = 0; m < 4; ++m) dst##8[m] = PG8_LD8(lds + PG8_SA(b, h) + aoff + m * 2048); } \
        else { _Pragma("unroll") for (int m = 0; m < 4; ++m) _Pragma("unroll") for (int k = 0; k < 2; ++k) dst[m][k] = *(const LAS bf16x8*)(lds + PG8_SA(b, h) + aoff + m * 2048 + k * 1024); } } while (0)
#define PG8_LDB(dst, b, h) do { if constexpr (FP8) { _Pragma("unroll") for (int n = 0; n < 2; ++n) dst##8[n] = PG8_LD8(lds + PG8_SB(b, h) + boff + n * 2048); } \
        else { _Pragma("unroll") for (int n = 0; n < 2; ++n) _Pragma("unroll") for (int k = 0; k < 2; ++k) dst[n][k] = *(const LAS bf16x8*)(lds + PG8_SB(b, h) + boff + n * 2048 + k * 1024); } } while (0)
#define PG8_MMA(ai, bj, At, Bt) do { __builtin_amdgcn_s_setprio(1); \
        if constexpr (FP8) { _Pragma("unroll") for (int m = 0; m < 4; ++m) _Pragma("unroll") for (int n = 0; n < 2; ++n) \
            acc[ai][bj][m][n] = __builtin_amdgcn_mfma_scale_f32_16x16x128_f8f6f4(Bt##8[n], At##8[m], acc[ai][bj][m][n], 0, 0, 0, 0x7f7f7f7f, 0, 0x7f7f7f7f); } \
        else { _Pragma("unroll") for (int m = 0; m < 4; ++m) _Pragma("unroll") for (int n = 0; n < 2; ++n) _Pragma("unroll") for (int k = 0; k < 2; ++k) \
            acc[ai][bj][m][n] = __builtin_amdgcn_mfma_f32_16x16x32_bf16(Bt[n][k], At[m][k], acc[ai][bj][m][n], 0, 0, 0); } \
        __builtin_amdgcn_s_setprio(0); } while (0)
#define PG8_WAIT_V(n) asm volatile("s_waitcnt vmcnt(" #n ")" ::: "memory")
#define PG8_WAIT_L(n) asm volatile("s_waitcnt lgkmcnt(" #n ")" ::: "memory")
#define PG8_BAR __builtin_amdgcn_s_barrier()
#define PG8_SCHED __builtin_amdgcn_sched_barrier(0)
    Unit cur, nxt; int ui = 0;
    if (!S.next(0, cur)) return;
    f32x4 acc[2][2][4][2];
    int zi_ = 0; asm volatile("" : "+s"(zi_)); const float zf_ = __builtin_bit_cast(float, zi_);
#pragma unroll
    for (int a = 0; a < 2; ++a)
#pragma unroll
        for (int b = 0; b < 2; ++b)
#pragma unroll
            for (int m = 0; m < 4; ++m)
#pragma unroll
                for (int n = 0; n < 2; ++n) acc[a][b][m][n] = (f32x4){zf_, zf_, zf_, zf_};
    bf16x8 At[4][2], B0[2][2], B1[2][2];
    i32x8 At8[4], B08[2], B18[2];
    unsigned cA = (unsigned)cur.pm * tstepA, cB = (unsigned)cur.e * estepB + (unsigned)cur.pn * tstepB;
    PG8_STAGE(PG8_SB(0, 0), rB, cB, voffB); PG8_STAGE(PG8_SB(0, 1), rB, cB + hstepB, voffB); PG8_STAGE(PG8_SA(0, 0), rA, cA, voffA); PG8_STAGE(PG8_SA(0, 1), rA, cA + hstepA, voffA);
    if (wr == 1) PG8_BAR;
    PG8_WAIT_V(2); PG8_BAR;
    PG8_STAGE(PG8_SB(1, 0), rB, cB + kstep, voffB); PG8_STAGE(PG8_SA(1, 0), rA, cA + kstep, voffA); PG8_STAGE(PG8_SB(1, 1), rB, cB + hstepB + kstep, voffB);
    PG8_WAIT_V(6); PG8_BAR;
    for (;;) {
        const bool has_next = S.next(ui + 1, nxt);
        const unsigned nA = has_next ? (unsigned)nxt.pm * tstepA : cA, nB = has_next ? (unsigned)nxt.e * estepB + (unsigned)nxt.pn * tstepB : cB;
        asm volatile(".p2align 8" ::: "memory");
        for (int t = 0; t < nt; t += 2) {
            const bool last = (t == nt - 2);
            const unsigned a1 = cA + (unsigned)(t + 1) * kstep;
            const unsigned a2 = last ? nA : cA + (unsigned)(t + 2) * kstep, b2 = last ? nB : cB + (unsigned)(t + 2) * kstep;
            const unsigned a3 = a2 + kstep, b3 = b2 + kstep;
            PG8_LDB(B0, 0, 0); PG8_LDB(B1, 0, 1); PG8_SCHED; PG8_LDA(At, 0, 0); PG8_STAGE(PG8_SA(1, 1), rA, a1 + hstepA, voffA);
            PG8_WAIT_V(8); PG8_WAIT_L(0); PG8_BAR; PG8_MMA(0, 0, At, B0); PG8_MMA(0, 1, At, B1); PG8_BAR; PG8_SCHED;
            PG8_LDA(At, 0, 1); PG8_STAGE(PG8_SB(0, 0), rB, b2, voffB); PG8_STAGE(PG8_SB(0, 1), rB, b2 + hstepB, voffB); PG8_STAGE(PG8_SA(0, 0), rA, a2, voffA);
            PG8_WAIT_V(8); PG8_WAIT_L(0); PG8_BAR; PG8_MMA(1, 0, At, B0); PG8_MMA(1, 1, At, B1); PG8_BAR; PG8_SCHED;
            PG8_LDB(B0, 1, 0); PG8_LDB(B1, 1, 1); PG8_SCHED; PG8_LDA(At, 1, 0); PG8_STAGE(PG8_SA(0, 1), rA, a2 + hstepA, voffA);
            PG8_WAIT_V(8); PG8_WAIT_L(0); PG8_BAR; PG8_MMA(0, 0, At, B0); PG8_MMA(0, 1, At, B1); PG8_BAR; PG8_SCHED;
            PG8_LDA(At, 1, 1); PG8_STAGE(PG8_SB(1, 0), rB, b3, voffB); PG8_STAGE(PG8_SB(1, 1), rB, b3 + hstepB, voffB); PG8_STAGE(PG8_SA(1, 0), rA, a3, voffA);
            PG8_WAIT_V(8); PG8_WAIT_L(0); PG8_BAR; PG8_MMA(1, 0, At, B0); PG8_MMA(1, 1, At, B1); PG8_BAR; PG8_SCHED;
        }
        if constexpr (ALIGN_EPI) { if (wr == 0) PG8_BAR; }
        { unsigned z_ = 0u; asm volatile("" : "+s"(z_)); const int l2 = (int)__builtin_amdgcn_mbcnt_hi(~0u, __builtin_amdgcn_mbcnt_lo(~0u, z_)); E(acc, cur, wr, wc, l2 & 15, l2 >> 4); }
        if (!has_next) break;
#pragma unroll
        for (int a = 0; a < 2; ++a)
#pragma unroll
            for (int b = 0; b < 2; ++b)
#pragma unroll
                for (int m = 0; m < 4; ++m)
#pragma unroll
                    for (int n = 0; n < 2; ++n) acc[a][b][m][n] = (f32x4){zf_, zf_, zf_, zf_};
        cur = nxt; cA = nA; cB = nB; ++ui;
        if constexpr (ALIGN_EPI) { if (wr == 1) PG8_BAR; }
    }
    PG8_WAIT_V(0);
    if constexpr (!ALIGN_EPI) { if (wr == 0) PG8_BAR; }
    PG8_BAR;
#undef PG8_SA
#undef PG8_SB
#undef PG8_STAGE
#undef PG8_LDA
#undef PG8_LDB
#undef PG8_MMA
#undef PG8_LD8
#undef PG8_WAIT_V
#undef PG8_WAIT_L
#undef PG8_BAR
#undef PG8_SCHED
}
}
constexpr int NB = 16, SEQ = 2048, T = NB * SEQ, D = 2048, DEPTH = 2;
constexpr int DPROJ_SRC = 6168, NU = 6400;
constexpr int DFF = 5632, NEXP = 8, DFFE = 7168, PLE = 256;
constexpr float EPS = 1e-6f;
constexpr int UQ = 0, UK = 512, UV = 1024, UO = 1536, UZ = 2048, UXBC = 3072, UAQ = 4608, UAK = 5120, UAV = 5632, UMI = 6144, UMF = 6148, UDT = 6152;
constexpr int MIXM = 0, MIXS = 512, MIXA = 1536;
constexpr int NWAVES = 8, NTHR = 512, NWG = 256;

constexpr size_t MiB = 1u << 20;
constexpr size_t WS_CTL = 0, CTL_ZERO_BYTES = 3 * MiB;
constexpr size_t WS_SSQ = 1 * MiB;
constexpr size_t WS_WIN = 4 * MiB;
constexpr size_t WS_WOUT = WS_WIN + 50 * MiB;
constexpr size_t WS_FGU = WS_WOUT + 16 * MiB;
constexpr size_t WS_FD = WS_FGU + 44 * MiB;
constexpr size_t WS_MGU = WS_FD + 22 * MiB;
constexpr size_t WS_MD = WS_MGU + 448 * MiB;
constexpr size_t WS_PG = WS_MD + 224 * MiB;
constexpr size_t WS_PP = WS_PG + 16 * MiB;
constexpr size_t WS_XN = WS_PP + 2 * MiB;
constexpr size_t WS_P16 = WS_XN + 128 * MiB;
constexpr size_t WS_R = WS_P16 + 32 * MiB;
constexpr size_t WS_U = WS_R;
constexpr size_t WS_MIX = WS_R + 400 * MiB;
constexpr size_t WS_CV = WS_R + 528 * MiB;
constexpr size_t WS_H = WS_R;
constexpr size_t WS_PPB0 = WS_R + 352 * MiB, WS_PPB1 = WS_R;
constexpr size_t WS_XG = WS_R;
constexpr size_t WS_HM = WS_R + 272 * MiB;
constexpr size_t WS_MISC = WS_R + 748 * MiB;
constexpr size_t WS_SSQM = WS_MISC;
constexpr size_t WS_SSQS = WS_SSQM + 4 * MiB;
constexpr size_t WS_KMEAN = WS_SSQS + 2 * MiB;
constexpr size_t WS_ROUTE = WS_KMEAN + 1 * MiB;
constexpr size_t WS_TOK = WS_ROUTE + 1 * MiB;
constexpr size_t WS_WGT = WS_TOK + 1 * MiB;
constexpr size_t WS_WGCNT = WS_WGT + 1 * MiB;
constexpr size_t WS_XBB = WS_WGCNT + 1 * MiB;
constexpr size_t WS_XA8 = WS_XBB + 128 * MiB;
constexpr size_t WS_END = WS_XA8 + 64 * MiB;
constexpr int MOE_ROWS = 69632, MOE_SLOT_ROWS = 34816;
constexpr int CW_TMO = 0, CW_BAR = 4096;

constexpr int RING_OFF = 0, RING_BYTES = 131072;
constexpr int LDSCTL_OFF = 139264;
constexpr int MISC_OFF = LDSCTL_OFF;
constexpr int LTAB_OFF = LDSCTL_OFF + 256;
constexpr int PTAB_OFF = LDSCTL_OFF + 6144;
constexpr int LDS_BYTES = 147456;

#define XB_TMO      128
#define XB_XCNT(j)  (256  + 64 * (j))
#define XB_XSUB(j)  (1280 + 64 * (j))
#define XB_XGEN(j)  (2304 + 64 * (j))
#define XB_TOP      3328
#define XB_TOPGEN   3392
#define XCD_BAR_WORDS 3456
#define XB_SPIN_CAP (1u << 18)

__device__ __forceinline__ unsigned xb_ld(unsigned* p)              { return __hip_atomic_load(p, __ATOMIC_RELAXED, __HIP_MEMORY_SCOPE_AGENT); }
__device__ __forceinline__ unsigned xb_add(unsigned* p, unsigned v) { return __hip_atomic_fetch_add(p, v, __ATOMIC_RELAXED, __HIP_MEMORY_SCOPE_AGENT); }
__device__ __forceinline__ unsigned xb_xcc_id() { return (unsigned)__builtin_amdgcn_s_getreg((3 << 11) | 20) & 0xFu; }
#define XB_SPIN(cond, bar) do { unsigned _sp = 0; while (cond) { __builtin_amdgcn_s_sleep(1); \
    if ((++_sp & 255u) == 0u) { if (xb_ld(&(bar)[XB_TMO])) break; if (_sp > XB_SPIN_CAP) { atomicAdd(&(bar)[XB_TMO], 1u); break; } } } } while (0)

struct XcdBarrier { unsigned* bar; unsigned x; volatile LAS unsigned* st; };

__device__ __forceinline__ XcdBarrier xcd_barrier_post(unsigned* bar, volatile LAS unsigned* st) {
    XcdBarrier b; b.bar = bar; b.x = xb_xcc_id(); b.st = st;
    if (threadIdx.x == 0) (void)xb_add(&bar[XB_XCNT(b.x)], 1u);
    return b;
}
__device__ __forceinline__ void xcd_barrier_complete(unsigned* bar, unsigned x, unsigned& nloc, unsigned& nx) {
    const unsigned G = NWG;
    unsigned sum, cnt, mine, sp = 0u;
    for (;;) {
        sum = 0u; cnt = 0u; mine = 0u;
#pragma unroll
        for (unsigned j = 0; j < 16; ++j) { const unsigned c = xb_ld(&bar[XB_XCNT(j)]); sum += c; cnt += (c > 0u) ? 1u : 0u; mine = (j == x) ? c : mine; }
        if (sum == G) break;
        __builtin_amdgcn_s_sleep(1);
        if ((++sp & 255u) == 0u) { if (xb_ld(&bar[XB_TMO])) break; if (sp > XB_SPIN_CAP) { atomicAdd(&bar[XB_TMO], 1u); break; } }
    }
    nloc = mine > 0u ? mine : 1u; nx = cnt > 0u ? cnt : 1u;
}
__device__ __forceinline__ void xcd_barrier(const XcdBarrier& b) {
    asm volatile("s_waitcnt vmcnt(0)" ::: "memory");
    __syncthreads();
    if (threadIdx.x == 0) {
        unsigned* bar = b.bar;
        __builtin_amdgcn_s_waitcnt(0);
        unsigned nloc = b.st[0], nx = b.st[1];
        if (nloc == 0u) { xcd_barrier_complete(bar, b.x, nloc, nx); b.st[0] = nloc; b.st[1] = nx; }
        const unsigned old = xb_add(&bar[XB_XSUB(b.x)], 1u);
        const unsigned gen = old / nloc;
        if (old + 1u == (gen + 1u) * nloc) {
            __builtin_amdgcn_fence(__ATOMIC_RELEASE, "agent");
            asm volatile("s_waitcnt vmcnt(0)" ::: "memory");
            const unsigned og = xb_add(&bar[XB_TOP], 1u);
            const unsigned tg = og / nx;
            if (og + 1u == (tg + 1u) * nx) xb_add(&bar[XB_TOPGEN], 1u);
            else XB_SPIN(xb_ld(&bar[XB_TOPGEN]) == tg, bar);
            __builtin_amdgcn_fence(__ATOMIC_ACQUIRE, "agent");
            xb_add(&bar[XB_XGEN(b.x)], 1u);
            asm volatile("s_waitcnt vmcnt(0)" ::: "memory");
        } else {
            XB_SPIN(xb_ld(&bar[XB_XGEN(b.x)]) == gen, bar);
            __builtin_amdgcn_fence(__ATOMIC_ACQUIRE, "agent");
            asm volatile("s_waitcnt vmcnt(0)" ::: "memory");
        }
    }
    __syncthreads();
}

struct Args {
    const float* in[27]; float* out; unsigned char* ws; int ph_lo, ph_hi;
};
struct Frame {
    LAS unsigned char* lds;
    int tid, lane, wave, vcu, bx;
    float zf; unsigned zu;
};
__device__ __forceinline__ float lshfl(float v, int src) { return __builtin_bit_cast(float, __builtin_amdgcn_ds_bpermute(src << 2, __builtin_bit_cast(int, v))); }
#define SHFL_XOR(v, o) lshfl((v), F.lane ^ (o))
#define SHFL_UP(v, o) lshfl((v), F.lane - (o))
#define SHFL_IDX(v, i) lshfl((v), (i))
__device__ __forceinline__ float wave_sum_l(float v, int lane) {
#pragma unroll
    for (int o = 1; o < 64; o <<= 1) v += lshfl(v, lane ^ o);
    return v;
}
#define wave_sum(v) wave_sum_l((v), F.lane)
#define WG_BAR() __syncthreads()
__device__ __forceinline__ void stagger(int cls, int ticks) {
    if (cls) { const unsigned long long tgt = __builtin_amdgcn_s_memrealtime() + (unsigned long long)(cls * ticks);
        while (__builtin_amdgcn_s_memrealtime() < tgt) __builtin_amdgcn_s_sleep(16); }
}
#ifdef USE_STAGGER
#define STAGGER(ticks) stagger((F.bx >> 3) & 3, (ticks))
#else
#define STAGGER(ticks) do {} while (0)
#endif
__device__ __forceinline__ unsigned char* ld_ptr(LAS unsigned char* lds, int i) {
    const unsigned long long v = ((const LAS unsigned long long*)(lds + PTAB_OFF))[i];
    const unsigned lo = __builtin_amdgcn_readfirstlane((unsigned)v), hi = __builtin_amdgcn_readfirstlane((unsigned)(v >> 32));
    return (unsigned char*)(__attribute__((address_space(1))) unsigned char*)(uintptr_t)(((unsigned long long)hi << 32) | lo);
}

constexpr int XP_SCR = 64 * 65 * 4;
template <bool F8 = false> __device__ __forceinline__ void xpose_item(const float* W, int ldsrc, int srccol4, int k0, bf16_t* WT, int K, int drow0, LAS float* scr, int lane, const float* gain, float zf = 0.f) {
    f32x4 v[16];
    const int r = lane >> 4, c4 = 4 * (lane & 15);
#pragma unroll
    for (int i = 0; i < 16; ++i) v[i] = (srccol4 >= 0) ? __builtin_nontemporal_load((const f32x4*)(W + (size_t)(k0 + 4 * i + r) * ldsrc + srccol4)) : (f32x4){zf, zf, zf, zf};
    if (gain) {
#pragma unroll
        for (int i = 0; i < 16; ++i) v[i] = v[i] * gain[k0 + 4 * i + r]; }
#pragma unroll
    for (int i = 0; i < 16; ++i) { LAS float* s = scr + (4 * i + r) * 65 + c4; s[0] = v[i].x; s[1] = v[i].y; s[2] = v[i].z; s[3] = v[i].w; }
    asm volatile("s_waitcnt lgkmcnt(0)" ::: "memory");
    const int c = lane & 7;
#pragma unroll
    for (int j = 0; j < 8; ++j) { const int n = (lane >> 3) + 8 * j; const LAS float* s = scr + (8 * c) * 65 + n;
        if constexpr (F8) { u32x2 o; o.x = pk4_fp8(s[0 * 65] * W8_SCALE, s[1 * 65] * W8_SCALE, s[2 * 65] * W8_SCALE, s[3 * 65] * W8_SCALE); o.y = pk4_fp8(s[4 * 65] * W8_SCALE, s[5 * 65] * W8_SCALE, s[6 * 65] * W8_SCALE, s[7 * 65] * W8_SCALE);
            __builtin_nontemporal_store(o, (u32x2*)((unsigned char*)WT + (size_t)(drow0 + n) * K + k0 + 8 * c)); }
        else { u32x4 o; o.x = pk2(s[0 * 65], s[1 * 65]); o.y = pk2(s[2 * 65], s[3 * 65]); o.z = pk2(s[4 * 65], s[5 * 65]); o.w = pk2(s[6 * 65], s[7 * 65]);
            __builtin_nontemporal_store(o, (u32x4*)(WT + (size_t)(drow0 + n) * K + k0 + 8 * c)); } }
    asm volatile("s_waitcnt lgkmcnt(0)" ::: "memory");
}
__device__ __forceinline__ int win_srccol(int d) {
    if (d < 2048) return d;
    if (d < 3072) return 2056 + (d - 2048);
    if (d < 4608) return 3080 + (d - 3072);
    if (d < 6144) return 4632 + (d - 4608);
    if (d < 6152) return 2048 + (d - 6144);
    if (d < 6168) return 4616 + (d - 6152);
    return -1;
}
template <bool F8 = false> __device__ __forceinline__ void xpose_plain(Frame& F, const float* W, int K, int N, bf16_t* WT, LAS float* scr, int gw, int NGW, const float* gain) {
    const int nblk = N / 64, items = (K / 64) * nblk;
    for (int it = gw; it < items; it += NGW) { const int kb = it / nblk, nb = it % nblk; xpose_item<F8>(W, N, nb * 64 + 4 * (F.lane & 15), kb * 64, WT, K, nb * 64, scr, F.lane, gain); }
}
__device__ __forceinline__ void xpose_gu(Frame& F, const float* Wg, const float* Wu, int K, int N, bf16_t* WT, LAS float* scr, int gw, int NGW, const float* gain) {
    const int nblk = 2 * N / 64, items = (K / 64) * nblk;
    for (int it = gw; it < items; it += NGW) { const int kb = it / nblk, nb = it % nblk; const int drow0 = nb * 64, tile = drow0 >> 8, within = drow0 & 255;
        const float* W = within < 128 ? Wg : Wu; const int sc = tile * 128 + (within & 127) + 4 * (F.lane & 15);
        xpose_item<true>(W, N, sc, kb * 64, WT, K, drow0, scr, F.lane, gain); }
}
__device__ __forceinline__ float load_row_ssq(Frame& F, const float* xrow, f32x4 (&v)[8]) {
    const f32x4* xr = (const f32x4*)xrow + F.lane; float s = 0.f;
#pragma unroll
    for (int j = 0; j < 8; ++j) { v[j] = xr[64 * j]; s += (v[j].x * v[j].x + v[j].y * v[j].y) + (v[j].z * v[j].z + v[j].w * v[j].w); }
    return wave_sum(s);
}
__device__ __forceinline__ float load_row16_ssq(Frame& F, const bf16_t* xrow, float (&v)[4][8]) {
    const u32x4* xr = (const u32x4*)xrow + F.lane; float s = 0.f;
#pragma unroll
    for (int j = 0; j < 4; ++j) { const u32x4 w = xr[64 * j]; v[j][0] = bflo(w.x); v[j][1] = bfhi(w.x); v[j][2] = bflo(w.y); v[j][3] = bfhi(w.y); v[j][4] = bflo(w.z); v[j][5] = bfhi(w.z); v[j][6] = bflo(w.w); v[j][7] = bfhi(w.w);
#pragma unroll
        for (int i = 0; i < 8; ++i) s += v[j][i] * v[j][i]; }
    return wave_sum(s);
}
typedef short v4i16_t __attribute__((ext_vector_type(4)));
__device__ __forceinline__ f32x4 mfma16(bf16x8 a, bf16x8 b, f32x4 c) { return __builtin_amdgcn_mfma_f32_16x16x32_bf16(a, b, c, 0, 0, 0); }
__device__ __forceinline__ s16x4 tr_read(const LAS unsigned char* p) { return __builtin_bit_cast(s16x4, __builtin_amdgcn_ds_read_tr16_b64_v4i16((LAS v4i16_t*)p)); }
__device__ __forceinline__ bf16x8 cat4(s16x4 a, s16x4 b) { return (bf16x8){a[0], a[1], a[2], a[3], b[0], b[1], b[2], b[3]}; }
__device__ __forceinline__ bf16x8 pack8f(const float (&v)[8]) { u32x4 w; w.x = pk2(v[0], v[1]); w.y = pk2(v[2], v[3]); w.z = pk2(v[4], v[5]); w.w = pk2(v[6], v[7]); return __builtin_bit_cast(bf16x8, w); }
__device__ __forceinline__ float softplusf_(float x) { return x > 20.f ? x : __logf(1.0f + __expf(x)); }
__device__ __forceinline__ float logsigmoidf_(float x) { return fminf(x, 0.f) - __logf(1.0f + __expf(-fabsf(x))); }

constexpr int SLD = 272;

constexpr int NCV = 2560;
#define CONV_LOAD(it_, arr) do { const int cg_ = (it_) % 320, tb_ = ((it_) / 320) & 127, b_ = (it_) / (320 * 128); \
        const int uc_ = cg_ < 128 ? 8 * cg_ : UXBC + (8 * cg_ - 1024); const bf16_t* up_ = U + ((size_t)b_ * SEQ + tb_ * 16) * NU + uc_; \
        if (tb_ > 0) { arr[0] = *(const u32x4*)(up_ - 3 * (ptrdiff_t)NU); arr[1] = *(const u32x4*)(up_ - 2 * (ptrdiff_t)NU); arr[2] = *(const u32x4*)(up_ - (ptrdiff_t)NU); } \
        else { arr[0] = (u32x4){F.zu, F.zu, F.zu, F.zu}; arr[1] = arr[0]; arr[2] = arr[0]; } \
        _Pragma("unroll") for (int t_ = 0; t_ < 16; ++t_) arr[3 + t_] = *(const u32x4*)(up_ + (size_t)t_ * NU); } while (0)
__device__ __forceinline__ void conv_phase(Frame& F, const bf16_t* __restrict__ U, bf16_t* __restrict__ CV, const float* __restrict__ mcw, const float* __restrict__ mcb, const float* __restrict__ scw, const float* __restrict__ scb) {
    LAS float* cw = (LAS float*)F.lds;
    WG_BAR();
    {
        f32x4 vm[3], vs[4];
#pragma unroll
        for (int it = 0; it < 3; ++it) { const int idx = F.tid + NTHR * it; if (idx < 5 * 256) { const int j = idx >> 8, c4 = idx & 255; vm[it] = *(const f32x4*)((j < 4 ? mcw + j * 1024 : mcb) + 4 * c4); } }
#pragma unroll
        for (int it = 0; it < 4; ++it) { const int idx = F.tid + NTHR * it; if (idx < 5 * 384) { const int j = idx / 384, c4 = idx % 384; vs[it] = *(const f32x4*)((j < 4 ? scw + j * 1536 : scb) + 4 * c4); } }
#pragma unroll
        for (int it = 0; it < 3; ++it) { const int idx = F.tid + NTHR * it; if (idx < 5 * 256) { const int j = idx >> 8, c4 = idx & 255; *(LAS f32x4*)(cw + j * 2560 + 4 * c4) = vm[it]; } }
#pragma unroll
        for (int it = 0; it < 4; ++it) { const int idx = F.tid + NTHR * it; if (idx < 5 * 384) { const int j = idx / 384, c4 = idx % 384; *(LAS f32x4*)(cw + j * 2560 + 1024 + 4 * c4) = vs[it]; } }
    }
    WG_BAR();
    const int gt = F.vcu * NTHR + F.tid; constexpr int STRIDE = NWG * NTHR, NIT = NB * 128 * 320 / STRIDE;
    static_assert(NIT * STRIDE == NB * 128 * 320, "conv items divide evenly");
    u32x4 cur[19], nxt[19];
    CONV_LOAD(gt, cur);
#pragma unroll 1
    for (int k = 0; k < NIT; ++k) {
        unsigned zl_ = 0u; asm volatile("" : "+s"(zl_)); const int ln_ = (int)__builtin_amdgcn_mbcnt_hi(~0u, __builtin_amdgcn_mbcnt_lo(~0u, zl_));
        const int it = F.vcu * NTHR + F.wave * 64 + k * STRIDE + ln_; const int cg = it % 320, tb = (it / 320) & 127, b = it / (320 * 128); const int cvcol = 8 * cg;
        if (k + 1 < NIT) CONV_LOAD(it + STRIDE, nxt);
        f32x2 wt[4][4], bs[4];
#pragma unroll
        for (int j = 0; j < 4; ++j) { const f32x4 a = *(const LAS f32x4*)(cw + j * 2560 + cvcol), c2 = *(const LAS f32x4*)(cw + j * 2560 + cvcol + 4);
            wt[j][0] = (f32x2){a[0], a[1]}; wt[j][1] = (f32x2){a[2], a[3]}; wt[j][2] = (f32x2){c2[0], c2[1]}; wt[j][3] = (f32x2){c2[2], c2[3]}; }
        { const f32x4 a = *(const LAS f32x4*)(cw + 4 * 2560 + cvcol), c2 = *(const LAS f32x4*)(cw + 4 * 2560 + cvcol + 4); bs[0] = (f32x2){a[0], a[1]}; bs[1] = (f32x2){a[2], a[3]}; bs[2] = (f32x2){c2[0], c2[1]}; bs[3] = (f32x2){c2[2], c2[3]}; }
        const float sc = (cg >= 64 && cg < 128) ? 0.08838834764831845f : 1.0f;
        bf16_t* op = CV + ((size_t)b * SEQ + tb * 16) * NCV + cvcol;
        f32x2 h0[4], h1[4], h2[4];
#pragma unroll
        for (int i = 0; i < 4; ++i) { h0[i] = (f32x2){bflo(cur[0][i]), bfhi(cur[0][i])}; h1[i] = (f32x2){bflo(cur[1][i]), bfhi(cur[1][i])}; h2[i] = (f32x2){bflo(cur[2][i]), bfhi(cur[2][i])}; }
#pragma unroll
        for (int t = 0; t < 16; ++t) {
            f32x2 h3[4], y[4];
#pragma unroll
            for (int i = 0; i < 4; ++i) { h3[i] = (f32x2){bflo(cur[3 + t][i]), bfhi(cur[3 + t][i])};
                f32x2 a = bs[i] + h0[i] * wt[0][i]; a = a + h1[i] * wt[1][i]; a = a + h2[i] * wt[2][i]; a = a + h3[i] * wt[3][i];
                const f32x2 e = a * (-1.4426950408889634f); f32x2 d; d.x = __builtin_amdgcn_exp2f(e.x); d.y = __builtin_amdgcn_exp2f(e.y); d = d + 1.0f;
                f32x2 r; r.x = __builtin_amdgcn_rcpf(d.x); r.y = __builtin_amdgcn_rcpf(d.y); y[i] = (a * sc) * r; }
            u32x4 o; o.x = pk2(y[0].x, y[0].y); o.y = pk2(y[1].x, y[1].y); o.z = pk2(y[2].x, y[2].y); o.w = pk2(y[3].x, y[3].y);
            *(u32x4*)(op + (size_t)t * NCV) = o;
#pragma unroll
            for (int i = 0; i < 4; ++i) { h0[i] = h1[i]; h1[i] = h2[i]; h2[i] = h3[i]; }
        }
        if (k + 1 < NIT) {
#pragma unroll
            for (int i = 0; i < 19; ++i) cur[i] = nxt[i]; }
    }
}
#undef CONV_LOAD

constexpr int XLD = 144;
constexpr int SS_Z = 110592;
constexpr int SS_CM = 0, SS_BM = 34816, SS_X = 69632, SS_HB = 88064, SS_F = 105472;
__device__ __forceinline__ void ssd_unit(Frame& F, int b, int hh, const bf16_t* __restrict__ U, const bf16_t* __restrict__ CV, bf16_t* __restrict__ MIX, float* __restrict__ SSQS,
                                         const float* __restrict__ dt_bias, const float* __restrict__ a_log, const float* __restrict__ d_skip) {
    LAS unsigned char* L = F.lds;
    const int tid = F.tid, lane = F.lane, w = F.wave, c16 = lane & 15, g4 = lane >> 4, grp = hh >> 3;
    WG_BAR();
    for (int i = tid; i < 64 * SLD / 4; i += NTHR) ((LAS unsigned*)(L + SS_HB))[i] = 0u;
    const float Aneg = -__expf(a_log[hh]), dtb = dt_bias[hh], Dsk = d_skip[hh];
    f32x4 hst[4];
#pragma unroll
    for (int i = 0; i < 4; ++i) hst[i] = (f32x4){F.zf, F.zf, F.zf, F.zf};
    const bf16_t* cvb = CV + (size_t)b * SEQ * NCV + 1024;
    u32x4 pc[4], pb_[4], px[2], pz[2]; unsigned graw0 = 0, graw1 = 0;
#define SSD_PREFETCH(cc) do { const size_t r0_ = (size_t)(cc) * 128; \
        _Pragma("unroll") for (int i = 0; i < 4; ++i) { const int q_ = tid + 512 * i; pc[i] = *(const u32x4*)(cvb + (r0_ + (q_ >> 4)) * NCV + 1280 + grp * 128 + 8 * (q_ & 15)); pb_[i] = *(const u32x4*)(cvb + (r0_ + (q_ >> 4)) * NCV + 1024 + grp * 128 + 8 * (q_ & 15)); } \
        _Pragma("unroll") for (int i = 0; i < 2; ++i) { const int q_ = tid + 512 * i; px[i] = *(const u32x4*)(cvb + (r0_ + (q_ >> 3)) * NCV + hh * 64 + 8 * (q_ & 7)); \
            pz[i] = *(const u32x4*)(U + ((size_t)b * SEQ + r0_ + (q_ >> 3)) * NU + UZ + hh * 64 + 8 * (q_ & 7)); } \
        if (w == 0) { graw0 = U[((size_t)b * SEQ + r0_ + lane) * NU + UDT + hh]; graw1 = U[((size_t)b * SEQ + r0_ + 64 + lane) * NU + UDT + hh]; } } while (0)
#define SSD_PF_CB(cc, i) do { const size_t r0_ = (size_t)(cc) * 128; int tq_ = tid; asm volatile("" : "+v"(tq_)); const int q_ = tq_ + 512 * (i); pc[i] = *(const u32x4*)(cvb + (r0_ + (q_ >> 4)) * NCV + 1280 + grp * 128 + 8 * (q_ & 15)); pb_[i] = *(const u32x4*)(cvb + (r0_ + (q_ >> 4)) * NCV + 1024 + grp * 128 + 8 * (q_ & 15)); } while (0)
#define SSD_PF_X(cc) do { const size_t r0_ = (size_t)(cc) * 128; int tq_ = tid; asm volatile("" : "+v"(tq_)); \
        _Pragma("unroll") for (int i = 0; i < 2; ++i) { const int q_ = tq_ + 512 * i; px[i] = *(const u32x4*)(cvb + (r0_ + (q_ >> 3)) * NCV + hh * 64 + 8 * (q_ & 7)); } \
        if (w == 0) { graw0 = U[((size_t)b * SEQ + r0_ + lane) * NU + UDT + hh]; graw1 = U[((size_t)b * SEQ + r0_ + 64 + lane) * NU + UDT + hh]; } } while (0)
#define SSD_GATES(buf) do { LAS float* fa_ = (LAS float*)(L + SS_F) + (buf) * 512; \
        const float dt0 = softplusf_(bf1((bf16_t)graw0) + dtb), dt1 = softplusf_(bf1((bf16_t)graw1) + dtb); float s0 = dt0 * Aneg, s1 = dt1 * Aneg; \
        _Pragma("unroll") for (int o = 1; o < 64; o <<= 1) { const float x0 = SHFL_UP(s0, o), x1 = SHFL_UP(s1, o); if (lane >= o) { s0 += x0; s1 += x1; } } \
        s1 += SHFL_IDX(s0, 63); const float tot = SHFL_IDX(s1, 63); \
        fa_[lane] = s0; fa_[64 + lane] = s1; fa_[128 + lane] = dt0; fa_[192 + lane] = dt1; fa_[256 + lane] = __expf(tot - s0) * dt0; fa_[320 + lane] = __expf(tot - s1) * dt1; fa_[384 + lane] = __expf(s0); fa_[448 + lane] = __expf(s1); } while (0)
    SSD_PREFETCH(0);
    if (w == 0) SSD_GATES(0);
#ifdef PROBE_ML
    unsigned long long pmt = 0, pa[7] = {0, 0, 0, 0, 0, 0, 0}; const unsigned long long pc0 = __builtin_amdgcn_s_memtime(), pr0 = __builtin_amdgcn_s_memrealtime();
#define PST(k) do { const unsigned long long t_ = __builtin_amdgcn_s_memrealtime(); pa[k] += t_ - pmt; pmt = t_; } while (0)
#endif
    for (int c = 0; c < 16; ++c) {
        const size_t row0 = (size_t)b * SEQ + c * 128;
#ifdef PROBE_ML
        pmt = __builtin_amdgcn_s_memrealtime();
#endif
#pragma unroll
        for (int i = 0; i < 4; ++i) { const int q_ = tid + 512 * i; *(LAS u32x4*)(L + SS_CM + (q_ >> 4) * SLD + (q_ & 15) * 16) = pc[i]; *(LAS u32x4*)(L + SS_BM + (q_ >> 4) * SLD + (q_ & 15) * 16) = pb_[i]; }
#pragma unroll
        for (int i = 0; i < 2; ++i) { const int q_ = tid + 512 * i; *(LAS u32x4*)(L + SS_X + (q_ >> 3) * XLD + (q_ & 7) * 16) = px[i]; *(LAS u32x4*)(L + SS_Z + (q_ >> 3) * XLD + (q_ & 7) * 16) = pz[i]; }
        WG_BAR();
#ifdef PROBE_ML
        PST(0);
#endif
        {
            const LAS float* fa = (const LAS float*)(L + SS_F) + (c & 1) * 512; const LAS float* fdt = fa + 128; const LAS float* fwdt = fa + 256; const LAS float* feac = fa + 384;
            const int l = 16 * w + c16; const size_t row = row0 + l;
#ifdef PROBE_ML
            PST(6);
#endif
            f32x4 accd[4], acco[4];
#pragma unroll
            for (int i = 0; i < 4; ++i) accd[i] = (f32x4){F.zf, F.zf, F.zf, F.zf};
            const float acl = fa[l]; const int q = c16 >> 2, pp = c16 & 3;
            bf16x8 cfr[4];
#pragma unroll
            for (int kn = 0; kn < 4; ++kn) cfr[kn] = *(const LAS bf16x8*)(L + SS_CM + (16 * w + c16) * SLD + (32 * kn + 8 * g4) * 2);
            for (int ks = 0; ks <= (w >> 1); ++ks) {
                float mv[8];
#pragma unroll
                for (int half = 0; half < 2; ++half) {
                    bf16x8 a0[4];
#pragma unroll
                    for (int kn = 0; kn < 4; ++kn) a0[kn] = *(const LAS bf16x8*)(L + SS_BM + (32 * ks + 16 * half + c16) * SLD + (32 * kn + 8 * g4) * 2);
                    const f32x4 fa0 = *(const LAS f32x4*)(fa + 32 * ks + 16 * half + 4 * g4), fd0 = *(const LAS f32x4*)(fdt + 32 * ks + 16 * half + 4 * g4);
                    __builtin_amdgcn_sched_barrier(0);
                    f32x4 gt0 = (f32x4){F.zf, F.zf, F.zf, F.zf};
#pragma unroll
                    for (int kn = 0; kn < 4; ++kn) gt0 = mfma16(a0[kn], cfr[kn], gt0);
#pragma unroll
                    for (int r = 0; r < 4; ++r) { const int s0 = 32 * ks + 16 * half + 4 * g4 + r; const float v0 = gt0[r] * __expf(acl - fa0[r]) * fd0[r]; mv[4 * half + r] = (s0 <= l) ? v0 : 0.f; }
                }
                s16x4 tA[4], tB[4];
#pragma unroll
                for (int pb = 0; pb < 4; ++pb) { tA[pb] = tr_read(L + SS_X + (32 * ks + 4 * g4 + q) * XLD + (16 * pb + 4 * pp) * 2); tB[pb] = tr_read(L + SS_X + (32 * ks + 16 + 4 * g4 + q) * XLD + (16 * pb + 4 * pp) * 2); }
                __builtin_amdgcn_sched_barrier(0);
                const bf16x8 bfrag = pack8f(mv);
#pragma unroll
                for (int pb = 0; pb < 4; ++pb) accd[pb] = mfma16(cat4(tA[pb], tB[pb]), bfrag, accd[pb]);
            }
            __builtin_amdgcn_sched_barrier(0);
            if (c + 1 < 16) SSD_PREFETCH(c + 1);
            __builtin_amdgcn_sched_barrier(0);
#pragma unroll
            for (int i = 0; i < 4; ++i) acco[i] = (f32x4){F.zf, F.zf, F.zf, F.zf};
#ifdef PROBE_ML
            PST(1);
#endif
#pragma unroll
            for (int kn = 0; kn < 4; ++kn) {
#pragma unroll
                for (int pb = 0; pb < 4; ++pb) { const bf16x8 a = *(const LAS bf16x8*)(L + SS_HB + (16 * pb + c16) * SLD + (32 * kn + 8 * g4) * 2); acco[pb] = mfma16(a, cfr[kn], acco[pb]); } }
#ifdef PROBE_ML
            PST(2);
#endif
            const float el = feac[l]; float ssq = 0.f;
#pragma unroll
            for (int pb = 0; pb < 4; ++pb) { const int p0 = 16 * pb + 4 * g4;
                const u32x2 zw = *(const LAS u32x2*)(L + SS_Z + l * XLD + p0 * 2); const float z[4] = {bflo(zw.x), bfhi(zw.x), bflo(zw.y), bfhi(zw.y)}; float o[4];
                const u32x2 xw = *(const LAS u32x2*)(L + SS_X + l * XLD + p0 * 2); const float xv[4] = {bflo(xw.x), bfhi(xw.x), bflo(xw.y), bfhi(xw.y)};
#pragma unroll
                for (int r = 0; r < 4; ++r) { const float y = accd[pb][r] + el * acco[pb][r] + Dsk * xv[r]; o[r] = y * siluf_(z[r]); ssq += o[r] * o[r]; }
                u32x2 ow; ow.x = pk2(o[0], o[1]); ow.y = pk2(o[2], o[3]); *(u32x2*)(MIX + row * 2048 + MIXS + hh * 64 + p0) = ow; }
            ssq += SHFL_XOR(ssq, 16); ssq += SHFL_XOR(ssq, 32);
            if (g4 == 0) SSQS[row * 16 + hh] = ssq;
#ifdef PROBE_ML
            PST(3);
#endif
            const float dec = feac[127];
#pragma unroll
            for (int pb = 0; pb < 4; ++pb) hst[pb] = hst[pb] * dec;
#pragma unroll
            for (int ks = 0; ks < 4; ++ks) {
                const s16x4 tA = tr_read(L + SS_BM + (32 * ks + 8 * g4 + q) * SLD + (16 * w + 4 * pp) * 2), tB = tr_read(L + SS_BM + (32 * ks + 8 * g4 + 4 + q) * SLD + (16 * w + 4 * pp) * 2);
                const f32x4 w0 = *(const LAS f32x4*)(fwdt + 32 * ks + 8 * g4), w1 = *(const LAS f32x4*)(fwdt + 32 * ks + 8 * g4 + 4);
                s16x4 xA[4], xB[4];
#pragma unroll
                for (int pb = 0; pb < 4; ++pb) { xA[pb] = tr_read(L + SS_X + (32 * ks + 8 * g4 + q) * XLD + (16 * pb + 4 * pp) * 2); xB[pb] = tr_read(L + SS_X + (32 * ks + 8 * g4 + 4 + q) * XLD + (16 * pb + 4 * pp) * 2); }
                const float bv[8] = {bf1((bf16_t)tA[0]) * w0[0], bf1((bf16_t)tA[1]) * w0[1], bf1((bf16_t)tA[2]) * w0[2], bf1((bf16_t)tA[3]) * w0[3], bf1((bf16_t)tB[0]) * w1[0], bf1((bf16_t)tB[1]) * w1[1], bf1((bf16_t)tB[2]) * w1[2], bf1((bf16_t)tB[3]) * w1[3]};
                const bf16x8 bfrag = pack8f(bv);
#pragma unroll
                for (int pb = 0; pb < 4; ++pb) hst[pb] = mfma16(cat4(xA[pb], xB[pb]), bfrag, hst[pb]);
            }
            if (w == 0 && c + 1 < 16) SSD_GATES((c + 1) & 1);
        }
#ifdef PROBE_ML
        PST(4);
#endif
        WG_BAR();
#pragma unroll
        for (int pb = 0; pb < 4; ++pb)
#pragma unroll
            for (int r = 0; r < 4; ++r) *(LAS bf16_t*)(L + SS_HB + (16 * pb + 4 * g4 + r) * SLD + (16 * w + c16) * 2) = f2bf(hst[pb][r]);
#ifdef PROBE_ML
        PST(5);
#endif
    }
#ifdef PROBE_ML
    if (F.bx == 0 && lane == 0) { unsigned long long* dg = (unsigned long long*)((unsigned char*)MIX - WS_MIX + 2883584); for (int k = 0; k < 7; ++k) dg[32 + 8 * w + k] = pa[k]; if (w == 7) { const unsigned long long dc = __builtin_amdgcn_s_memtime() - pc0, dr = __builtin_amdgcn_s_memrealtime() - pr0; dg[120] = dc * 400ull / dr; dg[121] = dr; } }
#endif
#undef SSD_PREFETCH
#undef SSD_PF_CB
#undef SSD_PF_X
#undef SSD_GATES
}

constexpr int VL2 = 80;
constexpr int ML_Q = 0, ML_K = 17408, ML_V = 34816, ML_CB = 39936, ML_F = 48640;
__device__ __forceinline__ void mlstm_unit(Frame& F, int b, int h, int vs, const bf16_t* __restrict__ U, const bf16_t* __restrict__ CV, bf16_t* __restrict__ MIX, float* __restrict__ SSQM, const float* __restrict__ gate_b) {
    LAS unsigned char* L = F.lds;
    const int tid = F.tid, lane = F.lane, w = F.wave, c16 = lane & 15, g4 = lane >> 4;
    LAS float* fbase = (LAS float*)(L + ML_F); LAS float* fnvec = fbase + 768;
    WG_BAR();
    for (int i = tid; i < 32 * SLD / 4; i += NTHR) ((LAS unsigned*)(L + ML_CB))[i] = 0u;
    if (tid < 128) fnvec[tid] = 0.f;
    const float bi = gate_b[h], bfg = gate_b[4 + h];
    float m_prev = 0.f;
    f32x4 cst[2], nacc; cst[0] = (f32x4){F.zf, F.zf, F.zf, F.zf}; cst[1] = cst[0]; nacc = cst[0];
    const bf16_t* cvq = CV + (size_t)b * SEQ * NCV + h * 128; const bf16_t* uv = U + (size_t)b * SEQ * NU + UV + h * 128 + vs * 32;
    u32x4 pq[2], pkk[2], pvv; unsigned gri = 0, grf = 0;
#define ML_PREFETCH(cc) do { const size_t r0_ = (size_t)(cc) * 64; \
        _Pragma("unroll") for (int i = 0; i < 2; ++i) { const int q_ = tid + 512 * i; pq[i] = *(const u32x4*)(cvq + (r0_ + (q_ >> 4)) * NCV + 8 * (q_ & 15)); pkk[i] = *(const u32x4*)(cvq + (r0_ + (q_ >> 4)) * NCV + 512 + 8 * (q_ & 15)); } \
        if (tid < 256) pvv = *(const u32x4*)(uv + (r0_ + (tid >> 2)) * NU + 8 * (tid & 3)); \
        if (w == 0) { gri = U[((size_t)b * SEQ + r0_ + lane) * NU + UMI + h]; grf = U[((size_t)b * SEQ + r0_ + lane) * NU + UMF + h]; } } while (0)
#define ML_GATES(buf) do { LAS float* fg_ = fbase + (buf) * 384; \
        const float li = bf1((bf16_t)gri) + bi, lf = logsigmoidf_(bf1((bf16_t)grf) + bfg); float bc = lf; \
        _Pragma("unroll") for (int o = 1; o < 64; o <<= 1) { const float x = SHFL_UP(bc, o); if (lane >= o) bc += x; } \
        const float total = SHFL_IDX(bc, 63), ct = li - bc; float cm = ct; \
        _Pragma("unroll") for (int o = 1; o < 64; o <<= 1) { const float x = SHFL_UP(cm, o); if (lane >= o) cm = fmaxf(cm, x); } \
        const float mj = bc + fmaxf(m_prev, cm); \
        fg_[lane] = bc - mj; fg_[64 + lane] = ct; fg_[128 + lane] = __expf(bc + m_prev - mj); fg_[192 + lane] = __expf(-mj); \
        const float m_new = total + fmaxf(m_prev, SHFL_IDX(cm, 63)); \
        fg_[256 + lane] = __expf(total - m_new + ct); if (lane == 0) fg_[320] = __expf(total + m_prev - m_new); \
        m_prev = m_new; } while (0)
    ML_PREFETCH(0);
    if (w == 0) ML_GATES(0);
#ifdef PROBE_ML
    unsigned long long pm0 = 0, pm1 = 0, pm2 = 0, pa1 = 0, pa2 = 0, pa3 = 0;
#endif
    for (int c = 0; c < 32; ++c) {
        const size_t row0 = (size_t)b * SEQ + c * 64;
#ifdef PROBE_ML
        pm0 = __builtin_amdgcn_s_memrealtime();
#endif
#pragma unroll
        for (int i = 0; i < 2; ++i) { const int q_ = tid + 512 * i; *(LAS u32x4*)(L + ML_Q + (q_ >> 4) * SLD + (q_ & 15) * 16) = pq[i]; *(LAS u32x4*)(L + ML_K + (q_ >> 4) * SLD + (q_ & 15) * 16) = pkk[i]; }
        if (tid < 256) *(LAS u32x4*)(L + ML_V + (tid >> 2) * VL2 + (tid & 3) * 16) = pvv;
        WG_BAR();
#ifdef PROBE_ML
        pm1 = __builtin_amdgcn_s_memrealtime(); pa1 += pm1 - pm0;
#endif
        if (c + 1 < 32) ML_PREFETCH(c + 1);
        {
            const LAS float* frow = fbase + (c & 1) * 384; const LAS float* fcol = frow + 64; const LAS float* fsint = frow + 128; const LAS float* femj = frow + 192; const LAS float* favec = frow + 256;
            const int jb = w & 3, vb = w >> 2; const int j = 16 * jb + c16; const float rt = frow[j]; const int q = c16 >> 2, pp = c16 & 3;
            f32x4 accD = (f32x4){F.zf, F.zf, F.zf, F.zf}, accI = accD; float dsum = 0.f;
            bf16x8 qfr[4];
#pragma unroll
            for (int kk = 0; kk < 4; ++kk) qfr[kk] = *(const LAS bf16x8*)(L + ML_Q + (16 * jb + c16) * SLD + (32 * kk + 8 * g4) * 2);
            for (int ks = 0; ks <= (jb >> 1); ++ks) {
                float mv[8];
#pragma unroll
                for (int half = 0; half < 2; ++half) {
                    bf16x8 a0[4];
#pragma unroll
                    for (int kk = 0; kk < 4; ++kk) a0[kk] = *(const LAS bf16x8*)(L + ML_K + (32 * ks + 16 * half + c16) * SLD + (32 * kk + 8 * g4) * 2);
                    const f32x4 fc0 = *(const LAS f32x4*)(fcol + 32 * ks + 16 * half + 4 * g4);
                    __builtin_amdgcn_sched_barrier(0);
                    f32x4 st = (f32x4){F.zf, F.zf, F.zf, F.zf};
#pragma unroll
                    for (int kk = 0; kk < 4; ++kk) st = mfma16(a0[kk], qfr[kk], st);
#pragma unroll
                    for (int r = 0; r < 4; ++r) { const int s = 32 * ks + 16 * half + 4 * g4 + r; float v = st[r] * __expf(rt + fc0[r]); v = (s <= j) ? v : 0.f; mv[4 * half + r] = v; dsum += v; }
                }
                const s16x4 tA = tr_read(L + ML_V + (32 * ks + 4 * g4 + q) * VL2 + (16 * vb + 4 * pp) * 2), tB = tr_read(L + ML_V + (32 * ks + 16 + 4 * g4 + q) * VL2 + (16 * vb + 4 * pp) * 2);
                const bf16x8 bfrag = pack8f(mv);
                accD = mfma16(cat4(tA, tB), bfrag, accD);
            }
            {
                bf16x8 cf[4];
#pragma unroll
                for (int kk = 0; kk < 4; ++kk) cf[kk] = *(const LAS bf16x8*)(L + ML_CB + (16 * vb + c16) * SLD + (32 * kk + 8 * g4) * 2);
                __builtin_amdgcn_sched_barrier(0);
#pragma unroll
                for (int kk = 0; kk < 4; ++kk) accI = mfma16(cf[kk], qfr[kk], accI);
            }
            float nq = 0.f;
#pragma unroll
            for (int i = 0; i < 4; ++i) { const u32x4 qr = *(const LAS u32x4*)(L + ML_Q + (16 * jb + c16) * SLD + (32 * g4 + 8 * i) * 2);
                const f32x4 n0 = *(const LAS f32x4*)(fnvec + 32 * g4 + 8 * i), n1 = *(const LAS f32x4*)(fnvec + 32 * g4 + 8 * i + 4);
                nq += bflo(qr.x) * n0[0] + bfhi(qr.x) * n0[1] + bflo(qr.y) * n0[2] + bfhi(qr.y) * n0[3] + bflo(qr.z) * n1[0] + bfhi(qr.z) * n1[1] + bflo(qr.w) * n1[2] + bfhi(qr.w) * n1[3]; }
            nq += SHFL_XOR(nq, 16); nq += SHFL_XOR(nq, 32);
            dsum += SHFL_XOR(dsum, 16); dsum += SHFL_XOR(dsum, 32);
            const float si = fsint[j]; const float den = si * nq + dsum; const float inv = 1.0f / fmaxf(fabsf(den), femj[j]);
            const size_t row = row0 + j; float o[4], ssq = 0.f;
#pragma unroll
            for (int r = 0; r < 4; ++r) { o[r] = (si * accI[r] + accD[r]) * inv; ssq += o[r] * o[r]; }
            u32x2 ow; ow.x = pk2(o[0], o[1]); ow.y = pk2(o[2], o[3]); *(u32x2*)(MIX + row * 2048 + MIXM + h * 128 + vs * 32 + 16 * vb + 4 * g4) = ow;
            ssq += SHFL_XOR(ssq, 16); ssq += SHFL_XOR(ssq, 32);
            if (g4 == 0) SSQM[row * 32 + h * 8 + vs * 2 + vb] = ssq;
            const float dec = frow[320];
            cst[0] = cst[0] * dec; cst[1] = cst[1] * dec; nacc = nacc * dec;
#pragma unroll
            for (int ks = 0; ks < 2; ++ks) {
                const s16x4 tA = tr_read(L + ML_K + (32 * ks + 8 * g4 + q) * SLD + (16 * w + 4 * pp) * 2), tB = tr_read(L + ML_K + (32 * ks + 8 * g4 + 4 + q) * SLD + (16 * w + 4 * pp) * 2);
                const f32x4 w0 = *(const LAS f32x4*)(favec + 32 * ks + 8 * g4), w1 = *(const LAS f32x4*)(favec + 32 * ks + 8 * g4 + 4);
                s16x4 xA[2], xB[2];
#pragma unroll
                for (int vb2 = 0; vb2 < 2; ++vb2) { xA[vb2] = tr_read(L + ML_V + (32 * ks + 8 * g4 + q) * VL2 + (16 * vb2 + 4 * pp) * 2); xB[vb2] = tr_read(L + ML_V + (32 * ks + 8 * g4 + 4 + q) * VL2 + (16 * vb2 + 4 * pp) * 2); }
                const float bv[8] = {bf1((bf16_t)tA[0]) * w0[0], bf1((bf16_t)tA[1]) * w0[1], bf1((bf16_t)tA[2]) * w0[2], bf1((bf16_t)tA[3]) * w0[3], bf1((bf16_t)tB[0]) * w1[0], bf1((bf16_t)tB[1]) * w1[1], bf1((bf16_t)tB[2]) * w1[2], bf1((bf16_t)tB[3]) * w1[3]};
                const bf16x8 bfrag = pack8f(bv);
                const bf16x8 ones8 = {(short)0x3f80, (short)0x3f80, (short)0x3f80, (short)0x3f80, (short)0x3f80, (short)0x3f80, (short)0x3f80, (short)0x3f80};
                nacc = mfma16(ones8, bfrag, nacc);
#pragma unroll
                for (int vb2 = 0; vb2 < 2; ++vb2) cst[vb2] = mfma16(cat4(xA[vb2], xB[vb2]), bfrag, cst[vb2]);
            }
            if (w == 0 && c + 1 < 32) ML_GATES((c + 1) & 1);
        }
#ifdef PROBE_ML
        pm2 = __builtin_amdgcn_s_memrealtime(); pa2 += pm2 - pm1;
#endif
        WG_BAR();
#pragma unroll
        for (int vb2 = 0; vb2 < 2; ++vb2)
#pragma unroll
            for (int r = 0; r < 4; ++r) *(LAS bf16_t*)(L + ML_CB + (16 * vb2 + 4 * g4 + r) * SLD + (16 * w + c16) * 2) = f2bf(cst[vb2][r]);
        if (g4 == 0) fnvec[16 * w + c16] = nacc[0];
#ifdef PROBE_ML
        pa3 += __builtin_amdgcn_s_memrealtime() - pm2;
#endif
    }
#ifdef PROBE_ML
    if (F.bx == 0 && lane == 0) { unsigned long long* dg = (unsigned long long*)((unsigned char*)MIX - WS_MIX + 2883584); dg[4 * w] = pa1; dg[4 * w + 1] = pa2; dg[4 * w + 2] = pa3; }
#endif
#undef ML_PREFETCH
#undef ML_GATES
}

constexpr int MB_K0 = 0, MB_V0 = 17408, MB_K1 = 34816, MB_V1 = 52224, MB_KM = 69632, MB_SEL = 73216;
__device__ __forceinline__ void moba_unit(Frame& F, int b, int h, int qb, const bf16_t* __restrict__ U, bf16_t* __restrict__ MIX, const float* __restrict__ KMEAN) {
    LAS unsigned char* L = F.lds;
    const int tid = F.tid, lane = F.lane, w = F.wave, c16 = lane & 15, g4 = lane >> 4;
    LAS float* km = (LAS float*)(L + MB_KM); LAS int* sel = (LAS int*)(L + MB_SEL);
    const size_t row0 = (size_t)b * SEQ + 256 * qb;
    WG_BAR();
    bf16x8 Qf[2][4]; u32x4 pk[2], pv[2];
    const int kr = tid >> 3, ch = tid & 7;
#pragma unroll
    for (int qq = 0; qq < 2; ++qq) { const bf16_t* qp = U + (row0 + 32 * w + 16 * qq + c16) * NU + UAQ + h * 128 + 8 * g4;
#pragma unroll
        for (int ds = 0; ds < 4; ++ds) Qf[qq][ds] = *(const bf16x8*)(qp + 32 * ds); }
    { const bf16_t* kp = U + ((size_t)b * SEQ + kr) * NU + UAK + h * 128; const bf16_t* vp = U + ((size_t)b * SEQ + kr) * NU + UAV + h * 128;
      pk[0] = *(const u32x4*)(kp + 8 * ch); pk[1] = *(const u32x4*)(kp + 8 * (ch + 8)); pv[0] = *(const u32x4*)(vp + 8 * ch); pv[1] = *(const u32x4*)(vp + 8 * (ch + 8)); }
    for (int i = tid; i < qb * 128; i += NTHR) { const float* kq = KMEAN + ((size_t)(b * 4 + h) * 8) * 128 + i; km[i] = (kq[0] + kq[NB * 4 * 8 * 128]) + (kq[2 * NB * 4 * 8 * 128] + kq[3 * NB * 4 * 8 * 128]); }
    WG_BAR();
    if (tid < 256) {
        int mask = (1 << qb) - 1;
        if (qb > 3) {
            float sc[7];
#pragma unroll
            for (int j = 0; j < 7; ++j) sc[j] = 0.f;
            const bf16_t* qp = U + (row0 + tid) * NU + UAQ + h * 128;
            for (int d8 = 0; d8 < 16; ++d8) { const u32x4 qr = *(const u32x4*)(qp + 8 * d8); const float qv[8] = {bflo(qr.x), bfhi(qr.x), bflo(qr.y), bfhi(qr.y), bflo(qr.z), bfhi(qr.z), bflo(qr.w), bfhi(qr.w)};
#pragma unroll
                for (int j = 0; j < 7; ++j) if (j < qb) { const f32x4 k0 = *(const LAS f32x4*)(km + j * 128 + 8 * d8), k1 = *(const LAS f32x4*)(km + j * 128 + 8 * d8 + 4);
                    sc[j] += qv[0] * k0[0] + qv[1] * k0[1] + qv[2] * k0[2] + qv[3] * k0[3] + qv[4] * k1[0] + qv[5] * k1[1] + qv[6] * k1[2] + qv[7] * k1[3]; } }
            mask = 0;
#pragma unroll
            for (int it = 0; it < 3; ++it) { float best = -__builtin_inff(); int bi = 0;
#pragma unroll
                for (int j = 0; j < 7; ++j) if (j < qb && !((mask >> j) & 1) && sc[j] > best) { best = sc[j]; bi = j; }
                mask |= 1 << bi; }
        }
        sel[tid] = mask;
    }
    WG_BAR();
    int msk[2]; float mrun[2], lsum[2]; f32x4 O[2][8];
#pragma unroll
    for (int qq = 0; qq < 2; ++qq) {
        msk[qq] = sel[32 * w + 16 * qq + c16]; mrun[qq] = -1e30f; lsum[qq] = 0.f;
#pragma unroll
        for (int db = 0; db < 8; ++db) O[qq][db] = (f32x4){F.zf, F.zf, F.zf, F.zf}; }
    const int ntiles = 4 * (qb + 1);
    const float SC = 0.08838834764831845f * 1.4426950408889634f;
    for (int tt = 0; tt < ntiles; ++tt) {
        const int kofs = (tt & 1) ? MB_K1 : MB_K0, vofs = (tt & 1) ? MB_V1 : MB_V0;
        *(LAS u32x4*)(L + kofs + kr * SLD + ch * 16) = pk[0]; *(LAS u32x4*)(L + kofs + kr * SLD + (ch + 8) * 16) = pk[1];
        *(LAS u32x4*)(L + vofs + kr * SLD + ch * 16) = pv[0]; *(LAS u32x4*)(L + vofs + kr * SLD + (ch + 8) * 16) = pv[1];
        WG_BAR();
        if (tt + 1 < ntiles) { const bf16_t* kp = U + ((size_t)b * SEQ + 64 * (tt + 1) + kr) * NU + UAK + h * 128; const bf16_t* vp = U + ((size_t)b * SEQ + 64 * (tt + 1) + kr) * NU + UAV + h * 128;
            pk[0] = *(const u32x4*)(kp + 8 * ch); pk[1] = *(const u32x4*)(kp + 8 * (ch + 8)); pv[0] = *(const u32x4*)(vp + 8 * ch); pv[1] = *(const u32x4*)(vp + 8 * (ch + 8)); }
        const int jblk = tt >> 2; const bool own = (jblk == qb);
        f32x4 st[4][2];
#pragma unroll
        for (int kb = 0; kb < 4; ++kb) { st[kb][0] = (f32x4){F.zf, F.zf, F.zf, F.zf}; st[kb][1] = st[kb][0];
#pragma unroll
            for (int ds = 0; ds < 4; ++ds) { const bf16x8 a = *(const LAS bf16x8*)(L + kofs + (16 * kb + c16) * SLD + (32 * ds + 8 * g4) * 2);
                st[kb][0] = mfma16(a, Qf[0][ds], st[kb][0]); st[kb][1] = mfma16(a, Qf[1][ds], st[kb][1]); } }
        bf16x8 pf[2][2];
#pragma unroll
        for (int qq = 0; qq < 2; ++qq) {
            const float NEG = -__builtin_inff();
            if (own) { const int qi = 32 * w + 16 * qq + c16, kbase = 64 * (tt & 3) + 4 * g4;
#pragma unroll
                for (int kb = 0; kb < 4; ++kb)
#pragma unroll
                    for (int r = 0; r < 4; ++r) if (kbase + 16 * kb + r > qi) st[kb][qq][r] = NEG;
            } else if (!((msk[qq] >> jblk) & 1)) {
#pragma unroll
                for (int kb = 0; kb < 4; ++kb) st[kb][qq] = (f32x4){NEG, NEG, NEG, NEG};
            }
            float rm = st[0][qq][0];
#pragma unroll
            for (int kb = 0; kb < 4; ++kb)
#pragma unroll
                for (int r = 0; r < 4; ++r) rm = fmaxf(rm, st[kb][qq][r]);
            rm = fmaxf(rm, SHFL_XOR(rm, 16)); rm = fmaxf(rm, SHFL_XOR(rm, 32));
            const float mn = fmaxf(mrun[qq], rm), alpha = __builtin_amdgcn_exp2f((mrun[qq] - mn) * SC), mnsc = -mn * SC; mrun[qq] = mn;
            float ps = 0.f; float pvv[4][4];
#pragma unroll
            for (int kb = 0; kb < 4; ++kb)
#pragma unroll
                for (int r = 0; r < 4; ++r) { const float pe = __builtin_amdgcn_exp2f(__builtin_fmaf(st[kb][qq][r], SC, mnsc)); pvv[kb][r] = pe; ps += pe; }
            lsum[qq] = lsum[qq] * alpha + ps;
            if (__builtin_amdgcn_ballot_w64(alpha != 1.0f) != 0ull) {
#pragma unroll
                for (int db = 0; db < 8; ++db) O[qq][db] = O[qq][db] * alpha; }
#pragma unroll
            for (int ks = 0; ks < 2; ++ks) { const float v8[8] = {pvv[2 * ks][0], pvv[2 * ks][1], pvv[2 * ks][2], pvv[2 * ks][3], pvv[2 * ks + 1][0], pvv[2 * ks + 1][1], pvv[2 * ks + 1][2], pvv[2 * ks + 1][3]}; pf[qq][ks] = pack8f(v8); }
        }
        const int q = c16 >> 2, p = c16 & 3;
#pragma unroll
        for (int ks = 0; ks < 2; ++ks)
#pragma unroll
            for (int db = 0; db < 8; ++db) {
                const s16x4 tA = tr_read(L + vofs + (32 * ks + 4 * g4 + q) * SLD + (16 * db + 4 * p) * 2), tB = tr_read(L + vofs + (32 * ks + 16 + 4 * g4 + q) * SLD + (16 * db + 4 * p) * 2);
                const bf16x8 a = cat4(tA, tB);
                O[0][db] = mfma16(a, pf[0][ks], O[0][db]); O[1][db] = mfma16(a, pf[1][ks], O[1][db]);
            }
    }
#pragma unroll
    for (int qq = 0; qq < 2; ++qq) { float ls = lsum[qq]; ls += SHFL_XOR(ls, 16); ls += SHFL_XOR(ls, 32); const float inv = 1.0f / ls;
        bf16_t* op = MIX + (row0 + 32 * w + 16 * qq + c16) * 2048 + MIXA + h * 128 + 4 * g4;
#pragma unroll
        for (int db = 0; db < 8; ++db) { u32x2 ow; ow.x = pk2(O[qq][db][0] * inv, O[qq][db][1] * inv); ow.y = pk2(O[qq][db][2] * inv, O[qq][db][3] * inv); *(u32x2*)(op + 16 * db) = ow; } }
}
constexpr int KM_Q = NB * 4 * 8 * 128;
__device__ __forceinline__ void kmean_items(Frame& F, const bf16_t* __restrict__ U, float* __restrict__ KMEAN) {
    const int gw = F.vcu * NWAVES + F.wave, NGW = NWG * NWAVES;
    for (int it4 = gw; it4 < NB * 4 * 8 * 4; it4 += NGW) {
        const int q = it4 & 3, it = it4 >> 2; const int blk = it & 7, h = (it >> 3) & 3, b = it >> 5;
        const int lane = F.lane, cg = lane & 15, rg = lane >> 4;
        const bf16_t* kp = U + ((size_t)b * SEQ + 256 * blk + 64 * q + rg) * NU + UAK + h * 128 + 8 * cg;
        u32x4 v[16];
#pragma unroll
        for (int i = 0; i < 16; ++i) v[i] = *(const u32x4*)(kp + (size_t)(4 * i) * NU);
        float s[8];
#pragma unroll
        for (int j = 0; j < 8; ++j) s[j] = 0.f;
#pragma unroll
        for (int i = 0; i < 16; ++i) { s[0] += bflo(v[i].x); s[1] += bfhi(v[i].x); s[2] += bflo(v[i].y); s[3] += bfhi(v[i].y); s[4] += bflo(v[i].z); s[5] += bfhi(v[i].z); s[6] += bflo(v[i].w); s[7] += bfhi(v[i].w); }
#pragma unroll
        for (int j = 0; j < 8; ++j) { s[j] += SHFL_XOR(s[j], 16); s[j] += SHFL_XOR(s[j], 32); }
        if (rg == 0) { float* op = KMEAN + (size_t)q * KM_Q + (size_t)it * 128 + 8 * cg;
            *(f32x4*)op = (f32x4){s[0] * (1.f / 256.f), s[1] * (1.f / 256.f), s[2] * (1.f / 256.f), s[3] * (1.f / 256.f)}; *(f32x4*)(op + 4) = (f32x4){s[4] * (1.f / 256.f), s[5] * (1.f / 256.f), s[6] * (1.f / 256.f), s[7] * (1.f / 256.f)}; }
    }
}
static_assert(T % (4 * NWG * NWAVES) == 0, "mixnorm row batches");
__device__ __forceinline__ void mixnorm_rows(Frame& F, const bf16_t* __restrict__ U, bf16_t* __restrict__ MIX, const float* __restrict__ SSQM, const float* __restrict__ SSQS,
                                             const float* __restrict__ m_norm_g, const float* __restrict__ s_norm_g) {
    const int gw = F.vcu * NWAVES + F.wave, NGW = NWG * NWAVES, lane = F.lane;
    const int colm = 8 * lane, hm = colm >> 7;
    const f32x4 gm0 = *(const f32x4*)(m_norm_g + colm), gm1 = *(const f32x4*)(m_norm_g + colm + 4);
    f32x4 gs0[2], gs1[2];
#pragma unroll
    for (int i = 0; i < 2; ++i) { gs0[i] = *(const f32x4*)(s_norm_g + 512 * i + 8 * lane); gs1[i] = *(const f32x4*)(s_norm_g + 512 * i + 8 * lane + 4); }
    for (int row0 = gw; row0 < T; row0 += 4 * NGW) {
        f32x4 qm0[4], qm1[4], qs0[4][2], qs1[4][2]; u32x4 hvm[4], ovm[4], hvs[4][2];
#pragma unroll
        for (int k = 0; k < 4; ++k) { const int row = row0 + k * NGW;
            qm0[k] = *(const f32x4*)(SSQM + (size_t)row * 32 + hm * 8); qm1[k] = *(const f32x4*)(SSQM + (size_t)row * 32 + hm * 8 + 4);
            hvm[k] = *(const u32x4*)(MIX + (size_t)row * 2048 + MIXM + colm); ovm[k] = *(const u32x4*)(U + (size_t)row * NU + UO + colm);
#pragma unroll
            for (int i = 0; i < 2; ++i) { qs0[k][i] = *(const f32x4*)(SSQS + (size_t)row * 16 + 8 * i); qs1[k][i] = *(const f32x4*)(SSQS + (size_t)row * 16 + 8 * i + 4); hvs[k][i] = *(const u32x4*)(MIX + (size_t)row * 2048 + MIXS + 512 * i + 8 * lane); } }
#pragma unroll
        for (int k = 0; k < 4; ++k) { const int row = row0 + k * NGW;
            {   const float ssq = (qm0[k][0] + qm0[k][1]) + (qm0[k][2] + qm0[k][3]) + (qm1[k][0] + qm1[k][1]) + (qm1[k][2] + qm1[k][3]);
                const float r = 1.0f / sqrtf(ssq * (1.f / 128.f) + EPS); const u32x4 hv = hvm[k], ov = ovm[k]; u32x4 o;
                o.x = pk2(bflo(hv.x) * r * gm0[0] * sigmoidf_(bflo(ov.x)), bfhi(hv.x) * r * gm0[1] * sigmoidf_(bfhi(ov.x)));
                o.y = pk2(bflo(hv.y) * r * gm0[2] * sigmoidf_(bflo(ov.y)), bfhi(hv.y) * r * gm0[3] * sigmoidf_(bfhi(ov.y)));
                o.z = pk2(bflo(hv.z) * r * gm1[0] * sigmoidf_(bflo(ov.z)), bfhi(hv.z) * r * gm1[1] * sigmoidf_(bfhi(ov.z)));
                o.w = pk2(bflo(hv.w) * r * gm1[2] * sigmoidf_(bflo(ov.w)), bfhi(hv.w) * r * gm1[3] * sigmoidf_(bfhi(ov.w)));
                *(u32x4*)(MIX + (size_t)row * 2048 + MIXM + colm) = o; }
#pragma unroll
            for (int i = 0; i < 2; ++i) { const f32x4 q0 = qs0[k][i], q1 = qs1[k][i];
                const float ssq = (q0[0] + q0[1]) + (q0[2] + q0[3]) + (q1[0] + q1[1]) + (q1[2] + q1[3]);
                const float r = 1.0f / sqrtf(ssq * (1.f / 512.f) + EPS); const u32x4 hv = hvs[k][i]; u32x4 o;
                o.x = pk2(bflo(hv.x) * r * gs0[i][0], bfhi(hv.x) * r * gs0[i][1]); o.y = pk2(bflo(hv.y) * r * gs0[i][2], bfhi(hv.y) * r * gs0[i][3]);
                o.z = pk2(bflo(hv.z) * r * gs1[i][0], bfhi(hv.z) * r * gs1[i][1]); o.w = pk2(bflo(hv.w) * r * gs1[i][2], bfhi(hv.w) * r * gs1[i][3]);
                *(u32x4*)(MIX + (size_t)row * 2048 + MIXS + 512 * i + 8 * lane) = o; } }
    }
}
constexpr int LT_TAB = 0, LT_CUMT = 320, LT_LCNT = 340, LT_BASE = 356, LT_TOT = 372, LT_GOFF = 388, LT_PART = 416, LT_PRE = 928;
__device__ __forceinline__ void moe_route(Frame& F, const bf16_t* XS, const float* g, const float* Wr, int* ROUTE, int* WGCNT, int* TOK) {
    LAS unsigned char* L = F.lds; LAS int* lt = (LAS int*)(L + LTAB_OFF); const int lane = F.lane;
    constexpr int WSTR = D + 4;
    LAS float* Wt = (LAS float*)L;
    LAS float* Cw = (LAS float*)(L + 66048) + F.wave * 256;
    WG_BAR();
    for (int i = F.tid; i < D * NEXP / 4; i += NTHR) { const int k = i >> 1, half = i & 1; const f32x4 v = ((const f32x4*)Wr)[i] * g[k];
        Wt[(4 * half + 0) * WSTR + k] = v[0]; Wt[(4 * half + 1) * WSTR + k] = v[1]; Wt[(4 * half + 2) * WSTR + k] = v[2]; Wt[(4 * half + 3) * WSTR + k] = v[3]; }
    if (F.tid < 16) lt[LT_LCNT + F.tid] = 0;
    for (int i = F.bx * NTHR + F.tid; i < MOE_ROWS; i += NWG * NTHR) TOK[i] = -1;
    WG_BAR();
    const int ri = lane & 15, kq = lane >> 4, row0 = 128 * F.bx + 16 * F.wave;
    const u32x4* xr = (const u32x4*)(XS + (size_t)(row0 + ri) * D) + kq;
    const LAS float* wl = Wt + (lane & 7) * WSTR + 8 * kq;
    f32x4 acc = (f32x4){F.zf, F.zf, F.zf, F.zf}; float ssq = 0.f;
    u32x4 cur[8], nxt[8];
#pragma unroll
    for (int c = 0; c < 8; ++c) cur[c] = xr[4 * c];
#pragma unroll 1
    for (int tb = 0; tb < 8; ++tb) {
        if (tb + 1 < 8) {
#pragma unroll
            for (int c = 0; c < 8; ++c) nxt[c] = xr[4 * (8 * (tb + 1) + c)]; }
#pragma unroll
        for (int c = 0; c < 8; ++c) {
            const f32x4 w0 = *(const LAS f32x4*)(wl + 32 * (8 * tb + c)), w1 = *(const LAS f32x4*)(wl + 32 * (8 * tb + c) + 4);
            const u32x4 r = cur[c]; const float xv[8] = {bflo(r.x), bfhi(r.x), bflo(r.y), bfhi(r.y), bflo(r.z), bfhi(r.z), bflo(r.w), bfhi(r.w)};
            const float wv[8] = {w0[0], w0[1], w0[2], w0[3], w1[0], w1[1], w1[2], w1[3]};
#pragma unroll
            for (int u = 0; u < 8; ++u) { ssq += xv[u] * xv[u]; acc = __builtin_amdgcn_mfma_f32_16x16x4f32(xv[u], wv[u], acc, 0, 0, 0); }
        }
        if (tb + 1 < 8) {
#pragma unroll
            for (int c = 0; c < 8; ++c) cur[c] = nxt[c]; }
    }
    ssq += SHFL_XOR(ssq, 16); ssq += SHFL_XOR(ssq, 32);
    const float rstd = 1.0f / sqrtf(ssq * (1.f / D) + EPS);
#pragma unroll
    for (int r = 0; r < 4; ++r) Cw[(4 * kq + r) * 16 + ri] = acc[r];
    if (lane < 16) {
        const f32x4 l0 = *(const LAS f32x4*)(Cw + lane * 16), l1 = *(const LAS f32x4*)(Cw + lane * 16 + 4);
        const float lg[8] = {l0[0] * rstd, l0[1] * rstd, l0[2] * rstd, l0[3] * rstd, l1[0] * rstd, l1[1] * rstd, l1[2] * rstd, l1[3] * rstd};
        const int row = row0 + lane;
        int e0 = 0; float b0 = lg[0];
#pragma unroll
        for (int e = 1; e < 8; ++e) if (lg[e] > b0) { b0 = lg[e]; e0 = e; }
        int e1 = -1; float b1 = -__builtin_inff();
#pragma unroll
        for (int e = 0; e < 8; ++e) if (e != e0 && lg[e] > b1) { b1 = lg[e]; e1 = e; }
        if (e1 < 0) e1 = (e0 == 0) ? 1 : 0;
        const float w1 = 1.0f / (1.0f + __expf(b0 - b1)), w0 = 1.0f - w1;
        const int r0 = __hip_atomic_fetch_add(lt + LT_LCNT + e0, 1, __ATOMIC_RELAXED, __HIP_MEMORY_SCOPE_WORKGROUP), r1 = __hip_atomic_fetch_add(lt + LT_LCNT + 8 + e1, 1, __ATOMIC_RELAXED, __HIP_MEMORY_SCOPE_WORKGROUP);
        ROUTE[row] = e0 | (e1 << 8); ROUTE[T + row] = r0; ROUTE[2 * T + row] = r1; ((float*)ROUTE)[3 * T + row] = w0; ((float*)ROUTE)[4 * T + row] = w1; ((float*)ROUTE)[5 * T + row] = rstd;
    }
    WG_BAR();
    if (F.tid < 16) WGCNT[F.bx * 16 + F.tid] = lt[LT_LCNT + F.tid];
}
__device__ __forceinline__ void moe_tables(Frame& F, const int* WGCNT) {
    LAS unsigned char* L = F.lds; LAS int* lt = (LAS int*)(L + LTAB_OFF); const int tid = F.tid, c = F.bx;
    WG_BAR();
    { const int g = tid & 15, chn = tid >> 4; int s = 0;
#pragma unroll
      for (int i = 0; i < 8; ++i) s += WGCNT[(8 * chn + i) * 16 + g];
      lt[LT_PART + chn * 16 + g] = s; }
    WG_BAR();
    if (tid < 16) { int run = 0; for (int chn = 0; chn < 32; ++chn) { lt[LT_PRE + chn * 16 + tid] = run; run += lt[LT_PART + chn * 16 + tid]; } lt[LT_TOT + tid] = run; }
    WG_BAR();
    if (tid == 0) { int off = 0;
        for (int g = 0; g < 16; ++g) { const int nt = (lt[LT_TOT + g] + 255) >> 8; lt[LT_CUMT + g] = off >> 8; lt[LT_GOFF + g] = off; for (int t = 0; t < nt; ++t) lt[LT_TAB + (off >> 8) + t] = g & 7; off += nt << 8; }
        lt[LT_CUMT + 16] = off >> 8; }
    WG_BAR();
    if (tid < 16) { int bs = lt[LT_GOFF + tid] + lt[LT_PRE + (c >> 3) * 16 + tid]; for (int w2 = 8 * (c >> 3); w2 < c; ++w2) bs += WGCNT[w2 * 16 + tid]; lt[LT_BASE + tid] = bs; }
    WG_BAR();
}
__device__ __forceinline__ void moe_gather(Frame& F, const unsigned char* XA8, const int* ROUTE, const int* WGCNT, unsigned char* XG8, int* TOK, float* WGT, float* RS) {
    LAS unsigned char* L = F.lds; LAS int* lt = (LAS int*)(L + LTAB_OFF); const int lane = F.lane, c = F.bx;
    int ee[8], ra[8], rb[8]; float wa[8], wb[8], rr[8]; u32x4 xv[8][2];
#define MG_LOAD(i0) do { _Pragma("unroll") for (int k = 0; k < 8; ++k) { const int row = 128 * c + 16 * F.wave + (i0) + k; ee[k] = ROUTE[row]; ra[k] = ROUTE[T + row]; rb[k] = ROUTE[2 * T + row]; \
            wa[k] = ((const float*)ROUTE)[3 * T + row]; wb[k] = ((const float*)ROUTE)[4 * T + row]; rr[k] = ((const float*)ROUTE)[5 * T + row]; \
            const u32x4* src = (const u32x4*)(XA8 + (size_t)row * D) + lane; xv[k][0] = src[0]; xv[k][1] = src[64]; } } while (0)
#define MG_STORE(i0) do { _Pragma("unroll") for (int k = 0; k < 8; ++k) { const int row = 128 * c + 16 * F.wave + (i0) + k; const int e0 = ee[k] & 255, e1 = ee[k] >> 8; \
            const int pos0 = lt[LT_BASE + e0] + ra[k], pos1 = lt[LT_BASE + 8 + e1] + rb[k]; \
            u32x4* d0 = (u32x4*)(XG8 + (size_t)pos0 * D) + lane; u32x4* d1 = (u32x4*)(XG8 + (size_t)pos1 * D) + lane; \
            d0[0] = xv[k][0]; d0[64] = xv[k][1]; d1[0] = xv[k][0]; d1[64] = xv[k][1]; \
            if (lane == 0) { TOK[pos0] = row; TOK[pos1] = row; WGT[pos0] = wa[k]; WGT[pos1] = wb[k]; RS[pos0] = rr[k]; RS[pos1] = rr[k]; } } } while (0)
    MG_LOAD(0);
    moe_tables(F, WGCNT);
    MG_STORE(0);
    MG_LOAD(8);
    MG_STORE(8);
#undef MG_LOAD
#undef MG_STORE
}

#ifndef NEXP_LATE
#define NEXP_LATE 1
#endif
#ifndef NEXP_TAIL
#define NEXP_TAIL 2
#endif
#ifndef NGEMM0
#define NGEMM0 192
#endif
#ifndef INPROJ1_FP8
#define INPROJ1_FP8 0
#endif
#ifndef FFN_DOWN_FP8
#define FFN_DOWN_FP8 0
#endif
#ifndef MOE_DOWN_FP8
#define MOE_DOWN_FP8 1
#endif
#ifndef PROBE_SSQ0
#define PROBE_SSQ0 SSQ_(7)
#endif
#ifndef RES_ALIGN
#define RES_ALIGN false
#endif
enum { I_X = 0, I_P, I_LNMIX, I_WIN, I_WOUT, I_MCW, I_MCB, I_MGB, I_MNG, I_SCW, I_SCB, I_SDTB, I_SALOG, I_SD, I_SNG, I_LNFFN, I_FWG, I_FWU, I_FWD, I_ROUTER, I_MWG, I_MWU, I_MWD, I_LNPLE, I_PPROJ, I_PGATE, I_LNFINAL };

__global__ void __launch_bounds__(NTHR, 2) hybrid_fwd(Args args) {
    extern __shared__ __attribute__((aligned(16))) unsigned char lds_raw[];
    Frame F;
    F.lds = (LAS unsigned char*)lds_raw;
    F.tid = threadIdx.x; F.lane = F.tid & 63; F.wave = __builtin_amdgcn_readfirstlane(F.tid >> 6);
    F.zf = 0.f; F.zu = 0u;
    const int wave0 = F.wave;
    F.bx = blockIdx.x; F.vcu = (F.bx % 8) * (NWG / 8) + F.bx / 8;
    volatile LAS unsigned* MISC = (volatile LAS unsigned*)(F.lds + MISC_OFF);
    for (int u = F.tid; u < 64; u += NTHR) MISC[u] = 0u;
    __syncthreads();
    unsigned* ctl = (unsigned*)(args.ws + WS_CTL);
    XcdBarrier bar = xcd_barrier_post(ctl + CW_BAR, MISC + 8);
    const int lo = args.ph_lo, hi = args.ph_hi; int ph = 0;
#define PHASE_BEGIN if (ph >= lo && ph < hi) { { int w_ = wave0; asm volatile("" : "+s"(w_)); unsigned z_ = 0u; asm volatile("" : "+s"(z_)); int t_ = (int)__builtin_amdgcn_mbcnt_hi(~0u, __builtin_amdgcn_mbcnt_lo(~0u, z_)); asm volatile("" : "+v"(t_)); t_ += w_ * 64; F.tid = t_; F.lane = t_ & 63; F.wave = w_; F.zu = z_; F.zf = __builtin_bit_cast(float, z_); LAS unsigned char* b_ = (LAS unsigned char*)lds_raw; asm volatile("" : "+s"(b_)); F.lds = b_; int x_ = blockIdx.x; asm volatile("" : "+s"(x_)); F.bx = x_; F.vcu = (x_ % 8) * (NWG / 8) + x_ / 8; }
#define REFRESH_TID() do { int w_ = wave0; asm volatile("" : "+s"(w_)); unsigned z_ = 0u; asm volatile("" : "+s"(z_)); int t_ = (int)__builtin_amdgcn_mbcnt_hi(~0u, __builtin_amdgcn_mbcnt_lo(~0u, z_)); asm volatile("" : "+v"(t_)); t_ += w_ * 64; F.tid = t_; F.lane = t_ & 63; F.wave = w_; F.zu = z_; F.zf = __builtin_bit_cast(float, z_); } while (0)
#ifdef PROBE_TS
#define TS_STAMP(idx) do { unsigned zz_ = 0u; asm volatile("" : "+s"(zz_)); const int ll_ = (int)__builtin_amdgcn_mbcnt_hi(~0u, __builtin_amdgcn_mbcnt_lo(~0u, zz_)); if (blockIdx.x == 0 && wave0 == 0 && ll_ == 0) ((LAS unsigned long long*)((LAS unsigned char*)lds_raw + PTAB_OFF + 512))[(idx)] = __builtin_amdgcn_s_memrealtime(); } while (0)
#else
#define TS_STAMP(idx) do {} while (0)
#endif
#define PHASE_END(last) if (!(last) && ph + 1 < hi) xcd_barrier(bar); TS_STAMP(ph + 1); } ++ph;

    if (F.tid == 0) { LAS unsigned long long* pt = (LAS unsigned long long*)(F.lds + PTAB_OFF);
#pragma unroll
        for (int i = 0; i < 27; ++i) pt[i] = (unsigned long long)(uintptr_t)args.in[i];
        pt[27] = (unsigned long long)(uintptr_t)args.out; pt[28] = (unsigned long long)(uintptr_t)args.ws; }
    __syncthreads();
    TS_STAMP(0);
#define PTR_(i) ld_ptr(F.lds, (i))
#define IN_(i) ((const float*)PTR_(i))
#define X_ ((float*)PTR_(27))
#define WSB_(off) (PTR_(28) + (off))
#define WIN ((bf16_t*)WSB_(WS_WIN))
#define WOUT ((bf16_t*)WSB_(WS_WOUT))
#define FGU ((bf16_t*)WSB_(WS_FGU))
#define FD ((bf16_t*)WSB_(WS_FD))
#define MGU ((bf16_t*)WSB_(WS_MGU))
#define MD ((bf16_t*)WSB_(WS_MD))
#define PG ((bf16_t*)WSB_(WS_PG))
#define PP ((bf16_t*)WSB_(WS_PP))
#define XN ((bf16_t*)WSB_(WS_XN))
#define P16 ((bf16_t*)WSB_(WS_P16))
#define U ((bf16_t*)WSB_(WS_U))
#define MIX ((bf16_t*)WSB_(WS_MIX))
#define CVB ((bf16_t*)WSB_(WS_CV))
#define H ((bf16_t*)WSB_(WS_H))
#define XBB ((bf16_t*)WSB_(WS_XBB))
#define XA8 ((unsigned char*)WSB_(WS_XA8))
#define XB8 ((unsigned char*)WSB_(WS_CV))
#define SSQ_(i) ((pg8::ssq_t*)WSB_(WS_SSQ) + (size_t)(i) * T)
#define RS ((float*)WSB_(WS_WGT + 512 * 1024))
#define XG ((bf16_t*)WSB_(WS_XG))
#define HM ((bf16_t*)WSB_(WS_HM))
#define SSQM ((float*)WSB_(WS_SSQM))
#define SSQS ((float*)WSB_(WS_SSQS))
#define KMEAN ((float*)WSB_(WS_KMEAN))
#define ROUTE ((int*)WSB_(WS_ROUTE))
#define TOK ((int*)WSB_(WS_TOK))
#define WGT ((float*)WSB_(WS_WGT))
#define WGCNT ((int*)WSB_(WS_WGCNT))
    PHASE_BEGIN
    {
        LAS float* scr = (LAS float*)(F.lds + RING_OFF + F.wave * XP_SCR); const int gw = F.vcu * NWAVES + F.wave, NGW = NWG * NWAVES;
        {   const float* W = IN_(I_WIN); bf16_t* WT = WIN; const int nblk = NU / 64, items = (D / 64) * nblk;
            for (int it = gw; it < items; it += NGW) { const int kb = it / nblk, nb = it % nblk; xpose_item<false>(W, DPROJ_SRC, win_srccol(nb * 64 + 4 * (F.lane & 15)), kb * 64, WT, D, nb * 64, scr, F.lane, IN_(I_LNMIX), F.zf); } }
        {
            const float* xs = IN_(I_X); bf16_t* xb = XBB; pg8::ssq_t* sq = SSQ_(0); f32x4 v[8];
            for (int m = gw; m < T; m += NGW) { (void)load_row_ssq(F, xs + (size_t)m * D, v); float s = 0.f;
#pragma unroll
                for (int j = 0; j < 8; ++j) { u32x2 w; w.x = pk2(v[j].x, v[j].y); w.y = pk2(v[j].z, v[j].w); ((u32x2*)(xb + (size_t)m * D) + F.lane)[64 * j] = w;
                    const float a = bflo(w.x), b = bfhi(w.x), c = bflo(w.y), d = bfhi(w.y); s += (a * a + b * b) + (c * c + d * d); }
                s = wave_sum(s);
                if (F.lane == 0) sq[m] = (pg8::ssq_t)(s * pg8::SSQ_SCALE + 0.5f); }
        }
    }
    PHASE_END(false)
    PHASE_BEGIN
    if (F.bx < NGEMM0) {
        pg8::StaticOrder S; S.init(T, NU, NGEMM0, F.bx); pg8::EpiBf16 E{U, NU, SSQ_(0), 1.0f};
        pg8::Gemm g{XBB, WIN, D, D, D, 0}; pg8::gemm_phase<pg8::EpiBf16, pg8::StaticOrder, true>(F.lds + RING_OFF, g, S, E, F.tid);
        REFRESH_TID();
        { LAS float* scr = (LAS float*)(F.lds + RING_OFF + F.wave * XP_SCR); const int gw = F.bx * NWAVES + F.wave, NGW = NGEMM0 * NWAVES;
          for (int e = NEXP - NEXP_TAIL; e < NEXP; ++e) {
            if (e < NEXP - NEXP_LATE) xpose_gu(F, IN_(I_MWG) + (size_t)e * D * DFFE, IN_(I_MWU) + (size_t)e * D * DFFE, D, DFFE, MGU + (size_t)e * 2 * DFFE * (D / 2), scr, gw, NGW, IN_(I_LNFFN) + D);
            xpose_plain<MOE_DOWN_FP8 != 0>(F, IN_(I_MWD) + (size_t)e * DFFE * D, DFFE, D, MD + (size_t)e * D * (MOE_DOWN_FP8 ? DFFE / 2 : DFFE), scr, gw, NGW, nullptr); } }
    } else {
        LAS float* scr = (LAS float*)(F.lds + RING_OFF + F.wave * XP_SCR); const int gw = (F.bx - NGEMM0) * NWAVES + F.wave, NGW = (NWG - NGEMM0) * NWAVES;
        for (int l = 0; l < DEPTH; ++l) {
            if (l == 1) {
                const float* W = IN_(I_WIN) + (size_t)l * D * DPROJ_SRC; bf16_t* WT = WIN + (size_t)l * NU * D;
                const int nblk = NU / 64, items = (D / 64) * nblk;
                for (int it = gw; it < items; it += NGW) { const int kb = it / nblk, nb = it % nblk; xpose_item<INPROJ1_FP8 != 0>(W, DPROJ_SRC, win_srccol(nb * 64 + 4 * (F.lane & 15)), kb * 64, WT, D, nb * 64, scr, F.lane, IN_(I_LNMIX) + (size_t)l * D, F.zf); }
            }
            xpose_plain(F, IN_(I_WOUT) + (size_t)l * D * D, D, D, WOUT + (size_t)l * D * D, scr, gw, NGW, nullptr);
            xpose_plain<true>(F, IN_(I_PGATE) + (size_t)l * D * D, D, D, PG + (size_t)l * D * (D / 2), scr, gw, NGW, IN_(I_LNPLE) + (size_t)l * D);
            xpose_plain(F, IN_(I_PPROJ) + (size_t)l * PLE * D, PLE, D, PP + (size_t)l * D * PLE, scr, gw, NGW, nullptr);
        }
        xpose_gu(F, IN_(I_FWG), IN_(I_FWU), D, DFF, FGU, scr, gw, NGW, IN_(I_LNFFN));
        xpose_plain<FFN_DOWN_FP8 != 0>(F, IN_(I_FWD), DFF, D, FD, scr, gw, NGW, nullptr);
        {
            const f32x4* ps = (const f32x4*)IN_(I_P); u32x2* pd = (u32x2*)P16; const size_t n4 = (size_t)DEPTH * T * PLE / 4, st = (size_t)(NWG - NGEMM0) * NTHR;
            for (size_t i = (size_t)(F.bx - NGEMM0) * NTHR + F.tid; i < n4; i += 8 * st) { f32x4 v[8];
#pragma unroll
                for (int k = 0; k < 8; ++k) if (i + k * st < n4) v[k] = ps[i + k * st];
#pragma unroll
                for (int k = 0; k < 8; ++k) if (i + k * st < n4) { u32x2 o; o.x = pk2(v[k].x, v[k].y); o.y = pk2(v[k].z, v[k].w); pd[i + k * st] = o; } }
        }
        for (int e = 0; e < NEXP - NEXP_TAIL; ++e) {
            xpose_gu(F, IN_(I_MWG) + (size_t)e * D * DFFE, IN_(I_MWU) + (size_t)e * D * DFFE, D, DFFE, MGU + (size_t)e * 2 * DFFE * (D / 2), scr, gw, NGW, IN_(I_LNFFN) + D);
            xpose_plain<MOE_DOWN_FP8 != 0>(F, IN_(I_MWD) + (size_t)e * DFFE * D, DFFE, D, MD + (size_t)e * D * (MOE_DOWN_FP8 ? DFFE / 2 : DFFE), scr, gw, NGW, nullptr);
        }
    }
    PHASE_END(false)

    for (int l = 0; l < DEPTH; ++l) {
        if (l > 0) {
        PHASE_BEGIN
        if (INPROJ1_FP8 && l == 1) { REFRESH_TID(); pg8::StaticOrder S; S.init(T, NU, NWG, F.bx); pg8::EpiBf16 E{U, NU, SSQ_(3 * l), W8_INV};
            pg8::Gemm g{(const bf16_t*)XB8, WIN + (size_t)l * NU * D, D / 2, D / 2, D / 2, 0}; pg8::gemm_phase<pg8::EpiBf16, pg8::StaticOrder, true, true>(F.lds + RING_OFF, g, S, E, F.tid); }
        else { REFRESH_TID(); pg8::StaticOrder S; S.init(T, NU, NWG, F.bx); pg8::EpiBf16 E{U, NU, SSQ_(3 * l), 1.0f};
            pg8::Gemm g{XBB, WIN + (size_t)l * NU * D, D, D, D, 0}; pg8::gemm_phase<pg8::EpiBf16, pg8::StaticOrder, true>(F.lds + RING_OFF, g, S, E, F.tid); }
        REFRESH_TID();
        { constexpr int IP1_REM = ((T / 256) * (NU / 256)) % NWG;
          if (NEXP_LATE > 0 && IP1_REM > 0 && F.bx >= IP1_REM) { LAS float* scr = (LAS float*)(F.lds + RING_OFF + F.wave * XP_SCR); const int gw = (F.bx - IP1_REM) * NWAVES + F.wave, NGW = (NWG - IP1_REM) * NWAVES;
            for (int e = NEXP - NEXP_LATE; e < NEXP; ++e)
              xpose_gu(F, IN_(I_MWG) + (size_t)e * D * DFFE, IN_(I_MWU) + (size_t)e * D * DFFE, D, DFFE, MGU + (size_t)e * 2 * DFFE * (D / 2), scr, gw, NGW, IN_(I_LNFFN) + D); } }
        PHASE_END(false)
        }
        PHASE_BEGIN
        {
            conv_phase(F, U, CVB, IN_(I_MCW) + (size_t)l * 4 * 1024, IN_(I_MCB) + (size_t)l * 1024, IN_(I_SCW) + (size_t)l * 4 * 1536, IN_(I_SCB) + (size_t)l * 1536);
            REFRESH_TID();
            kmean_items(F, U, KMEAN);
        }
        PHASE_END(false)
        PHASE_BEGIN
        {
            for (int u = F.vcu; u < NB * 16; u += NWG)
                ssd_unit(F, u >> 4, u & 15, U, CVB, MIX, SSQS, IN_(I_SDTB) + l * 16, IN_(I_SALOG) + l * 16, IN_(I_SD) + l * 16);
#ifdef PROBE_SSD2
            if (l == 0) { REFRESH_TID(); for (int u = F.vcu; u < NB * 16; u += NWG)
                ssd_unit(F, u >> 4, u & 15, U, CVB, MIX, SSQS, IN_(I_SDTB) + l * 16, IN_(I_SALOG) + l * 16, IN_(I_SD) + l * 16); REFRESH_TID(); }
#endif
            for (int u = F.vcu; u < NB * 16; u += NWG)
                mlstm_unit(F, u >> 4, (u >> 2) & 3, u & 3, U, CVB, MIX, SSQM, IN_(I_MGB) + l * 8);
        }
        PHASE_END(false)
        PHASE_BEGIN
        {
            for (int u = F.vcu; u < NB * 4 * 4; u += NWG) { const int bh = u >> 2, s = u & 3;
                moba_unit(F, bh >> 2, bh & 3, 7 - s, U, MIX, KMEAN); moba_unit(F, bh >> 2, bh & 3, s, U, MIX, KMEAN); }
            REFRESH_TID();
            mixnorm_rows(F, U, MIX, SSQM, SSQS, IN_(I_MNG) + (size_t)l * 512, IN_(I_SNG) + (size_t)l * 1024);
        }
        PHASE_END(false)
        PHASE_BEGIN
        { pg8::Gemm g{MIX, WOUT + (size_t)l * D * D, D, D, D, 0}; pg8::StaticOrder S; S.init(T, D, NWG, F.bx); STAGGER(920);
#ifdef PROBE_OUT2
          { pg8::EpiResidualStat E0{XBB, XN, XA8, PROBE_SSQ0, D, 0.5f}; pg8::gemm_phase<pg8::EpiResidualStat, pg8::StaticOrder, RES_ALIGN>(F.lds + RING_OFF, g, S, E0, F.tid); }
          xcd_barrier(bar);
          pg8::EpiResidualStat E{XN, XN, XA8, SSQ_(3 * l + 1), D, 0.5f};
#else
          pg8::EpiResidualStat E{XBB, XN, XA8, SSQ_(3 * l + 1), D, 1.0f};
#endif
          pg8::gemm_phase<pg8::EpiResidualStat, pg8::StaticOrder, RES_ALIGN>(F.lds + RING_OFF, g, S, E, F.tid); }
        PHASE_END(false)
        if (l == 0) {
            PHASE_BEGIN
            { pg8::Gemm g{(const bf16_t*)XA8, FGU, D / 2, D / 2, D / 2, 0}; pg8::StaticOrder S; S.init(T, 2 * DFF, NWG, F.bx); pg8::EpiSwiGLU<FFN_DOWN_FP8 != 0> E{H, DFF, nullptr, 0, SSQ_(3 * l + 1), nullptr, W8_INV};
              pg8::gemm_phase<pg8::EpiSwiGLU<FFN_DOWN_FP8 != 0>, pg8::StaticOrder, true, true>(F.lds + RING_OFF, g, S, E, F.tid); }
            PHASE_END(false)
            PHASE_BEGIN
            { constexpr int KD = FFN_DOWN_FP8 ? DFF / 2 : DFF; pg8::Gemm g{H, FD, KD, KD, KD, 0}; pg8::StaticOrder S; S.init(T, D, NWG, F.bx); pg8::EpiResidualStat E{XN, XN, XA8, SSQ_(3 * l + 2), D, FFN_DOWN_FP8 ? W8_INV * H8_INV : 1.0f};
              pg8::gemm_phase<pg8::EpiResidualStat, pg8::StaticOrder, RES_ALIGN, FFN_DOWN_FP8 != 0>(F.lds + RING_OFF, g, S, E, F.tid); }
            REFRESH_TID();
            { pg8::Gemm g{P16 + (size_t)l * T * PLE, PP + (size_t)l * D * PLE, PLE, PLE, PLE, 0}; pg8::StaticOrder S; S.init(T, D, NWG, F.bx); pg8::EpiBf16 E{(bf16_t*)WSB_(WS_PPB0), D, nullptr, 1.0f};
              pg8::gemm_phase<pg8::EpiBf16, pg8::StaticOrder, true>(F.lds + RING_OFF, g, S, E, F.tid); }
            PHASE_END(false)
        } else {
            PHASE_BEGIN
            moe_route(F, XN, IN_(I_LNFFN) + (size_t)l * D, IN_(I_ROUTER), ROUTE, WGCNT, TOK);
            PHASE_END(false)
            PHASE_BEGIN
            moe_gather(F, XA8, ROUTE, WGCNT, (unsigned char*)XG, TOK, WGT, RS);
            PHASE_END(false)
            {
                const LAS int* lt = (const LAS int*)(F.lds + LTAB_OFF);
                PHASE_BEGIN
                { const int rtb = lt[LT_CUMT + 8], rtc = lt[LT_CUMT + 16];
                  const int r0 = ((rtb - lt[LT_CUMT]) * (D / 256)) % NWG, nl = r0 > 0 ? NWG - r0 : 0, n1 = (rtc - rtb) * (2 * DFFE / 256), nu = rtc * (2 * DFFE / 256), ndmax = 3 * nl < n1 ? 3 * nl : n1, drem = (nu - ndmax) % NWG, ndtry = ndmax - ((NWG - drem) % NWG), ndef = ndtry >= 0 ? ndtry : ndmax;
                  pg8::Gemm g{XG, MGU, D / 2, D / 2, D / 2, (size_t)2 * DFFE * (D / 2)}; pg8::MoeOrderGU S{rtb, rtc, 2 * DFFE / 256, NWG, F.bx, 0, nu - ndef, lt + LT_TAB}; pg8::EpiSwiGLU<MOE_DOWN_FP8 != 0> E{HM, DFFE, WGT, 0, nullptr, RS, W8_INV};
                  pg8::gemm_phase<pg8::EpiSwiGLU<MOE_DOWN_FP8 != 0>, pg8::MoeOrderGU, true, true>(F.lds + RING_OFF, g, S, E, F.tid);
                }
                PHASE_END(false)
            }
            for (int slot = 0; slot < 2; ++slot) {
                const LAS int* lt = (const LAS int*)(F.lds + LTAB_OFF);
                PHASE_BEGIN
                { const int rt0 = lt[LT_CUMT + 8 * slot], rt1 = lt[LT_CUMT + 8 * slot + 8];
                  constexpr int KM = MOE_DOWN_FP8 ? DFFE / 2 : DFFE; pg8::Gemm g{HM, MD, KM, KM, KM, (size_t)D * KM}; pg8::MoeOrder S{rt0, rt1 - rt0, D / 256, NWG, F.bx, lt + LT_TAB};
                  #ifdef PROBE_MOEDOWN2
                  { pg8::EpiScatter<false> E0{XN, D, TOK, nullptr, nullptr, 0.5f * (MOE_DOWN_FP8 ? W8_INV * H8_INV : 1.0f)}; pg8::gemm_phase<pg8::EpiScatter<false>, pg8::MoeOrder, RES_ALIGN, MOE_DOWN_FP8 != 0>(F.lds + RING_OFF, g, S, E0, F.tid); } xcd_barrier(bar);
                  const float al_ = 0.5f * (MOE_DOWN_FP8 ? W8_INV * H8_INV : 1.0f);
#else
                  const float al_ = MOE_DOWN_FP8 ? W8_INV * H8_INV : 1.0f;
#endif
                  if (slot == 0) { pg8::EpiScatter<false> E{XN, D, TOK, nullptr, nullptr, al_}; pg8::gemm_phase<pg8::EpiScatter<false>, pg8::MoeOrder, RES_ALIGN, MOE_DOWN_FP8 != 0>(F.lds + RING_OFF, g, S, E, F.tid);
                    REFRESH_TID();
                    const int rtb = lt[LT_CUMT + 8], rtc = lt[LT_CUMT + 16];
                    const int r0 = ((rtb - lt[LT_CUMT]) * (D / 256)) % NWG, nl = r0 > 0 ? NWG - r0 : 0, n1 = (rtc - rtb) * (2 * DFFE / 256), nu = rtc * (2 * DFFE / 256), ndmax = 3 * nl < n1 ? 3 * nl : n1, drem = (nu - ndmax) % NWG, ndtry = ndmax - ((NWG - drem) % NWG), ndef = ndtry >= 0 ? ndtry : ndmax;
                    if (ndef > 0 && F.bx >= r0) { pg8::Gemm g3{XG, MGU, D / 2, D / 2, D / 2, (size_t)2 * DFFE * (D / 2)}; pg8::MoeOrderGU S3{rtb, rtc, 2 * DFFE / 256, nl, F.bx - r0, nu - ndef, nu, lt + LT_TAB}; pg8::EpiSwiGLU<MOE_DOWN_FP8 != 0> E3{HM, DFFE, WGT, 0, nullptr, RS, W8_INV};
                      pg8::gemm_phase<pg8::EpiSwiGLU<MOE_DOWN_FP8 != 0>, pg8::MoeOrderGU, true, true>(F.lds + RING_OFF, g3, S3, E3, F.tid); } }
                  else { pg8::EpiScatter<true> E{XN, D, TOK, XA8, SSQ_(3 * l + 2), al_}; pg8::gemm_phase<pg8::EpiScatter<true>, pg8::MoeOrder, RES_ALIGN, MOE_DOWN_FP8 != 0>(F.lds + RING_OFF, g, S, E, F.tid);
                    REFRESH_TID();
                    const int rem = ((rt1 - rt0) * (D / 256)) % NWG;
                    if (F.bx >= rem) { pg8::Gemm g2{P16 + (size_t)l * T * PLE, PP + (size_t)l * D * PLE, PLE, PLE, PLE, 0}; pg8::StaticOrder S2; S2.init(T, D, NWG - rem, F.bx - rem); pg8::EpiBf16 E2{(bf16_t*)WSB_(WS_PPB1), D, nullptr, 1.0f};
                      pg8::gemm_phase<pg8::EpiBf16, pg8::StaticOrder, true>(F.lds + RING_OFF, g2, S2, E2, F.tid); } } }
                PHASE_END(false)
            }
        }
        PHASE_BEGIN
        { pg8::Gemm g{(const bf16_t*)XA8, PG + (size_t)l * D * (D / 2), D / 2, D / 2, D / 2, 0}; pg8::StaticOrder S; S.init(T, D, NWG, F.bx); pg8::EpiPleGate E{XN, XBB, (const bf16_t*)WSB_(l == 0 ? WS_PPB0 : WS_PPB1), D, SSQ_(3 * l + 2), SSQ_(3 * l + 3), W8_INV, (INPROJ1_FP8 && l == 0) ? XB8 : nullptr};
          pg8::gemm_phase<pg8::EpiPleGate, pg8::StaticOrder, RES_ALIGN, true>(F.lds + RING_OFF, g, S, E, F.tid); }
        PHASE_END(false)
    }
    PHASE_BEGIN
    {
        const float* g = IN_(I_LNFINAL); float* X = X_; const bf16_t* xs = XBB; const pg8::ssq_t* sq = SSQ_(6); const int gw = F.vcu * NWAVES + F.wave, NGW = NWG * NWAVES;
        for (int m0 = gw; m0 < T; m0 += 4 * NGW) {
            u32x2 w[4][8]; float rstd[4];
#pragma unroll
            for (int k = 0; k < 4; ++k) { const int m = m0 + k * NGW; rstd[k] = pg8::ssq_rstd(sq, m); const u32x2* xr = (const u32x2*)(xs + (size_t)m * D) + F.lane;
#pragma unroll
                for (int j = 0; j < 8; ++j) w[k][j] = xr[64 * j]; }
#pragma unroll
            for (int k = 0; k < 4; ++k) { const int m = m0 + k * NGW; f32x4* orow = (f32x4*)(X + (size_t)m * D) + F.lane;
#pragma unroll
                for (int j = 0; j < 8; ++j) { const f32x4 gg = ((const f32x4*)g + F.lane)[64 * j]; f32x4 o; o.x = bflo(w[k][j].x) * rstd[k] * gg.x; o.y = bfhi(w[k][j].x) * rstd[k] * gg.y; o.z = bflo(w[k][j].y) * rstd[k] * gg.z; o.w = bfhi(w[k][j].y) * rstd[k] * gg.w; orow[64 * j] = o; } }
        }
    }
#ifdef PROBE_ML
    REFRESH_TID();
    if (ph >= lo && ph < hi && blockIdx.x == 0 && F.tid == 0) {
        asm volatile("s_waitcnt vmcnt(0)" ::: "memory");
        const unsigned long long* dg = (const unsigned long long*)(args.ws + 2883584);
        const unsigned long long d1 = dg[PROBE_I1], d2 = dg[PROBE_I2];
        X_[0] += 2.0f + (float)d1 * (1.0f / 4000.0f);
        const unsigned long long tgt = __builtin_amdgcn_s_memrealtime() + 8ull * d2;
        while (__builtin_amdgcn_s_memrealtime() < tgt) __builtin_amdgcn_s_sleep(32);
    }
#endif
#ifdef PROBE_TS
    REFRESH_TID();
    if (ph >= lo && ph < hi && blockIdx.x == 0 && F.tid == 0) {
        const LAS unsigned long long* ts = (const LAS unsigned long long*)((LAS unsigned char*)lds_raw + PTAB_OFF + 512);
        const unsigned long long dA = (PROBE_PA == 20 ? __builtin_amdgcn_s_memrealtime() : ts[PROBE_PA + 1]) - ts[PROBE_PA], dB = ts[PROBE_PB + 1] - ts[PROBE_PB];
        asm volatile("s_waitcnt vmcnt(0)" ::: "memory");
        X_[0] += 2.0f + (float)dB * (1.0f / 2000.0f);
        const unsigned long long tgt = __builtin_amdgcn_s_memrealtime() + 8ull * dA;
        while (__builtin_amdgcn_s_memrealtime() < tgt) __builtin_amdgcn_s_sleep(32);
    }
#endif
    PHASE_END(true)
#undef PHASE_BEGIN
#undef PHASE_END
}

extern "C" void kernel_launch(void* const* d_in, const int* in_sizes, int n_in, void* d_out, int out_size, void* d_ws, size_t ws_size, hipStream_t stream) {
    static int grid = 0;
    if (grid == 0) {
        if (n_in != 27 || out_size != T * D || ws_size < WS_END) { fprintf(stderr, "kernel_launch: unexpected shapes (n_in %d, out %d, ws %zu < %zu)\n", n_in, out_size, ws_size, (size_t)WS_END); grid = -1; return; }
        int dev = 0, cus = 0, per_cu = 0;
        if (hipGetDevice(&dev) != hipSuccess || hipDeviceGetAttribute(&cus, hipDeviceAttributeMultiprocessorCount, dev) != hipSuccess) { grid = -1; return; }
        if (hipFuncSetAttribute((const void*)hybrid_fwd, hipFuncAttributeMaxDynamicSharedMemorySize, LDS_BYTES) != hipSuccess) { fprintf(stderr, "kernel_launch: hipFuncSetAttribute failed\n"); grid = -1; return; }
        if (hipOccupancyMaxActiveBlocksPerMultiprocessor(&per_cu, (const void*)hybrid_fwd, NTHR, LDS_BYTES) != hipSuccess || per_cu < 1) fprintf(stderr, "kernel_launch: occupancy query reports %d\n", per_cu);
        (void)hipGetLastError();
        if (cus != 256) { fprintf(stderr, "kernel_launch: built for 256 CUs, device has %d\n", cus); grid = -1; return; }
        grid = cus;
    }
    if (grid < 0) return;
    if (hipMemsetAsync((char*)d_ws + WS_CTL, 0, CTL_ZERO_BYTES, stream) != hipSuccess) return;
    Args a{};
    for (int i = 0; i < 27; ++i) a.in[i] = (const float*)d_in[i];
    a.out = (float*)d_out; a.ws = (unsigned char*)d_ws;
#ifndef MK_SPLIT
    a.ph_lo = 0; a.ph_hi = 1000;
    hipLaunchKernelGGL(hybrid_fwd, dim3(NWG), dim3(NTHR), LDS_BYTES, stream, a);
#else
    for (int p = 0; p < 40; ++p) { a.ph_lo = p; a.ph_hi = p + 1; hipLaunchKernelGGL(hybrid_fwd, dim3(NWG), dim3(NTHR), LDS_BYTES, stream, a); }
#endif
}
```

```cpp
#define FFN_DOWN_FP8 1
#include <hip/hip_runtime.h>
#include <cstdio>
#include <cstdint>

#define GAS __attribute__((address_space(1)))
#define LAS __attribute__((address_space(3)))
typedef unsigned short bf16_t;
typedef short bf16x8 __attribute__((ext_vector_type(8)));
typedef short s16x4 __attribute__((ext_vector_type(4)));
typedef float f32x4 __attribute__((ext_vector_type(4)));
typedef float f32x2 __attribute__((ext_vector_type(2)));
typedef unsigned u32x4 __attribute__((ext_vector_type(4)));
typedef unsigned u32x2 __attribute__((ext_vector_type(2)));
typedef __bf16 bf16x2_t __attribute__((ext_vector_type(2)));

__device__ __forceinline__ unsigned pk2(float lo, float hi) { f32x2 v = {lo, hi}; bf16x2_t b = __builtin_convertvector(v, bf16x2_t); return __builtin_bit_cast(unsigned, b); }
__device__ __forceinline__ float bflo(unsigned w) { return __builtin_bit_cast(float, w << 16); }
__device__ __forceinline__ float bfhi(unsigned w) { return __builtin_bit_cast(float, w & 0xffff0000u); }
__device__ __forceinline__ float bf1(bf16_t h) { return __builtin_bit_cast(float, ((unsigned)h) << 16); }
__device__ __forceinline__ bf16_t f2bf(float f) { return (bf16_t)(pk2(f, 0.f) & 0xffffu); }
__device__ __forceinline__ float fast_exp(float x) { return __builtin_amdgcn_exp2f(x * 1.4426950408889634f); }
__device__ __forceinline__ float sigmoidf_(float x) { return __builtin_amdgcn_rcpf(1.0f + fast_exp(-x)); }
__device__ __forceinline__ float siluf_(float x) { return x * sigmoidf_(x); }
typedef int i32x8 __attribute__((ext_vector_type(8)));
__device__ __forceinline__ unsigned pk4_fp8(float a, float b, float c, float d) { int w; asm("" : "=v"(w)); w = __builtin_amdgcn_cvt_pk_fp8_f32(a, b, w, false); w = __builtin_amdgcn_cvt_pk_fp8_f32(c, d, w, true); return (unsigned)w; }
constexpr float W8_SCALE = 32.0f, W8_INV = 1.0f / 32.0f, H8_SCALE = 4.0f, H8_INV = 0.25f;

namespace pg8 {
constexpr int BM = 256, BK = 64, HALF = 128, HTB = HALF * BK * 2  , STAGE_BYTES = 8 * HTB, NXCD = 8, WGM = 8;

__host__ __device__ __forceinline__ int lds_byte(int r, int c) { const int st = (r >> 4) * 2 + (c >> 5), rr = r & 15, cc = c & 31, ob = rr * 64 + cc * 2; return st * 1024 + (ob ^ (((ob >> 9) & 1) << 5)); }
__host__ __device__ __forceinline__ void stage_rc(int b, int& R, int& C) { const int st = b / 1024, sb = b % 1024, swz = sb ^ (((sb >> 9) & 1) << 5); R = (st >> 1) * 16 + swz / 64; C = (st & 1) * 32 + (swz % 64) / 2; }
__host__ __device__ __forceinline__ int perm32(int rho) { const int n = rho >> 4, i = rho & 15; return 8 * (i >> 2) + 4 * n + (i & 3); }

struct Unit { int pm, pn, e; };
struct Gemm { const bf16_t* A; const bf16_t* Bt; int lda, ldb, K; size_t estride; };

struct StaticOrder {
    int nM, nN, nwg, G, c;
    __device__ void init(int M, int N, int G_, int c_) { nM = M / BM; nN = N / BM; nwg = nM * nN; G = G_; c = c_; }
    __device__ bool next(int i, Unit& u) const {
        const long L = (long)i * G + c; if (L >= nwg) return false;
        int wgid = (int)L; { const int q = nwg / NXCD, r = nwg % NXCD, xcd = wgid % NXCD, off = wgid / NXCD; wgid = (xcd < r ? xcd * (q + 1) : r * (q + 1) + (xcd - r) * q) + off; }
        const int nig = WGM * nN, gid = wgid / nig, fm = gid * WGM, gsz = (nM - fm) < WGM ? (nM - fm) : WGM;
        u.pm = fm + ((wgid % nig) % gsz); u.pn = (wgid % nig) / gsz; u.e = 0; return true;
    }
};
struct MoeOrder {
    int rt0, nrt, nN, G, c; const LAS int* tab;
    __device__ bool next(int i, Unit& u) const {
        const int nwg = nrt * nN; const long L = (long)i * G + c; if (L >= nwg) return false;
        int wgid = (int)L; { const int q = nwg / NXCD, r = nwg % NXCD, xcd = wgid % NXCD, off = wgid / NXCD; wgid = (xcd < r ? xcd * (q + 1) : r * (q + 1) + (xcd - r) * q) + off; }
        const int nig = WGM * nN, gid = wgid / nig, fm = gid * WGM, gsz = (nrt - fm) < WGM ? (nrt - fm) : WGM;
        u.pm = rt0 + fm + ((wgid % nig) % gsz); u.pn = (wgid % nig) / gsz; u.e = tab[u.pm]; return true;
    }
};

struct MoeOrderGU {
    int rtb, rtc, nN, G, c, L0, Lend; const LAS int* tab;
    __device__ bool next(int i, Unit& u) const {
        const int L = L0 + i * G + c; if (L >= Lend || c < 0) return false;
        const int n0 = rtb * nN; int j, nrt, rt0; if (L < n0) { j = L; nrt = rtb; rt0 = 0; } else { j = L - n0; nrt = rtc - rtb; rt0 = rtb; }
        const int nwg = nrt * nN; { const int q = nwg / NXCD, r = nwg % NXCD, xcd = j % NXCD, off = j / NXCD; j = (xcd < r ? xcd * (q + 1) : r * (q + 1) + (xcd - r) * q) + off; }
        const int nig = WGM * nN, gid = j / nig, fm = gid * WGM, gsz = (nrt - fm) < WGM ? (nrt - fm) : WGM;
        u.pm = rt0 + fm + ((j % nig) % gsz); u.pn = (j % nig) / gsz; u.e = tab[u.pm]; return true;
    }
};


__device__ __forceinline__ float epi_shfl(float v, int src) { return __builtin_bit_cast(float, __builtin_amdgcn_ds_bpermute(src << 2, __builtin_bit_cast(int, v))); }
constexpr float RMS_EPS = 1e-6f, INV_D = 1.0f / 2048.0f, SSQ_SCALE = 16777216.0f, SSQ_INV = INV_D / 16777216.0f;
typedef unsigned long long ssq_t;
__device__ __forceinline__ float ssq_rstd(const ssq_t* p, int row) { return __builtin_amdgcn_rsqf((float)p[row] * SSQ_INV + RMS_EPS); }
__device__ __forceinline__ void ssq_add(ssq_t* p, int row, float q) { __hip_atomic_fetch_add(p + row, (ssq_t)(q * SSQ_SCALE + 0.5f), __ATOMIC_RELAXED, __HIP_MEMORY_SCOPE_AGENT); }
struct EpiBf16 {
    static constexpr bool PERM = true;
    bf16_t* O; int ldc; const ssq_t* ssq; float wscale;
    __device__ __forceinline__ void operator()(const f32x4 (&acc)[2][2][4][2], const Unit& u, int wr, int wc, int fr, int fq) const {
        const int row0 = u.pm * BM + wr * 64 + fr, col0 = u.pn * BM + wc * 32 + 8 * fq;
#pragma unroll
        for (int ai = 0; ai < 2; ++ai)
#pragma unroll
            for (int m = 0; m < 4; ++m) { const int row = row0 + ai * HALF + m * 16; const float s = (ssq ? ssq_rstd(ssq, row) : 1.0f) * wscale;
                bf16_t* rowp = O + (size_t)row * ldc + col0;
#pragma unroll
                for (int bj = 0; bj < 2; ++bj) { const f32x4 v0 = acc[ai][bj][m][0] * s, v1 = acc[ai][bj][m][1] * s;
                    u32x4 w; w.x = pk2(v0[0], v0[1]); w.y = pk2(v0[2], v0[3]); w.z = pk2(v1[0], v1[1]); w.w = pk2(v1[2], v1[3]);
                    *(u32x4*)(rowp + bj * HALF) = w; } }
    }
};
template <bool OUT8> struct EpiSwiGLU {
    static constexpr bool PERM = true;
    bf16_t* H; int ldc; const float* wgt; int rt0; const ssq_t* ssq; const float* rs; float wscale;
    LAS float* cch; volatile LAS unsigned* ctag;
    __device__ __forceinline__ void operator()(const f32x4 (&acc)[2][2][4][2], const Unit& u, int wr, int wc, int fr, int fq) const {
        const int row0 = u.pm * BM + wr * 64 + fr, col0 = u.pn * HALF + wc * 32 + 8 * fq;
        float sv[2][4], rv[2][4];
        if (cch) { const int wid = wr * 4 + wc; LAS f32x2* my = (LAS f32x2*)(cch + wid * 256);
            const unsigned tg = (unsigned)__builtin_amdgcn_readfirstlane((int)ctag[wid]);
            if (tg != (unsigned)(u.pm + 1)) {
#pragma unroll
                for (int ai = 0; ai < 2; ++ai)
#pragma unroll
                    for (int m = 0; m < 4; ++m) { const int row = row0 + ai * HALF + m * 16; const f32x2 pr = {wgt[row], rs[row]}; if (fq == 0) my[(ai * 4 + m) * 16 + fr] = pr; }
                if (fq == 0 && fr == 0) ctag[wid] = (unsigned)(u.pm + 1); }
#pragma unroll
            for (int ai = 0; ai < 2; ++ai)
#pragma unroll
                for (int m = 0; m < 4; ++m) { const f32x2 pr = my[(ai * 4 + m) * 16 + fr]; sv[ai][m] = pr.x; rv[ai][m] = pr.y; } }
        else {
#pragma unroll
            for (int ai = 0; ai < 2; ++ai)
#pragma unroll
                for (int m = 0; m < 4; ++m) { const int row = row0 + ai * HALF + m * 16; sv[ai][m] = wgt ? wgt[row] : 1.0f; rv[ai][m] = rs ? rs[row] : ssq_rstd(ssq, row); } }
#pragma unroll
        for (int ai = 0; ai < 2; ++ai)
#pragma unroll
            for (int m = 0; m < 4; ++m) { const int row = row0 + ai * HALF + m * 16; const float s = sv[ai][m]; const float rn = rv[ai][m] * wscale;
                const float kn = rn * -1.4426950408889634f, ku = rn * s * (OUT8 ? H8_SCALE : 1.0f);
                const f32x2 rn2 = {rn, rn}, kn2 = {kn, kn}, ku2 = {ku, ku};
                f32x2 o[4];
#pragma unroll
                for (int n = 0; n < 2; ++n)
#pragma unroll
                    for (int h = 0; h < 2; ++h) { const f32x2 g = {acc[ai][0][m][n][2 * h], acc[ai][0][m][n][2 * h + 1]}, uu = {acc[ai][1][m][n][2 * h], acc[ai][1][m][n][2 * h + 1]};
                        const f32x2 t = g * kn2; f32x2 e; e.x = __builtin_amdgcn_exp2f(t.x); e.y = __builtin_amdgcn_exp2f(t.y);
                        const f32x2 d = e + 1.0f; f32x2 r; r.x = __builtin_amdgcn_rcpf(d.x); r.y = __builtin_amdgcn_rcpf(d.y);
                        o[2 * n + h] = ((g * rn2) * r) * (uu * ku2); }
                if constexpr (OUT8) { u32x2 b; b.x = pk4_fp8(o[0].x, o[0].y, o[1].x, o[1].y); b.y = pk4_fp8(o[2].x, o[2].y, o[3].x, o[3].y);
                    *(u32x2*)((unsigned char*)H + (size_t)(row - rt0 * BM) * ldc + col0) = b; }
                else { u32x4 w; w.x = pk2(o[0].x, o[0].y); w.y = pk2(o[1].x, o[1].y); w.z = pk2(o[2].x, o[2].y); w.w = pk2(o[3].x, o[3].y);
                    *(u32x4*)(H + (size_t)(row - rt0 * BM) * ldc + col0) = w; } }
    }
};
__device__ __forceinline__ void unpack8(const u32x4 w, float (&f)[8]) { f[0] = bflo(w.x); f[1] = bfhi(w.x); f[2] = bflo(w.y); f[3] = bfhi(w.y); f[4] = bflo(w.z); f[5] = bfhi(w.z); f[6] = bflo(w.w); f[7] = bfhi(w.w); }
__device__ __forceinline__ float store_row8(bf16_t* XSo, unsigned char* X8, size_t off, const float (&x)[8]) {
    u32x4 w; w.x = pk2(x[0], x[1]); w.y = pk2(x[2], x[3]); w.z = pk2(x[4], x[5]); w.w = pk2(x[6], x[7]); *(u32x4*)(XSo + off) = w;
    if (X8) { u32x2 b; b.x = pk4_fp8(x[0], x[1], x[2], x[3]); b.y = pk4_fp8(x[4], x[5], x[6], x[7]); *(u32x2*)(X8 + off) = b; }
    float r[8]; unpack8(w, r); return ((r[0] * r[0] + r[1] * r[1]) + (r[2] * r[2] + r[3] * r[3])) + ((r[4] * r[4] + r[5] * r[5]) + (r[6] * r[6] + r[7] * r[7]));
}
struct EpiResidualStat {
    static constexpr bool PERM = true;
    const bf16_t* XSi; bf16_t* XSo; unsigned char* X8; ssq_t* ssq; int ldc; float alpha;
    __device__ __forceinline__ void operator()(const f32x4 (&acc)[2][2][4][2], const Unit& u, int wr, int wc, int fr, int fq) const {
        const int row0 = u.pm * BM + wr * 64 + fr, col0 = u.pn * BM + wc * 32 + 8 * fq, lane = fq * 16 + fr;
#pragma unroll
        for (int ai = 0; ai < 2; ++ai) {
            u32x4 xi[4][2]; float q[4];
#pragma unroll
            for (int m = 0; m < 4; ++m)
#pragma unroll
                for (int bj = 0; bj < 2; ++bj) xi[m][bj] = *(const u32x4*)(XSi + (size_t)(row0 + ai * HALF + m * 16) * ldc + col0 + bj * HALF);
#pragma unroll
            for (int m = 0; m < 4; ++m) { const size_t off = (size_t)(row0 + ai * HALF + m * 16) * ldc + col0; q[m] = 0.f;
#pragma unroll
                for (int bj = 0; bj < 2; ++bj) { float x[8]; unpack8(xi[m][bj], x);
#pragma unroll
                    for (int j = 0; j < 4; ++j) { x[j] += acc[ai][bj][m][0][j] * alpha; x[4 + j] += acc[ai][bj][m][1][j] * alpha; }
                    q[m] += store_row8(XSo, X8, off + bj * HALF, x); } }
#pragma unroll
            for (int m = 0; m < 4; ++m) { q[m] += epi_shfl(q[m], lane ^ 16); q[m] += epi_shfl(q[m], lane ^ 32); }
            if (fq == 0 && ssq) {
#pragma unroll
                for (int m = 0; m < 4; ++m) ssq_add(ssq, row0 + ai * HALF + m * 16, q[m]); }
        }
    }
};
template <bool STAT> struct EpiScatter {
    static constexpr bool PERM = true;
    bf16_t* XS; int ldc; const int* tok; unsigned char* X8; ssq_t* ssq; float alpha;
    __device__ __forceinline__ void operator()(const f32x4 (&acc)[2][2][4][2], const Unit& u, int wr, int wc, int fr, int fq) const {
        const int row0 = u.pm * BM + wr * 64 + fr, col0 = u.pn * BM + wc * 32 + 8 * fq, lane = fq * 16 + fr;
        int tk[2][4];
#pragma unroll
        for (int ai = 0; ai < 2; ++ai)
#pragma unroll
            for (int m = 0; m < 4; ++m) tk[ai][m] = tok[row0 + ai * HALF + m * 16];
#pragma unroll
        for (int ai = 0; ai < 2; ++ai) {
            u32x4 xi[4][2]; float q[4];
#pragma unroll
            for (int m = 0; m < 4; ++m) { const int t = tk[ai][m] >= 0 ? tk[ai][m] : 0;
#pragma unroll
                for (int bj = 0; bj < 2; ++bj) xi[m][bj] = *(const u32x4*)(XS + (size_t)t * ldc + col0 + bj * HALF); }
#pragma unroll
            for (int m = 0; m < 4; ++m) { const int t = tk[ai][m]; q[m] = 0.f;
                if (t >= 0) { const size_t off = (size_t)t * ldc + col0;
#pragma unroll
                    for (int bj = 0; bj < 2; ++bj) { float x[8]; unpack8(xi[m][bj], x);
#pragma unroll
                        for (int j = 0; j < 4; ++j) { x[j] += acc[ai][bj][m][0][j] * alpha; x[4 + j] += acc[ai][bj][m][1][j] * alpha; }
                        q[m] += store_row8(XS, STAT ? X8 : nullptr, off + bj * HALF, x); } } }
            if (STAT) {
#pragma unroll
                for (int m = 0; m < 4; ++m) { q[m] += epi_shfl(q[m], lane ^ 16); q[m] += epi_shfl(q[m], lane ^ 32); }
                if (fq == 0) {
#pragma unroll
                    for (int m = 0; m < 4; ++m) if (tk[ai][m] >= 0) ssq_add(ssq, tk[ai][m], q[m]); } }
        }
    }
};
struct EpiPleGate {
    static constexpr bool PERM = true;
    const bf16_t* XSi; bf16_t* XSo; const bf16_t* PPB; int ldc; const ssq_t* ssq_in; ssq_t* ssq_out; float wscale; unsigned char* X8o;
    __device__ __forceinline__ void operator()(const f32x4 (&acc)[2][2][4][2], const Unit& u, int wr, int wc, int fr, int fq) const {
        const int row0 = u.pm * BM + wr * 64 + fr, col0 = u.pn * BM + wc * 32 + 8 * fq, lane = fq * 16 + fr;
#pragma unroll
        for (int ai = 0; ai < 2; ++ai) {
            u32x4 xi[4][2], pp[4][2]; float q[4], rn[4];
#pragma unroll
            for (int m = 0; m < 4; ++m) { rn[m] = ssq_rstd(ssq_in, row0 + ai * HALF + m * 16) * wscale;
#pragma unroll
                for (int bj = 0; bj < 2; ++bj) { const size_t o = (size_t)(row0 + ai * HALF + m * 16) * ldc + col0 + bj * HALF; xi[m][bj] = *(const u32x4*)(XSi + o); pp[m][bj] = *(const u32x4*)(PPB + o); } }
#pragma unroll
            for (int m = 0; m < 4; ++m) { const size_t off = (size_t)(row0 + ai * HALF + m * 16) * ldc + col0; q[m] = 0.f;
#pragma unroll
                for (int bj = 0; bj < 2; ++bj) { float x[8], p[8]; unpack8(xi[m][bj], x); unpack8(pp[m][bj], p);
                    const float kn = rn[m] * -1.4426950408889634f; const f32x2 kn2 = {kn, kn};
#pragma unroll
                    for (int n = 0; n < 2; ++n)
#pragma unroll
                        for (int h = 0; h < 2; ++h) { const f32x2 a = {acc[ai][bj][m][n][2 * h], acc[ai][bj][m][n][2 * h + 1]}; const f32x2 t = a * kn2;
                            f32x2 e; e.x = __builtin_amdgcn_exp2f(t.x); e.y = __builtin_amdgcn_exp2f(t.y); const f32x2 d = e + 1.0f; f32x2 r; r.x = __builtin_amdgcn_rcpf(d.x); r.y = __builtin_amdgcn_rcpf(d.y);
                            const f32x2 pv = {p[4 * n + 2 * h], p[4 * n + 2 * h + 1]}, xv = {x[4 * n + 2 * h], x[4 * n + 2 * h + 1]}; const f32x2 o = pv * r + xv; x[4 * n + 2 * h] = o.x; x[4 * n + 2 * h + 1] = o.y; }
                    q[m] += store_row8(XSo, X8o, off + bj * HALF, x); } }
#pragma unroll
            for (int m = 0; m < 4; ++m) { q[m] += epi_shfl(q[m], lane ^ 16); q[m] += epi_shfl(q[m], lane ^ 32); }
            if (fq == 0) {
#pragma unroll
                for (int m = 0; m < 4; ++m) ssq_add(ssq_out, row0 + ai * HALF + m * 16, q[m]); }
        }
    }
};

template <class Epi, class Sched, bool ALIGN_EPI, bool FP8 = false>
__device__ __forceinline__ void gemm_phase(LAS unsigned char* lds, const Gemm g, const Sched& S, const Epi& E, int tid_in) {
    int tid_ = tid_in; asm volatile("" : "+v"(tid_));
    const int tid = tid_, wid = __builtin_amdgcn_readfirstlane(tid >> 6), lane = tid & 63, wr = wid >> 2, wc = wid & 3, fr = lane & 15, fq = lane >> 4;
    const int K = g.K, nt = K / BK;
    unsigned voffA[2], voffB[2];
#pragma unroll
    for (int i = 0; i < 2; ++i) { int R, C; stage_rc(tid * 16 + i * 8192, R, C); const int Rb = Epi::PERM ? ((R & ~31) + perm32(R & 31)) : R;
        voffA[i] = (unsigned)(R * g.lda + C) * 2u; voffB[i] = (unsigned)(Rb * g.ldb + C) * 2u; }
    const __amdgpu_buffer_rsrc_t rA = __builtin_amdgcn_make_buffer_rsrc((void*)g.A, 0, 0xffffffff, 0x00020000), rB = __builtin_amdgcn_make_buffer_rsrc((void*)g.Bt, 0, 0xffffffff, 0x00020000);
    const unsigned kstep = (unsigned)(BK * 2);
    const unsigned hstepA = (unsigned)HALF * g.lda * 2u, hstepB = (unsigned)HALF * g.ldb * 2u;
    const unsigned tstepA = 2u * hstepA, tstepB = 2u * hstepB, estepB = (unsigned)(g.estride * 2);
    const unsigned ldsw = (unsigned)wid * 1024u;
    const int aoff = lds_byte(wr * 64 + fr, fq * 8), boff = lds_byte(wc * 32 + fr, fq * 8);
#define PG8_SA(b, h) (((b) * 2 + (h)) * HTB)
#define PG8_SB(b, h) ((4 + (b) * 2 + (h)) * HTB)
#define PG8_STAGE(bufoff, rs, soff, voff) do { _Pragma("unroll") for (int _i = 0; _i < 2; ++_i) \
        __builtin_amdgcn_raw_ptr_buffer_load_lds((rs), (LAS unsigned*)(lds + (bufoff) + ldsw + _i * 8192), 16, (voff)[_i], (soff), 0, 0); } while (0)
#define PG8_LD8(base) __builtin_bit_cast(i32x8, __builtin_shufflevector(*(const LAS u32x4*)(base), *(const LAS u32x4*)((base) + 1024), 0, 1, 2, 3, 4, 5, 6, 7))
#define PG8_LDA(dst, b, h) do { if constexpr (FP8) { _Pragma("unroll") for (int m = 0; m < 4; ++m) dst##8[m] = PG8_LD8(lds + PG8_SA(b, h) + aoff + m * 2048); } \
        else { _Pragma("unroll") for (int m = 0; m < 4; ++m) _Pragma("unroll") for (int k = 0; k < 2; ++k) dst[m][k] = *(const LAS bf16x8*)(lds + PG8_SA(b, h) + aoff + m * 2048 + k * 1024); } } while (0)
#define PG8_LDB(dst, b, h) do { if constexpr (FP8) { _Pragma("unroll") for (int n = 0; n < 2; ++n) dst##8[n] = PG8_LD8(lds + PG8_SB(b, h) + boff + n * 2048); } \
        else { _Pragma("unroll") for (int n = 0; n < 2; ++n) _Pragma("unroll") for (int k = 0; k < 2; ++k) dst[n][k] = *(const LAS bf16x8*)(lds + PG8_SB(b, h) + boff + n * 2048 + k * 1024); } } while (0)
#define PG8_MMA(ai, bj, At, Bt) do { __builtin_amdgcn_s_setprio(1); \
        if constexpr (FP8) { _Pragma("unroll") for (int m = 0; m < 4; ++m) _Pragma("unroll") for (int n = 0; n < 2; ++n) \
            acc[ai][bj][m][n] = __builtin_amdgcn_mfma_scale_f32_16x16x128_f8f6f4(Bt##8[n], At##8[m], acc[ai][bj][m][n], 0, 0, 0, 0x7f7f7f7f, 0, 0x7f7f7f7f); } \
        else { _Pragma("unroll") for (int m = 0; m < 4; ++m) _Pragma("unroll") for (int n = 0; n < 2; ++n) _Pragma("unroll") for (int k = 0; k < 2; ++k) \
            acc[ai][bj][m][n] = __builtin_amdgcn_mfma_f32_16x16x32_bf16(Bt[n][k], At[m][k], acc[ai][bj][m][n], 0, 0, 0); } \
        __builtin_amdgcn_s_setprio(0); } while (0)
#define PG8_WAIT_V(n) asm volatile("s_waitcnt vmcnt(" #n ")" ::: "memory")
#define PG8_WAIT_L(n) asm volatile("s_waitcnt lgkmcnt(" #n ")" ::: "memory")
#define PG8_BAR __builtin_amdgcn_s_barrier()
#define PG8_SCHED __builtin_amdgcn_sched_barrier(0)
    Unit cur, nxt; int ui = 0;
    if (!S.next(0, cur)) return;
    f32x4 acc[2][2][4][2];
    int zi_ = 0; asm volatile("" : "+s"(zi_)); const float zf_ = __builtin_bit_cast(float, zi_);
#pragma unroll
    for (int a = 0; a < 2; ++a)
#pragma unroll
        for (int b = 0; b < 2; ++b)
#pragma unroll
            for (int m = 0; m < 4; ++m)
#pragma unroll
                for (int n = 0; n < 2; ++n) acc[a][b][m][n] = (f32x4){zf_, zf_, zf_, zf_};
    bf16x8 At[4][2], B0[2][2], B1[2][2];
    i32x8 At8[4], B08[2], B18[2];
    unsigned cA = (unsigned)cur.pm * tstepA, cB = (unsigned)cur.e * estepB + (unsigned)cur.pn * tstepB;
    PG8_STAGE(PG8_SB(0, 0), rB, cB, voffB); PG8_STAGE(PG8_SB(0, 1), rB, cB + hstepB, voffB); PG8_STAGE(PG8_SA(0, 0), rA, cA, voffA); PG8_STAGE(PG8_SA(0, 1), rA, cA + hstepA, voffA);
    if (wr == 1) PG8_BAR;
    PG8_WAIT_V(2); PG8_BAR;
    PG8_STAGE(PG8_SB(1, 0), rB, cB + kstep, voffB); PG8_STAGE(PG8_SA(1, 0), rA, cA + kstep, voffA); PG8_STAGE(PG8_SB(1, 1), rB, cB + hstepB + kstep, voffB);
    PG8_WAIT_V(6); PG8_BAR;
    for (;;) {
        const bool has_next = S.next(ui + 1, nxt);
        const unsigned nA = has_next ? (unsigned)nxt.pm * tstepA : cA, nB = has_next ? (unsigned)nxt.e * estepB + (unsigned)nxt.pn * tstepB : cB;
        asm volatile(".p2align 8" ::: "memory");
        for (int t = 0; t < nt; t += 2) {
            const bool last = (t == nt - 2);
            const unsigned a1 = cA + (unsigned)(t + 1) * kstep;
            const unsigned a2 = last ? nA : cA + (unsigned)(t + 2) * kstep, b2 = last ? nB : cB + (unsigned)(t + 2) * kstep;
            const unsigned a3 = a2 + kstep, b3 = b2 + kstep;
            PG8_LDB(B0, 0, 0); PG8_LDB(B1, 0, 1); PG8_SCHED; PG8_LDA(At, 0, 0); PG8_STAGE(PG8_SA(1, 1), rA, a1 + hstepA, voffA);
            PG8_WAIT_V(8); PG8_WAIT_L(0); PG8_BAR; PG8_MMA(0, 0, At, B0); PG8_MMA(0, 1, At, B1); PG8_BAR; PG8_SCHED;
            PG8_LDA(At, 0, 1); PG8_STAGE(PG8_SB(0, 0), rB, b2, voffB); PG8_STAGE(PG8_SB(0, 1), rB, b2 + hstepB, voffB); PG8_STAGE(PG8_SA(0, 0), rA, a2, voffA);
            PG8_WAIT_V(8); PG8_WAIT_L(0); PG8_BAR; PG8_MMA(1, 0, At, B0); PG8_MMA(1, 1, At, B1); PG8_BAR; PG8_SCHED;
            PG8_LDB(B0, 1, 0); PG8_LDB(B1, 1, 1); PG8_SCHED; PG8_LDA(At, 1, 0); PG8_STAGE(PG8_SA(0, 1), rA, a2 + hstepA, voffA);
            PG8_WAIT_V(8); PG8_WAIT_L(0); PG8_BAR; PG8_MMA(0, 0, At, B0); PG8_MMA(0, 1, At, B1); PG8_BAR; PG8_SCHED;
            PG8_LDA(At, 1, 1); PG8_STAGE(PG8_SB(1, 0), rB, b3, voffB); PG8_STAGE(PG8_SB(1, 1), rB, b3 + hstepB, voffB); PG8_STAGE(PG8_SA(1, 0), rA, a3, voffA);
            PG8_WAIT_V(8); PG8_WAIT_L(0); PG8_BAR; PG8_MMA(1, 0, At, B0); PG8_MMA(1, 1, At, B1); PG8_BAR; PG8_SCHED;
        }
        if constexpr (ALIGN_EPI) { if (wr == 0) PG8_BAR; }
        { unsigned z_ = 0u; asm volatile("" : "+s"(z_)); const int l2 = (int)__builtin_amdgcn_mbcnt_hi(~0u, __builtin_amdgcn_mbcnt_lo(~0u, z_)); E(acc, cur, wr, wc, l2 & 15, l2 >> 4); }
        if (!has_next) break;
#pragma unroll
        for (int a = 0; a < 2; ++a)
#pragma unroll
            for (int b = 0; b < 2; ++b)
#pragma unroll
                for (int m = 0; m < 4; ++m)
#pragma unroll
                    for (int n = 0; n < 2; ++n) acc[a][b][m][n] = (f32x4){zf_, zf_, zf_, zf_};
        cur = nxt; cA = nA; cB = nB; ++ui;
        if constexpr (ALIGN_EPI) { if (wr == 1) PG8_BAR; }
    }
    PG8_WAIT_V(0);
    if constexpr (!ALIGN_EPI) { if (wr == 0) PG8_BAR; }
    PG8_BAR;
#undef PG8_SA
#undef PG8_SB
#undef PG8_STAGE
#undef PG8_LDA
#undef PG8_LDB
#undef PG8_MMA
#undef PG8_LD8
#undef PG8_WAIT_V
#undef PG8_WAIT_L
#undef PG8_BAR
#undef PG8_SCHED
}
}
constexpr int NB = 16, SEQ = 2048, T = NB * SEQ, D = 2048, DEPTH = 2;
constexpr int DPROJ_SRC = 6168, NU = 6400;
constexpr int DFF = 5632, NEXP = 8, DFFE = 7168, PLE = 256;
constexpr float EPS = 1e-6f;
constexpr int UQ = 0, UK = 512, UV = 1024, UO = 1536, UZ = 2048, UXBC = 3072, UAQ = 4608, UAK = 5120, UAV = 5632, UMI = 6144, UMF = 6148, UDT = 6152;
constexpr int MIXM = 0, MIXS = 512, MIXA = 1536;
constexpr int NWAVES = 8, NTHR = 512, NWG = 256;

constexpr size_t MiB = 1u << 20;
constexpr size_t WS_CTL = 0, CTL_ZERO_BYTES = 3 * MiB;
constexpr size_t WS_SSQ = 1 * MiB;
constexpr size_t WS_WIN = 4 * MiB;
constexpr size_t WS_WOUT = WS_WIN + 50 * MiB;
constexpr size_t WS_FGU = WS_WOUT + 16 * MiB;
constexpr size_t WS_FD = WS_FGU + 44 * MiB;
constexpr size_t WS_MGU = WS_FD + 22 * MiB;
constexpr size_t WS_MD = WS_MGU + 448 * MiB;
constexpr size_t WS_PG = WS_MD + 224 * MiB;
constexpr size_t WS_PP = WS_PG + 16 * MiB;
constexpr size_t WS_XN = WS_PP + 2 * MiB;
constexpr size_t WS_P16 = WS_XN + 128 * MiB;
constexpr size_t WS_R = WS_P16 + 32 * MiB;
constexpr size_t WS_U = WS_R;
constexpr size_t WS_MIX = WS_R + 400 * MiB;
constexpr size_t WS_CV = WS_R + 528 * MiB;
constexpr size_t WS_H = WS_R;
constexpr size_t WS_PPB0 = WS_R + 352 * MiB, WS_PPB1 = WS_R;
constexpr size_t WS_XG = WS_R;
constexpr size_t WS_HM = WS_R + 272 * MiB;
constexpr size_t WS_MISC = WS_R + 748 * MiB;
constexpr size_t WS_SSQM = WS_MISC;
constexpr size_t WS_SSQS = WS_SSQM + 4 * MiB;
constexpr size_t WS_KMEAN = WS_SSQS + 2 * MiB;
constexpr size_t WS_ROUTE = WS_KMEAN + 1 * MiB;
constexpr size_t WS_TOK = WS_ROUTE + 1 * MiB;
constexpr size_t WS_WGT = WS_TOK + 1 * MiB;
constexpr size_t WS_WGCNT = WS_WGT + 1 * MiB;
constexpr size_t WS_XBB = WS_WGCNT + 1 * MiB;
constexpr size_t WS_XA8 = WS_XBB + 128 * MiB;
constexpr size_t WS_END = WS_XA8 + 64 * MiB;
constexpr int MOE_ROWS = 69632, MOE_SLOT_ROWS = 34816;
constexpr int CW_TMO = 0, CW_BAR = 4096;

constexpr int RING_OFF = 0, RING_BYTES = 131072;
constexpr int LDSCTL_OFF = 139264;
constexpr int MISC_OFF = LDSCTL_OFF;
constexpr int LTAB_OFF = LDSCTL_OFF + 256;
constexpr int PTAB_OFF = LDSCTL_OFF + 6144;
constexpr int LDS_BYTES = 147456;

#define XB_TMO      128
#define XB_XCNT(j)  (256  + 64 * (j))
#define XB_XSUB(j)  (1280 + 64 * (j))
#define XB_XGEN(j)  (2304 + 64 * (j))
#define XB_TOP      3328
#define XB_TOPGEN   3392
#define XCD_BAR_WORDS 3456
#define XB_SPIN_CAP (1u << 18)

__device__ __forceinline__ unsigned xb_ld(unsigned* p)              { return __hip_atomic_load(p, __ATOMIC_RELAXED, __HIP_MEMORY_SCOPE_AGENT); }
__device__ __forceinline__ unsigned xb_add(unsigned* p, unsigned v) { return __hip_atomic_fetch_add(p, v, __ATOMIC_RELAXED, __HIP_MEMORY_SCOPE_AGENT); }
__device__ __forceinline__ unsigned xb_xcc_id() { return (unsigned)__builtin_amdgcn_s_getreg((3 << 11) | 20) & 0xFu; }
#define XB_SPIN(cond, bar) do { unsigned _sp = 0; while (cond) { __builtin_amdgcn_s_sleep(1); \
    if ((++_sp & 255u) == 0u) { if (xb_ld(&(bar)[XB_TMO])) break; if (_sp > XB_SPIN_CAP) { atomicAdd(&(bar)[XB_TMO], 1u); break; } } } } while (0)

struct XcdBarrier { unsigned* bar; unsigned x; volatile LAS unsigned* st; };

__device__ __forceinline__ XcdBarrier xcd_barrier_post(unsigned* bar, volatile LAS unsigned* st) {
    XcdBarrier b; b.bar = bar; b.x = xb_xcc_id(); b.st = st;
    if (threadIdx.x == 0) (void)xb_add(&bar[XB_XCNT(b.x)], 1u);
    return b;
}
__device__ __forceinline__ void xcd_barrier_complete(unsigned* bar, unsigned x, unsigned& nloc, unsigned& nx) {
    const unsigned G = NWG;
    unsigned sum, cnt, mine, sp = 0u;
    for (;;) {
        sum = 0u; cnt = 0u; mine = 0u;
#pragma unroll
        for (unsigned j = 0; j < 16; ++j) { const unsigned c = xb_ld(&bar[XB_XCNT(j)]); sum += c; cnt += (c > 0u) ? 1u : 0u; mine = (j == x) ? c : mine; }
        if (sum == G) break;
        __builtin_amdgcn_s_sleep(1);
        if ((++sp & 255u) == 0u) { if (xb_ld(&bar[XB_TMO])) break; if (sp > XB_SPIN_CAP) { atomicAdd(&bar[XB_TMO], 1u); break; } }
    }
    nloc = mine > 0u ? mine : 1u; nx = cnt > 0u ? cnt : 1u;
}
__device__ __forceinline__ void xcd_barrier(const XcdBarrier& b) {
    asm volatile("s_waitcnt vmcnt(0)" ::: "memory");
    __syncthreads();
    if (threadIdx.x == 0) {
        unsigned* bar = b.bar;
        __builtin_amdgcn_s_waitcnt(0);
        unsigned nloc = b.st[0], nx = b.st[1];
        if (nloc == 0u) { xcd_barrier_complete(bar, b.x, nloc, nx); b.st[0] = nloc; b.st[1] = nx; }
        const unsigned old = xb_add(&bar[XB_XSUB(b.x)], 1u);
        const unsigned gen = old / nloc;
        if (old + 1u == (gen + 1u) * nloc) {
            __builtin_amdgcn_fence(__ATOMIC_RELEASE, "agent");
            asm volatile("s_waitcnt vmcnt(0)" ::: "memory");
            const unsigned og = xb_add(&bar[XB_TOP], 1u);
            const unsigned tg = og / nx;
            if (og + 1u == (tg + 1u) * nx) xb_add(&bar[XB_TOPGEN], 1u);
            else XB_SPIN(xb_ld(&bar[XB_TOPGEN]) == tg, bar);
            __builtin_amdgcn_fence(__ATOMIC_ACQUIRE, "agent");
            xb_add(&bar[XB_XGEN(b.x)], 1u);
            asm volatile("s_waitcnt vmcnt(0)" ::: "memory");
        } else {
            XB_SPIN(xb_ld(&bar[XB_XGEN(b.x)]) == gen, bar);
            __builtin_amdgcn_fence(__ATOMIC_ACQUIRE, "agent");
            asm volatile("s_waitcnt vmcnt(0)" ::: "memory");
        }
    }
    __syncthreads();
}

struct Args {
    const float* in[27]; float* out; unsigned char* ws; int ph_lo, ph_hi;
};
struct Frame {
    LAS unsigned char* lds;
    int tid, lane, wave, vcu, bx;
    float zf; unsigned zu;
};
__device__ __forceinline__ float lshfl(float v, int src) { return __builtin_bit_cast(float, __builtin_amdgcn_ds_bpermute(src << 2, __builtin_bit_cast(int, v))); }
#define SHFL_XOR(v, o) lshfl((v), F.lane ^ (o))
#define SHFL_UP(v, o) lshfl((v), F.lane - (o))
#define SHFL_IDX(v, i) lshfl((v), (i))
__device__ __forceinline__ float wave_sum_l(float v, int lane) {
#pragma unroll
    for (int o = 1; o < 64; o <<= 1) v += lshfl(v, lane ^ o);
    return v;
}
#define wave_sum(v) wave_sum_l((v), F.lane)
#define WG_BAR() __syncthreads()
__device__ __forceinline__ void stagger(int cls, int ticks) {
    if (cls) { const unsigned long long tgt = __builtin_amdgcn_s_memrealtime() + (unsigned long long)(cls * ticks);
        while (__builtin_amdgcn_s_memrealtime() < tgt) __builtin_amdgcn_s_sleep(16); }
}
#ifdef USE_STAGGER
#define STAGGER(ticks) stagger((F.bx >> 3) & 3, (ticks))
#else
#define STAGGER(ticks) do {} while (0)
#endif
__device__ __forceinline__ unsigned char* ld_ptr(LAS unsigned char* lds, int i) {
    const unsigned long long v = ((const LAS unsigned long long*)(lds + PTAB_OFF))[i];
    const unsigned lo = __builtin_amdgcn_readfirstlane((unsigned)v), hi = __builtin_amdgcn_readfirstlane((unsigned)(v >> 32));
    return (unsigned char*)(__attribute__((address_space(1))) unsigned char*)(uintptr_t)(((unsigned long long)hi << 32) | lo);
}

constexpr int XP_SCR = 64 * 65 * 4;
template <bool F8 = false> __device__ __forceinline__ void xpose_item(const float* W, int ldsrc, int srccol4, int k0, bf16_t* WT, int K, int drow0, LAS float* scr, int lane, const float* gain, float zf = 0.f) {
    f32x4 v[16];
    const int r = lane >> 4, c4 = 4 * (lane & 15);
#pragma unroll
    for (int i = 0; i < 16; ++i) v[i] = (srccol4 >= 0) ? __builtin_nontemporal_load((const f32x4*)(W + (size_t)(k0 + 4 * i + r) * ldsrc + srccol4)) : (f32x4){zf, zf, zf, zf};
    if (gain) {
#pragma unroll
        for (int i = 0; i < 16; ++i) v[i] = v[i] * gain[k0 + 4 * i + r]; }
#pragma unroll
    for (int i = 0; i < 16; ++i) { LAS float* s = scr + (4 * i + r) * 65 + c4; s[0] = v[i].x; s[1] = v[i].y; s[2] = v[i].z; s[3] = v[i].w; }
    asm volatile("s_waitcnt lgkmcnt(0)" ::: "memory");
    const int c = lane & 7;
#pragma unroll
    for (int j = 0; j < 8; ++j) { const int n = (lane >> 3) + 8 * j; const LAS float* s = scr + (8 * c) * 65 + n;
        if constexpr (F8) { u32x2 o; o.x = pk4_fp8(s[0 * 65] * W8_SCALE, s[1 * 65] * W8_SCALE, s[2 * 65] * W8_SCALE, s[3 * 65] * W8_SCALE); o.y = pk4_fp8(s[4 * 65] * W8_SCALE, s[5 * 65] * W8_SCALE, s[6 * 65] * W8_SCALE, s[7 * 65] * W8_SCALE);
            __builtin_nontemporal_store(o, (u32x2*)((unsigned char*)WT + (size_t)(drow0 + n) * K + k0 + 8 * c)); }
        else { u32x4 o; o.x = pk2(s[0 * 65], s[1 * 65]); o.y = pk2(s[2 * 65], s[3 * 65]); o.z = pk2(s[4 * 65], s[5 * 65]); o.w = pk2(s[6 * 65], s[7 * 65]);
            __builtin_nontemporal_store(o, (u32x4*)(WT + (size_t)(drow0 + n) * K + k0 + 8 * c)); } }
    asm volatile("s_waitcnt lgkmcnt(0)" ::: "memory");
}
__device__ __forceinline__ int win_srccol(int d) {
    if (d < 2048) return d;
    if (d < 3072) return 2056 + (d - 2048);
    if (d < 4608) return 3080 + (d - 3072);
    if (d < 6144) return 4632 + (d - 4608);
    if (d < 6152) return 2048 + (d - 6144);
    if (d < 6168) return 4616 + (d - 6152);
    return -1;
}
template <bool F8 = false> __device__ __forceinline__ void xpose_plain(Frame& F, const float* W, int K, int N, bf16_t* WT, LAS float* scr, int gw, int NGW, const float* gain) {
    const int nblk = N / 64, items = (K / 64) * nblk;
    for (int it = gw; it < items; it += NGW) { const int kb = it / nblk, nb = it % nblk; xpose_item<F8>(W, N, nb * 64 + 4 * (F.lane & 15), kb * 64, WT, K, nb * 64, scr, F.lane, gain); }
}
__device__ __forceinline__ void xpose_gu(Frame& F, const float* Wg, const float* Wu, int K, int N, bf16_t* WT, LAS float* scr, int gw, int NGW, const float* gain) {
    const int nblk = 2 * N / 64, items = (K / 64) * nblk;
    for (int it = gw; it < items; it += NGW) { const int kb = it / nblk, nb = it % nblk; const int drow0 = nb * 64, tile = drow0 >> 8, within = drow0 & 255;
        const float* W = within < 128 ? Wg : Wu; const int sc = tile * 128 + (within & 127) + 4 * (F.lane & 15);
        xpose_item<true>(W, N, sc, kb * 64, WT, K, drow0, scr, F.lane, gain); }
}
__device__ __forceinline__ float load_row_ssq(Frame& F, const float* xrow, f32x4 (&v)[8]) {
    const f32x4* xr = (const f32x4*)xrow + F.lane; float s = 0.f;
#pragma unroll
    for (int j = 0; j < 8; ++j) { v[j] = xr[64 * j]; s += (v[j].x * v[j].x + v[j].y * v[j].y) + (v[j].z * v[j].z + v[j].w * v[j].w); }
    return wave_sum(s);
}
__device__ __forceinline__ float load_row16_ssq(Frame& F, const bf16_t* xrow, float (&v)[4][8]) {
    const u32x4* xr = (const u32x4*)xrow + F.lane; float s = 0.f;
#pragma unroll
    for (int j = 0; j < 4; ++j) { const u32x4 w = xr[64 * j]; v[j][0] = bflo(w.x); v[j][1] = bfhi(w.x); v[j][2] = bflo(w.y); v[j][3] = bfhi(w.y); v[j][4] = bflo(w.z); v[j][5] = bfhi(w.z); v[j][6] = bflo(w.w); v[j][7] = bfhi(w.w);
#pragma unroll
        for (int i = 0; i < 8; ++i) s += v[j][i] * v[j][i]; }
    return wave_sum(s);
}
typedef short v4i16_t __attribute__((ext_vector_type(4)));
__device__ __forceinline__ f32x4 mfma16(bf16x8 a, bf16x8 b, f32x4 c) { return __builtin_amdgcn_mfma_f32_16x16x32_bf16(a, b, c, 0, 0, 0); }
__device__ __forceinline__ s16x4 tr_read(const LAS unsigned char* p) { return __builtin_bit_cast(s16x4, __builtin_amdgcn_ds_read_tr16_b64_v4i16((LAS v4i16_t*)p)); }
__device__ __forceinline__ bf16x8 cat4(s16x4 a, s16x4 b) { return (bf16x8){a[0], a[1], a[2], a[3], b[0], b[1], b[2], b[3]}; }
__device__ __forceinline__ bf16x8 pack8f(const float (&v)[8]) { u32x4 w; w.x = pk2(v[0], v[1]); w.y = pk2(v[2], v[3]); w.z = pk2(v[4], v[5]); w.w = pk2(v[6], v[7]); return __builtin_bit_cast(bf16x8, w); }
__device__ __forceinline__ float softplusf_(float x) { return x > 20.f ? x : __logf(1.0f + __expf(x)); }
__device__ __forceinline__ float logsigmoidf_(float x) { return fminf(x, 0.f) - __logf(1.0f + __expf(-fabsf(x))); }

constexpr int SLD = 272;

constexpr int NCV = 2560;
#define CONV_LOAD(it_, arr) do { const int cg_ = (it_) % 320, tb_ = ((it_) / 320) & 127, b_ = (it_) / (320 * 128); \
        const int uc_ = cg_ < 128 ? 8 * cg_ : UXBC + (8 * cg_ - 1024); const bf16_t* up_ = U + ((size_t)b_ * SEQ + tb_ * 16) * NU + uc_; \
        if (tb_ > 0) { arr[0] = *(const u32x4*)(up_ - 3 * (ptrdiff_t)NU); arr[1] = *(const u32x4*)(up_ - 2 * (ptrdiff_t)NU); arr[2] = *(const u32x4*)(up_ - (ptrdiff_t)NU); } \
        else { arr[0] = (u32x4){F.zu, F.zu, F.zu, F.zu}; arr[1] = arr[0]; arr[2] = arr[0]; } \
        _Pragma("unroll") for (int t_ = 0; t_ < 16; ++t_) arr[3 + t_] = *(const u32x4*)(up_ + (size_t)t_ * NU); } while (0)
__device__ __forceinline__ void conv_phase(Frame& F, const bf16_t* __restrict__ U, bf16_t* __restrict__ CV, const float* __restrict__ mcw, const float* __restrict__ mcb, const float* __restrict__ scw, const float* __restrict__ scb) {
    LAS float* cw = (LAS float*)F.lds;
    WG_BAR();
    {
        f32x4 vm[3], vs[4];
#pragma unroll
        for (int it = 0; it < 3; ++it) { const int idx = F.tid + NTHR * it; if (idx < 5 * 256) { const int j = idx >> 8, c4 = idx & 255; vm[it] = *(const f32x4*)((j < 4 ? mcw + j * 1024 : mcb) + 4 * c4); } }
#pragma unroll
        for (int it = 0; it < 4; ++it) { const int idx = F.tid + NTHR * it; if (idx < 5 * 384) { const int j = idx / 384, c4 = idx % 384; vs[it] = *(const f32x4*)((j < 4 ? scw + j * 1536 : scb) + 4 * c4); } }
#pragma unroll
        for (int it = 0; it < 3; ++it) { const int idx = F.tid + NTHR * it; if (idx < 5 * 256) { const int j = idx >> 8, c4 = idx & 255; *(LAS f32x4*)(cw + j * 2560 + 4 * c4) = vm[it]; } }
#pragma unroll
        for (int it = 0; it < 4; ++it) { const int idx = F.tid + NTHR * it; if (idx < 5 * 384) { const int j = idx / 384, c4 = idx % 384; *(LAS f32x4*)(cw + j * 2560 + 1024 + 4 * c4) = vs[it]; } }
    }
    WG_BAR();
    const int gt = F.vcu * NTHR + F.tid; constexpr int STRIDE = NWG * NTHR, NIT = NB * 128 * 320 / STRIDE;
    static_assert(NIT * STRIDE == NB * 128 * 320, "conv items divide evenly");
    u32x4 cur[19], nxt[19];
    CONV_LOAD(gt, cur);
#pragma unroll 1
    for (int k = 0; k < NIT; ++k) {
        unsigned zl_ = 0u; asm volatile("" : "+s"(zl_)); const int ln_ = (int)__builtin_amdgcn_mbcnt_hi(~0u, __builtin_amdgcn_mbcnt_lo(~0u, zl_));
        const int it = F.vcu * NTHR + F.wave * 64 + k * STRIDE + ln_; const int cg = it % 320, tb = (it / 320) & 127, b = it / (320 * 128); const int cvcol = 8 * cg;
        if (k + 1 < NIT) CONV_LOAD(it + STRIDE, nxt);
        f32x2 wt[4][4], bs[4];
#pragma unroll
        for (int j = 0; j < 4; ++j) { const f32x4 a = *(const LAS f32x4*)(cw + j * 2560 + cvcol), c2 = *(const LAS f32x4*)(cw + j * 2560 + cvcol + 4);
            wt[j][0] = (f32x2){a[0], a[1]}; wt[j][1] = (f32x2){a[2], a[3]}; wt[j][2] = (f32x2){c2[0], c2[1]}; wt[j][3] = (f32x2){c2[2], c2[3]}; }
        { const f32x4 a = *(const LAS f32x4*)(cw + 4 * 2560 + cvcol), c2 = *(const LAS f32x4*)(cw + 4 * 2560 + cvcol + 4); bs[0] = (f32x2){a[0], a[1]}; bs[1] = (f32x2){a[2], a[3]}; bs[2] = (f32x2){c2[0], c2[1]}; bs[3] = (f32x2){c2[2], c2[3]}; }
        const float sc = (cg >= 64 && cg < 128) ? 0.08838834764831845f : 1.0f;
        bf16_t* op = CV + ((size_t)b * SEQ + tb * 16) * NCV + cvcol;
        f32x2 h0[4], h1[4], h2[4];
#pragma unroll
        for (int i = 0; i < 4; ++i) { h0[i] = (f32x2){bflo(cur[0][i]), bfhi(cur[0][i])}; h1[i] = (f32x2){bflo(cur[1][i]), bfhi(cur[1][i])}; h2[i] = (f32x2){bflo(cur[2][i]), bfhi(cur[2][i])}; }
#pragma unroll
        for (int t = 0; t < 16; ++t) {
            f32x2 h3[4], y[4];
#pragma unroll
            for (int i = 0; i < 4; ++i) { h3[i] = (f32x2){bflo(cur[3 + t][i]), bfhi(cur[3 + t][i])};
                f32x2 a = bs[i] + h0[i] * wt[0][i]; a = a + h1[i] * wt[1][i]; a = a + h2[i] * wt[2][i]; a = a + h3[i] * wt[3][i];
                const f32x2 e = a * (-1.4426950408889634f); f32x2 d; d.x = __builtin_amdgcn_exp2f(e.x); d.y = __builtin_amdgcn_exp2f(e.y); d = d + 1.0f;
                f32x2 r; r.x = __builtin_amdgcn_rcpf(d.x); r.y = __builtin_amdgcn_rcpf(d.y); y[i] = (a * sc) * r; }
            u32x4 o; o.x = pk2(y[0].x, y[0].y); o.y = pk2(y[1].x, y[1].y); o.z = pk2(y[2].x, y[2].y); o.w = pk2(y[3].x, y[3].y);
            *(u32x4*)(op + (size_t)t * NCV) = o;
#pragma unroll
            for (int i = 0; i < 4; ++i) { h0[i] = h1[i]; h1[i] = h2[i]; h2[i] = h3[i]; }
        }
        if (k + 1 < NIT) {
#pragma unroll
            for (int i = 0; i < 19; ++i) cur[i] = nxt[i]; }
    }
}
#undef CONV_LOAD

constexpr int XLD = 144;
constexpr int SS_Z = 110592;
constexpr int SS_CM = 0, SS_BM = 34816, SS_X = 69632, SS_HB = 88064, SS_F = 105472;
__device__ __forceinline__ void ssd_unit(Frame& F, int b, int hh, const bf16_t* __restrict__ U, const bf16_t* __restrict__ CV, bf16_t* __restrict__ MIX, float* __restrict__ SSQS,
                                         const float* __restrict__ dt_bias, const float* __restrict__ a_log, const float* __restrict__ d_skip) {
    LAS unsigned char* L = F.lds;
    const int tid = F.tid, lane = F.lane, w = F.wave, c16 = lane & 15, g4 = lane >> 4, grp = hh >> 3;
    WG_BAR();
    for (int i = tid; i < 64 * SLD / 4; i += NTHR) ((LAS unsigned*)(L + SS_HB))[i] = 0u;
    const float Aneg = -__expf(a_log[hh]), dtb = dt_bias[hh], Dsk = d_skip[hh];
    f32x4 hst[4];
#pragma unroll
    for (int i = 0; i < 4; ++i) hst[i] = (f32x4){F.zf, F.zf, F.zf, F.zf};
    const bf16_t* cvb = CV + (size_t)b * SEQ * NCV + 1024;
    u32x4 pc[4], pb_[4], px[2], pz[2]; unsigned graw0 = 0, graw1 = 0;
#define SSD_PREFETCH(cc) do { const size_t r0_ = (size_t)(cc) * 128; \
        _Pragma("unroll") for (int i = 0; i < 4; ++i) { const int q_ = tid + 512 * i; pc[i] = *(const u32x4*)(cvb + (r0_ + (q_ >> 4)) * NCV + 1280 + grp * 128 + 8 * (q_ & 15)); pb_[i] = *(const u32x4*)(cvb + (r0_ + (q_ >> 4)) * NCV + 1024 + grp * 128 + 8 * (q_ & 15)); } \
        _Pragma("unroll") for (int i = 0; i < 2; ++i) { const int q_ = tid + 512 * i; px[i] = *(const u32x4*)(cvb + (r0_ + (q_ >> 3)) * NCV + hh * 64 + 8 * (q_ & 7)); \
            pz[i] = *(const u32x4*)(U + ((size_t)b * SEQ + r0_ + (q_ >> 3)) * NU + UZ + hh * 64 + 8 * (q_ & 7)); } \
        if (w == 0) { graw0 = U[((size_t)b * SEQ + r0_ + lane) * NU + UDT + hh]; graw1 = U[((size_t)b * SEQ + r0_ + 64 + lane) * NU + UDT + hh]; } } while (0)
#define SSD_PF_CB(cc, i) do { const size_t r0_ = (size_t)(cc) * 128; int tq_ = tid; asm volatile("" : "+v"(tq_)); const int q_ = tq_ + 512 * (i); pc[i] = *(const u32x4*)(cvb + (r0_ + (q_ >> 4)) * NCV + 1280 + grp * 128 + 8 * (q_ & 15)); pb_[i] = *(const u32x4*)(cvb + (r0_ + (q_ >> 4)) * NCV + 1024 + grp * 128 + 8 * (q_ & 15)); } while (0)
#define SSD_PF_X(cc) do { const size_t r0_ = (size_t)(cc) * 128; int tq_ = tid; asm volatile("" : "+v"(tq_)); \
        _Pragma("unroll") for (int i = 0; i < 2; ++i) { const int q_ = tq_ + 512 * i; px[i] = *(const u32x4*)(cvb + (r0_ + (q_ >> 3)) * NCV + hh * 64 + 8 * (q_ & 7)); } \
        if (w == 0) { graw0 = U[((size_t)b * SEQ + r0_ + lane) * NU + UDT + hh]; graw1 = U[((size_t)b * SEQ + r0_ + 64 + lane) * NU + UDT + hh]; } } while (0)
#define SSD_GATES(buf) do { LAS float* fa_ = (LAS float*)(L + SS_F) + (buf) * 512; \
        const float dt0 = softplusf_(bf1((bf16_t)graw0) + dtb), dt1 = softplusf_(bf1((bf16_t)graw1) + dtb); float s0 = dt0 * Aneg, s1 = dt1 * Aneg; \
        _Pragma("unroll") for (int o = 1; o < 64; o <<= 1) { const float x0 = SHFL_UP(s0, o), x1 = SHFL_UP(s1, o); if (lane >= o) { s0 += x0; s1 += x1; } } \
        s1 += SHFL_IDX(s0, 63); const float tot = SHFL_IDX(s1, 63); \
        fa_[lane] = s0; fa_[64 + lane] = s1; fa_[128 + lane] = dt0; fa_[192 + lane] = dt1; fa_[256 + lane] = __expf(tot - s0) * dt0; fa_[320 + lane] = __expf(tot - s1) * dt1; fa_[384 + lane] = __expf(s0); fa_[448 + lane] = __expf(s1); } while (0)
    SSD_PREFETCH(0);
    if (w == 0) SSD_GATES(0);
#ifdef PROBE_ML
    unsigned long long pmt = 0, pa[7] = {0, 0, 0, 0, 0, 0, 0}; const unsigned long long pc0 = __builtin_amdgcn_s_memtime(), pr0 = __builtin_amdgcn_s_memrealtime();
#define PST(k) do { const unsigned long long t_ = __builtin_amdgcn_s_memrealtime(); pa[k] += t_ - pmt; pmt = t_; } while (0)
#endif
    for (int c = 0; c < 16; ++c) {
        const size_t row0 = (size_t)b * SEQ + c * 128;
#ifdef PROBE_ML
        pmt = __builtin_amdgcn_s_memrealtime();
#endif
#pragma unroll
        for (int i = 0; i < 4; ++i) { const int q_ = tid + 512 * i; *(LAS u32x4*)(L + SS_CM + (q_ >> 4) * SLD + (q_ & 15) * 16) = pc[i]; *(LAS u32x4*)(L + SS_BM + (q_ >> 4) * SLD + (q_ & 15) * 16) = pb_[i]; }
#pragma unroll
        for (int i = 0; i < 2; ++i) { const int q_ = tid + 512 * i; *(LAS u32x4*)(L + SS_X + (q_ >> 3) * XLD + (q_ & 7) * 16) = px[i]; *(LAS u32x4*)(L + SS_Z + (q_ >> 3) * XLD + (q_ & 7) * 16) = pz[i]; }
        WG_BAR();
#ifdef PROBE_ML
        PST(0);
#endif
        {
            const LAS float* fa = (const LAS float*)(L + SS_F) + (c & 1) * 512; const LAS float* fdt = fa + 128; const LAS float* fwdt = fa + 256; const LAS float* feac = fa + 384;
            const int l = 16 * w + c16; const size_t row = row0 + l;
#ifdef PROBE_ML
            PST(6);
#endif
            f32x4 accd[4], acco[4];
#pragma unroll
            for (int i = 0; i < 4; ++i) accd[i] = (f32x4){F.zf, F.zf, F.zf, F.zf};
            const float acl = fa[l]; const int q = c16 >> 2, pp = c16 & 3;
            bf16x8 cfr[4];
#pragma unroll
            for (int kn = 0; kn < 4; ++kn) cfr[kn] = *(const LAS bf16x8*)(L + SS_CM + (16 * w + c16) * SLD + (32 * kn + 8 * g4) * 2);
            for (int ks = 0; ks <= (w >> 1); ++ks) {
                float mv[8];
#pragma unroll
                for (int half = 0; half < 2; ++half) {
                    bf16x8 a0[4];
#pragma unroll
                    for (int kn = 0; kn < 4; ++kn) a0[kn] = *(const LAS bf16x8*)(L + SS_BM + (32 * ks + 16 * half + c16) * SLD + (32 * kn + 8 * g4) * 2);
                    const f32x4 fa0 = *(const LAS f32x4*)(fa + 32 * ks + 16 * half + 4 * g4), fd0 = *(const LAS f32x4*)(fdt + 32 * ks + 16 * half + 4 * g4);
                    __builtin_amdgcn_sched_barrier(0);
                    f32x4 gt0 = (f32x4){F.zf, F.zf, F.zf, F.zf};
#pragma unroll
                    for (int kn = 0; kn < 4; ++kn) gt0 = mfma16(a0[kn], cfr[kn], gt0);
#pragma unroll
                    for (int r = 0; r < 4; ++r) { const int s0 = 32 * ks + 16 * half + 4 * g4 + r; const float v0 = gt0[r] * __expf(acl - fa0[r]) * fd0[r]; mv[4 * half + r] = (s0 <= l) ? v0 : 0.f; }
                }
                s16x4 tA[4], tB[4];
#pragma unroll
                for (int pb = 0; pb < 4; ++pb) { tA[pb] = tr_read(L + SS_X + (32 * ks + 4 * g4 + q) * XLD + (16 * pb + 4 * pp) * 2); tB[pb] = tr_read(L + SS_X + (32 * ks + 16 + 4 * g4 + q) * XLD + (16 * pb + 4 * pp) * 2); }
                __builtin_amdgcn_sched_barrier(0);
                const bf16x8 bfrag = pack8f(mv);
#pragma unroll
                for (int pb = 0; pb < 4; ++pb) accd[pb] = mfma16(cat4(tA[pb], tB[pb]), bfrag, accd[pb]);
            }
            __builtin_amdgcn_sched_barrier(0);
            if (c + 1 < 16) SSD_PREFETCH(c + 1);
            __builtin_amdgcn_sched_barrier(0);
#pragma unroll
            for (int i = 0; i < 4; ++i) acco[i] = (f32x4){F.zf, F.zf, F.zf, F.zf};
#ifdef PROBE_ML
            PST(1);
#endif
#pragma unroll
            for (int kn = 0; kn < 4; ++kn) {
#pragma unroll
                for (int pb = 0; pb < 4; ++pb) { const bf16x8 a = *(const LAS bf16x8*)(L + SS_HB + (16 * pb + c16) * SLD + (32 * kn + 8 * g4) * 2); acco[pb] = mfma16(a, cfr[kn], acco[pb]); } }
#ifdef PROBE_ML
            PST(2);
#endif
            const float el = feac[l]; float ssq = 0.f;
#pragma unroll
            for (int pb = 0; pb < 4; ++pb) { const int p0 = 16 * pb + 4 * g4;
                const u32x2 zw = *(const LAS u32x2*)(L + SS_Z + l * XLD + p0 * 2); const float z[4] = {bflo(zw.x), bfhi(zw.x), bflo(zw.y), bfhi(zw.y)}; float o[4];
                const u32x2 xw = *(const LAS u32x2*)(L + SS_X + l * XLD + p0 * 2); const float xv[4] = {bflo(xw.x), bfhi(xw.x), bflo(xw.y), bfhi(xw.y)};
#pragma unroll
                for (int r = 0; r < 4; ++r) { const float y = accd[pb][r] + el * acco[pb][r] + Dsk * xv[r]; o[r] = y * siluf_(z[r]); ssq += o[r] * o[r]; }
                u32x2 ow; ow.x = pk2(o[0], o[1]); ow.y = pk2(o[2], o[3]); *(u32x2*)(MIX + row * 2048 + MIXS + hh * 64 + p0) = ow; }
            ssq += SHFL_XOR(ssq, 16); ssq += SHFL_XOR(ssq, 32);
            if (g4 == 0) SSQS[row * 16 + hh] = ssq;
#ifdef PROBE_ML
            PST(3);
#endif
            const float dec = feac[127];
#pragma unroll
            for (int pb = 0; pb < 4; ++pb) hst[pb] = hst[pb] * dec;
#pragma unroll
            for (int ks = 0; ks < 4; ++ks) {
                const s16x4 tA = tr_read(L + SS_BM + (32 * ks + 8 * g4 + q) * SLD + (16 * w + 4 * pp) * 2), tB = tr_read(L + SS_BM + (32 * ks + 8 * g4 + 4 + q) * SLD + (16 * w + 4 * pp) * 2);
                const f32x4 w0 = *(const LAS f32x4*)(fwdt + 32 * ks + 8 * g4), w1 = *(const LAS f32x4*)(fwdt + 32 * ks + 8 * g4 + 4);
                s16x4 xA[4], xB[4];
#pragma unroll
                for (int pb = 0; pb < 4; ++pb) { xA[pb] = tr_read(L + SS_X + (32 * ks + 8 * g4 + q) * XLD + (16 * pb + 4 * pp) * 2); xB[pb] = tr_read(L + SS_X + (32 * ks + 8 * g4 + 4 + q) * XLD + (16 * pb + 4 * pp) * 2); }
                const float bv[8] = {bf1((bf16_t)tA[0]) * w0[0], bf1((bf16_t)tA[1]) * w0[1], bf1((bf16_t)tA[2]) * w0[2], bf1((bf16_t)tA[3]) * w0[3], bf1((bf16_t)tB[0]) * w1[0], bf1((bf16_t)tB[1]) * w1[1], bf1((bf16_t)tB[2]) * w1[2], bf1((bf16_t)tB[3]) * w1[3]};
                const bf16x8 bfrag = pack8f(bv);
#pragma unroll
                for (int pb = 0; pb < 4; ++pb) hst[pb] = mfma16(cat4(xA[pb], xB[pb]), bfrag, hst[pb]);
            }
            if (w == 0 && c + 1 < 16) SSD_GATES((c + 1) & 1);
        }
#ifdef PROBE_ML
        PST(4);
#endif
        WG_BAR();
#pragma unroll
        for (int pb = 0; pb < 4; ++pb)
#pragma unroll
            for (int r = 0; r < 4; ++r) *(LAS bf16_t*)(L + SS_HB + (16 * pb + 4 * g4 + r) * SLD + (16 * w + c16) * 2) = f2bf(hst[pb][r]);
#ifdef PROBE_ML
        PST(5);
#endif
    }
#ifdef PROBE_ML
    if (F.bx == 0 && lane == 0) { unsigned long long* dg = (unsigned long long*)((unsigned char*)MIX - WS_MIX + 2883584); for (int k = 0; k < 7; ++k) dg[32 + 8 * w + k] = pa[k]; if (w == 7) { const unsigned long long dc = __builtin_amdgcn_s_memtime() - pc0, dr = __builtin_amdgcn_s_memrealtime() - pr0; dg[120] = dc * 400ull / dr; dg[121] = dr; } }
#endif
#undef SSD_PREFETCH
#undef SSD_PF_CB
#undef SSD_PF_X
#undef SSD_GATES
}

constexpr int VL2 = 80;
constexpr int ML_Q = 0, ML_K = 17408, ML_V = 34816, ML_CB = 39936, ML_F = 48640;
__device__ __forceinline__ void mlstm_unit(Frame& F, int b, int h, int vs, const bf16_t* __restrict__ U, const bf16_t* __restrict__ CV, bf16_t* __restrict__ MIX, float* __restrict__ SSQM, const float* __restrict__ gate_b) {
    LAS unsigned char* L = F.lds;
    const int tid = F.tid, lane = F.lane, w = F.wave, c16 = lane & 15, g4 = lane >> 4;
    LAS float* fbase = (LAS float*)(L + ML_F); LAS float* fnvec = fbase + 768;
    WG_BAR();
    for (int i = tid; i < 32 * SLD / 4; i += NTHR) ((LAS unsigned*)(L + ML_CB))[i] = 0u;
    if (tid < 128) fnvec[tid] = 0.f;
    const float bi = gate_b[h], bfg = gate_b[4 + h];
    float m_prev = 0.f;
    f32x4 cst[2], nacc; cst[0] = (f32x4){F.zf, F.zf, F.zf, F.zf}; cst[1] = cst[0]; nacc = cst[0];
    const bf16_t* cvq = CV + (size_t)b * SEQ * NCV + h * 128; const bf16_t* uv = U + (size_t)b * SEQ * NU + UV + h * 128 + vs * 32;
    u32x4 pq[2], pkk[2], pvv; unsigned gri = 0, grf = 0;
#define ML_PREFETCH(cc) do { const size_t r0_ = (size_t)(cc) * 64; \
        _Pragma("unroll") for (int i = 0; i < 2; ++i) { const int q_ = tid + 512 * i; pq[i] = *(const u32x4*)(cvq + (r0_ + (q_ >> 4)) * NCV + 8 * (q_ & 15)); pkk[i] = *(const u32x4*)(cvq + (r0_ + (q_ >> 4)) * NCV + 512 + 8 * (q_ & 15)); } \
        if (tid < 256) pvv = *(const u32x4*)(uv + (r0_ + (tid >> 2)) * NU + 8 * (tid & 3)); \
        if (w == 0) { gri = U[((size_t)b * SEQ + r0_ + lane) * NU + UMI + h]; grf = U[((size_t)b * SEQ + r0_ + lane) * NU + UMF + h]; } } while (0)
#define ML_GATES(buf) do { LAS float* fg_ = fbase + (buf) * 384; \
        const float li = bf1((bf16_t)gri) + bi, lf = logsigmoidf_(bf1((bf16_t)grf) + bfg); float bc = lf; \
        _Pragma("unroll") for (int o = 1; o < 64; o <<= 1) { const float x = SHFL_UP(bc, o); if (lane >= o) bc += x; } \
        const float total = SHFL_IDX(bc, 63), ct = li - bc; float cm = ct; \
        _Pragma("unroll") for (int o = 1; o < 64; o <<= 1) { const float x = SHFL_UP(cm, o); if (lane >= o) cm = fmaxf(cm, x); } \
        const float mj = bc + fmaxf(m_prev, cm); \
        fg_[lane] = bc - mj; fg_[64 + lane] = ct; fg_[128 + lane] = __expf(bc + m_prev - mj); fg_[192 + lane] = __expf(-mj); \
        const float m_new = total + fmaxf(m_prev, SHFL_IDX(cm, 63)); \
        fg_[256 + lane] = __expf(total - m_new + ct); if (lane == 0) fg_[320] = __expf(total + m_prev - m_new); \
        m_prev = m_new; } while (0)
    ML_PREFETCH(0);
    if (w == 0) ML_GATES(0);
#ifdef PROBE_ML
    unsigned long long pm0 = 0, pm1 = 0, pm2 = 0, pa1 = 0, pa2 = 0, pa3 = 0;
#endif
    for (int c = 0; c < 32; ++c) {
        const size_t row0 = (size_t)b * SEQ + c * 64;
#ifdef PROBE_ML
        pm0 = __builtin_amdgcn_s_memrealtime();
#endif
#pragma unroll
        for (int i = 0; i < 2; ++i) { const int q_ = tid + 512 * i; *(LAS u32x4*)(L + ML_Q + (q_ >> 4) * SLD + (q_ & 15) * 16) = pq[i]; *(LAS u32x4*)(L + ML_K + (q_ >> 4) * SLD + (q_ & 15) * 16) = pkk[i]; }
        if (tid < 256) *(LAS u32x4*)(L + ML_V + (tid >> 2) * VL2 + (tid & 3) * 16) = pvv;
        WG_BAR();
#ifdef PROBE_ML
        pm1 = __builtin_amdgcn_s_memrealtime(); pa1 += pm1 - pm0;
#endif
        if (c + 1 < 32) ML_PREFETCH(c + 1);
        {
            const LAS float* frow = fbase + (c & 1) * 384; const LAS float* fcol = frow + 64; const LAS float* fsint = frow + 128; const LAS float* femj = frow + 192; const LAS float* favec = frow + 256;
            const int jb = w & 3, vb = w >> 2; const int j = 16 * jb + c16; const float rt = frow[j]; const int q = c16 >> 2, pp = c16 & 3;
            f32x4 accD = (f32x4){F.zf, F.zf, F.zf, F.zf}, accI = accD; float dsum = 0.f;
            bf16x8 qfr[4];
#pragma unroll
            for (int kk = 0; kk < 4; ++kk) qfr[kk] = *(const LAS bf16x8*)(L + ML_Q + (16 * jb + c16) * SLD + (32 * kk + 8 * g4) * 2);
            for (int ks = 0; ks <= (jb >> 1); ++ks) {
                float mv[8];
#pragma unroll
                for (int half = 0; half < 2; ++half) {
                    bf16x8 a0[4];
#pragma unroll
                    for (int kk = 0; kk < 4; ++kk) a0[kk] = *(const LAS bf16x8*)(L + ML_K + (32 * ks + 16 * half + c16) * SLD + (32 * kk + 8 * g4) * 2);
                    const f32x4 fc0 = *(const LAS f32x4*)(fcol + 32 * ks + 16 * half + 4 * g4);
                    __builtin_amdgcn_sched_barrier(0);
                    f32x4 st = (f32x4){F.zf, F.zf, F.zf, F.zf};
#pragma unroll
                    for (int kk = 0; kk < 4; ++kk) st = mfma16(a0[kk], qfr[kk], st);
#pragma unroll
                    for (int r = 0; r < 4; ++r) { const int s = 32 * ks + 16 * half + 4 * g4 + r; float v = st[r] * __expf(rt + fc0[r]); v = (s <= j) ? v : 0.f; mv[4 * half + r] = v; dsum += v; }
                }
                const s16x4 tA = tr_read(L + ML_V + (32 * ks + 4 * g4 + q) * VL2 + (16 * vb + 4 * pp) * 2), tB = tr_read(L + ML_V + (32 * ks + 16 + 4 * g4 + q) * VL2 + (16 * vb + 4 * pp) * 2);
                const bf16x8 bfrag = pack8f(mv);
                accD = mfma16(cat4(tA, tB), bfrag, accD);
            }
            {
                bf16x8 cf[4];
#pragma unroll
                for (int kk = 0; kk < 4; ++kk) cf[kk] = *(const LAS bf16x8*)(L + ML_CB + (16 * vb + c16) * SLD + (32 * kk + 8 * g4) * 2);
                __builtin_amdgcn_sched_barrier(0);
#pragma unroll
                for (int kk = 0; kk < 4; ++kk) accI = mfma16(cf[kk], qfr[kk], accI);
            }
            float nq = 0.f;
#pragma unroll
            for (int i = 0; i < 4; ++i) { const u32x4 qr = *(const LAS u32x4*)(L + ML_Q + (16 * jb + c16) * SLD + (32 * g4 + 8 * i) * 2);
                const f32x4 n0 = *(const LAS f32x4*)(fnvec + 32 * g4 + 8 * i), n1 = *(const LAS f32x4*)(fnvec + 32 * g4 + 8 * i + 4);
                nq += bflo(qr.x) * n0[0] + bfhi(qr.x) * n0[1] + bflo(qr.y) * n0[2] + bfhi(qr.y) * n0[3] + bflo(qr.z) * n1[0] + bfhi(qr.z) * n1[1] + bflo(qr.w) * n1[2] + bfhi(qr.w) * n1[3]; }
            nq += SHFL_XOR(nq, 16); nq += SHFL_XOR(nq, 32);
            dsum += SHFL_XOR(dsum, 16); dsum += SHFL_XOR(dsum, 32);
            const float si = fsint[j]; const float den = si * nq + dsum; const float inv = 1.0f / fmaxf(fabsf(den), femj[j]);
            const size_t row = row0 + j; float o[4], ssq = 0.f;
#pragma unroll
            for (int r = 0; r < 4; ++r) { o[r] = (si * accI[r] + accD[r]) * inv; ssq += o[r] * o[r]; }
            u32x2 ow; ow.x = pk2(o[0], o[1]); ow.y = pk2(o[2], o[3]); *(u32x2*)(MIX + row * 2048 + MIXM + h * 128 + vs * 32 + 16 * vb + 4 * g4) = ow;
            ssq += SHFL_XOR(ssq, 16); ssq += SHFL_XOR(ssq, 32);
            if (g4 == 0) SSQM[row * 32 + h * 8 + vs * 2 + vb] = ssq;
            const float dec = frow[320];
            cst[0] = cst[0] * dec; cst[1] = cst[1] * dec; nacc = nacc * dec;
#pragma unroll
            for (int ks = 0; ks < 2; ++ks) {
                const s16x4 tA = tr_read(L + ML_K + (32 * ks + 8 * g4 + q) * SLD + (16 * w + 4 * pp) * 2), tB = tr_read(L + ML_K + (32 * ks + 8 * g4 + 4 + q) * SLD + (16 * w + 4 * pp) * 2);
                const f32x4 w0 = *(const LAS f32x4*)(favec + 32 * ks + 8 * g4), w1 = *(const LAS f32x4*)(favec + 32 * ks + 8 * g4 + 4);
                s16x4 xA[2], xB[2];
#pragma unroll
                for (int vb2 = 0; vb2 < 2; ++vb2) { xA[vb2] = tr_read(L + ML_V + (32 * ks + 8 * g4 + q) * VL2 + (16 * vb2 + 4 * pp) * 2); xB[vb2] = tr_read(L + ML_V + (32 * ks + 8 * g4 + 4 + q) * VL2 + (16 * vb2 + 4 * pp) * 2); }
                const float bv[8] = {bf1((bf16_t)tA[0]) * w0[0], bf1((bf16_t)tA[1]) * w0[1], bf1((bf16_t)tA[2]) * w0[2], bf1((bf16_t)tA[3]) * w0[3], bf1((bf16_t)tB[0]) * w1[0], bf1((bf16_t)tB[1]) * w1[1], bf1((bf16_t)tB[2]) * w1[2], bf1((bf16_t)tB[3]) * w1[3]};
                const bf16x8 bfrag = pack8f(bv);
                const bf16x8 ones8 = {(short)0x3f80, (short)0x3f80, (short)0x3f80, (short)0x3f80, (short)0x3f80, (short)0x3f80, (short)0x3f80, (short)0x3f80};
                nacc = mfma16(ones8, bfrag, nacc);
#pragma unroll
                for (int vb2 = 0; vb2 < 2; ++vb2) cst[vb2] = mfma16(cat4(xA[vb2], xB[vb2]), bfrag, cst[vb2]);
            }
            if (w == 0 && c + 1 < 32) ML_GATES((c + 1) & 1);
        }
#ifdef PROBE_ML
        pm2 = __builtin_amdgcn_s_memrealtime(); pa2 += pm2 - pm1;
#endif
        WG_BAR();
#pragma unroll
        for (int vb2 = 0; vb2 < 2; ++vb2)
#pragma unroll
            for (int r = 0; r < 4; ++r) *(LAS bf16_t*)(L + ML_CB + (16 * vb2 + 4 * g4 + r) * SLD + (16 * w + c16) * 2) = f2bf(cst[vb2][r]);
        if (g4 == 0) fnvec[16 * w + c16] = nacc[0];
#ifdef PROBE_ML
        pa3 += __builtin_amdgcn_s_memrealtime() - pm2;
#endif
    }
#ifdef PROBE_ML
    if (F.bx == 0 && lane == 0) { unsigned long long* dg = (unsigned long long*)((unsigned char*)MIX - WS_MIX + 2883584); dg[4 * w] = pa1; dg[4 * w + 1] = pa2; dg[4 * w + 2] = pa3; }
#endif
#undef ML_PREFETCH
#undef ML_GATES
}

constexpr int MB_K0 = 0, MB_V0 = 17408, MB_K1 = 34816, MB_V1 = 52224, MB_KM = 69632, MB_SEL = 73216;
__device__ __forceinline__ void moba_unit(Frame& F, int b, int h, int qb, const bf16_t* __restrict__ U, bf16_t* __restrict__ MIX, const float* __restrict__ KMEAN) {
    LAS unsigned char* L = F.lds;
    const int tid = F.tid, lane = F.lane, w = F.wave, c16 = lane & 15, g4 = lane >> 4;
    LAS float* km = (LAS float*)(L + MB_KM); LAS int* sel = (LAS int*)(L + MB_SEL);
    const size_t row0 = (size_t)b * SEQ + 256 * qb;
    WG_BAR();
    bf16x8 Qf[2][4]; u32x4 pk[2], pv[2];
    const int kr = tid >> 3, ch = tid & 7;
#pragma unroll
    for (int qq = 0; qq < 2; ++qq) { const bf16_t* qp = U + (row0 + 32 * w + 16 * qq + c16) * NU + UAQ + h * 128 + 8 * g4;
#pragma unroll
        for (int ds = 0; ds < 4; ++ds) Qf[qq][ds] = *(const bf16x8*)(qp + 32 * ds); }
    { const bf16_t* kp = U + ((size_t)b * SEQ + kr) * NU + UAK + h * 128; const bf16_t* vp = U + ((size_t)b * SEQ + kr) * NU + UAV + h * 128;
      pk[0] = *(const u32x4*)(kp + 8 * ch); pk[1] = *(const u32x4*)(kp + 8 * (ch + 8)); pv[0] = *(const u32x4*)(vp + 8 * ch); pv[1] = *(const u32x4*)(vp + 8 * (ch + 8)); }
    for (int i = tid; i < qb * 128; i += NTHR) { const float* kq = KMEAN + ((size_t)(b * 4 + h) * 8) * 128 + i; km[i] = (kq[0] + kq[NB * 4 * 8 * 128]) + (kq[2 * NB * 4 * 8 * 128] + kq[3 * NB * 4 * 8 * 128]); }
    WG_BAR();
    if (tid < 256) {
        int mask = (1 << qb) - 1;
        if (qb > 3) {
            float sc[7];
#pragma unroll
            for (int j = 0; j < 7; ++j) sc[j] = 0.f;
            const bf16_t* qp = U + (row0 + tid) * NU + UAQ + h * 128;
            for (int d8 = 0; d8 < 16; ++d8) { const u32x4 qr = *(const u32x4*)(qp + 8 * d8); const float qv[8] = {bflo(qr.x), bfhi(qr.x), bflo(qr.y), bfhi(qr.y), bflo(qr.z), bfhi(qr.z), bflo(qr.w), bfhi(qr.w)};
#pragma unroll
                for (int j = 0; j < 7; ++j) if (j < qb) { const f32x4 k0 = *(const LAS f32x4*)(km + j * 128 + 8 * d8), k1 = *(const LAS f32x4*)(km + j * 128 + 8 * d8 + 4);
                    sc[j] += qv[0] * k0[0] + qv[1] * k0[1] + qv[2] * k0[2] + qv[3] * k0[3] + qv[4] * k1[0] + qv[5] * k1[1] + qv[6] * k1[2] + qv[7] * k1[3]; } }
            mask = 0;
#pragma unroll
            for (int it = 0; it < 3; ++it) { float best = -__builtin_inff(); int bi = 0;
#pragma unroll
                for (int j = 0; j < 7; ++j) if (j < qb && !((mask >> j) & 1) && sc[j] > best) { best = sc[j]; bi = j; }
                mask |= 1 << bi; }
        }
        sel[tid] = mask;
    }
    WG_BAR();
    int msk[2]; float mrun[2], lsum[2]; f32x4 O[2][8];
#pragma unroll
    for (int qq = 0; qq < 2; ++qq) {
        msk[qq] = sel[32 * w + 16 * qq + c16]; mrun[qq] = -1e30f; lsum[qq] = 0.f;
#pragma unroll
        for (int db = 0; db < 8; ++db) O[qq][db] = (f32x4){F.zf, F.zf, F.zf, F.zf}; }
    const int ntiles = 4 * (qb + 1);
    const float SC = 0.08838834764831845f * 1.4426950408889634f;
    for (int tt = 0; tt < ntiles; ++tt) {
        const int kofs = (tt & 1) ? MB_K1 : MB_K0, vofs = (tt & 1) ? MB_V1 : MB_V0;
        *(LAS u32x4*)(L + kofs + kr * SLD + ch * 16) = pk[0]; *(LAS u32x4*)(L + kofs + kr * SLD + (ch + 8) * 16) = pk[1];
        *(LAS u32x4*)(L + vofs + kr * SLD + ch * 16) = pv[0]; *(LAS u32x4*)(L + vofs + kr * SLD + (ch + 8) * 16) = pv[1];
        WG_BAR();
        if (tt + 1 < ntiles) { const bf16_t* kp = U + ((size_t)b * SEQ + 64 * (tt + 1) + kr) * NU + UAK + h * 128; const bf16_t* vp = U + ((size_t)b * SEQ + 64 * (tt + 1) + kr) * NU + UAV + h * 128;
            pk[0] = *(const u32x4*)(kp + 8 * ch); pk[1] = *(const u32x4*)(kp + 8 * (ch + 8)); pv[0] = *(const u32x4*)(vp + 8 * ch); pv[1] = *(const u32x4*)(vp + 8 * (ch + 8)); }
        const int jblk = tt >> 2; const bool own = (jblk == qb);
        f32x4 st[4][2];
#pragma unroll
        for (int kb = 0; kb < 4; ++kb) { st[kb][0] = (f32x4){F.zf, F.zf, F.zf, F.zf}; st[kb][1] = st[kb][0];
#pragma unroll
            for (int ds = 0; ds < 4; ++ds) { const bf16x8 a = *(const LAS bf16x8*)(L + kofs + (16 * kb + c16) * SLD + (32 * ds + 8 * g4) * 2);
                st[kb][0] = mfma16(a, Qf[0][ds], st[kb][0]); st[kb][1] = mfma16(a, Qf[1][ds], st[kb][1]); } }
        bf16x8 pf[2][2];
#pragma unroll
        for (int qq = 0; qq < 2; ++qq) {
            const float NEG = -__builtin_inff();
            if (own) { const int qi = 32 * w + 16 * qq + c16, kbase = 64 * (tt & 3) + 4 * g4;
#pragma unroll
                for (int kb = 0; kb < 4; ++kb)
#pragma unroll
                    for (int r = 0; r < 4; ++r) if (kbase + 16 * kb + r > qi) st[kb][qq][r] = NEG;
            } else if (!((msk[qq] >> jblk) & 1)) {
#pragma unroll
                for (int kb = 0; kb < 4; ++kb) st[kb][qq] = (f32x4){NEG, NEG, NEG, NEG};
            }
            float rm = st[0][qq][0];
#pragma unroll
            for (int kb = 0; kb < 4; ++kb)
#pragma unroll
                for (int r = 0; r < 4; ++r) rm = fmaxf(rm, st[kb][qq][r]);
            rm = fmaxf(rm, SHFL_XOR(rm, 16)); rm = fmaxf(rm, SHFL_XOR(rm, 32));
            const float mn = fmaxf(mrun[qq], rm), alpha = __builtin_amdgcn_exp2f((mrun[qq] - mn) * SC), mnsc = -mn * SC; mrun[qq] = mn;
            float ps = 0.f; float pvv[4][4];
#pragma unroll
            for (int kb = 0; kb < 4; ++kb)
#pragma unroll
                for (int r = 0; r < 4; ++r) { const float pe = __builtin_amdgcn_exp2f(__builtin_fmaf(st[kb][qq][r], SC, mnsc)); pvv[kb][r] = pe; ps += pe; }
            lsum[qq] = lsum[qq] * alpha + ps;
            if (__builtin_amdgcn_ballot_w64(alpha != 1.0f) != 0ull) {
#pragma unroll
                for (int db = 0; db < 8; ++db) O[qq][db] = O[qq][db] * alpha; }
#pragma unroll
            for (int ks = 0; ks < 2; ++ks) { const float v8[8] = {pvv[2 * ks][0], pvv[2 * ks][1], pvv[2 * ks][2], pvv[2 * ks][3], pvv[2 * ks + 1][0], pvv[2 * ks + 1][1], pvv[2 * ks + 1][2], pvv[2 * ks + 1][3]}; pf[qq][ks] = pack8f(v8); }
        }
        const int q = c16 >> 2, p = c16 & 3;
#pragma unroll
        for (int ks = 0; ks < 2; ++ks)
#pragma unroll
            for (int db = 0; db < 8; ++db) {
                const s16x4 tA = tr_read(L + vofs + (32 * ks + 4 * g4 + q) * SLD + (16 * db + 4 * p) * 2), tB = tr_read(L + vofs + (32 * ks + 16 + 4 * g4 + q) * SLD + (16 * db + 4 * p) * 2);
                const bf16x8 a = cat4(tA, tB);
                O[0][db] = mfma16(a, pf[0][ks], O[0][db]); O[1][db] = mfma16(a, pf[1][ks], O[1][db]);
            }
    }
#pragma unroll
    for (int qq = 0; qq < 2; ++qq) { float ls = lsum[qq]; ls += SHFL_XOR(ls, 16); ls += SHFL_XOR(ls, 32); const float inv = 1.0f / ls;
        bf16_t* op = MIX + (row0 + 32 * w + 16 * qq + c16) * 2048 + MIXA + h * 128 + 4 * g4;
#pragma unroll
        for (int db = 0; db < 8; ++db) { u32x2 ow; ow.x = pk2(O[qq][db][0] * inv, O[qq][db][1] * inv); ow.y = pk2(O[qq][db][2] * inv, O[qq][db][3] * inv); *(u32x2*)(op + 16 * db) = ow; } }
}
constexpr int KM_Q = NB * 4 * 8 * 128;
__device__ __forceinline__ void kmean_items(Frame& F, const bf16_t* __restrict__ U, float* __restrict__ KMEAN) {
    const int gw = F.vcu * NWAVES + F.wave, NGW = NWG * NWAVES;
    for (int it4 = gw; it4 < NB * 4 * 8 * 4; it4 += NGW) {
        const int q = it4 & 3, it = it4 >> 2; const int blk = it & 7, h = (it >> 3) & 3, b = it >> 5;
        const int lane = F.lane, cg = lane & 15, rg = lane >> 4;
        const bf16_t* kp = U + ((size_t)b * SEQ + 256 * blk + 64 * q + rg) * NU + UAK + h * 128 + 8 * cg;
        u32x4 v[16];
#pragma unroll
        for (int i = 0; i < 16; ++i) v[i] = *(const u32x4*)(kp + (size_t)(4 * i) * NU);
        float s[8];
#pragma unroll
        for (int j = 0; j < 8; ++j) s[j] = 0.f;
#pragma unroll
        for (int i = 0; i < 16; ++i) { s[0] += bflo(v[i].x); s[1] += bfhi(v[i].x); s[2] += bflo(v[i].y); s[3] += bfhi(v[i].y); s[4] += bflo(v[i].z); s[5] += bfhi(v[i].z); s[6] += bflo(v[i].w); s[7] += bfhi(v[i].w); }
#pragma unroll
        for (int j = 0; j < 8; ++j) { s[j] += SHFL_XOR(s[j], 16); s[j] += SHFL_XOR(s[j], 32); }
        if (rg == 0) { float* op = KMEAN + (size_t)q * KM_Q + (size_t)it * 128 + 8 * cg;
            *(f32x4*)op = (f32x4){s[0] * (1.f / 256.f), s[1] * (1.f / 256.f), s[2] * (1.f / 256.f), s[3] * (1.f / 256.f)}; *(f32x4*)(op + 4) = (f32x4){s[4] * (1.f / 256.f), s[5] * (1.f / 256.f), s[6] * (1.f / 256.f), s[7] * (1.f / 256.f)}; }
    }
}
static_assert(T % (4 * NWG * NWAVES) == 0, "mixnorm row batches");
__device__ __forceinline__ void mixnorm_rows(Frame& F, const bf16_t* __restrict__ U, bf16_t* __restrict__ MIX, const float* __restrict__ SSQM, const float* __restrict__ SSQS,
                                             const float* __restrict__ m_norm_g, const float* __restrict__ s_norm_g) {
    const int gw = F.vcu * NWAVES + F.wave, NGW = NWG * NWAVES, lane = F.lane;
    const int colm = 8 * lane, hm = colm >> 7;
    const f32x4 gm0 = *(const f32x4*)(m_norm_g + colm), gm1 = *(const f32x4*)(m_norm_g + colm + 4);
    f32x4 gs0[2], gs1[2];
#pragma unroll
    for (int i = 0; i < 2; ++i) { gs0[i] = *(const f32x4*)(s_norm_g + 512 * i + 8 * lane); gs1[i] = *(const f32x4*)(s_norm_g + 512 * i + 8 * lane + 4); }
    for (int row0 = gw; row0 < T; row0 += 4 * NGW) {
        f32x4 qm0[4], qm1[4], qs0[4][2], qs1[4][2]; u32x4 hvm[4], ovm[4], hvs[4][2];
#pragma unroll
        for (int k = 0; k < 4; ++k) { const int row = row0 + k * NGW;
            qm0[k] = *(const f32x4*)(SSQM + (size_t)row * 32 + hm * 8); qm1[k] = *(const f32x4*)(SSQM + (size_t)row * 32 + hm * 8 + 4);
            hvm[k] = *(const u32x4*)(MIX + (size_t)row * 2048 + MIXM + colm); ovm[k] = *(const u32x4*)(U + (size_t)row * NU + UO + colm);
#pragma unroll
            for (int i = 0; i < 2; ++i) { qs0[k][i] = *(const f32x4*)(SSQS + (size_t)row * 16 + 8 * i); qs1[k][i] = *(const f32x4*)(SSQS + (size_t)row * 16 + 8 * i + 4); hvs[k][i] = *(const u32x4*)(MIX + (size_t)row * 2048 + MIXS + 512 * i + 8 * lane); } }
#pragma unroll
        for (int k = 0; k < 4; ++k) { const int row = row0 + k * NGW;
            {   const float ssq = (qm0[k][0] + qm0[k][1]) + (qm0[k][2] + qm0[k][3]) + (qm1[k][0] + qm1[k][1]) + (qm1[k][2] + qm1[k][3]);
                const float r = 1.0f / sqrtf(ssq * (1.f / 128.f) + EPS); const u32x4 hv = hvm[k], ov = ovm[k]; u32x4 o;
                o.x = pk2(bflo(hv.x) * r * gm0[0] * sigmoidf_(bflo(ov.x)), bfhi(hv.x) * r * gm0[1] * sigmoidf_(bfhi(ov.x)));
                o.y = pk2(bflo(hv.y) * r * gm0[2] * sigmoidf_(bflo(ov.y)), bfhi(hv.y) * r * gm0[3] * sigmoidf_(bfhi(ov.y)));
                o.z = pk2(bflo(hv.z) * r * gm1[0] * sigmoidf_(bflo(ov.z)), bfhi(hv.z) * r * gm1[1] * sigmoidf_(bfhi(ov.z)));
                o.w = pk2(bflo(hv.w) * r * gm1[2] * sigmoidf_(bflo(ov.w)), bfhi(hv.w) * r * gm1[3] * sigmoidf_(bfhi(ov.w)));
                *(u32x4*)(MIX + (size_t)row * 2048 + MIXM + colm) = o; }
#pragma unroll
            for (int i = 0; i < 2; ++i) { const f32x4 q0 = qs0[k][i], q1 = qs1[k][i];
                const float ssq = (q0[0] + q0[1]) + (q0[2] + q0[3]) + (q1[0] + q1[1]) + (q1[2] + q1[3]);
                const float r = 1.0f / sqrtf(ssq * (1.f / 512.f) + EPS); const u32x4 hv = hvs[k][i]; u32x4 o;
                o.x = pk2(bflo(hv.x) * r * gs0[i][0], bfhi(hv.x) * r * gs0[i][1]); o.y = pk2(bflo(hv.y) * r * gs0[i][2], bfhi(hv.y) * r * gs0[i][3]);
                o.z = pk2(bflo(hv.z) * r * gs1[i][0], bfhi(hv.z) * r * gs1[i][1]); o.w = pk2(bflo(hv.w) * r * gs1[i][2], bfhi(hv.w) * r * gs1[i][3]);
                *(u32x4*)(MIX + (size_t)row * 2048 + MIXS + 512 * i + 8 * lane) = o; } }
    }
}
constexpr int LT_TAB = 0, LT_CUMT = 320, LT_LCNT = 340, LT_BASE = 356, LT_TOT = 372, LT_GOFF = 388, LT_PART = 416, LT_PRE = 928;
__device__ __forceinline__ void moe_route(Frame& F, const bf16_t* XS, const float* g, const float* Wr, int* ROUTE, int* WGCNT, int* TOK) {
    LAS unsigned char* L = F.lds; LAS int* lt = (LAS int*)(L + LTAB_OFF); const int lane = F.lane;
    constexpr int WSTR = D + 4;
    LAS float* Wt = (LAS float*)L;
    LAS float* Cw = (LAS float*)(L + 66048) + F.wave * 256;
    WG_BAR();
    for (int i = F.tid; i < D * NEXP / 4; i += NTHR) { const int k = i >> 1, half = i & 1; const f32x4 v = ((const f32x4*)Wr)[i] * g[k];
        Wt[(4 * half + 0) * WSTR + k] = v[0]; Wt[(4 * half + 1) * WSTR + k] = v[1]; Wt[(4 * half + 2) * WSTR + k] = v[2]; Wt[(4 * half + 3) * WSTR + k] = v[3]; }
    if (F.tid < 16) lt[LT_LCNT + F.tid] = 0;
    for (int i = F.bx * NTHR + F.tid; i < MOE_ROWS; i += NWG * NTHR) TOK[i] = -1;
    WG_BAR();
    const int ri = lane & 15, kq = lane >> 4, row0 = 128 * F.bx + 16 * F.wave;
    const u32x4* xr = (const u32x4*)(XS + (size_t)(row0 + ri) * D) + kq;
    const LAS float* wl = Wt + (lane & 7) * WSTR + 8 * kq;
    f32x4 acc = (f32x4){F.zf, F.zf, F.zf, F.zf}; float ssq = 0.f;
    u32x4 cur[8], nxt[8];
#pragma unroll
    for (int c = 0; c < 8; ++c) cur[c] = xr[4 * c];
#pragma unroll 1
    for (int tb = 0; tb < 8; ++tb) {
        if (tb + 1 < 8) {
#pragma unroll
            for (int c = 0; c < 8; ++c) nxt[c] = xr[4 * (8 * (tb + 1) + c)]; }
#pragma unroll
        for (int c = 0; c < 8; ++c) {
            const f32x4 w0 = *(const LAS f32x4*)(wl + 32 * (8 * tb + c)), w1 = *(const LAS f32x4*)(wl + 32 * (8 * tb + c) + 4);
            const u32x4 r = cur[c]; const float xv[8] = {bflo(r.x), bfhi(r.x), bflo(r.y), bfhi(r.y), bflo(r.z), bfhi(r.z), bflo(r.w), bfhi(r.w)};
            const float wv[8] = {w0[0], w0[1], w0[2], w0[3], w1[0], w1[1], w1[2], w1[3]};
#pragma unroll
            for (int u = 0; u < 8; ++u) { ssq += xv[u] * xv[u]; acc = __builtin_amdgcn_mfma_f32_16x16x4f32(xv[u], wv[u], acc, 0, 0, 0); }
        }
        if (tb + 1 < 8) {
#pragma unroll
            for (int c = 0; c < 8; ++c) cur[c] = nxt[c]; }
    }
    ssq += SHFL_XOR(ssq, 16); ssq += SHFL_XOR(ssq, 32);
    const float rstd = 1.0f / sqrtf(ssq * (1.f / D) + EPS);
#pragma unroll
    for (int r = 0; r < 4; ++r) Cw[(4 * kq + r) * 16 + ri] = acc[r];
    if (lane < 16) {
        const f32x4 l0 = *(const LAS f32x4*)(Cw + lane * 16), l1 = *(const LAS f32x4*)(Cw + lane * 16 + 4);
        const float lg[8] = {l0[0] * rstd, l0[1] * rstd, l0[2] * rstd, l0[3] * rstd, l1[0] * rstd, l1[1] * rstd, l1[2] * rstd, l1[3] * rstd};
        const int row = row0 + lane;
        int e0 = 0; float b0 = lg[0];
#pragma unroll
        for (int e = 1; e < 8; ++e) if (lg[e] > b0) { b0 = lg[e]; e0 = e; }
        int e1 = -1; float b1 = -__builtin_inff();
#pragma unroll
        for (int e = 0; e < 8; ++e) if (e != e0 && lg[e] > b1) { b1 = lg[e]; e1 = e; }
        if (e1 < 0) e1 = (e0 == 0) ? 1 : 0;
        const float w1 = 1.0f / (1.0f + __expf(b0 - b1)), w0 = 1.0f - w1;
        const int r0 = __hip_atomic_fetch_add(lt + LT_LCNT + e0, 1, __ATOMIC_RELAXED, __HIP_MEMORY_SCOPE_WORKGROUP), r1 = __hip_atomic_fetch_add(lt + LT_LCNT + 8 + e1, 1, __ATOMIC_RELAXED, __HIP_MEMORY_SCOPE_WORKGROUP);
        ROUTE[row] = e0 | (e1 << 8); ROUTE[T + row] = r0; ROUTE[2 * T + row] = r1; ((float*)ROUTE)[3 * T + row] = w0; ((float*)ROUTE)[4 * T + row] = w1; ((float*)ROUTE)[5 * T + row] = rstd;
    }
    WG_BAR();
    if (F.tid < 16) WGCNT[F.bx * 16 + F.tid] = lt[LT_LCNT + F.tid];
}
__device__ __forceinline__ void moe_tables(Frame& F, const int* WGCNT) {
    LAS unsigned char* L = F.lds; LAS int* lt = (LAS int*)(L + LTAB_OFF); const int tid = F.tid, c = F.bx;
    WG_BAR();
    { const int g = tid & 15, chn = tid >> 4; int s = 0;
#pragma unroll
      for (int i = 0; i < 8; ++i) s += WGCNT[(8 * chn + i) * 16 + g];
      lt[LT_PART + chn * 16 + g] = s; }
    WG_BAR();
    if (tid < 16) { int run = 0; for (int chn = 0; chn < 32; ++chn) { lt[LT_PRE + chn * 16 + tid] = run; run += lt[LT_PART + chn * 16 + tid]; } lt[LT_TOT + tid] = run; }
    WG_BAR();
    if (tid == 0) { int off = 0;
        for (int g = 0; g < 16; ++g) { const int nt = (lt[LT_TOT + g] + 255) >> 8; lt[LT_CUMT + g] = off >> 8; lt[LT_GOFF + g] = off; for (int t = 0; t < nt; ++t) lt[LT_TAB + (off >> 8) + t] = g & 7; off += nt << 8; }
        lt[LT_CUMT + 16] = off >> 8; }
    WG_BAR();
    if (tid < 16) { int bs = lt[LT_GOFF + tid] + lt[LT_PRE + (c >> 3) * 16 + tid]; for (int w2 = 8 * (c >> 3); w2 < c; ++w2) bs += WGCNT[w2 * 16 + tid]; lt[LT_BASE + tid] = bs; }
    WG_BAR();
}
__device__ __forceinline__ void moe_gather(Frame& F, const unsigned char* XA8, const int* ROUTE, const int* WGCNT, unsigned char* XG8, int* TOK, float* WGT, float* RS) {
    LAS unsigned char* L = F.lds; LAS int* lt = (LAS int*)(L + LTAB_OFF); const int lane = F.lane, c = F.bx;
    int ee[8], ra[8], rb[8]; float wa[8], wb[8], rr[8]; u32x4 xv[8][2];
#define MG_LOAD(i0) do { _Pragma("unroll") for (int k = 0; k < 8; ++k) { const int row = 128 * c + 16 * F.wave + (i0) + k; ee[k] = ROUTE[row]; ra[k] = ROUTE[T + row]; rb[k] = ROUTE[2 * T + row]; \
            wa[k] = ((const float*)ROUTE)[3 * T + row]; wb[k] = ((const float*)ROUTE)[4 * T + row]; rr[k] = ((const float*)ROUTE)[5 * T + row]; \
            const u32x4* src = (const u32x4*)(XA8 + (size_t)row * D) + lane; xv[k][0] = src[0]; xv[k][1] = src[64]; } } while (0)
#define MG_STORE(i0) do { _Pragma("unroll") for (int k = 0; k < 8; ++k) { const int row = 128 * c + 16 * F.wave + (i0) + k; const int e0 = ee[k] & 255, e1 = ee[k] >> 8; \
            const int pos0 = lt[LT_BASE + e0] + ra[k], pos1 = lt[LT_BASE + 8 + e1] + rb[k]; \
            u32x4* d0 = (u32x4*)(XG8 + (size_t)pos0 * D) + lane; u32x4* d1 = (u32x4*)(XG8 + (size_t)pos1 * D) + lane; \
            d0[0] = xv[k][0]; d0[64] = xv[k][1]; d1[0] = xv[k][0]; d1[64] = xv[k][1]; \
            if (lane == 0) { TOK[pos0] = row; TOK[pos1] = row; WGT[pos0] = wa[k]; WGT[pos1] = wb[k]; RS[pos0] = rr[k]; RS[pos1] = rr[k]; } } } while (0)
    MG_LOAD(0);
    moe_tables(F, WGCNT);
    MG_STORE(0);
    MG_LOAD(8);
    MG_STORE(8);
#undef MG_LOAD
#undef MG_STORE
}

#ifndef NEXP_LATE
#define NEXP_LATE 1
#endif
#ifndef NEXP_TAIL
#define NEXP_TAIL 2
#endif
#ifndef NGEMM0
#define NGEMM0 192
#endif
#ifndef INPROJ1_FP8
#define INPROJ1_FP8 0
#endif
#ifndef FFN_DOWN_FP8
#define FFN_DOWN_FP8 0
#endif
#ifndef MOE_DOWN_FP8
#define MOE_DOWN_FP8 1
#endif
#ifndef PROBE_SSQ0
#define PROBE_SSQ0 SSQ_(7)
#endif
#ifndef RES_ALIGN
#define RES_ALIGN false
#endif
enum { I_X = 0, I_P, I_LNMIX, I_WIN, I_WOUT, I_MCW, I_MCB, I_MGB, I_MNG, I_SCW, I_SCB, I_SDTB, I_SALOG, I_SD, I_SNG, I_LNFFN, I_FWG, I_FWU, I_FWD, I_ROUTER, I_MWG, I_MWU, I_MWD, I_LNPLE, I_PPROJ, I_PGATE, I_LNFINAL };

__global__ void __launch_bounds__(NTHR, 2) hybrid_fwd(Args args) {
    extern __shared__ __attribute__((aligned(16))) unsigned char lds_raw[];
    Frame F;
    F.lds = (LAS unsigned char*)lds_raw;
    F.tid = threadIdx.x; F.lane = F.tid & 63; F.wave = __builtin_amdgcn_readfirstlane(F.tid >> 6);
    F.zf = 0.f; F.zu = 0u;
    const int wave0 = F.wave;
    F.bx = blockIdx.x; F.vcu = (F.bx % 8) * (NWG / 8) + F.bx / 8;
    volatile LAS unsigned* MISC = (volatile LAS unsigned*)(F.lds + MISC_OFF);
    for (int u = F.tid; u < 64; u += NTHR) MISC[u] = 0u;
    __syncthreads();
    unsigned* ctl = (unsigned*)(args.ws + WS_CTL);
    XcdBarrier bar = xcd_barrier_post(ctl + CW_BAR, MISC + 8);
    const int lo = args.ph_lo, hi = args.ph_hi; int ph = 0;
#define PHASE_BEGIN if (ph >= lo && ph < hi) { { int w_ = wave0; asm volatile("" : "+s"(w_)); unsigned z_ = 0u; asm volatile("" : "+s"(z_)); int t_ = (int)__builtin_amdgcn_mbcnt_hi(~0u, __builtin_amdgcn_mbcnt_lo(~0u, z_)); asm volatile("" : "+v"(t_)); t_ += w_ * 64; F.tid = t_; F.lane = t_ & 63; F.wave = w_; F.zu = z_; F.zf = __builtin_bit_cast(float, z_); LAS unsigned char* b_ = (LAS unsigned char*)lds_raw; asm volatile("" : "+s"(b_)); F.lds = b_; int x_ = blockIdx.x; asm volatile("" : "+s"(x_)); F.bx = x_; F.vcu = (x_ % 8) * (NWG / 8) + x_ / 8; }
#define REFRESH_TID() do { int w_ = wave0; asm volatile("" : "+s"(w_)); unsigned z_ = 0u; asm volatile("" : "+s"(z_)); int t_ = (int)__builtin_amdgcn_mbcnt_hi(~0u, __builtin_amdgcn_mbcnt_lo(~0u, z_)); asm volatile("" : "+v"(t_)); t_ += w_ * 64; F.tid = t_; F.lane = t_ & 63; F.wave = w_; F.zu = z_; F.zf = __builtin_bit_cast(float, z_); } while (0)
#ifdef PROBE_TS
#define TS_STAMP(idx) do { unsigned zz_ = 0u; asm volatile("" : "+s"(zz_)); const int ll_ = (int)__builtin_amdgcn_mbcnt_hi(~0u, __builtin_amdgcn_mbcnt_lo(~0u, zz_)); if (blockIdx.x == 0 && wave0 == 0 && ll_ == 0) ((LAS unsigned long long*)((LAS unsigned char*)lds_raw + PTAB_OFF + 512))[(idx)] = __builtin_amdgcn_s_memrealtime(); } while (0)
#else
#define TS_STAMP(idx) do {} while (0)
#endif
#define PHASE_END(last) if (!(last) && ph + 1 < hi) xcd_barrier(bar); TS_STAMP(ph + 1); } ++ph;

    if (F.tid == 0) { LAS unsigned long long* pt = (LAS unsigned long long*)(F.lds + PTAB_OFF);
#pragma unroll
        for (int i = 0; i < 27; ++i) pt[i] = (unsigned long long)(uintptr_t)args.in[i];
        pt[27] = (unsigned long long)(uintptr_t)args.out; pt[28] = (unsigned long long)(uintptr_t)args.ws; }
    __syncthreads();
    TS_STAMP(0);
#define PTR_(i) ld_ptr(F.lds, (i))
#define IN_(i) ((const float*)PTR_(i))
#define X_ ((float*)PTR_(27))
#define WSB_(off) (PTR_(28) + (off))
#define WIN ((bf16_t*)WSB_(WS_WIN))
#define WOUT ((bf16_t*)WSB_(WS_WOUT))
#define FGU ((bf16_t*)WSB_(WS_FGU))
#define FD ((bf16_t*)WSB_(WS_FD))
#define MGU ((bf16_t*)WSB_(WS_MGU))
#define MD ((bf16_t*)WSB_(WS_MD))
#define PG ((bf16_t*)WSB_(WS_PG))
#define PP ((bf16_t*)WSB_(WS_PP))
#define XN ((bf16_t*)WSB_(WS_XN))
#define P16 ((bf16_t*)WSB_(WS_P16))
#define U ((bf16_t*)WSB_(WS_U))
#define MIX ((bf16_t*)WSB_(WS_MIX))
#define CVB ((bf16_t*)WSB_(WS_CV))
#define H ((bf16_t*)WSB_(WS_H))
#define XBB ((bf16_t*)WSB_(WS_XBB))
#define XA8 ((unsigned char*)WSB_(WS_XA8))
#define XB8 ((unsigned char*)WSB_(WS_CV))
#define SSQ_(i) ((pg8::ssq_t*)WSB_(WS_SSQ) + (size_t)(i) * T)
#define RS ((float*)WSB_(WS_WGT + 512 * 1024))
#define XG ((bf16_t*)WSB_(WS_XG))
#define HM ((bf16_t*)WSB_(WS_HM))
#define SSQM ((float*)WSB_(WS_SSQM))
#define SSQS ((float*)WSB_(WS_SSQS))
#define KMEAN ((float*)WSB_(WS_KMEAN))
#define ROUTE ((int*)WSB_(WS_ROUTE))
#define TOK ((int*)WSB_(WS_TOK))
#define WGT ((float*)WSB_(WS_WGT))
#define WGCNT ((int*)WSB_(WS_WGCNT))
    PHASE_BEGIN
    {
        LAS float* scr = (LAS float*)(F.lds + RING_OFF + F.wave * XP_SCR); const int gw = F.vcu * NWAVES + F.wave, NGW = NWG * NWAVES;
        {   const float* W = IN_(I_WIN); bf16_t* WT = WIN; const int nblk = NU / 64, items = (D / 64) * nblk;
            for (int it = gw; it < items; it += NGW) { const int kb = it / nblk, nb = it % nblk; xpose_item<false>(W, DPROJ_SRC, win_srccol(nb * 64 + 4 * (F.lane & 15)), kb * 64, WT, D, nb * 64, scr, F.lane, IN_(I_LNMIX), F.zf); } }
        {
            const float* xs = IN_(I_X); bf16_t* xb = XBB; pg8::ssq_t* sq = SSQ_(0); f32x4 v[8];
            for (int m = gw; m < T; m += NGW) { (void)load_row_ssq(F, xs + (size_t)m * D, v); float s = 0.f;
#pragma unroll
                for (int j = 0; j < 8; ++j) { u32x2 w; w.x = pk2(v[j].x, v[j].y); w.y = pk2(v[j].z, v[j].w); ((u32x2*)(xb + (size_t)m * D) + F.lane)[64 * j] = w;
                    const float a = bflo(w.x), b = bfhi(w.x), c = bflo(w.y), d = bfhi(w.y); s += (a * a + b * b) + (c * c + d * d); }
                s = wave_sum(s);
                if (F.lane == 0) sq[m] = (pg8::ssq_t)(s * pg8::SSQ_SCALE + 0.5f); }
        }
    }
    PHASE_END(false)
    PHASE_BEGIN
    if (F.bx < NGEMM0) {
        pg8::StaticOrder S; S.init(T, NU, NGEMM0, F.bx); pg8::EpiBf16 E{U, NU, SSQ_(0), 1.0f};
        pg8::Gemm g{XBB, WIN, D, D, D, 0}; pg8::gemm_phase<pg8::EpiBf16, pg8::StaticOrder, true>(F.lds + RING_OFF, g, S, E, F.tid);
        REFRESH_TID();
        { LAS float* scr = (LAS float*)(F.lds + RING_OFF + F.wave * XP_SCR); const int gw = F.bx * NWAVES + F.wave, NGW = NGEMM0 * NWAVES;
          for (int e = NEXP - NEXP_TAIL; e < NEXP; ++e) {
            if (e < NEXP - NEXP_LATE) xpose_gu(F, IN_(I_MWG) + (size_t)e * D * DFFE, IN_(I_MWU) + (size_t)e * D * DFFE, D, DFFE, MGU + (size_t)e * 2 * DFFE * (D / 2), scr, gw, NGW, IN_(I_LNFFN) + D);
            xpose_plain<MOE_DOWN_FP8 != 0>(F, IN_(I_MWD) + (size_t)e * DFFE * D, DFFE, D, MD + (size_t)e * D * (MOE_DOWN_FP8 ? DFFE / 2 : DFFE), scr, gw, NGW, nullptr); } }
    } else {
        LAS float* scr = (LAS float*)(F.lds + RING_OFF + F.wave * XP_SCR); const int gw = (F.bx - NGEMM0) * NWAVES + F.wave, NGW = (NWG - NGEMM0) * NWAVES;
        for (int l = 0; l < DEPTH; ++l) {
            if (l == 1) {
                const float* W = IN_(I_WIN) + (size_t)l * D * DPROJ_SRC; bf16_t* WT = WIN + (size_t)l * NU * D;
                const int nblk = NU / 64, items = (D / 64) * nblk;
                for (int it = gw; it < items; it += NGW) { const int kb = it / nblk, nb = it % nblk; xpose_item<INPROJ1_FP8 != 0>(W, DPROJ_SRC, win_srccol(nb * 64 + 4 * (F.lane & 15)), kb * 64, WT, D, nb * 64, scr, F.lane, IN_(I_LNMIX) + (size_t)l * D, F.zf); }
            }
            xpose_plain(F, IN_(I_WOUT) + (size_t)l * D * D, D, D, WOUT + (size_t)l * D * D, scr, gw, NGW, nullptr);
            xpose_plain<true>(F, IN_(I_PGATE) + (size_t)l * D * D, D, D, PG + (size_t)l * D * (D / 2), scr, gw, NGW, IN_(I_LNPLE) + (size_t)l * D);
            xpose_plain(F, IN_(I_PPROJ) + (size_t)l * PLE * D, PLE, D, PP + (size_t)l * D * PLE, scr, gw, NGW, nullptr);
        }
        xpose_gu(F, IN_(I_FWG), IN_(I_FWU), D, DFF, FGU, scr, gw, NGW, IN_(I_LNFFN));
        xpose_plain<FFN_DOWN_FP8 != 0>(F, IN_(I_FWD), DFF, D, FD, scr, gw, NGW, nullptr);
        {
            const f32x4* ps = (const f32x4*)IN_(I_P); u32x2* pd = (u32x2*)P16; const size_t n4 = (size_t)DEPTH * T * PLE / 4, st = (size_t)(NWG - NGEMM0) * NTHR;
            for (size_t i = (size_t)(F.bx - NGEMM0) * NTHR + F.tid; i < n4; i += 8 * st) { f32x4 v[8];
#pragma unroll
                for (int k = 0; k < 8; ++k) if (i + k * st < n4) v[k] = ps[i + k * st];
#pragma unroll
                for (int k = 0; k < 8; ++k) if (i + k * st < n4) { u32x2 o; o.x = pk2(v[k].x, v[k].y); o.y = pk2(v[k].z, v[k].w); pd[i + k * st] = o; } }
        }
        for (int e = 0; e < NEXP - NEXP_TAIL; ++e) {
            xpose_gu(F, IN_(I_MWG) + (size_t)e * D * DFFE, IN_(I_MWU) + (size_t)e * D * DFFE, D, DFFE, MGU + (size_t)e * 2 * DFFE * (D / 2), scr, gw, NGW, IN_(I_LNFFN) + D);
            xpose_plain<MOE_DOWN_FP8 != 0>(F, IN_(I_MWD) + (size_t)e * DFFE * D, DFFE, D, MD + (size_t)e * D * (MOE_DOWN_FP8 ? DFFE / 2 : DFFE), scr, gw, NGW, nullptr);
        }
    }
    PHASE_END(false)

    for (int l = 0; l < DEPTH; ++l) {
        if (l > 0) {
        PHASE_BEGIN
        if (INPROJ1_FP8 && l == 1) { REFRESH_TID(); pg8::StaticOrder S; S.init(T, NU, NWG, F.bx); pg8::EpiBf16 E{U, NU, SSQ_(3 * l), W8_INV};
            pg8::Gemm g{(const bf16_t*)XB8, WIN + (size_t)l * NU * D, D / 2, D / 2, D / 2, 0}; pg8::gemm_phase<pg8::EpiBf16, pg8::StaticOrder, true, true>(F.lds + RING_OFF, g, S, E, F.tid); }
        else { REFRESH_TID(); pg8::StaticOrder S; S.init(T, NU, NWG, F.bx); pg8::EpiBf16 E{U, NU, SSQ_(3 * l), 1.0f};
            pg8::Gemm g{XBB, WIN + (size_t)l * NU * D, D, D, D, 0}; pg8::gemm_phase<pg8::EpiBf16, pg8::StaticOrder, true>(F.lds + RING_OFF, g, S, E, F.tid); }
        REFRESH_TID();
        { constexpr int IP1_REM = ((T / 256) * (NU / 256)) % NWG;
          if (NEXP_LATE > 0 && IP1_REM > 0 && F.bx >= IP1_REM) { LAS float* scr = (LAS float*)(F.lds + RING_OFF + F.wave * XP_SCR); const int gw = (F.bx - IP1_REM) * NWAVES + F.wave, NGW = (NWG - IP1_REM) * NWAVES;
            for (int e = NEXP - NEXP_LATE; e < NEXP; ++e)
              xpose_gu(F, IN_(I_MWG) + (size_t)e * D * DFFE, IN_(I_MWU) + (size_t)e * D * DFFE, D, DFFE, MGU + (size_t)e * 2 * DFFE * (D / 2), scr, gw, NGW, IN_(I_LNFFN) + D); } }
        PHASE_END(false)
        }
        PHASE_BEGIN
        {
            conv_phase(F, U, CVB, IN_(I_MCW) + (size_t)l * 4 * 1024, IN_(I_MCB) + (size_t)l * 1024, IN_(I_SCW) + (size_t)l * 4 * 1536, IN_(I_SCB) + (size_t)l * 1536);
            REFRESH_TID();
            kmean_items(F, U, KMEAN);
        }
        PHASE_END(false)
        PHASE_BEGIN
        {
            for (int u = F.vcu; u < NB * 16; u += NWG)
                ssd_unit(F, u >> 4, u & 15, U, CVB, MIX, SSQS, IN_(I_SDTB) + l * 16, IN_(I_SALOG) + l * 16, IN_(I_SD) + l * 16);
#ifdef PROBE_SSD2
            if (l == 0) { REFRESH_TID(); for (int u = F.vcu; u < NB * 16; u += NWG)
                ssd_unit(F, u >> 4, u & 15, U, CVB, MIX, SSQS, IN_(I_SDTB) + l * 16, IN_(I_SALOG) + l * 16, IN_(I_SD) + l * 16); REFRESH_TID(); }
#endif
            for (int u = F.vcu; u < NB * 16; u += NWG)
                mlstm_unit(F, u >> 4, (u >> 2) & 3, u & 3, U, CVB, MIX, SSQM, IN_(I_MGB) + l * 8);
        }
        PHASE_END(false)
        PHASE_BEGIN
        {
            for (int u = F.vcu; u < NB * 4 * 4; u += NWG) { const int bh = u >> 2, s = u & 3;
                moba_unit(F, bh >> 2, bh & 3, 7 - s, U, MIX, KMEAN); moba_unit(F, bh >> 2, bh & 3, s, U, MIX, KMEAN); }
            REFRESH_TID();
            mixnorm_rows(F, U, MIX, SSQM, SSQS, IN_(I_MNG) + (size_t)l * 512, IN_(I_SNG) + (size_t)l * 1024);
        }
        PHASE_END(false)
        PHASE_BEGIN
        { pg8::Gemm g{MIX, WOUT + (size_t)l * D * D, D, D, D, 0}; pg8::StaticOrder S; S.init(T, D, NWG, F.bx); STAGGER(920);
#ifdef PROBE_OUT2
          { pg8::EpiResidualStat E0{XBB, XN, XA8, PROBE_SSQ0, D, 0.5f}; pg8::gemm_phase<pg8::EpiResidualStat, pg8::StaticOrder, RES_ALIGN>(F.lds + RING_OFF, g, S, E0, F.tid); }
          xcd_barrier(bar);
          pg8::EpiResidualStat E{XN, XN, XA8, SSQ_(3 * l + 1), D, 0.5f};
#else
          pg8::EpiResidualStat E{XBB, XN, XA8, SSQ_(3 * l + 1), D, 1.0f};
#endif
          pg8::gemm_phase<pg8::EpiResidualStat, pg8::StaticOrder, RES_ALIGN>(F.lds + RING_OFF, g, S, E, F.tid); }
        PHASE_END(false)
        if (l == 0) {
            PHASE_BEGIN
            { pg8::Gemm g{(const bf16_t*)XA8, FGU, D / 2, D / 2, D / 2, 0}; pg8::StaticOrder S; S.init(T, 2 * DFF, NWG, F.bx); pg8::EpiSwiGLU<FFN_DOWN_FP8 != 0> E{H, DFF, nullptr, 0, SSQ_(3 * l + 1), nullptr, W8_INV, nullptr, nullptr};
              pg8::gemm_phase<pg8::EpiSwiGLU<FFN_DOWN_FP8 != 0>, pg8::StaticOrder, true, true>(F.lds + RING_OFF, g, S, E, F.tid); }
            PHASE_END(false)
            PHASE_BEGIN
            { constexpr int KD = FFN_DOWN_FP8 ? DFF / 2 : DFF; pg8::Gemm g{H, FD, KD, KD, KD, 0}; pg8::StaticOrder S; S.init(T, D, NWG, F.bx); pg8::EpiResidualStat E{XN, XN, XA8, SSQ_(3 * l + 2), D, FFN_DOWN_FP8 ? W8_INV * H8_INV : 1.0f};
              pg8::gemm_phase<pg8::EpiResidualStat, pg8::StaticOrder, RES_ALIGN, FFN_DOWN_FP8 != 0>(F.lds + RING_OFF, g, S, E, F.tid); }
            REFRESH_TID();
            { pg8::Gemm g{P16 + (size_t)l * T * PLE, PP + (size_t)l * D * PLE, PLE, PLE, PLE, 0}; pg8::StaticOrder S; S.init(T, D, NWG, F.bx); pg8::EpiBf16 E{(bf16_t*)WSB_(WS_PPB0), D, nullptr, 1.0f};
              pg8::gemm_phase<pg8::EpiBf16, pg8::StaticOrder, true>(F.lds + RING_OFF, g, S, E, F.tid); }
            PHASE_END(false)
        } else {
            PHASE_BEGIN
            moe_route(F, XN, IN_(I_LNFFN) + (size_t)l * D, IN_(I_ROUTER), ROUTE, WGCNT, TOK);
            PHASE_END(false)
            PHASE_BEGIN
            moe_gather(F, XA8, ROUTE, WGCNT, (unsigned char*)XG, TOK, WGT, RS);
            PHASE_END(false)
            {
                const LAS int* lt = (const LAS int*)(F.lds + LTAB_OFF);
                PHASE_BEGIN
                { const int rtb = lt[LT_CUMT + 8], rtc = lt[LT_CUMT + 16];
                  const int r0 = ((rtb - lt[LT_CUMT]) * (D / 256)) % NWG, nl = r0 > 0 ? NWG - r0 : 0, n1 = (rtc - rtb) * (2 * DFFE / 256), nu = rtc * (2 * DFFE / 256), ndmax = 3 * nl < n1 ? 3 * nl : n1, drem = (nu - ndmax) % NWG, ndtry = ndmax - ((NWG - drem) % NWG), ndef = ndtry >= 0 ? ndtry : ndmax;
                  pg8::Gemm g{XG, MGU, D / 2, D / 2, D / 2, (size_t)2 * DFFE * (D / 2)}; pg8::MoeOrderGU S{rtb, rtc, 2 * DFFE / 256, NWG, F.bx, 0, nu - ndef, lt + LT_TAB}; pg8::EpiSwiGLU<MOE_DOWN_FP8 != 0> E{HM, DFFE, WGT, 0, nullptr, RS, W8_INV, (LAS float*)(F.lds + RING_BYTES), (volatile LAS unsigned*)(F.lds + MISC_OFF) + 24};
                  pg8::gemm_phase<pg8::EpiSwiGLU<MOE_DOWN_FP8 != 0>, pg8::MoeOrderGU, true, true>(F.lds + RING_OFF, g, S, E, F.tid);
                }
                PHASE_END(false)
            }
            for (int slot = 0; slot < 2; ++slot) {
                const LAS int* lt = (const LAS int*)(F.lds + LTAB_OFF);
                PHASE_BEGIN
                { const int rt0 = lt[LT_CUMT + 8 * slot], rt1 = lt[LT_CUMT + 8 * slot + 8];
                  constexpr int KM = MOE_DOWN_FP8 ? DFFE / 2 : DFFE; pg8::Gemm g{HM, MD, KM, KM, KM, (size_t)D * KM}; pg8::MoeOrder S{rt0, rt1 - rt0, D / 256, NWG, F.bx, lt + LT_TAB};
                  #ifdef PROBE_MOEDOWN2
                  { pg8::EpiScatter<false> E0{XN, D, TOK, nullptr, nullptr, 0.5f * (MOE_DOWN_FP8 ? W8_INV * H8_INV : 1.0f)}; pg8::gemm_phase<pg8::EpiScatter<false>, pg8::MoeOrder, RES_ALIGN, MOE_DOWN_FP8 != 0>(F.lds + RING_OFF, g, S, E0, F.tid); } xcd_barrier(bar);
                  const float al_ = 0.5f * (MOE_DOWN_FP8 ? W8_INV * H8_INV : 1.0f);
#else
                  const float al_ = MOE_DOWN_FP8 ? W8_INV * H8_INV : 1.0f;
#endif
                  if (slot == 0) { pg8::EpiScatter<false> E{XN, D, TOK, nullptr, nullptr, al_}; pg8::gemm_phase<pg8::EpiScatter<false>, pg8::MoeOrder, RES_ALIGN, MOE_DOWN_FP8 != 0>(F.lds + RING_OFF, g, S, E, F.tid);
                    REFRESH_TID();
                    const int rtb = lt[LT_CUMT + 8], rtc = lt[LT_CUMT + 16];
                    const int r0 = ((rtb - lt[LT_CUMT]) * (D / 256)) % NWG, nl = r0 > 0 ? NWG - r0 : 0, n1 = (rtc - rtb) * (2 * DFFE / 256), nu = rtc * (2 * DFFE / 256), ndmax = 3 * nl < n1 ? 3 * nl : n1, drem = (nu - ndmax) % NWG, ndtry = ndmax - ((NWG - drem) % NWG), ndef = ndtry >= 0 ? ndtry : ndmax;
                    if (ndef > 0 && F.bx >= r0) { pg8::Gemm g3{XG, MGU, D / 2, D / 2, D / 2, (size_t)2 * DFFE * (D / 2)}; pg8::MoeOrderGU S3{rtb, rtc, 2 * DFFE / 256, nl, F.bx - r0, nu - ndef, nu, lt + LT_TAB}; pg8::EpiSwiGLU<MOE_DOWN_FP8 != 0> E3{HM, DFFE, WGT, 0, nullptr, RS, W8_INV, (LAS float*)(F.lds + RING_BYTES), (volatile LAS unsigned*)(F.lds + MISC_OFF) + 24};
                      pg8::gemm_phase<pg8::EpiSwiGLU<MOE_DOWN_FP8 != 0>, pg8::MoeOrderGU, true, true>(F.lds + RING_OFF, g3, S3, E3, F.tid); } }
                  else { pg8::EpiScatter<true> E{XN, D, TOK, XA8, SSQ_(3 * l + 2), al_}; pg8::gemm_phase<pg8::EpiScatter<true>, pg8::MoeOrder, RES_ALIGN, MOE_DOWN_FP8 != 0>(F.lds + RING_OFF, g, S, E, F.tid);
                    REFRESH_TID();
                    const int rem = ((rt1 - rt0) * (D / 256)) % NWG;
                    if (F.bx >= rem) { pg8::Gemm g2{P16 + (size_t)l * T * PLE, PP + (size_t)l * D * PLE, PLE, PLE, PLE, 0}; pg8::StaticOrder S2; S2.init(T, D, NWG - rem, F.bx - rem); pg8::EpiBf16 E2{(bf16_t*)WSB_(WS_PPB1), D, nullptr, 1.0f};
                      pg8::gemm_phase<pg8::EpiBf16, pg8::StaticOrder, true>(F.lds + RING_OFF, g2, S2, E2, F.tid); } } }
                PHASE_END(false)
            }
        }
        PHASE_BEGIN
        { pg8::Gemm g{(const bf16_t*)XA8, PG + (size_t)l * D * (D / 2), D / 2, D / 2, D / 2, 0}; pg8::StaticOrder S; S.init(T, D, NWG, F.bx); pg8::EpiPleGate E{XN, XBB, (const bf16_t*)WSB_(l == 0 ? WS_PPB0 : WS_PPB1), D, SSQ_(3 * l + 2), SSQ_(3 * l + 3), W8_INV, (INPROJ1_FP8 && l == 0) ? XB8 : nullptr};
          pg8::gemm_phase<pg8::EpiPleGate, pg8::StaticOrder, RES_ALIGN, true>(F.lds + RING_OFF, g, S, E, F.tid); }
        PHASE_END(false)
    }
    PHASE_BEGIN
    {
        const float* g = IN_(I_LNFINAL); float* X = X_; const bf16_t* xs = XBB; const pg8::ssq_t* sq = SSQ_(6); const int gw = F.vcu * NWAVES + F.wave, NGW = NWG * NWAVES;
        for (int m0 = gw; m0 < T; m0 += 2 * NGW) {
            u32x2 w[2][8]; float rstd[2];
#pragma unroll
            for (int k = 0; k < 2; ++k) { const int m = m0 + k * NGW; rstd[k] = pg8::ssq_rstd(sq, m); const u32x2* xr = (const u32x2*)(xs + (size_t)m * D) + F.lane;
#pragma unroll
                for (int j = 0; j < 8; ++j) w[k][j] = xr[64 * j]; }
#pragma unroll
            for (int k = 0; k < 2; ++k) { const int m = m0 + k * NGW; f32x4* orow = (f32x4*)(X + (size_t)m * D) + F.lane;
#pragma unroll
                for (int j = 0; j < 8; ++j) { const f32x4 gg = ((const f32x4*)g + F.lane)[64 * j]; f32x4 o; o.x = bflo(w[k][j].x) * rstd[k] * gg.x; o.y = bfhi(w[k][j].x) * rstd[k] * gg.y; o.z = bflo(w[k][j].y) * rstd[k] * gg.z; o.w = bfhi(w[k][j].y) * rstd[k] * gg.w; orow[64 * j] = o; } }
        }
    }
#ifdef PROBE_ML
    REFRESH_TID();
    if (ph >= lo && ph < hi && blockIdx.x == 0 && F.tid == 0) {
        asm volatile("s_waitcnt vmcnt(0)" ::: "memory");
        const unsigned long long* dg = (const unsigned long long*)(args.ws + 2883584);
        const unsigned long long d1 = dg[PROBE_I1], d2 = dg[PROBE_I2];
        X_[0] += 2.0f + (float)d1 * (1.0f / 4000.0f);
        const unsigned long long tgt = __builtin_amdgcn_s_memrealtime() + 8ull * d2;
        while (__builtin_amdgcn_s_memrealtime() < tgt) __builtin_amdgcn_s_sleep(32);
    }
#endif
#ifdef PROBE_TS
    REFRESH_TID();
    if (ph >= lo && ph < hi && blockIdx.x == 0 && F.tid == 0) {
        const LAS unsigned long long* ts = (const LAS unsigned long long*)((LAS unsigned char*)lds_raw + PTAB_OFF + 512);
        const unsigned long long dA = (PROBE_PA == 20 ? __builtin_amdgcn_s_memrealtime() : ts[PROBE_PA + 1]) - ts[PROBE_PA], dB = ts[PROBE_PB + 1] - ts[PROBE_PB];
        asm volatile("s_waitcnt vmcnt(0)" ::: "memory");
        X_[0] += 2.0f + (float)dB * (1.0f / 2000.0f);
        const unsigned long long tgt = __builtin_amdgcn_s_memrealtime() + 8ull * dA;
        while (__builtin_amdgcn_s_memrealtime() < tgt) __builtin_amdgcn_s_sleep(32);
    }
#endif
    PHASE_END(true)
#undef PHASE_BEGIN
#undef PHASE_END
}

extern "C" void kernel_launch(void* const* d_in, const int* in_sizes, int n_in, void* d_out, int out_size, void* d_ws, size_t ws_size, hipStream_t stream) {
    static int grid = 0;
    if (grid == 0) {
        if (n_in != 27 || out_size != T * D || ws_size < WS_END) { fprintf(stderr, "kernel_launch: unexpected shapes (n_in %d, out %d, ws %zu < %zu)\n", n_in, out_size, ws_size, (size_t)WS_END); grid = -1; return; }
        int dev = 0, cus = 0, per_cu = 0;
        if (hipGetDevice(&dev) != hipSuccess || hipDeviceGetAttribute(&cus, hipDeviceAttributeMultiprocessorCount, dev) != hipSuccess) { grid = -1; return; }
        if (hipFuncSetAttribute((const void*)hybrid_fwd, hipFuncAttributeMaxDynamicSharedMemorySize, LDS_BYTES) != hipSuccess) { fprintf(stderr, "kernel_launch: hipFuncSetAttribute failed\n"); grid = -1; return; }
        if (hipOccupancyMaxActiveBlocksPerMultiprocessor(&per_cu, (const void*)hybrid_fwd, NTHR, LDS_BYTES) != hipSuccess || per_cu < 1) fprintf(stderr, "kernel_launch: occupancy query reports %d\n", per_cu);
        (void)hipGetLastError();
        if (cus != 256) { fprintf(stderr, "kernel_launch: built for 256 CUs, device has %d\n", cus); grid = -1; return; }
        grid = cus;
    }
    if (grid < 0) return;
    if (hipMemsetAsync((char*)d_ws + WS_CTL, 0, CTL_ZERO_BYTES, stream) != hipSuccess) return;
    Args a{};
    for (int i = 0; i < 27; ++i) a.in[i] = (const float*)d_in[i];
    a.out = (float*)d_out; a.ws = (unsigned char*)d_ws;
#ifndef MK_SPLIT
    a.ph_lo = 0; a.ph_hi = 1000;
    hipLaunchKernelGGL(hybrid_fwd, dim3(NWG), dim3(NTHR), LDS_BYTES, stream, a);
#else
    for (int p = 0; p < 40; ++p) { a.ph_lo = p; a.ph_hi = p + 1; hipLaunchKernelGGL(hybrid_fwd, dim3(NWG), dim3(NTHR), LDS_BYTES, stream, a); }
#endif
}
```

```cpp
#define FFN_DOWN_FP8 1
#include <hip/hip_runtime.h>
#include <cstdio>
#include <cstdint>

#define GAS __attribute__((address_space(1)))
#define LAS __attribute__((address_space(3)))
typedef unsigned short bf16_t;
typedef short bf16x8 __attribute__((ext_vector_type(8)));
typedef short s16x4 __attribute__((ext_vector_type(4)));
typedef float f32x4 __attribute__((ext_vector_type(4)));
typedef float f32x2 __attribute__((ext_vector_type(2)));
typedef unsigned u32x4 __attribute__((ext_vector_type(4)));
typedef unsigned u32x2 __attribute__((ext_vector_type(2)));
typedef __bf16 bf16x2_t __attribute__((ext_vector_type(2)));

__device__ __forceinline__ unsigned pk2(float lo, float hi) { f32x2 v = {lo, hi}; bf16x2_t b = __builtin_convertvector(v, bf16x2_t); return __builtin_bit_cast(unsigned, b); }
__device__ __forceinline__ float bflo(unsigned w) { return __builtin_bit_cast(float, w << 16); }
__device__ __forceinline__ float bfhi(unsigned w) { return __builtin_bit_cast(float, w & 0xffff0000u); }
__device__ __forceinline__ float bf1(bf16_t h) { return __builtin_bit_cast(float, ((unsigned)h) << 16); }
__device__ __forceinline__ bf16_t f2bf(float f) { return (bf16_t)(pk2(f, 0.f) & 0xffffu); }
__device__ __forceinline__ float fast_exp(float x) { return __builtin_amdgcn_exp2f(x * 1.4426950408889634f); }
__device__ __forceinline__ float sigmoidf_(float x) { return __builtin_amdgcn_rcpf(1.0f + fast_exp(-x)); }
__device__ __forceinline__ float siluf_(float x) { return x * sigmoidf_(x); }
typedef int i32x8 __attribute__((ext_vector_type(8)));
__device__ __forceinline__ unsigned pk4_fp8(float a, float b, float c, float d) { int w; asm("" : "=v"(w)); w = __builtin_amdgcn_cvt_pk_fp8_f32(a, b, w, false); w = __builtin_amdgcn_cvt_pk_fp8_f32(c, d, w, true); return (unsigned)w; }
constexpr float W8_SCALE = 32.0f, W8_INV = 1.0f / 32.0f, H8_SCALE = 4.0f, H8_INV = 0.25f;

namespace pg8 {
constexpr int BM = 256, BK = 64, HALF = 128, HTB = HALF * BK * 2  , STAGE_BYTES = 8 * HTB, NXCD = 8, WGM = 8;

__host__ __device__ __forceinline__ int lds_byte(int r, int c) { const int st = (r >> 4) * 2 + (c >> 5), rr = r & 15, cc = c & 31, ob = rr * 64 + cc * 2; return st * 1024 + (ob ^ (((ob >> 9) & 1) << 5)); }
__host__ __device__ __forceinline__ void stage_rc(int b, int& R, int& C) { const int st = b / 1024, sb = b % 1024, swz = sb ^ (((sb >> 9) & 1) << 5); R = (st >> 1) * 16 + swz / 64; C = (st & 1) * 32 + (swz % 64) / 2; }
__host__ __device__ __forceinline__ int perm32(int rho) { const int n = rho >> 4, i = rho & 15; return 8 * (i >> 2) + 4 * n + (i & 3); }

struct Unit { int pm, pn, e; };
struct Gemm { const bf16_t* A; const bf16_t* Bt; int lda, ldb, K; size_t estride; };

struct StaticOrder {
    int nM, nN, nwg, G, c;
    __device__ void init(int M, int N, int G_, int c_) { nM = M / BM; nN = N / BM; nwg = nM * nN; G = G_; c = c_; }
    __device__ bool next(int i, Unit& u) const {
        const long L = (long)i * G + c; if (L >= nwg) return false;
        int wgid = (int)L; { const int q = nwg / NXCD, r = nwg % NXCD, xcd = wgid % NXCD, off = wgid / NXCD; wgid = (xcd < r ? xcd * (q + 1) : r * (q + 1) + (xcd - r) * q) + off; }
        const int nig = WGM * nN, gid = wgid / nig, fm = gid * WGM, gsz = (nM - fm) < WGM ? (nM - fm) : WGM;
        u.pm = fm + ((wgid % nig) % gsz); u.pn = (wgid % nig) / gsz; u.e = 0; return true;
    }
};
struct MoeOrder {
    int rt0, nrt, nN, G, c; const LAS int* tab;
    __device__ bool next(int i, Unit& u) const {
        const int nwg = nrt * nN; const long L = (long)i * G + c; if (L >= nwg) return false;
        int wgid = (int)L; { const int q = nwg / NXCD, r = nwg % NXCD, xcd = wgid % NXCD, off = wgid / NXCD; wgid = (xcd < r ? xcd * (q + 1) : r * (q + 1) + (xcd - r) * q) + off; }
        const int nig = WGM * nN, gid = wgid / nig, fm = gid * WGM, gsz = (nrt - fm) < WGM ? (nrt - fm) : WGM;
        u.pm = rt0 + fm + ((wgid % nig) % gsz); u.pn = (wgid % nig) / gsz; u.e = tab[u.pm]; return true;
    }
};

struct MoeOrderGU {
    int rtb, rtc, nN, G, c, L0, Lend; const LAS int* tab;
    __device__ bool next(int i, Unit& u) const {
        const int L = L0 + i * G + c; if (L >= Lend || c < 0) return false;
        const int n0 = rtb * nN; int j, nrt, rt0; if (L < n0) { j = L; nrt = rtb; rt0 = 0; } else { j = L - n0; nrt = rtc - rtb; rt0 = rtb; }
        const int nwg = nrt * nN; { const int q = nwg / NXCD, r = nwg % NXCD, xcd = j % NXCD, off = j / NXCD; j = (xcd < r ? xcd * (q + 1) : r * (q + 1) + (xcd - r) * q) + off; }
        const int nig = WGM * nN, gid = j / nig, fm = gid * WGM, gsz = (nrt - fm) < WGM ? (nrt - fm) : WGM;
        u.pm = rt0 + fm + ((j % nig) % gsz); u.pn = (j % nig) / gsz; u.e = tab[u.pm]; return true;
    }
};


__device__ __forceinline__ float epi_shfl(float v, int src) { return __builtin_bit_cast(float, __builtin_amdgcn_ds_bpermute(src << 2, __builtin_bit_cast(int, v))); }
constexpr float RMS_EPS = 1e-6f, INV_D = 1.0f / 2048.0f, SSQ_SCALE = 16777216.0f, SSQ_INV = INV_D / 16777216.0f;
typedef unsigned long long ssq_t;
__device__ __forceinline__ float ssq_rstd(const ssq_t* p, int row) { return __builtin_amdgcn_rsqf((float)p[row] * SSQ_INV + RMS_EPS); }
__device__ __forceinline__ void ssq_add(ssq_t* p, int row, float q) { __hip_atomic_fetch_add(p + row, (ssq_t)(q * SSQ_SCALE + 0.5f), __ATOMIC_RELAXED, __HIP_MEMORY_SCOPE_AGENT); }
struct EpiBf16 {
    static constexpr bool PERM = true;
    bf16_t* O; int ldc; const ssq_t* ssq; float wscale; LAS float* cch; volatile LAS unsigned* ctag; unsigned tagbase;
    __device__ __forceinline__ void operator()(const f32x4 (&acc)[2][2][4][2], const Unit& u, int wr, int wc, int fr, int fq) const {
        const int row0 = u.pm * BM + wr * 64 + fr, col0 = u.pn * BM + wc * 32 + 8 * fq;
        float sv[2][4];
        if (cch && ssq) { const int wid = wr * 4 + wc; LAS float* my = cch + wid * 256;
            const unsigned tg = (unsigned)__builtin_amdgcn_readfirstlane((int)ctag[wid]), want = tagbase + (unsigned)(u.pm + 1);
            if (tg != want) {
#pragma unroll
                for (int ai = 0; ai < 2; ++ai)
#pragma unroll
                    for (int m = 0; m < 4; ++m) { const float r = ssq_rstd(ssq, row0 + ai * HALF + m * 16); if (fq == 0) my[(ai * 4 + m) * 16 + fr] = r; }
                if (fq == 0 && fr == 0) ctag[wid] = want; }
#pragma unroll
            for (int ai = 0; ai < 2; ++ai)
#pragma unroll
                for (int m = 0; m < 4; ++m) sv[ai][m] = my[(ai * 4 + m) * 16 + fr]; }
        else {
#pragma unroll
            for (int ai = 0; ai < 2; ++ai)
#pragma unroll
                for (int m = 0; m < 4; ++m) sv[ai][m] = ssq ? ssq_rstd(ssq, row0 + ai * HALF + m * 16) : 1.0f; }
#pragma unroll
        for (int ai = 0; ai < 2; ++ai)
#pragma unroll
            for (int m = 0; m < 4; ++m) { const int row = row0 + ai * HALF + m * 16; const float s = sv[ai][m] * wscale;
                bf16_t* rowp = O + (size_t)row * ldc + col0;
#pragma unroll
                for (int bj = 0; bj < 2; ++bj) { const f32x4 v0 = acc[ai][bj][m][0] * s, v1 = acc[ai][bj][m][1] * s;
                    u32x4 w; w.x = pk2(v0[0], v0[1]); w.y = pk2(v0[2], v0[3]); w.z = pk2(v1[0], v1[1]); w.w = pk2(v1[2], v1[3]);
                    *(u32x4*)(rowp + bj * HALF) = w; } }
    }
};
template <bool OUT8> struct EpiSwiGLU {
    static constexpr bool PERM = true;
    bf16_t* H; int ldc; const float* wgt; int rt0; const ssq_t* ssq; const float* rs; float wscale;
    LAS float* cch; volatile LAS unsigned* ctag;
    __device__ __forceinline__ void operator()(const f32x4 (&acc)[2][2][4][2], const Unit& u, int wr, int wc, int fr, int fq) const {
        const int row0 = u.pm * BM + wr * 64 + fr, col0 = u.pn * HALF + wc * 32 + 8 * fq;
        float sv[2][4], rv[2][4];
        if (cch) { const int wid = wr * 4 + wc; LAS f32x2* my = (LAS f32x2*)(cch + wid * 256);
            const unsigned tg = (unsigned)__builtin_amdgcn_readfirstlane((int)ctag[wid]);
            if (tg != (unsigned)(u.pm + 1)) {
#pragma unroll
                for (int ai = 0; ai < 2; ++ai)
#pragma unroll
                    for (int m = 0; m < 4; ++m) { const int row = row0 + ai * HALF + m * 16; const f32x2 pr = {wgt[row], rs[row]}; if (fq == 0) my[(ai * 4 + m) * 16 + fr] = pr; }
                if (fq == 0 && fr == 0) ctag[wid] = (unsigned)(u.pm + 1); }
#pragma unroll
            for (int ai = 0; ai < 2; ++ai)
#pragma unroll
                for (int m = 0; m < 4; ++m) { const f32x2 pr = my[(ai * 4 + m) * 16 + fr]; sv[ai][m] = pr.x; rv[ai][m] = pr.y; } }
        else {
#pragma unroll
            for (int ai = 0; ai < 2; ++ai)
#pragma unroll
                for (int m = 0; m < 4; ++m) { const int row = row0 + ai * HALF + m * 16; sv[ai][m] = wgt ? wgt[row] : 1.0f; rv[ai][m] = rs ? rs[row] : ssq_rstd(ssq, row); } }
#pragma unroll
        for (int ai = 0; ai < 2; ++ai)
#pragma unroll
            for (int m = 0; m < 4; ++m) { const int row = row0 + ai * HALF + m * 16; const float s = sv[ai][m]; const float rn = rv[ai][m] * wscale;
                const float kn = rn * -1.4426950408889634f, ku = rn * s * (OUT8 ? H8_SCALE : 1.0f);
                const f32x2 rn2 = {rn, rn}, kn2 = {kn, kn}, ku2 = {ku, ku};
                f32x2 o[4];
#pragma unroll
                for (int n = 0; n < 2; ++n)
#pragma unroll
                    for (int h = 0; h < 2; ++h) { const f32x2 g = {acc[ai][0][m][n][2 * h], acc[ai][0][m][n][2 * h + 1]}, uu = {acc[ai][1][m][n][2 * h], acc[ai][1][m][n][2 * h + 1]};
                        const f32x2 t = g * kn2; f32x2 e; e.x = __builtin_amdgcn_exp2f(t.x); e.y = __builtin_amdgcn_exp2f(t.y);
                        const f32x2 d = e + 1.0f; f32x2 r; r.x = __builtin_amdgcn_rcpf(d.x); r.y = __builtin_amdgcn_rcpf(d.y);
                        o[2 * n + h] = ((g * rn2) * r) * (uu * ku2); }
                if constexpr (OUT8) { u32x2 b; b.x = pk4_fp8(o[0].x, o[0].y, o[1].x, o[1].y); b.y = pk4_fp8(o[2].x, o[2].y, o[3].x, o[3].y);
                    *(u32x2*)((unsigned char*)H + (size_t)(row - rt0 * BM) * ldc + col0) = b; }
                else { u32x4 w; w.x = pk2(o[0].x, o[0].y); w.y = pk2(o[1].x, o[1].y); w.z = pk2(o[2].x, o[2].y); w.w = pk2(o[3].x, o[3].y);
                    *(u32x4*)(H + (size_t)(row - rt0 * BM) * ldc + col0) = w; } }
    }
};
__device__ __forceinline__ void unpack8(const u32x4 w, float (&f)[8]) { f[0] = bflo(w.x); f[1] = bfhi(w.x); f[2] = bflo(w.y); f[3] = bfhi(w.y); f[4] = bflo(w.z); f[5] = bfhi(w.z); f[6] = bflo(w.w); f[7] = bfhi(w.w); }
__device__ __forceinline__ float store_row8(bf16_t* XSo, unsigned char* X8, size_t off, const float (&x)[8]) {
    u32x4 w; w.x = pk2(x[0], x[1]); w.y = pk2(x[2], x[3]); w.z = pk2(x[4], x[5]); w.w = pk2(x[6], x[7]); *(u32x4*)(XSo + off) = w;
    if (X8) { u32x2 b; b.x = pk4_fp8(x[0], x[1], x[2], x[3]); b.y = pk4_fp8(x[4], x[5], x[6], x[7]); *(u32x2*)(X8 + off) = b; }
    float r[8]; unpack8(w, r); return ((r[0] * r[0] + r[1] * r[1]) + (r[2] * r[2] + r[3] * r[3])) + ((r[4] * r[4] + r[5] * r[5]) + (r[6] * r[6] + r[7] * r[7]));
}
struct EpiResidualStat {
    static constexpr bool PERM = true;
    const bf16_t* XSi; bf16_t* XSo; unsigned char* X8; ssq_t* ssq; int ldc; float alpha;
    __device__ __forceinline__ void operator()(const f32x4 (&acc)[2][2][4][2], const Unit& u, int wr, int wc, int fr, int fq) const {
        const int row0 = u.pm * BM + wr * 64 + fr, col0 = u.pn * BM + wc * 32 + 8 * fq, lane = fq * 16 + fr;
#pragma unroll
        for (int ai = 0; ai < 2; ++ai) {
            u32x4 xi[4][2]; float q[4];
#pragma unroll
            for (int m = 0; m < 4; ++m)
#pragma unroll
                for (int bj = 0; bj < 2; ++bj) xi[m][bj] = *(const u32x4*)(XSi + (size_t)(row0 + ai * HALF + m * 16) * ldc + col0 + bj * HALF);
#pragma unroll
            for (int m = 0; m < 4; ++m) { const size_t off = (size_t)(row0 + ai * HALF + m * 16) * ldc + col0; q[m] = 0.f;
#pragma unroll
                for (int bj = 0; bj < 2; ++bj) { float x[8]; unpack8(xi[m][bj], x);
#pragma unroll
                    for (int j = 0; j < 4; ++j) { x[j] += acc[ai][bj][m][0][j] * alpha; x[4 + j] += acc[ai][bj][m][1][j] * alpha; }
                    q[m] += store_row8(XSo, X8, off + bj * HALF, x); } }
#pragma unroll
            for (int m = 0; m < 4; ++m) { q[m] += epi_shfl(q[m], lane ^ 16); q[m] += epi_shfl(q[m], lane ^ 32); }
            if (fq == 0 && ssq) {
#pragma unroll
                for (int m = 0; m < 4; ++m) ssq_add(ssq, row0 + ai * HALF + m * 16, q[m]); }
        }
    }
};
template <bool STAT> struct EpiScatter {
    static constexpr bool PERM = true;
    bf16_t* XS; int ldc; const int* tok; unsigned char* X8; ssq_t* ssq; float alpha;
    __device__ __forceinline__ void operator()(const f32x4 (&acc)[2][2][4][2], const Unit& u, int wr, int wc, int fr, int fq) const {
        const int row0 = u.pm * BM + wr * 64 + fr, col0 = u.pn * BM + wc * 32 + 8 * fq, lane = fq * 16 + fr;
        int tk[2][4];
#pragma unroll
        for (int ai = 0; ai < 2; ++ai)
#pragma unroll
            for (int m = 0; m < 4; ++m) tk[ai][m] = tok[row0 + ai * HALF + m * 16];
#pragma unroll
        for (int ai = 0; ai < 2; ++ai) {
            u32x4 xi[4][2]; float q[4];
#pragma unroll
            for (int m = 0; m < 4; ++m) { const int t = tk[ai][m] >= 0 ? tk[ai][m] : 0;
#pragma unroll
                for (int bj = 0; bj < 2; ++bj) xi[m][bj] = *(const u32x4*)(XS + (size_t)t * ldc + col0 + bj * HALF); }
#pragma unroll
            for (int m = 0; m < 4; ++m) { const int t = tk[ai][m]; q[m] = 0.f;
                if (t >= 0) { const size_t off = (size_t)t * ldc + col0;
#pragma unroll
                    for (int bj = 0; bj < 2; ++bj) { float x[8]; unpack8(xi[m][bj], x);
#pragma unroll
                        for (int j = 0; j < 4; ++j) { x[j] += acc[ai][bj][m][0][j] * alpha; x[4 + j] += acc[ai][bj][m][1][j] * alpha; }
                        q[m] += store_row8(XS, STAT ? X8 : nullptr, off + bj * HALF, x); } } }
            if (STAT) {
#pragma unroll
                for (int m = 0; m < 4; ++m) { q[m] += epi_shfl(q[m], lane ^ 16); q[m] += epi_shfl(q[m], lane ^ 32); }
                if (fq == 0) {
#pragma unroll
                    for (int m = 0; m < 4; ++m) if (tk[ai][m] >= 0) ssq_add(ssq, tk[ai][m], q[m]); } }
        }
    }
};
struct EpiPleGate {
    static constexpr bool PERM = true;
    const bf16_t* XSi; bf16_t* XSo; const bf16_t* PPB; int ldc; const ssq_t* ssq_in; ssq_t* ssq_out; float wscale; unsigned char* X8o;
    __device__ __forceinline__ void operator()(const f32x4 (&acc)[2][2][4][2], const Unit& u, int wr, int wc, int fr, int fq) const {
        const int row0 = u.pm * BM + wr * 64 + fr, col0 = u.pn * BM + wc * 32 + 8 * fq, lane = fq * 16 + fr;
#pragma unroll
        for (int ai = 0; ai < 2; ++ai) {
            u32x4 xi[4][2], pp[4][2]; float q[4], rn[4];
#pragma unroll
            for (int m = 0; m < 4; ++m) { rn[m] = ssq_rstd(ssq_in, row0 + ai * HALF + m * 16) * wscale;
#pragma unroll
                for (int bj = 0; bj < 2; ++bj) { const size_t o = (size_t)(row0 + ai * HALF + m * 16) * ldc + col0 + bj * HALF; xi[m][bj] = *(const u32x4*)(XSi + o); pp[m][bj] = *(const u32x4*)(PPB + o); } }
#pragma unroll
            for (int m = 0; m < 4; ++m) { const size_t off = (size_t)(row0 + ai * HALF + m * 16) * ldc + col0; q[m] = 0.f;
#pragma unroll
                for (int bj = 0; bj < 2; ++bj) { float x[8], p[8]; unpack8(xi[m][bj], x); unpack8(pp[m][bj], p);
                    const float kn = rn[m] * -1.4426950408889634f; const f32x2 kn2 = {kn, kn};
#pragma unroll
                    for (int n = 0; n < 2; ++n)
#pragma unroll
                        for (int h = 0; h < 2; ++h) { const f32x2 a = {acc[ai][bj][m][n][2 * h], acc[ai][bj][m][n][2 * h + 1]}; const f32x2 t = a * kn2;
                            f32x2 e; e.x = __builtin_amdgcn_exp2f(t.x); e.y = __builtin_amdgcn_exp2f(t.y); const f32x2 d = e + 1.0f; f32x2 r; r.x = __builtin_amdgcn_rcpf(d.x); r.y = __builtin_amdgcn_rcpf(d.y);
                            const f32x2 pv = {p[4 * n + 2 * h], p[4 * n + 2 * h + 1]}, xv = {x[4 * n + 2 * h], x[4 * n + 2 * h + 1]}; const f32x2 o = pv * r + xv; x[4 * n + 2 * h] = o.x; x[4 * n + 2 * h + 1] = o.y; }
                    q[m] += store_row8(XSo, X8o, off + bj * HALF, x); } }
#pragma unroll
            for (int m = 0; m < 4; ++m) { q[m] += epi_shfl(q[m], lane ^ 16); q[m] += epi_shfl(q[m], lane ^ 32); }
            if (fq == 0) {
#pragma unroll
                for (int m = 0; m < 4; ++m) ssq_add(ssq_out, row0 + ai * HALF + m * 16, q[m]); }
        }
    }
};

template <class Epi, class Sched, bool ALIGN_EPI, bool FP8 = false>
__device__ __forceinline__ void gemm_phase(LAS unsigned char* lds, const Gemm g, const Sched& S, const Epi& E, int tid_in) {
    int tid_ = tid_in; asm volatile("" : "+v"(tid_));
    const int tid = tid_, wid = __builtin_amdgcn_readfirstlane(tid >> 6), lane = tid & 63, wr = wid >> 2, wc = wid & 3, fr = lane & 15, fq = lane >> 4;
    const int K = g.K, nt = K / BK;
    unsigned voffA[2], voffB[2];
#pragma unroll
    for (int i = 0; i < 2; ++i) { int R, C; stage_rc(tid * 16 + i * 8192, R, C); const int Rb = Epi::PERM ? ((R & ~31) + perm32(R & 31)) : R;
        voffA[i] = (unsigned)(R * g.lda + C) * 2u; voffB[i] = (unsigned)(Rb * g.ldb + C) * 2u; }
    const __amdgpu_buffer_rsrc_t rA = __builtin_amdgcn_make_buffer_rsrc((void*)g.A, 0, 0xffffffff, 0x00020000), rB = __builtin_amdgcn_make_buffer_rsrc((void*)g.Bt, 0, 0xffffffff, 0x00020000);
    const unsigned kstep = (unsigned)(BK * 2);
    const unsigned hstepA = (unsigned)HALF * g.lda * 2u, hstepB = (unsigned)HALF * g.ldb * 2u;
    const unsigned tstepA = 2u * hstepA, tstepB = 2u * hstepB, estepB = (unsigned)(g.estride * 2);
    const unsigned ldsw = (unsigned)wid * 1024u;
    const int aoff = lds_byte(wr * 64 + fr, fq * 8), boff = lds_byte(wc * 32 + fr, fq * 8);
#define PG8_SA(b, h) (((b) * 2 + (h)) * HTB)
#define PG8_SB(b, h) ((4 + (b) * 2 + (h)) * HTB)
#define PG8_STAGE(bufoff, rs, soff, voff) do { _Pragma("unroll") for (int _i = 0; _i < 2; ++_i) \
        __builtin_amdgcn_raw_ptr_buffer_load_lds((rs), (LAS unsigned*)(lds + (bufoff) + ldsw + _i * 8192), 16, (voff)[_i], (soff), 0, 0); } while (0)
#define PG8_LD8(base) __builtin_bit_cast(i32x8, __builtin_shufflevector(*(const LAS u32x4*)(base), *(const LAS u32x4*)((base) + 1024), 0, 1, 2, 3, 4, 5, 6, 7))
#define PG8_LDA(dst, b, h) do { if constexpr (FP8) { _Pragma("unroll") for (int m = 0; m < 4; ++m) dst##8[m] = PG8_LD8(lds + PG8_SA(b, h) + aoff + m * 2048); } \
        else { _Pragma("unroll") for (int m = 0; m < 4; ++m) _Pragma("unroll") for (int k = 0; k < 2; ++k) dst[m][k] = *(const LAS bf16x8*)(lds + PG8_SA(b, h) + aoff + m * 2048 + k * 1024); } } while (0)
#define PG8_LDB(dst, b, h) do { if constexpr (FP8) { _Pragma("unroll") for (int n = 0; n < 2; ++n) dst##8[n] = PG8_LD8(lds + PG8_SB(b, h) + boff + n * 2048); } \
        else { _Pragma("unroll") for (int n = 0; n < 2; ++n) _Pragma("unroll") for (int k = 0; k < 2; ++k) dst[n][k] = *(const LAS bf16x8*)(lds + PG8_SB(b, h) + boff + n * 2048 + k * 1024); } } while (0)
#define PG8_MMA(ai, bj, At, Bt) do { __builtin_amdgcn_s_setprio(1); \
        if constexpr (FP8) { _Pragma("unroll") for (int m = 0; m < 4; ++m) _Pragma("unroll") for (int n = 0; n < 2; ++n) \
            acc[ai][bj][m][n] = __builtin_amdgcn_mfma_scale_f32_16x16x128_f8f6f4(Bt##8[n], At##8[m], acc[ai][bj][m][n], 0, 0, 0, 0x7f7f7f7f, 0, 0x7f7f7f7f); } \
        else { _Pragma("unroll") for (int m = 0; m < 4; ++m) _Pragma("unroll") for (int n = 0; n < 2; ++n) _Pragma("unroll") for (int k = 0; k < 2; ++k) \
            acc[ai][bj][m][n] = __builtin_amdgcn_mfma_f32_16x16x32_bf16(Bt[n][k], At[m][k], acc[ai][bj][m][n], 0, 0, 0); } \
        __builtin_amdgcn_s_setprio(0); } while (0)
#define PG8_WAIT_V(n) asm volatile("s_waitcnt vmcnt(" #n ")" ::: "memory")
#define PG8_WAIT_L(n) asm volatile("s_waitcnt lgkmcnt(" #n ")" ::: "memory")
#define PG8_BAR __builtin_amdgcn_s_barrier()
#define PG8_SCHED __builtin_amdgcn_sched_barrier(0)
    Unit cur, nxt; int ui = 0;
    if (!S.next(0, cur)) return;
    f32x4 acc[2][2][4][2];
    int zi_ = 0; asm volatile("" : "+s"(zi_)); const float zf_ = __builtin_bit_cast(float, zi_);
#pragma unroll
    for (int a = 0; a < 2; ++a)
#pragma unroll
        for (int b = 0; b < 2; ++b)
#pragma unroll
            for (int m = 0; m < 4; ++m)
#pragma unroll
                for (int n = 0; n < 2; ++n) acc[a][b][m][n] = (f32x4){zf_, zf_, zf_, zf_};
    bf16x8 At[4][2], B0[2][2], B1[2][2];
    i32x8 At8[4], B08[2], B18[2];
    unsigned cA = (unsigned)cur.pm * tstepA, cB = (unsigned)cur.e * estepB + (unsigned)cur.pn * tstepB;
    PG8_STAGE(PG8_SB(0, 0), rB, cB, voffB); PG8_STAGE(PG8_SB(0, 1), rB, cB + hstepB, voffB); PG8_STAGE(PG8_SA(0, 0), rA, cA, voffA); PG8_STAGE(PG8_SA(0, 1), rA, cA + hstepA, voffA);
    if (wr == 1) PG8_BAR;
    PG8_WAIT_V(2); PG8_BAR;
    PG8_STAGE(PG8_SB(1, 0), rB, cB + kstep, voffB); PG8_STAGE(PG8_SA(1, 0), rA, cA + kstep, voffA); PG8_STAGE(PG8_SB(1, 1), rB, cB + hstepB + kstep, voffB);
    PG8_WAIT_V(6); PG8_BAR;
    for (;;) {
        const bool has_next = S.next(ui + 1, nxt);
        const unsigned nA = has_next ? (unsigned)nxt.pm * tstepA : cA, nB = has_next ? (unsigned)nxt.e * estepB + (unsigned)nxt.pn * tstepB : cB;
        asm volatile(".p2align 8" ::: "memory");
        for (int t = 0; t < nt; t += 2) {
            const bool last = (t == nt - 2);
            const unsigned a1 = cA + (unsigned)(t + 1) * kstep;
            const unsigned a2 = last ? nA : cA + (unsigned)(t + 2) * kstep, b2 = last ? nB : cB + (unsigned)(t + 2) * kstep;
            const unsigned a3 = a2 + kstep, b3 = b2 + kstep;
            PG8_LDB(B0, 0, 0); PG8_LDB(B1, 0, 1); PG8_SCHED; PG8_LDA(At, 0, 0); PG8_STAGE(PG8_SA(1, 1), rA, a1 + hstepA, voffA);
            PG8_WAIT_V(8); PG8_WAIT_L(0); PG8_BAR; PG8_MMA(0, 0, At, B0); PG8_MMA(0, 1, At, B1); PG8_BAR; PG8_SCHED;
            PG8_LDA(At, 0, 1); PG8_STAGE(PG8_SB(0, 0), rB, b2, voffB); PG8_STAGE(PG8_SB(0, 1), rB, b2 + hstepB, voffB); PG8_STAGE(PG8_SA(0, 0), rA, a2, voffA);
            PG8_WAIT_V(8); PG8_WAIT_L(0); PG8_BAR; PG8_MMA(1, 0, At, B0); PG8_MMA(1, 1, At, B1); PG8_BAR; PG8_SCHED;
            PG8_LDB(B0, 1, 0); PG8_LDB(B1, 1, 1); PG8_SCHED; PG8_LDA(At, 1, 0); PG8_STAGE(PG8_SA(0, 1), rA, a2 + hstepA, voffA);
            PG8_WAIT_V(8); PG8_WAIT_L(0); PG8_BAR; PG8_MMA(0, 0, At, B0); PG8_MMA(0, 1, At, B1); PG8_BAR; PG8_SCHED;
            PG8_LDA(At, 1, 1); PG8_STAGE(PG8_SB(1, 0), rB, b3, voffB); PG8_STAGE(PG8_SB(1, 1), rB, b3 + hstepB, voffB); PG8_STAGE(PG8_SA(1, 0), rA, a3, voffA);
            PG8_WAIT_V(8); PG8_WAIT_L(0); PG8_BAR; PG8_MMA(1, 0, At, B0); PG8_MMA(1, 1, At, B1); PG8_BAR; PG8_SCHED;
        }
        if constexpr (ALIGN_EPI) { if (wr == 0) PG8_BAR; }
        { unsigned z_ = 0u; asm volatile("" : "+s"(z_)); const int l2 = (int)__builtin_amdgcn_mbcnt_hi(~0u, __builtin_amdgcn_mbcnt_lo(~0u, z_)); E(acc, cur, wr, wc, l2 & 15, l2 >> 4); }
        if (!has_next) break;
#pragma unroll
        for (int a = 0; a < 2; ++a)
#pragma unroll
            for (int b = 0; b < 2; ++b)
#pragma unroll
                for (int m = 0; m < 4; ++m)
#pragma unroll
                    for (int n = 0; n < 2; ++n) acc[a][b][m][n] = (f32x4){zf_, zf_, zf_, zf_};
        cur = nxt; cA = nA; cB = nB; ++ui;
        if constexpr (ALIGN_EPI) { if (wr == 1) PG8_BAR; }
    }
    PG8_WAIT_V(0);
    if constexpr (!ALIGN_EPI) { if (wr == 0) PG8_BAR; }
    PG8_BAR;
#undef PG8_SA
#undef PG8_SB
#undef PG8_STAGE
#undef PG8_LDA
#undef PG8_LDB
#undef PG8_MMA
#undef PG8_LD8
#undef PG8_WAIT_V
#undef PG8_WAIT_L
#undef PG8_BAR
#undef PG8_SCHED
}
}
constexpr int NB = 16, SEQ = 2048, T = NB * SEQ, D = 2048, DEPTH = 2;
constexpr int DPROJ_SRC = 6168, NU = 6400;
constexpr int DFF = 5632, NEXP = 8, DFFE = 7168, PLE = 256;
constexpr float EPS = 1e-6f;
constexpr int UQ = 0, UK = 512, UV = 1024, UO = 1536, UZ = 2048, UXBC = 3072, UAQ = 4608, UAK = 5120, UAV = 5632, UMI = 6144, UMF = 6148, UDT = 6152;
constexpr int MIXM = 0, MIXS = 512, MIXA = 1536;
constexpr int NWAVES = 8, NTHR = 512, NWG = 256;

constexpr size_t MiB = 1u << 20;
constexpr size_t WS_CTL = 0, CTL_ZERO_BYTES = 3 * MiB;
constexpr size_t WS_SSQ = 1 * MiB;
constexpr size_t WS_WIN = 4 * MiB;
constexpr size_t WS_WOUT = WS_WIN + 50 * MiB;
constexpr size_t WS_FGU = WS_WOUT + 16 * MiB;
constexpr size_t WS_FD = WS_FGU + 44 * MiB;
constexpr size_t WS_MGU = WS_FD + 22 * MiB;
constexpr size_t WS_MD = WS_MGU + 448 * MiB;
constexpr size_t WS_PG = WS_MD + 224 * MiB;
constexpr size_t WS_PP = WS_PG + 16 * MiB;
constexpr size_t WS_XN = WS_PP + 2 * MiB;
constexpr size_t WS_P16 = WS_XN + 128 * MiB;
constexpr size_t WS_R = WS_P16 + 32 * MiB;
constexpr size_t WS_U = WS_R;
constexpr size_t WS_MIX = WS_R + 400 * MiB;
constexpr size_t WS_CV = WS_R + 528 * MiB;
constexpr size_t WS_H = WS_R;
constexpr size_t WS_PPB0 = WS_R + 352 * MiB, WS_PPB1 = WS_R;
constexpr size_t WS_XG = WS_R;
constexpr size_t WS_HM = WS_R + 272 * MiB;
constexpr size_t WS_MISC = WS_R + 748 * MiB;
constexpr size_t WS_SSQM = WS_MISC;
constexpr size_t WS_SSQS = WS_SSQM + 4 * MiB;
constexpr size_t WS_KMEAN = WS_SSQS + 2 * MiB;
constexpr size_t WS_ROUTE = WS_KMEAN + 1 * MiB;
constexpr size_t WS_TOK = WS_ROUTE + 1 * MiB;
constexpr size_t WS_WGT = WS_TOK + 1 * MiB;
constexpr size_t WS_WGCNT = WS_WGT + 1 * MiB;
constexpr size_t WS_XBB = WS_WGCNT + 1 * MiB;
constexpr size_t WS_XA8 = WS_XBB + 128 * MiB;
constexpr size_t WS_END = WS_XA8 + 64 * MiB;
constexpr int MOE_ROWS = 69632, MOE_SLOT_ROWS = 34816;
constexpr int CW_TMO = 0, CW_BAR = 4096;

constexpr int RING_OFF = 0, RING_BYTES = 131072;
constexpr int LDSCTL_OFF = 139264;
constexpr int MISC_OFF = LDSCTL_OFF;
constexpr int LTAB_OFF = LDSCTL_OFF + 256;
constexpr int PTAB_OFF = LDSCTL_OFF + 6144;
constexpr int LDS_BYTES = 147456;

#define XB_TMO      128
#define XB_XCNT(j)  (256  + 64 * (j))
#define XB_XSUB(j)  (1280 + 64 * (j))
#define XB_XGEN(j)  (2304 + 64 * (j))
#define XB_TOP      3328
#define XB_TOPGEN   3392
#define XCD_BAR_WORDS 3456
#define XB_SPIN_CAP (1u << 18)

__device__ __forceinline__ unsigned xb_ld(unsigned* p)              { return __hip_atomic_load(p, __ATOMIC_RELAXED, __HIP_MEMORY_SCOPE_AGENT); }
__device__ __forceinline__ unsigned xb_add(unsigned* p, unsigned v) { return __hip_atomic_fetch_add(p, v, __ATOMIC_RELAXED, __HIP_MEMORY_SCOPE_AGENT); }
__device__ __forceinline__ unsigned xb_xcc_id() { return (unsigned)__builtin_amdgcn_s_getreg((3 << 11) | 20) & 0xFu; }
#define XB_SPIN(cond, bar) do { unsigned _sp = 0; while (cond) { __builtin_amdgcn_s_sleep(1); \
    if ((++_sp & 255u) == 0u) { if (xb_ld(&(bar)[XB_TMO])) break; if (_sp > XB_SPIN_CAP) { atomicAdd(&(bar)[XB_TMO], 1u); break; } } } } while (0)

struct XcdBarrier { unsigned* bar; unsigned x; volatile LAS unsigned* st; };

__device__ __forceinline__ XcdBarrier xcd_barrier_post(unsigned* bar, volatile LAS unsigned* st) {
    XcdBarrier b; b.bar = bar; b.x = xb_xcc_id(); b.st = st;
    if (threadIdx.x == 0) (void)xb_add(&bar[XB_XCNT(b.x)], 1u);
    return b;
}
__device__ __forceinline__ void xcd_barrier_complete(unsigned* bar, unsigned x, unsigned& nloc, unsigned& nx) {
    const unsigned G = NWG;
    unsigned sum, cnt, mine, sp = 0u;
    for (;;) {
        sum = 0u; cnt = 0u; mine = 0u;
#pragma unroll
        for (unsigned j = 0; j < 16; ++j) { const unsigned c = xb_ld(&bar[XB_XCNT(j)]); sum += c; cnt += (c > 0u) ? 1u : 0u; mine = (j == x) ? c : mine; }
        if (sum == G) break;
        __builtin_amdgcn_s_sleep(1);
        if ((++sp & 255u) == 0u) { if (xb_ld(&bar[XB_TMO])) break; if (sp > XB_SPIN_CAP) { atomicAdd(&bar[XB_TMO], 1u); break; } }
    }
    nloc = mine > 0u ? mine : 1u; nx = cnt > 0u ? cnt : 1u;
}
__device__ __forceinline__ void xcd_barrier(const XcdBarrier& b) {
    asm volatile("s_waitcnt vmcnt(0)" ::: "memory");
    __syncthreads();
    if (threadIdx.x == 0) {
        unsigned* bar = b.bar;
        __builtin_amdgcn_s_waitcnt(0);
        unsigned nloc = b.st[0], nx = b.st[1];
        if (nloc == 0u) { xcd_barrier_complete(bar, b.x, nloc, nx); b.st[0] = nloc; b.st[1] = nx; }
        const unsigned old = xb_add(&bar[XB_XSUB(b.x)], 1u);
        const unsigned gen = old / nloc;
        if (old + 1u == (gen + 1u) * nloc) {
            __builtin_amdgcn_fence(__ATOMIC_RELEASE, "agent");
            asm volatile("s_waitcnt vmcnt(0)" ::: "memory");
            const unsigned og = xb_add(&bar[XB_TOP], 1u);
            const unsigned tg = og / nx;
            if (og + 1u == (tg + 1u) * nx) xb_add(&bar[XB_TOPGEN], 1u);
            else XB_SPIN(xb_ld(&bar[XB_TOPGEN]) == tg, bar);
            __builtin_amdgcn_fence(__ATOMIC_ACQUIRE, "agent");
            xb_add(&bar[XB_XGEN(b.x)], 1u);
            asm volatile("s_waitcnt vmcnt(0)" ::: "memory");
        } else {
            XB_SPIN(xb_ld(&bar[XB_XGEN(b.x)]) == gen, bar);
            __builtin_amdgcn_fence(__ATOMIC_ACQUIRE, "agent");
            asm volatile("s_waitcnt vmcnt(0)" ::: "memory");
        }
    }
    __syncthreads();
}

struct Args {
    const float* in[27]; float* out; unsigned char* ws; int ph_lo, ph_hi;
};
struct Frame {
    LAS unsigned char* lds;
    int tid, lane, wave, vcu, bx;
    float zf; unsigned zu;
};
__device__ __forceinline__ float lshfl(float v, int src) { return __builtin_bit_cast(float, __builtin_amdgcn_ds_bpermute(src << 2, __builtin_bit_cast(int, v))); }
#define SHFL_XOR(v, o) lshfl((v), F.lane ^ (o))
#define SHFL_UP(v, o) lshfl((v), F.lane - (o))
#define SHFL_IDX(v, i) lshfl((v), (i))
__device__ __forceinline__ float wave_sum_l(float v, int lane) {
#pragma unroll
    for (int o = 1; o < 64; o <<= 1) v += lshfl(v, lane ^ o);
    return v;
}
#define wave_sum(v) wave_sum_l((v), F.lane)
#define WG_BAR() __syncthreads()
__device__ __forceinline__ void stagger(int cls, int ticks) {
    if (cls) { const unsigned long long tgt = __builtin_amdgcn_s_memrealtime() + (unsigned long long)(cls * ticks);
        while (__builtin_amdgcn_s_memrealtime() < tgt) __builtin_amdgcn_s_sleep(16); }
}
#ifdef USE_STAGGER
#define STAGGER(ticks) stagger((F.bx >> 3) & 3, (ticks))
#else
#define STAGGER(ticks) do {} while (0)
#endif
__device__ __forceinline__ unsigned char* ld_ptr(LAS unsigned char* lds, int i) {
    const unsigned long long v = ((const LAS unsigned long long*)(lds + PTAB_OFF))[i];
    const unsigned lo = __builtin_amdgcn_readfirstlane((unsigned)v), hi = __builtin_amdgcn_readfirstlane((unsigned)(v >> 32));
    return (unsigned char*)(__attribute__((address_space(1))) unsigned char*)(uintptr_t)(((unsigned long long)hi << 32) | lo);
}

constexpr int XP_SCR = 64 * 65 * 4;
template <bool F8 = false> __device__ __forceinline__ void xpose_item(const float* W, int ldsrc, int srccol4, int k0, bf16_t* WT, int K, int drow0, LAS float* scr, int lane, const float* gain, float zf = 0.f) {
    f32x4 v[16];
    const int r = lane >> 4, c4 = 4 * (lane & 15);
#pragma unroll
    for (int i = 0; i < 16; ++i) v[i] = (srccol4 >= 0) ? __builtin_nontemporal_load((const f32x4*)(W + (size_t)(k0 + 4 * i + r) * ldsrc + srccol4)) : (f32x4){zf, zf, zf, zf};
    if (gain) {
#pragma unroll
        for (int i = 0; i < 16; ++i) v[i] = v[i] * gain[k0 + 4 * i + r]; }
#pragma unroll
    for (int i = 0; i < 16; ++i) { LAS float* s = scr + (4 * i + r) * 65 + c4; s[0] = v[i].x; s[1] = v[i].y; s[2] = v[i].z; s[3] = v[i].w; }
    asm volatile("s_waitcnt lgkmcnt(0)" ::: "memory");
    const int c = lane & 7;
#pragma unroll
    for (int j = 0; j < 8; ++j) { const int n = (lane >> 3) + 8 * j; const LAS float* s = scr + (8 * c) * 65 + n;
        if constexpr (F8) { u32x2 o; o.x = pk4_fp8(s[0 * 65] * W8_SCALE, s[1 * 65] * W8_SCALE, s[2 * 65] * W8_SCALE, s[3 * 65] * W8_SCALE); o.y = pk4_fp8(s[4 * 65] * W8_SCALE, s[5 * 65] * W8_SCALE, s[6 * 65] * W8_SCALE, s[7 * 65] * W8_SCALE);
            __builtin_nontemporal_store(o, (u32x2*)((unsigned char*)WT + (size_t)(drow0 + n) * K + k0 + 8 * c)); }
        else { u32x4 o; o.x = pk2(s[0 * 65], s[1 * 65]); o.y = pk2(s[2 * 65], s[3 * 65]); o.z = pk2(s[4 * 65], s[5 * 65]); o.w = pk2(s[6 * 65], s[7 * 65]);
            __builtin_nontemporal_store(o, (u32x4*)(WT + (size_t)(drow0 + n) * K + k0 + 8 * c)); } }
    asm volatile("s_waitcnt lgkmcnt(0)" ::: "memory");
}
__device__ __forceinline__ int win_srccol(int d) {
    if (d < 2048) return d;
    if (d < 3072) return 2056 + (d - 2048);
    if (d < 4608) return 3080 + (d - 3072);
    if (d < 6144) return 4632 + (d - 4608);
    if (d < 6152) return 2048 + (d - 6144);
    if (d < 6168) return 4616 + (d - 6152);
    return -1;
}
template <bool F8 = false> __device__ __forceinline__ void xpose_plain(Frame& F, const float* W, int K, int N, bf16_t* WT, LAS float* scr, int gw, int NGW, const float* gain) {
    const int nblk = N / 64, items = (K / 64) * nblk;
    for (int it = gw; it < items; it += NGW) { const int kb = it / nblk, nb = it % nblk; xpose_item<F8>(W, N, nb * 64 + 4 * (F.lane & 15), kb * 64, WT, K, nb * 64, scr, F.lane, gain); }
}
__device__ __forceinline__ void xpose_gu(Frame& F, const float* Wg, const float* Wu, int K, int N, bf16_t* WT, LAS float* scr, int gw, int NGW, const float* gain) {
    const int nblk = 2 * N / 64, items = (K / 64) * nblk;
    for (int it = gw; it < items; it += NGW) { const int kb = it / nblk, nb = it % nblk; const int drow0 = nb * 64, tile = drow0 >> 8, within = drow0 & 255;
        const float* W = within < 128 ? Wg : Wu; const int sc = tile * 128 + (within & 127) + 4 * (F.lane & 15);
        xpose_item<true>(W, N, sc, kb * 64, WT, K, drow0, scr, F.lane, gain); }
}
__device__ __forceinline__ float load_row_ssq(Frame& F, const float* xrow, f32x4 (&v)[8]) {
    const f32x4* xr = (const f32x4*)xrow + F.lane; float s = 0.f;
#pragma unroll
    for (int j = 0; j < 8; ++j) { v[j] = xr[64 * j]; s += (v[j].x * v[j].x + v[j].y * v[j].y) + (v[j].z * v[j].z + v[j].w * v[j].w); }
    return wave_sum(s);
}
__device__ __forceinline__ float load_row16_ssq(Frame& F, const bf16_t* xrow, float (&v)[4][8]) {
    const u32x4* xr = (const u32x4*)xrow + F.lane; float s = 0.f;
#pragma unroll
    for (int j = 0; j < 4; ++j) { const u32x4 w = xr[64 * j]; v[j][0] = bflo(w.x); v[j][1] = bfhi(w.x); v[j][2] = bflo(w.y); v[j][3] = bfhi(w.y); v[j][4] = bflo(w.z); v[j][5] = bfhi(w.z); v[j][6] = bflo(w.w); v[j][7] = bfhi(w.w);
#pragma unroll
        for (int i = 0; i < 8; ++i) s += v[j][i] * v[j][i]; }
    return wave_sum(s);
}
typedef short v4i16_t __attribute__((ext_vector_type(4)));
__device__ __forceinline__ f32x4 mfma16(bf16x8 a, bf16x8 b, f32x4 c) { return __builtin_amdgcn_mfma_f32_16x16x32_bf16(a, b, c, 0, 0, 0); }
__device__ __forceinline__ s16x4 tr_read(const LAS unsigned char* p) { return __builtin_bit_cast(s16x4, __builtin_amdgcn_ds_read_tr16_b64_v4i16((LAS v4i16_t*)p)); }
__device__ __forceinline__ bf16x8 cat4(s16x4 a, s16x4 b) { return (bf16x8){a[0], a[1], a[2], a[3], b[0], b[1], b[2], b[3]}; }
__device__ __forceinline__ bf16x8 pack8f(const float (&v)[8]) { u32x4 w; w.x = pk2(v[0], v[1]); w.y = pk2(v[2], v[3]); w.z = pk2(v[4], v[5]); w.w = pk2(v[6], v[7]); return __builtin_bit_cast(bf16x8, w); }
__device__ __forceinline__ float softplusf_(float x) { return x > 20.f ? x : __logf(1.0f + __expf(x)); }
__device__ __forceinline__ float logsigmoidf_(float x) { return fminf(x, 0.f) - __logf(1.0f + __expf(-fabsf(x))); }

constexpr int SLD = 272;

constexpr int NCV = 2560;
#define CONV_LOAD(it_, arr) do { const int cg_ = (it_) % 320, tb_ = ((it_) / 320) & 127, b_ = (it_) / (320 * 128); \
        const int uc_ = cg_ < 128 ? 8 * cg_ : UXBC + (8 * cg_ - 1024); const bf16_t* up_ = U + ((size_t)b_ * SEQ + tb_ * 16) * NU + uc_; \
        if (tb_ > 0) { arr[0] = *(const u32x4*)(up_ - 3 * (ptrdiff_t)NU); arr[1] = *(const u32x4*)(up_ - 2 * (ptrdiff_t)NU); arr[2] = *(const u32x4*)(up_ - (ptrdiff_t)NU); } \
        else { arr[0] = (u32x4){F.zu, F.zu, F.zu, F.zu}; arr[1] = arr[0]; arr[2] = arr[0]; } \
        _Pragma("unroll") for (int t_ = 0; t_ < 16; ++t_) arr[3 + t_] = *(const u32x4*)(up_ + (size_t)t_ * NU); } while (0)
__device__ __forceinline__ void conv_phase(Frame& F, const bf16_t* __restrict__ U, bf16_t* __restrict__ CV, const float* __restrict__ mcw, const float* __restrict__ mcb, const float* __restrict__ scw, const float* __restrict__ scb) {
    LAS float* cw = (LAS float*)F.lds;
    WG_BAR();
    {
        f32x4 vm[3], vs[4];
#pragma unroll
        for (int it = 0; it < 3; ++it) { const int idx = F.tid + NTHR * it; if (idx < 5 * 256) { const int j = idx >> 8, c4 = idx & 255; vm[it] = *(const f32x4*)((j < 4 ? mcw + j * 1024 : mcb) + 4 * c4); } }
#pragma unroll
        for (int it = 0; it < 4; ++it) { const int idx = F.tid + NTHR * it; if (idx < 5 * 384) { const int j = idx / 384, c4 = idx % 384; vs[it] = *(const f32x4*)((j < 4 ? scw + j * 1536 : scb) + 4 * c4); } }
#pragma unroll
        for (int it = 0; it < 3; ++it) { const int idx = F.tid + NTHR * it; if (idx < 5 * 256) { const int j = idx >> 8, c4 = idx & 255; *(LAS f32x4*)(cw + j * 2560 + 4 * c4) = vm[it]; } }
#pragma unroll
        for (int it = 0; it < 4; ++it) { const int idx = F.tid + NTHR * it; if (idx < 5 * 384) { const int j = idx / 384, c4 = idx % 384; *(LAS f32x4*)(cw + j * 2560 + 1024 + 4 * c4) = vs[it]; } }
    }
    WG_BAR();
    const int gt = F.vcu * NTHR + F.tid; constexpr int STRIDE = NWG * NTHR, NIT = NB * 128 * 320 / STRIDE;
    static_assert(NIT * STRIDE == NB * 128 * 320, "conv items divide evenly");
    u32x4 cur[19], nxt[19];
    CONV_LOAD(gt, cur);
#pragma unroll 1
    for (int k = 0; k < NIT; ++k) {
        unsigned zl_ = 0u; asm volatile("" : "+s"(zl_)); const int ln_ = (int)__builtin_amdgcn_mbcnt_hi(~0u, __builtin_amdgcn_mbcnt_lo(~0u, zl_));
        const int it = F.vcu * NTHR + F.wave * 64 + k * STRIDE + ln_; const int cg = it % 320, tb = (it / 320) & 127, b = it / (320 * 128); const int cvcol = 8 * cg;
        if (k + 1 < NIT) CONV_LOAD(it + STRIDE, nxt);
        f32x2 wt[4][4], bs[4];
#pragma unroll
        for (int j = 0; j < 4; ++j) { const f32x4 a = *(const LAS f32x4*)(cw + j * 2560 + cvcol), c2 = *(const LAS f32x4*)(cw + j * 2560 + cvcol + 4);
            wt[j][0] = (f32x2){a[0], a[1]}; wt[j][1] = (f32x2){a[2], a[3]}; wt[j][2] = (f32x2){c2[0], c2[1]}; wt[j][3] = (f32x2){c2[2], c2[3]}; }
        { const f32x4 a = *(const LAS f32x4*)(cw + 4 * 2560 + cvcol), c2 = *(const LAS f32x4*)(cw + 4 * 2560 + cvcol + 4); bs[0] = (f32x2){a[0], a[1]}; bs[1] = (f32x2){a[2], a[3]}; bs[2] = (f32x2){c2[0], c2[1]}; bs[3] = (f32x2){c2[2], c2[3]}; }
        const float sc = (cg >= 64 && cg < 128) ? 0.08838834764831845f : 1.0f;
        bf16_t* op = CV + ((size_t)b * SEQ + tb * 16) * NCV + cvcol;
        f32x2 h0[4], h1[4], h2[4];
#pragma unroll
        for (int i = 0; i < 4; ++i) { h0[i] = (f32x2){bflo(cur[0][i]), bfhi(cur[0][i])}; h1[i] = (f32x2){bflo(cur[1][i]), bfhi(cur[1][i])}; h2[i] = (f32x2){bflo(cur[2][i]), bfhi(cur[2][i])}; }
#pragma unroll
        for (int t = 0; t < 16; ++t) {
            f32x2 h3[4], y[4];
#pragma unroll
            for (int i = 0; i < 4; ++i) { h3[i] = (f32x2){bflo(cur[3 + t][i]), bfhi(cur[3 + t][i])};
                f32x2 a = bs[i] + h0[i] * wt[0][i]; a = a + h1[i] * wt[1][i]; a = a + h2[i] * wt[2][i]; a = a + h3[i] * wt[3][i];
                const f32x2 e = a * (-1.4426950408889634f); f32x2 d; d.x = __builtin_amdgcn_exp2f(e.x); d.y = __builtin_amdgcn_exp2f(e.y); d = d + 1.0f;
                f32x2 r; r.x = __builtin_amdgcn_rcpf(d.x); r.y = __builtin_amdgcn_rcpf(d.y); y[i] = (a * sc) * r; }
            u32x4 o; o.x = pk2(y[0].x, y[0].y); o.y = pk2(y[1].x, y[1].y); o.z = pk2(y[2].x, y[2].y); o.w = pk2(y[3].x, y[3].y);
            *(u32x4*)(op + (size_t)t * NCV) = o;
#pragma unroll
            for (int i = 0; i < 4; ++i) { h0[i] = h1[i]; h1[i] = h2[i]; h2[i] = h3[i]; }
        }
        if (k + 1 < NIT) {
#pragma unroll
            for (int i = 0; i < 19; ++i) cur[i] = nxt[i]; }
    }
}
#undef CONV_LOAD

constexpr int XLD = 144;
constexpr int SS_Z = 110592;
constexpr int SS_CM = 0, SS_BM = 34816, SS_X = 69632, SS_HB = 88064, SS_F = 105472;
__device__ __forceinline__ void ssd_unit(Frame& F, int b, int hh, const bf16_t* __restrict__ U, const bf16_t* __restrict__ CV, bf16_t* __restrict__ MIX, float* __restrict__ SSQS,
                                         const float* __restrict__ dt_bias, const float* __restrict__ a_log, const float* __restrict__ d_skip) {
    LAS unsigned char* L = F.lds;
    const int tid = F.tid, lane = F.lane, w = F.wave, c16 = lane & 15, g4 = lane >> 4, grp = hh >> 3;
    WG_BAR();
    for (int i = tid; i < 64 * SLD / 4; i += NTHR) ((LAS unsigned*)(L + SS_HB))[i] = 0u;
    const float Aneg = -__expf(a_log[hh]), dtb = dt_bias[hh], Dsk = d_skip[hh];
    f32x4 hst[4];
#pragma unroll
    for (int i = 0; i < 4; ++i) hst[i] = (f32x4){F.zf, F.zf, F.zf, F.zf};
    const bf16_t* cvb = CV + (size_t)b * SEQ * NCV + 1024;
    u32x4 pc[4], pb_[4], px[2], pz[2]; unsigned graw0 = 0, graw1 = 0;
#define SSD_PREFETCH(cc) do { const size_t r0_ = (size_t)(cc) * 128; \
        _Pragma("unroll") for (int i = 0; i < 4; ++i) { const int q_ = tid + 512 * i; pc[i] = *(const u32x4*)(cvb + (r0_ + (q_ >> 4)) * NCV + 1280 + grp * 128 + 8 * (q_ & 15)); pb_[i] = *(const u32x4*)(cvb + (r0_ + (q_ >> 4)) * NCV + 1024 + grp * 128 + 8 * (q_ & 15)); } \
        _Pragma("unroll") for (int i = 0; i < 2; ++i) { const int q_ = tid + 512 * i; px[i] = *(const u32x4*)(cvb + (r0_ + (q_ >> 3)) * NCV + hh * 64 + 8 * (q_ & 7)); \
            pz[i] = *(const u32x4*)(U + ((size_t)b * SEQ + r0_ + (q_ >> 3)) * NU + UZ + hh * 64 + 8 * (q_ & 7)); } \
        if (w == 0) { graw0 = U[((size_t)b * SEQ + r0_ + lane) * NU + UDT + hh]; graw1 = U[((size_t)b * SEQ + r0_ + 64 + lane) * NU + UDT + hh]; } } while (0)
#define SSD_PF_CB(cc, i) do { const size_t r0_ = (size_t)(cc) * 128; int tq_ = tid; asm volatile("" : "+v"(tq_)); const int q_ = tq_ + 512 * (i); pc[i] = *(const u32x4*)(cvb + (r0_ + (q_ >> 4)) * NCV + 1280 + grp * 128 + 8 * (q_ & 15)); pb_[i] = *(const u32x4*)(cvb + (r0_ + (q_ >> 4)) * NCV + 1024 + grp * 128 + 8 * (q_ & 15)); } while (0)
#define SSD_PF_X(cc) do { const size_t r0_ = (size_t)(cc) * 128; int tq_ = tid; asm volatile("" : "+v"(tq_)); \
        _Pragma("unroll") for (int i = 0; i < 2; ++i) { const int q_ = tq_ + 512 * i; px[i] = *(const u32x4*)(cvb + (r0_ + (q_ >> 3)) * NCV + hh * 64 + 8 * (q_ & 7)); } \
        if (w == 0) { graw0 = U[((size_t)b * SEQ + r0_ + lane) * NU + UDT + hh]; graw1 = U[((size_t)b * SEQ + r0_ + 64 + lane) * NU + UDT + hh]; } } while (0)
#define SSD_GATES(buf) do { LAS float* fa_ = (LAS float*)(L + SS_F) + (buf) * 512; \
        const float dt0 = softplusf_(bf1((bf16_t)graw0) + dtb), dt1 = softplusf_(bf1((bf16_t)graw1) + dtb); float s0 = dt0 * Aneg, s1 = dt1 * Aneg; \
        _Pragma("unroll") for (int o = 1; o < 64; o <<= 1) { const float x0 = SHFL_UP(s0, o), x1 = SHFL_UP(s1, o); if (lane >= o) { s0 += x0; s1 += x1; } } \
        s1 += SHFL_IDX(s0, 63); const float tot = SHFL_IDX(s1, 63); \
        fa_[lane] = s0; fa_[64 + lane] = s1; fa_[128 + lane] = dt0; fa_[192 + lane] = dt1; fa_[256 + lane] = __expf(tot - s0) * dt0; fa_[320 + lane] = __expf(tot - s1) * dt1; fa_[384 + lane] = __expf(s0); fa_[448 + lane] = __expf(s1); } while (0)
    SSD_PREFETCH(0);
    if (w == 0) SSD_GATES(0);
#ifdef PROBE_ML
    unsigned long long pmt = 0, pa[7] = {0, 0, 0, 0, 0, 0, 0}; const unsigned long long pc0 = __builtin_amdgcn_s_memtime(), pr0 = __builtin_amdgcn_s_memrealtime();
#define PST(k) do { const unsigned long long t_ = __builtin_amdgcn_s_memrealtime(); pa[k] += t_ - pmt; pmt = t_; } while (0)
#endif
    for (int c = 0; c < 16; ++c) {
        const size_t row0 = (size_t)b * SEQ + c * 128;
#ifdef PROBE_ML
        pmt = __builtin_amdgcn_s_memrealtime();
#endif
#pragma unroll
        for (int i = 0; i < 4; ++i) { const int q_ = tid + 512 * i; *(LAS u32x4*)(L + SS_CM + (q_ >> 4) * SLD + (q_ & 15) * 16) = pc[i]; *(LAS u32x4*)(L + SS_BM + (q_ >> 4) * SLD + (q_ & 15) * 16) = pb_[i]; }
#pragma unroll
        for (int i = 0; i < 2; ++i) { const int q_ = tid + 512 * i; *(LAS u32x4*)(L + SS_X + (q_ >> 3) * XLD + (q_ & 7) * 16) = px[i]; *(LAS u32x4*)(L + SS_Z + (q_ >> 3) * XLD + (q_ & 7) * 16) = pz[i]; }
        WG_BAR();
#ifdef PROBE_ML
        PST(0);
#endif
        {
            const LAS float* fa = (const LAS float*)(L + SS_F) + (c & 1) * 512; const LAS float* fdt = fa + 128; const LAS float* fwdt = fa + 256; const LAS float* feac = fa + 384;
            const int l = 16 * w + c16; const size_t row = row0 + l;
#ifdef PROBE_ML
            PST(6);
#endif
            f32x4 accd[4], acco[4];
#pragma unroll
            for (int i = 0; i < 4; ++i) accd[i] = (f32x4){F.zf, F.zf, F.zf, F.zf};
            const float acl = fa[l]; const int q = c16 >> 2, pp = c16 & 3;
            bf16x8 cfr[4];
#pragma unroll
            for (int kn = 0; kn < 4; ++kn) cfr[kn] = *(const LAS bf16x8*)(L + SS_CM + (16 * w + c16) * SLD + (32 * kn + 8 * g4) * 2);
            for (int ks = 0; ks <= (w >> 1); ++ks) {
                float mv[8];
#pragma unroll
                for (int half = 0; half < 2; ++half) {
                    bf16x8 a0[4];
#pragma unroll
                    for (int kn = 0; kn < 4; ++kn) a0[kn] = *(const LAS bf16x8*)(L + SS_BM + (32 * ks + 16 * half + c16) * SLD + (32 * kn + 8 * g4) * 2);
                    const f32x4 fa0 = *(const LAS f32x4*)(fa + 32 * ks + 16 * half + 4 * g4), fd0 = *(const LAS f32x4*)(fdt + 32 * ks + 16 * half + 4 * g4);
                    __builtin_amdgcn_sched_barrier(0);
                    f32x4 gt0 = (f32x4){F.zf, F.zf, F.zf, F.zf};
#pragma unroll
                    for (int kn = 0; kn < 4; ++kn) gt0 = mfma16(a0[kn], cfr[kn], gt0);
#pragma unroll
                    for (int r = 0; r < 4; ++r) { const int s0 = 32 * ks + 16 * half + 4 * g4 + r; const float v0 = gt0[r] * __expf(acl - fa0[r]) * fd0[r]; mv[4 * half + r] = (s0 <= l) ? v0 : 0.f; }
                }
                s16x4 tA[4], tB[4];
#pragma unroll
                for (int pb = 0; pb < 4; ++pb) { tA[pb] = tr_read(L + SS_X + (32 * ks + 4 * g4 + q) * XLD + (16 * pb + 4 * pp) * 2); tB[pb] = tr_read(L + SS_X + (32 * ks + 16 + 4 * g4 + q) * XLD + (16 * pb + 4 * pp) * 2); }
                __builtin_amdgcn_sched_barrier(0);
                const bf16x8 bfrag = pack8f(mv);
#pragma unroll
                for (int pb = 0; pb < 4; ++pb) accd[pb] = mfma16(cat4(tA[pb], tB[pb]), bfrag, accd[pb]);
            }
            __builtin_amdgcn_sched_barrier(0);
            if (c + 1 < 16) SSD_PREFETCH(c + 1);
            __builtin_amdgcn_sched_barrier(0);
#pragma unroll
            for (int i = 0; i < 4; ++i) acco[i] = (f32x4){F.zf, F.zf, F.zf, F.zf};
#ifdef PROBE_ML
            PST(1);
#endif
#pragma unroll
            for (int kn = 0; kn < 4; ++kn) {
#pragma unroll
                for (int pb = 0; pb < 4; ++pb) { const bf16x8 a = *(const LAS bf16x8*)(L + SS_HB + (16 * pb + c16) * SLD + (32 * kn + 8 * g4) * 2); acco[pb] = mfma16(a, cfr[kn], acco[pb]); } }
#ifdef PROBE_ML
            PST(2);
#endif
            const float el = feac[l]; float ssq = 0.f;
#pragma unroll
            for (int pb = 0; pb < 4; ++pb) { const int p0 = 16 * pb + 4 * g4;
                const u32x2 zw = *(const LAS u32x2*)(L + SS_Z + l * XLD + p0 * 2); const float z[4] = {bflo(zw.x), bfhi(zw.x), bflo(zw.y), bfhi(zw.y)}; float o[4];
                const u32x2 xw = *(const LAS u32x2*)(L + SS_X + l * XLD + p0 * 2); const float xv[4] = {bflo(xw.x), bfhi(xw.x), bflo(xw.y), bfhi(xw.y)};
#pragma unroll
                for (int r = 0; r < 4; ++r) { const float y = accd[pb][r] + el * acco[pb][r] + Dsk * xv[r]; o[r] = y * siluf_(z[r]); ssq += o[r] * o[r]; }
                u32x2 ow; ow.x = pk2(o[0], o[1]); ow.y = pk2(o[2], o[3]); *(u32x2*)(MIX + row * 2048 + MIXS + hh * 64 + p0) = ow; }
            ssq += SHFL_XOR(ssq, 16); ssq += SHFL_XOR(ssq, 32);
            if (g4 == 0) SSQS[row * 16 + hh] = ssq;
#ifdef PROBE_ML
            PST(3);
#endif
            const float dec = feac[127];
#pragma unroll
            for (int pb = 0; pb < 4; ++pb) hst[pb] = hst[pb] * dec;
#pragma unroll
            for (int ks = 0; ks < 4; ++ks) {
                const s16x4 tA = tr_read(L + SS_BM + (32 * ks + 8 * g4 + q) * SLD + (16 * w + 4 * pp) * 2), tB = tr_read(L + SS_BM + (32 * ks + 8 * g4 + 4 + q) * SLD + (16 * w + 4 * pp) * 2);
                const f32x4 w0 = *(const LAS f32x4*)(fwdt + 32 * ks + 8 * g4), w1 = *(const LAS f32x4*)(fwdt + 32 * ks + 8 * g4 + 4);
                s16x4 xA[4], xB[4];
#pragma unroll
                for (int pb = 0; pb < 4; ++pb) { xA[pb] = tr_read(L + SS_X + (32 * ks + 8 * g4 + q) * XLD + (16 * pb + 4 * pp) * 2); xB[pb] = tr_read(L + SS_X + (32 * ks + 8 * g4 + 4 + q) * XLD + (16 * pb + 4 * pp) * 2); }
                const float bv[8] = {bf1((bf16_t)tA[0]) * w0[0], bf1((bf16_t)tA[1]) * w0[1], bf1((bf16_t)tA[2]) * w0[2], bf1((bf16_t)tA[3]) * w0[3], bf1((bf16_t)tB[0]) * w1[0], bf1((bf16_t)tB[1]) * w1[1], bf1((bf16_t)tB[2]) * w1[2], bf1((bf16_t)tB[3]) * w1[3]};
                const bf16x8 bfrag = pack8f(bv);
#pragma unroll
                for (int pb = 0; pb < 4; ++pb) hst[pb] = mfma16(cat4(xA[pb], xB[pb]), bfrag, hst[pb]);
            }
            if (w == 0 && c + 1 < 16) SSD_GATES((c + 1) & 1);
        }
#ifdef PROBE_ML
        PST(4);
#endif
        WG_BAR();
#pragma unroll
        for (int pb = 0; pb < 4; ++pb)
#pragma unroll
            for (int r = 0; r < 4; ++r) *(LAS bf16_t*)(L + SS_HB + (16 * pb + 4 * g4 + r) * SLD + (16 * w + c16) * 2) = f2bf(hst[pb][r]);
#ifdef PROBE_ML
        PST(5);
#endif
    }
#ifdef PROBE_ML
    if (F.bx == 0 && lane == 0) { unsigned long long* dg = (unsigned long long*)((unsigned char*)MIX - WS_MIX + 2883584); for (int k = 0; k < 7; ++k) dg[32 + 8 * w + k] = pa[k]; if (w == 7) { const unsigned long long dc = __builtin_amdgcn_s_memtime() - pc0, dr = __builtin_amdgcn_s_memrealtime() - pr0; dg[120] = dc * 400ull / dr; dg[121] = dr; } }
#endif
#undef SSD_PREFETCH
#undef SSD_PF_CB
#undef SSD_PF_X
#undef SSD_GATES
}

constexpr int VL2 = 80;
constexpr int ML_Q = 0, ML_K = 17408, ML_V = 34816, ML_CB = 39936, ML_F = 48640;
__device__ __forceinline__ void mlstm_unit(Frame& F, int b, int h, int vs, const bf16_t* __restrict__ U, const bf16_t* __restrict__ CV, bf16_t* __restrict__ MIX, float* __restrict__ SSQM, const float* __restrict__ gate_b) {
    LAS unsigned char* L = F.lds;
    const int tid = F.tid, lane = F.lane, w = F.wave, c16 = lane & 15, g4 = lane >> 4;
    LAS float* fbase = (LAS float*)(L + ML_F); LAS float* fnvec = fbase + 768;
    WG_BAR();
    for (int i = tid; i < 32 * SLD / 4; i += NTHR) ((LAS unsigned*)(L + ML_CB))[i] = 0u;
    if (tid < 128) fnvec[tid] = 0.f;
    const float bi = gate_b[h], bfg = gate_b[4 + h];
    float m_prev = 0.f;
    f32x4 cst[2], nacc; cst[0] = (f32x4){F.zf, F.zf, F.zf, F.zf}; cst[1] = cst[0]; nacc = cst[0];
    const bf16_t* cvq = CV + (size_t)b * SEQ * NCV + h * 128; const bf16_t* uv = U + (size_t)b * SEQ * NU + UV + h * 128 + vs * 32;
    u32x4 pq[2], pkk[2], pvv; unsigned gri = 0, grf = 0;
#define ML_PREFETCH(cc) do { const size_t r0_ = (size_t)(cc) * 64; \
        _Pragma("unroll") for (int i = 0; i < 2; ++i) { const int q_ = tid + 512 * i; pq[i] = *(const u32x4*)(cvq + (r0_ + (q_ >> 4)) * NCV + 8 * (q_ & 15)); pkk[i] = *(const u32x4*)(cvq + (r0_ + (q_ >> 4)) * NCV + 512 + 8 * (q_ & 15)); } \
        if (tid < 256) pvv = *(const u32x4*)(uv + (r0_ + (tid >> 2)) * NU + 8 * (tid & 3)); \
        if (w == 0) { gri = U[((size_t)b * SEQ + r0_ + lane) * NU + UMI + h]; grf = U[((size_t)b * SEQ + r0_ + lane) * NU + UMF + h]; } } while (0)
#define ML_GATES(buf) do { LAS float* fg_ = fbase + (buf) * 384; \
        const float li = bf1((bf16_t)gri) + bi, lf = logsigmoidf_(bf1((bf16_t)grf) + bfg); float bc = lf; \
        _Pragma("unroll") for (int o = 1; o < 64; o <<= 1) { const float x = SHFL_UP(bc, o); if (lane >= o) bc += x; } \
        const float total = SHFL_IDX(bc, 63), ct = li - bc; float cm = ct; \
        _Pragma("unroll") for (int o = 1; o < 64; o <<= 1) { const float x = SHFL_UP(cm, o); if (lane >= o) cm = fmaxf(cm, x); } \
        const float mj = bc + fmaxf(m_prev, cm); \
        fg_[lane] = bc - mj; fg_[64 + lane] = ct; fg_[128 + lane] = __expf(bc + m_prev - mj); fg_[192 + lane] = __expf(-mj); \
        const float m_new = total + fmaxf(m_prev, SHFL_IDX(cm, 63)); \
        fg_[256 + lane] = __expf(total - m_new + ct); if (lane == 0) fg_[320] = __expf(total + m_prev - m_new); \
        m_prev = m_new; } while (0)
    ML_PREFETCH(0);
    if (w == 0) ML_GATES(0);
#ifdef PROBE_ML
    unsigned long long pm0 = 0, pm1 = 0, pm2 = 0, pa1 = 0, pa2 = 0, pa3 = 0;
#endif
    for (int c = 0; c < 32; ++c) {
        const size_t row0 = (size_t)b * SEQ + c * 64;
#ifdef PROBE_ML
        pm0 = __builtin_amdgcn_s_memrealtime();
#endif
#pragma unroll
        for (int i = 0; i < 2; ++i) { const int q_ = tid + 512 * i; *(LAS u32x4*)(L + ML_Q + (q_ >> 4) * SLD + (q_ & 15) * 16) = pq[i]; *(LAS u32x4*)(L + ML_K + (q_ >> 4) * SLD + (q_ & 15) * 16) = pkk[i]; }
        if (tid < 256) *(LAS u32x4*)(L + ML_V + (tid >> 2) * VL2 + (tid & 3) * 16) = pvv;
        WG_BAR();
#ifdef PROBE_ML
        pm1 = __builtin_amdgcn_s_memrealtime(); pa1 += pm1 - pm0;
#endif
        if (c + 1 < 32) ML_PREFETCH(c + 1);
        {
            const LAS float* frow = fbase + (c & 1) * 384; const LAS float* fcol = frow + 64; const LAS float* fsint = frow + 128; const LAS float* femj = frow + 192; const LAS float* favec = frow + 256;
            const int jb = w & 3, vb = w >> 2; const int j = 16 * jb + c16; const float rt = frow[j]; const int q = c16 >> 2, pp = c16 & 3;
            f32x4 accD = (f32x4){F.zf, F.zf, F.zf, F.zf}, accI = accD; float dsum = 0.f;
            bf16x8 qfr[4];
#pragma unroll
            for (int kk = 0; kk < 4; ++kk) qfr[kk] = *(const LAS bf16x8*)(L + ML_Q + (16 * jb + c16) * SLD + (32 * kk + 8 * g4) * 2);
            for (int ks = 0; ks <= (jb >> 1); ++ks) {
                float mv[8];
#pragma unroll
                for (int half = 0; half < 2; ++half) {
                    bf16x8 a0[4];
#pragma unroll
                    for (int kk = 0; kk < 4; ++kk) a0[kk] = *(const LAS bf16x8*)(L + ML_K + (32 * ks + 16 * half + c16) * SLD + (32 * kk + 8 * g4) * 2);
                    const f32x4 fc0 = *(const LAS f32x4*)(fcol + 32 * ks + 16 * half + 4 * g4);
                    __builtin_amdgcn_sched_barrier(0);
                    f32x4 st = (f32x4){F.zf, F.zf, F.zf, F.zf};
#pragma unroll
                    for (int kk = 0; kk < 4; ++kk) st = mfma16(a0[kk], qfr[kk], st);
#pragma unroll
                    for (int r = 0; r < 4; ++r) { const int s = 32 * ks + 16 * half + 4 * g4 + r; float v = st[r] * __expf(rt + fc0[r]); v = (s <= j) ? v : 0.f; mv[4 * half + r] = v; dsum += v; }
                }
                const s16x4 tA = tr_read(L + ML_V + (32 * ks + 4 * g4 + q) * VL2 + (16 * vb + 4 * pp) * 2), tB = tr_read(L + ML_V + (32 * ks + 16 + 4 * g4 + q) * VL2 + (16 * vb + 4 * pp) * 2);
                const bf16x8 bfrag = pack8f(mv);
                accD = mfma16(cat4(tA, tB), bfrag, accD);
            }
            {
                bf16x8 cf[4];
#pragma unroll
                for (int kk = 0; kk < 4; ++kk) cf[kk] = *(const LAS bf16x8*)(L + ML_CB + (16 * vb + c16) * SLD + (32 * kk + 8 * g4) * 2);
                __builtin_amdgcn_sched_barrier(0);
#pragma unroll
                for (int kk = 0; kk < 4; ++kk) accI = mfma16(cf[kk], qfr[kk], accI);
            }
            float nq = 0.f;
#pragma unroll
            for (int i = 0; i < 4; ++i) { const u32x4 qr = *(const LAS u32x4*)(L + ML_Q + (16 * jb + c16) * SLD + (32 * g4 + 8 * i) * 2);
                const f32x4 n0 = *(const LAS f32x4*)(fnvec + 32 * g4 + 8 * i), n1 = *(const LAS f32x4*)(fnvec + 32 * g4 + 8 * i + 4);
                nq += bflo(qr.x) * n0[0] + bfhi(qr.x) * n0[1] + bflo(qr.y) * n0[2] + bfhi(qr.y) * n0[3] + bflo(qr.z) * n1[0] + bfhi(qr.z) * n1[1] + bflo(qr.w) * n1[2] + bfhi(qr.w) * n1[3]; }
            nq += SHFL_XOR(nq, 16); nq += SHFL_XOR(nq, 32);
            dsum += SHFL_XOR(dsum, 16); dsum += SHFL_XOR(dsum, 32);
            const float si = fsint[j]; const float den = si * nq + dsum; const float inv = 1.0f / fmaxf(fabsf(den), femj[j]);
            const size_t row = row0 + j; float o[4], ssq = 0.f;
#pragma unroll
            for (int r = 0; r < 4; ++r) { o[r] = (si * accI[r] + accD[r]) * inv; ssq += o[r] * o[r]; }
            u32x2 ow; ow.x = pk2(o[0], o[1]); ow.y = pk2(o[2], o[3]); *(u32x2*)(MIX + row * 2048 + MIXM + h * 128 + vs * 32 + 16 * vb + 4 * g4) = ow;
            ssq += SHFL_XOR(ssq, 16); ssq += SHFL_XOR(ssq, 32);
            if (g4 == 0) SSQM[row * 32 + h * 8 + vs * 2 + vb] = ssq;
            const float dec = frow[320];
            cst[0] = cst[0] * dec; cst[1] = cst[1] * dec; nacc = nacc * dec;
#pragma unroll
            for (int ks = 0; ks < 2; ++ks) {
                const s16x4 tA = tr_read(L + ML_K + (32 * ks + 8 * g4 + q) * SLD + (16 * w + 4 * pp) * 2), tB = tr_read(L + ML_K + (32 * ks + 8 * g4 + 4 + q) * SLD + (16 * w + 4 * pp) * 2);
                const f32x4 w0 = *(const LAS f32x4*)(favec + 32 * ks + 8 * g4), w1 = *(const LAS f32x4*)(favec + 32 * ks + 8 * g4 + 4);
                s16x4 xA[2], xB[2];
#pragma unroll
                for (int vb2 = 0; vb2 < 2; ++vb2) { xA[vb2] = tr_read(L + ML_V + (32 * ks + 8 * g4 + q) * VL2 + (16 * vb2 + 4 * pp) * 2); xB[vb2] = tr_read(L + ML_V + (32 * ks + 8 * g4 + 4 + q) * VL2 + (16 * vb2 + 4 * pp) * 2); }
                const float bv[8] = {bf1((bf16_t)tA[0]) * w0[0], bf1((bf16_t)tA[1]) * w0[1], bf1((bf16_t)tA[2]) * w0[2], bf1((bf16_t)tA[3]) * w0[3], bf1((bf16_t)tB[0]) * w1[0], bf1((bf16_t)tB[1]) * w1[1], bf1((bf16_t)tB[2]) * w1[2], bf1((bf16_t)tB[3]) * w1[3]};
                const bf16x8 bfrag = pack8f(bv);
                const bf16x8 ones8 = {(short)0x3f80, (short)0x3f80, (short)0x3f80, (short)0x3f80, (short)0x3f80, (short)0x3f80, (short)0x3f80, (short)0x3f80};
                nacc = mfma16(ones8, bfrag, nacc);
#pragma unroll
                for (int vb2 = 0; vb2 < 2; ++vb2) cst[vb2] = mfma16(cat4(xA[vb2], xB[vb2]), bfrag, cst[vb2]);
            }
            if (w == 0 && c + 1 < 32) ML_GATES((c + 1) & 1);
        }
#ifdef PROBE_ML
        pm2 = __builtin_amdgcn_s_memrealtime(); pa2 += pm2 - pm1;
#endif
        WG_BAR();
#pragma unroll
        for (int vb2 = 0; vb2 < 2; ++vb2)
#pragma unroll
            for (int r = 0; r < 4; ++r) *(LAS bf16_t*)(L + ML_CB + (16 * vb2 + 4 * g4 + r) * SLD + (16 * w + c16) * 2) = f2bf(cst[vb2][r]);
        if (g4 == 0) fnvec[16 * w + c16] = nacc[0];
#ifdef PROBE_ML
        pa3 += __builtin_amdgcn_s_memrealtime() - pm2;
#endif
    }
#ifdef PROBE_ML
    if (F.bx == 0 && lane == 0) { unsigned long long* dg = (unsigned long long*)((unsigned char*)MIX - WS_MIX + 2883584); dg[4 * w] = pa1; dg[4 * w + 1] = pa2; dg[4 * w + 2] = pa3; }
#endif
#undef ML_PREFETCH
#undef ML_GATES
}

constexpr int MB_K0 = 0, MB_V0 = 17408, MB_K1 = 34816, MB_V1 = 52224, MB_KM = 69632, MB_SEL = 73216;
__device__ __forceinline__ void moba_unit(Frame& F, int b, int h, int qb, const bf16_t* __restrict__ U, bf16_t* __restrict__ MIX, const float* __restrict__ KMEAN) {
    LAS unsigned char* L = F.lds;
    const int tid = F.tid, lane = F.lane, w = F.wave, c16 = lane & 15, g4 = lane >> 4;
    LAS float* km = (LAS float*)(L + MB_KM); LAS int* sel = (LAS int*)(L + MB_SEL);
    const size_t row0 = (size_t)b * SEQ + 256 * qb;
    WG_BAR();
    bf16x8 Qf[2][4]; u32x4 pk[2], pv[2];
    const int kr = tid >> 3, ch = tid & 7;
#pragma unroll
    for (int qq = 0; qq < 2; ++qq) { const bf16_t* qp = U + (row0 + 32 * w + 16 * qq + c16) * NU + UAQ + h * 128 + 8 * g4;
#pragma unroll
        for (int ds = 0; ds < 4; ++ds) Qf[qq][ds] = *(const bf16x8*)(qp + 32 * ds); }
    { const bf16_t* kp = U + ((size_t)b * SEQ + kr) * NU + UAK + h * 128; const bf16_t* vp = U + ((size_t)b * SEQ + kr) * NU + UAV + h * 128;
      pk[0] = *(const u32x4*)(kp + 8 * ch); pk[1] = *(const u32x4*)(kp + 8 * (ch + 8)); pv[0] = *(const u32x4*)(vp + 8 * ch); pv[1] = *(const u32x4*)(vp + 8 * (ch + 8)); }
    for (int i = tid; i < qb * 128; i += NTHR) { const float* kq = KMEAN + ((size_t)(b * 4 + h) * 8) * 128 + i; km[i] = (kq[0] + kq[NB * 4 * 8 * 128]) + (kq[2 * NB * 4 * 8 * 128] + kq[3 * NB * 4 * 8 * 128]); }
    WG_BAR();
    if (tid < 256) {
        int mask = (1 << qb) - 1;
        if (qb > 3) {
            float sc[7];
#pragma unroll
            for (int j = 0; j < 7; ++j) sc[j] = 0.f;
            const bf16_t* qp = U + (row0 + tid) * NU + UAQ + h * 128;
            for (int d8 = 0; d8 < 16; ++d8) { const u32x4 qr = *(const u32x4*)(qp + 8 * d8); const float qv[8] = {bflo(qr.x), bfhi(qr.x), bflo(qr.y), bfhi(qr.y), bflo(qr.z), bfhi(qr.z), bflo(qr.w), bfhi(qr.w)};
#pragma unroll
                for (int j = 0; j < 7; ++j) if (j < qb) { const f32x4 k0 = *(const LAS f32x4*)(km + j * 128 + 8 * d8), k1 = *(const LAS f32x4*)(km + j * 128 + 8 * d8 + 4);
                    sc[j] += qv[0] * k0[0] + qv[1] * k0[1] + qv[2] * k0[2] + qv[3] * k0[3] + qv[4] * k1[0] + qv[5] * k1[1] + qv[6] * k1[2] + qv[7] * k1[3]; } }
            mask = 0;
#pragma unroll
            for (int it = 0; it < 3; ++it) { float best = -__builtin_inff(); int bi = 0;
#pragma unroll
                for (int j = 0; j < 7; ++j) if (j < qb && !((mask >> j) & 1) && sc[j] > best) { best = sc[j]; bi = j; }
                mask |= 1 << bi; }
        }
        sel[tid] = mask;
    }
    WG_BAR();
    int msk[2]; float mrun[2], lsum[2]; f32x4 O[2][8];
#pragma unroll
    for (int qq = 0; qq < 2; ++qq) {
        msk[qq] = sel[32 * w + 16 * qq + c16]; mrun[qq] = -1e30f; lsum[qq] = 0.f;
#pragma unroll
        for (int db = 0; db < 8; ++db) O[qq][db] = (f32x4){F.zf, F.zf, F.zf, F.zf}; }
    const int ntiles = 4 * (qb + 1);
    const float SC = 0.08838834764831845f * 1.4426950408889634f;
    for (int tt = 0; tt < ntiles; ++tt) {
        const int kofs = (tt & 1) ? MB_K1 : MB_K0, vofs = (tt & 1) ? MB_V1 : MB_V0;
        *(LAS u32x4*)(L + kofs + kr * SLD + ch * 16) = pk[0]; *(LAS u32x4*)(L + kofs + kr * SLD + (ch + 8) * 16) = pk[1];
        *(LAS u32x4*)(L + vofs + kr * SLD + ch * 16) = pv[0]; *(LAS u32x4*)(L + vofs + kr * SLD + (ch + 8) * 16) = pv[1];
        WG_BAR();
        if (tt + 1 < ntiles) { const bf16_t* kp = U + ((size_t)b * SEQ + 64 * (tt + 1) + kr) * NU + UAK + h * 128; const bf16_t* vp = U + ((size_t)b * SEQ + 64 * (tt + 1) + kr) * NU + UAV + h * 128;
            pk[0] = *(const u32x4*)(kp + 8 * ch); pk[1] = *(const u32x4*)(kp + 8 * (ch + 8)); pv[0] = *(const u32x4*)(vp + 8 * ch); pv[1] = *(const u32x4*)(vp + 8 * (ch + 8)); }
        const int jblk = tt >> 2; const bool own = (jblk == qb);
        f32x4 st[4][2];
#pragma unroll
        for (int kb = 0; kb < 4; ++kb) { st[kb][0] = (f32x4){F.zf, F.zf, F.zf, F.zf}; st[kb][1] = st[kb][0];
#pragma unroll
            for (int ds = 0; ds < 4; ++ds) { const bf16x8 a = *(const LAS bf16x8*)(L + kofs + (16 * kb + c16) * SLD + (32 * ds + 8 * g4) * 2);
                st[kb][0] = mfma16(a, Qf[0][ds], st[kb][0]); st[kb][1] = mfma16(a, Qf[1][ds], st[kb][1]); } }
        bf16x8 pf[2][2];
#pragma unroll
        for (int qq = 0; qq < 2; ++qq) {
            const float NEG = -__builtin_inff();
            if (own) { const int qi = 32 * w + 16 * qq + c16, kbase = 64 * (tt & 3) + 4 * g4;
#pragma unroll
                for (int kb = 0; kb < 4; ++kb)
#pragma unroll
                    for (int r = 0; r < 4; ++r) if (kbase + 16 * kb + r > qi) st[kb][qq][r] = NEG;
            } else if (!((msk[qq] >> jblk) & 1)) {
#pragma unroll
                for (int kb = 0; kb < 4; ++kb) st[kb][qq] = (f32x4){NEG, NEG, NEG, NEG};
            }
            float rm = st[0][qq][0];
#pragma unroll
            for (int kb = 0; kb < 4; ++kb)
#pragma unroll
                for (int r = 0; r < 4; ++r) rm = fmaxf(rm, st[kb][qq][r]);
            rm = fmaxf(rm, SHFL_XOR(rm, 16)); rm = fmaxf(rm, SHFL_XOR(rm, 32));
            const float mn = fmaxf(mrun[qq], rm), alpha = __builtin_amdgcn_exp2f((mrun[qq] - mn) * SC), mnsc = -mn * SC; mrun[qq] = mn;
            float ps = 0.f; float pvv[4][4];
#pragma unroll
            for (int kb = 0; kb < 4; ++kb)
#pragma unroll
                for (int r = 0; r < 4; ++r) { const float pe = __builtin_amdgcn_exp2f(__builtin_fmaf(st[kb][qq][r], SC, mnsc)); pvv[kb][r] = pe; ps += pe; }
            lsum[qq] = lsum[qq] * alpha + ps;
            if (__builtin_amdgcn_ballot_w64(alpha != 1.0f) != 0ull) {
#pragma unroll
                for (int db = 0; db < 8; ++db) O[qq][db] = O[qq][db] * alpha; }
#pragma unroll
            for (int ks = 0; ks < 2; ++ks) { const float v8[8] = {pvv[2 * ks][0], pvv[2 * ks][1], pvv[2 * ks][2], pvv[2 * ks][3], pvv[2 * ks + 1][0], pvv[2 * ks + 1][1], pvv[2 * ks + 1][2], pvv[2 * ks + 1][3]}; pf[qq][ks] = pack8f(v8); }
        }
        const int q = c16 >> 2, p = c16 & 3;
#pragma unroll
        for (int ks = 0; ks < 2; ++ks)
#pragma unroll
            for (int db = 0; db < 8; ++db) {
                const s16x4 tA = tr_read(L + vofs + (32 * ks + 4 * g4 + q) * SLD + (16 * db + 4 * p) * 2), tB = tr_read(L + vofs + (32 * ks + 16 + 4 * g4 + q) * SLD + (16 * db + 4 * p) * 2);
                const bf16x8 a = cat4(tA, tB);
                O[0][db] = mfma16(a, pf[0][ks], O[0][db]); O[1][db] = mfma16(a, pf[1][ks], O[1][db]);
            }
    }
#pragma unroll
    for (int qq = 0; qq < 2; ++qq) { float ls = lsum[qq]; ls += SHFL_XOR(ls, 16); ls += SHFL_XOR(ls, 32); const float inv = 1.0f / ls;
        bf16_t* op = MIX + (row0 + 32 * w + 16 * qq + c16) * 2048 + MIXA + h * 128 + 4 * g4;
#pragma unroll
        for (int db = 0; db < 8; ++db) { u32x2 ow; ow.x = pk2(O[qq][db][0] * inv, O[qq][db][1] * inv); ow.y = pk2(O[qq][db][2] * inv, O[qq][db][3] * inv); *(u32x2*)(op + 16 * db) = ow; } }
}
constexpr int KM_Q = NB * 4 * 8 * 128;
__device__ __forceinline__ void kmean_items(Frame& F, const bf16_t* __restrict__ U, float* __restrict__ KMEAN) {
    const int gw = F.vcu * NWAVES + F.wave, NGW = NWG * NWAVES;
    for (int it4 = gw; it4 < NB * 4 * 8 * 4; it4 += NGW) {
        const int q = it4 & 3, it = it4 >> 2; const int blk = it & 7, h = (it >> 3) & 3, b = it >> 5;
        const int lane = F.lane, cg = lane & 15, rg = lane >> 4;
        const bf16_t* kp = U + ((size_t)b * SEQ + 256 * blk + 64 * q + rg) * NU + UAK + h * 128 + 8 * cg;
        u32x4 v[16];
#pragma unroll
        for (int i = 0; i < 16; ++i) v[i] = *(const u32x4*)(kp + (size_t)(4 * i) * NU);
        float s[8];
#pragma unroll
        for (int j = 0; j < 8; ++j) s[j] = 0.f;
#pragma unroll
        for (int i = 0; i < 16; ++i) { s[0] += bflo(v[i].x); s[1] += bfhi(v[i].x); s[2] += bflo(v[i].y); s[3] += bfhi(v[i].y); s[4] += bflo(v[i].z); s[5] += bfhi(v[i].z); s[6] += bflo(v[i].w); s[7] += bfhi(v[i].w); }
#pragma unroll
        for (int j = 0; j < 8; ++j) { s[j] += SHFL_XOR(s[j], 16); s[j] += SHFL_XOR(s[j], 32); }
        if (rg == 0) { float* op = KMEAN + (size_t)q * KM_Q + (size_t)it * 128 + 8 * cg;
            *(f32x4*)op = (f32x4){s[0] * (1.f / 256.f), s[1] * (1.f / 256.f), s[2] * (1.f / 256.f), s[3] * (1.f / 256.f)}; *(f32x4*)(op + 4) = (f32x4){s[4] * (1.f / 256.f), s[5] * (1.f / 256.f), s[6] * (1.f / 256.f), s[7] * (1.f / 256.f)}; }
    }
}
static_assert(T % (4 * NWG * NWAVES) == 0, "mixnorm row batches");
__device__ __forceinline__ void mixnorm_rows(Frame& F, const bf16_t* __restrict__ U, bf16_t* __restrict__ MIX, const float* __restrict__ SSQM, const float* __restrict__ SSQS,
                                             const float* __restrict__ m_norm_g, const float* __restrict__ s_norm_g) {
    const int gw = F.vcu * NWAVES + F.wave, NGW = NWG * NWAVES, lane = F.lane;
    const int colm = 8 * lane, hm = colm >> 7;
    const f32x4 gm0 = *(const f32x4*)(m_norm_g + colm), gm1 = *(const f32x4*)(m_norm_g + colm + 4);
    f32x4 gs0[2], gs1[2];
#pragma unroll
    for (int i = 0; i < 2; ++i) { gs0[i] = *(const f32x4*)(s_norm_g + 512 * i + 8 * lane); gs1[i] = *(const f32x4*)(s_norm_g + 512 * i + 8 * lane + 4); }
    for (int row0 = gw; row0 < T; row0 += 4 * NGW) {
        f32x4 qm0[4], qm1[4], qs0[4][2], qs1[4][2]; u32x4 hvm[4], ovm[4], hvs[4][2];
#pragma unroll
        for (int k = 0; k < 4; ++k) { const int row = row0 + k * NGW;
            qm0[k] = *(const f32x4*)(SSQM + (size_t)row * 32 + hm * 8); qm1[k] = *(const f32x4*)(SSQM + (size_t)row * 32 + hm * 8 + 4);
            hvm[k] = *(const u32x4*)(MIX + (size_t)row * 2048 + MIXM + colm); ovm[k] = *(const u32x4*)(U + (size_t)row * NU + UO + colm);
#pragma unroll
            for (int i = 0; i < 2; ++i) { qs0[k][i] = *(const f32x4*)(SSQS + (size_t)row * 16 + 8 * i); qs1[k][i] = *(const f32x4*)(SSQS + (size_t)row * 16 + 8 * i + 4); hvs[k][i] = *(const u32x4*)(MIX + (size_t)row * 2048 + MIXS + 512 * i + 8 * lane); } }
#pragma unroll
        for (int k = 0; k < 4; ++k) { const int row = row0 + k * NGW;
            {   const float ssq = (qm0[k][0] + qm0[k][1]) + (qm0[k][2] + qm0[k][3]) + (qm1[k][0] + qm1[k][1]) + (qm1[k][2] + qm1[k][3]);
                const float r = 1.0f / sqrtf(ssq * (1.f / 128.f) + EPS); const u32x4 hv = hvm[k], ov = ovm[k]; u32x4 o;
                o.x = pk2(bflo(hv.x) * r * gm0[0] * sigmoidf_(bflo(ov.x)), bfhi(hv.x) * r * gm0[1] * sigmoidf_(bfhi(ov.x)));
                o.y = pk2(bflo(hv.y) * r * gm0[2] * sigmoidf_(bflo(ov.y)), bfhi(hv.y) * r * gm0[3] * sigmoidf_(bfhi(ov.y)));
                o.z = pk2(bflo(hv.z) * r * gm1[0] * sigmoidf_(bflo(ov.z)), bfhi(hv.z) * r * gm1[1] * sigmoidf_(bfhi(ov.z)));
                o.w = pk2(bflo(hv.w) * r * gm1[2] * sigmoidf_(bflo(ov.w)), bfhi(hv.w) * r * gm1[3] * sigmoidf_(bfhi(ov.w)));
                *(u32x4*)(MIX + (size_t)row * 2048 + MIXM + colm) = o; }
#pragma unroll
            for (int i = 0; i < 2; ++i) { const f32x4 q0 = qs0[k][i], q1 = qs1[k][i];
                const float ssq = (q0[0] + q0[1]) + (q0[2] + q0[3]) + (q1[0] + q1[1]) + (q1[2] + q1[3]);
                const float r = 1.0f / sqrtf(ssq * (1.f / 512.f) + EPS); const u32x4 hv = hvs[k][i]; u32x4 o;
                o.x = pk2(bflo(hv.x) * r * gs0[i][0], bfhi(hv.x) * r * gs0[i][1]); o.y = pk2(bflo(hv.y) * r * gs0[i][2], bfhi(hv.y) * r * gs0[i][3]);
                o.z = pk2(bflo(hv.z) * r * gs1[i][0], bfhi(hv.z) * r * gs1[i][1]); o.w = pk2(bflo(hv.w) * r * gs1[i][2], bfhi(hv.w) * r * gs1[i][3]);
                *(u32x4*)(MIX + (size_t)row * 2048 + MIXS + 512 * i + 8 * lane) = o; } }
    }
}
constexpr int LT_TAB = 0, LT_CUMT = 320, LT_LCNT = 340, LT_BASE = 356, LT_TOT = 372, LT_GOFF = 388, LT_PART = 416, LT_PRE = 928;
__device__ __forceinline__ void moe_route(Frame& F, const bf16_t* XS, const float* g, const float* Wr, int* ROUTE, int* WGCNT, int* TOK) {
    LAS unsigned char* L = F.lds; LAS int* lt = (LAS int*)(L + LTAB_OFF); const int lane = F.lane;
    constexpr int WSTR = D + 4;
    LAS float* Wt = (LAS float*)L;
    LAS float* Cw = (LAS float*)(L + 66048) + F.wave * 256;
    WG_BAR();
    for (int i = F.tid; i < D * NEXP / 4; i += NTHR) { const int k = i >> 1, half = i & 1; const f32x4 v = ((const f32x4*)Wr)[i] * g[k];
        Wt[(4 * half + 0) * WSTR + k] = v[0]; Wt[(4 * half + 1) * WSTR + k] = v[1]; Wt[(4 * half + 2) * WSTR + k] = v[2]; Wt[(4 * half + 3) * WSTR + k] = v[3]; }
    if (F.tid < 16) lt[LT_LCNT + F.tid] = 0;
    for (int i = F.bx * NTHR + F.tid; i < MOE_ROWS; i += NWG * NTHR) TOK[i] = -1;
    WG_BAR();
    const int ri = lane & 15, kq = lane >> 4, row0 = 128 * F.bx + 16 * F.wave;
    const u32x4* xr = (const u32x4*)(XS + (size_t)(row0 + ri) * D) + kq;
    const LAS float* wl = Wt + (lane & 7) * WSTR + 8 * kq;
    f32x4 acc = (f32x4){F.zf, F.zf, F.zf, F.zf}; float ssq = 0.f;
    u32x4 cur[8], nxt[8];
#pragma unroll
    for (int c = 0; c < 8; ++c) cur[c] = xr[4 * c];
#pragma unroll 1
    for (int tb = 0; tb < 8; ++tb) {
        if (tb + 1 < 8) {
#pragma unroll
            for (int c = 0; c < 8; ++c) nxt[c] = xr[4 * (8 * (tb + 1) + c)]; }
#pragma unroll
        for (int c = 0; c < 8; ++c) {
            const f32x4 w0 = *(const LAS f32x4*)(wl + 32 * (8 * tb + c)), w1 = *(const LAS f32x4*)(wl + 32 * (8 * tb + c) + 4);
            const u32x4 r = cur[c]; const float xv[8] = {bflo(r.x), bfhi(r.x), bflo(r.y), bfhi(r.y), bflo(r.z), bfhi(r.z), bflo(r.w), bfhi(r.w)};
            const float wv[8] = {w0[0], w0[1], w0[2], w0[3], w1[0], w1[1], w1[2], w1[3]};
#pragma unroll
            for (int u = 0; u < 8; ++u) { ssq += xv[u] * xv[u]; acc = __builtin_amdgcn_mfma_f32_16x16x4f32(xv[u], wv[u], acc, 0, 0, 0); }
        }
        if (tb + 1 < 8) {
#pragma unroll
            for (int c = 0; c < 8; ++c) cur[c] = nxt[c]; }
    }
    ssq += SHFL_XOR(ssq, 16); ssq += SHFL_XOR(ssq, 32);
    const float rstd = 1.0f / sqrtf(ssq * (1.f / D) + EPS);
#pragma unroll
    for (int r = 0; r < 4; ++r) Cw[(4 * kq + r) * 16 + ri] = acc[r];
    if (lane < 16) {
        const f32x4 l0 = *(const LAS f32x4*)(Cw + lane * 16), l1 = *(const LAS f32x4*)(Cw + lane * 16 + 4);
        const float lg[8] = {l0[0] * rstd, l0[1] * rstd, l0[2] * rstd, l0[3] * rstd, l1[0] * rstd, l1[1] * rstd, l1[2] * rstd, l1[3] * rstd};
        const int row = row0 + lane;
        int e0 = 0; float b0 = lg[0];
#pragma unroll
        for (int e = 1; e < 8; ++e) if (lg[e] > b0) { b0 = lg[e]; e0 = e; }
        int e1 = -1; float b1 = -__builtin_inff();
#pragma unroll
        for (int e = 0; e < 8; ++e) if (e != e0 && lg[e] > b1) { b1 = lg[e]; e1 = e; }
        if (e1 < 0) e1 = (e0 == 0) ? 1 : 0;
        const float w1 = 1.0f / (1.0f + __expf(b0 - b1)), w0 = 1.0f - w1;
        const int r0 = __hip_atomic_fetch_add(lt + LT_LCNT + e0, 1, __ATOMIC_RELAXED, __HIP_MEMORY_SCOPE_WORKGROUP), r1 = __hip_atomic_fetch_add(lt + LT_LCNT + 8 + e1, 1, __ATOMIC_RELAXED, __HIP_MEMORY_SCOPE_WORKGROUP);
        ROUTE[row] = e0 | (e1 << 8); ROUTE[T + row] = r0; ROUTE[2 * T + row] = r1; ((float*)ROUTE)[3 * T + row] = w0; ((float*)ROUTE)[4 * T + row] = w1; ((float*)ROUTE)[5 * T + row] = rstd;
    }
    WG_BAR();
    if (F.tid < 16) WGCNT[F.bx * 16 + F.tid] = lt[LT_LCNT + F.tid];
}
__device__ __forceinline__ void moe_tables(Frame& F, const int* WGCNT) {
    LAS unsigned char* L = F.lds; LAS int* lt = (LAS int*)(L + LTAB_OFF); const int tid = F.tid, c = F.bx;
    WG_BAR();
    { const int g = tid & 15, chn = tid >> 4; int s = 0;
#pragma unroll
      for (int i = 0; i < 8; ++i) s += WGCNT[(8 * chn + i) * 16 + g];
      lt[LT_PART + chn * 16 + g] = s; }
    WG_BAR();
    if (tid < 16) { int run = 0; for (int chn = 0; chn < 32; ++chn) { lt[LT_PRE + chn * 16 + tid] = run; run += lt[LT_PART + chn * 16 + tid]; } lt[LT_TOT + tid] = run; }
    WG_BAR();
    if (tid == 0) { int off = 0;
        for (int g = 0; g < 16; ++g) { const int nt = (lt[LT_TOT + g] + 255) >> 8; lt[LT_CUMT + g] = off >> 8; lt[LT_GOFF + g] = off; for (int t = 0; t < nt; ++t) lt[LT_TAB + (off >> 8) + t] = g & 7; off += nt << 8; }
        lt[LT_CUMT + 16] = off >> 8; }
    WG_BAR();
    if (tid < 16) { int bs = lt[LT_GOFF + tid] + lt[LT_PRE + (c >> 3) * 16 + tid]; for (int w2 = 8 * (c >> 3); w2 < c; ++w2) bs += WGCNT[w2 * 16 + tid]; lt[LT_BASE + tid] = bs; }
    WG_BAR();
}
__device__ __forceinline__ void moe_gather(Frame& F, const unsigned char* XA8, const int* ROUTE, const int* WGCNT, unsigned char* XG8, int* TOK, float* WGT, float* RS) {
    LAS unsigned char* L = F.lds; LAS int* lt = (LAS int*)(L + LTAB_OFF); const int lane = F.lane, c = F.bx;
    int ee[8], ra[8], rb[8]; float wa[8], wb[8], rr[8]; u32x4 xv[8][2];
#define MG_LOAD(i0) do { _Pragma("unroll") for (int k = 0; k < 8; ++k) { const int row = 128 * c + 16 * F.wave + (i0) + k; ee[k] = ROUTE[row]; ra[k] = ROUTE[T + row]; rb[k] = ROUTE[2 * T + row]; \
            wa[k] = ((const float*)ROUTE)[3 * T + row]; wb[k] = ((const float*)ROUTE)[4 * T + row]; rr[k] = ((const float*)ROUTE)[5 * T + row]; \
            const u32x4* src = (const u32x4*)(XA8 + (size_t)row * D) + lane; xv[k][0] = src[0]; xv[k][1] = src[64]; } } while (0)
#define MG_STORE(i0) do { _Pragma("unroll") for (int k = 0; k < 8; ++k) { const int row = 128 * c + 16 * F.wave + (i0) + k; const int e0 = ee[k] & 255, e1 = ee[k] >> 8; \
            const int pos0 = lt[LT_BASE + e0] + ra[k], pos1 = lt[LT_BASE + 8 + e1] + rb[k]; \
            u32x4* d0 = (u32x4*)(XG8 + (size_t)pos0 * D) + lane; u32x4* d1 = (u32x4*)(XG8 + (size_t)pos1 * D) + lane; \
            d0[0] = xv[k][0]; d0[64] = xv[k][1]; d1[0] = xv[k][0]; d1[64] = xv[k][1]; \
            if (lane == 0) { TOK[pos0] = row; TOK[pos1] = row; WGT[pos0] = wa[k]; WGT[pos1] = wb[k]; RS[pos0] = rr[k]; RS[pos1] = rr[k]; } } } while (0)
    MG_LOAD(0);
    moe_tables(F, WGCNT);
    MG_STORE(0);
    MG_LOAD(8);
    MG_STORE(8);
#undef MG_LOAD
#undef MG_STORE
}

#ifndef NEXP_LATE
#define NEXP_LATE 1
#endif
#ifndef NEXP_TAIL
#define NEXP_TAIL 2
#endif
#ifndef NGEMM0
#define NGEMM0 192
#endif
#ifndef INPROJ1_FP8
#define INPROJ1_FP8 0
#endif
#ifndef FFN_DOWN_FP8
#define FFN_DOWN_FP8 0
#endif
#ifndef MOE_DOWN_FP8
#define MOE_DOWN_FP8 1
#endif
#ifndef PROBE_SSQ0
#define PROBE_SSQ0 SSQ_(7)
#endif
#ifndef RES_ALIGN
#define RES_ALIGN false
#endif
enum { I_X = 0, I_P, I_LNMIX, I_WIN, I_WOUT, I_MCW, I_MCB, I_MGB, I_MNG, I_SCW, I_SCB, I_SDTB, I_SALOG, I_SD, I_SNG, I_LNFFN, I_FWG, I_FWU, I_FWD, I_ROUTER, I_MWG, I_MWU, I_MWD, I_LNPLE, I_PPROJ, I_PGATE, I_LNFINAL };

__global__ void __launch_bounds__(NTHR, 2) hybrid_fwd(Args args) {
    extern __shared__ __attribute__((aligned(16))) unsigned char lds_raw[];
    Frame F;
    F.lds = (LAS unsigned char*)lds_raw;
    F.tid = threadIdx.x; F.lane = F.tid & 63; F.wave = __builtin_amdgcn_readfirstlane(F.tid >> 6);
    F.zf = 0.f; F.zu = 0u;
    const int wave0 = F.wave;
    F.bx = blockIdx.x; F.vcu = (F.bx % 8) * (NWG / 8) + F.bx / 8;
    volatile LAS unsigned* MISC = (volatile LAS unsigned*)(F.lds + MISC_OFF);
    for (int u = F.tid; u < 64; u += NTHR) MISC[u] = 0u;
    __syncthreads();
    unsigned* ctl = (unsigned*)(args.ws + WS_CTL);
    XcdBarrier bar = xcd_barrier_post(ctl + CW_BAR, MISC + 8);
    const int lo = args.ph_lo, hi = args.ph_hi; int ph = 0;
#define PHASE_BEGIN if (ph >= lo && ph < hi) { { int w_ = wave0; asm volatile("" : "+s"(w_)); unsigned z_ = 0u; asm volatile("" : "+s"(z_)); int t_ = (int)__builtin_amdgcn_mbcnt_hi(~0u, __builtin_amdgcn_mbcnt_lo(~0u, z_)); asm volatile("" : "+v"(t_)); t_ += w_ * 64; F.tid = t_; F.lane = t_ & 63; F.wave = w_; F.zu = z_; F.zf = __builtin_bit_cast(float, z_); LAS unsigned char* b_ = (LAS unsigned char*)lds_raw; asm volatile("" : "+s"(b_)); F.lds = b_; int x_ = blockIdx.x; asm volatile("" : "+s"(x_)); F.bx = x_; F.vcu = (x_ % 8) * (NWG / 8) + x_ / 8; }
#define REFRESH_TID() do { int w_ = wave0; asm volatile("" : "+s"(w_)); unsigned z_ = 0u; asm volatile("" : "+s"(z_)); int t_ = (int)__builtin_amdgcn_mbcnt_hi(~0u, __builtin_amdgcn_mbcnt_lo(~0u, z_)); asm volatile("" : "+v"(t_)); t_ += w_ * 64; F.tid = t_; F.lane = t_ & 63; F.wave = w_; F.zu = z_; F.zf = __builtin_bit_cast(float, z_); } while (0)
#ifdef PROBE_TS
#define TS_STAMP(idx) do { unsigned zz_ = 0u; asm volatile("" : "+s"(zz_)); const int ll_ = (int)__builtin_amdgcn_mbcnt_hi(~0u, __builtin_amdgcn_mbcnt_lo(~0u, zz_)); if (blockIdx.x == 0 && wave0 == 0 && ll_ == 0) ((LAS unsigned long long*)((LAS unsigned char*)lds_raw + PTAB_OFF + 512))[(idx)] = __builtin_amdgcn_s_memrealtime(); } while (0)
#else
#define TS_STAMP(idx) do {} while (0)
#endif
#define PHASE_END(last) if (!(last) && ph + 1 < hi) xcd_barrier(bar); TS_STAMP(ph + 1); } ++ph;

    if (F.tid == 0) { LAS unsigned long long* pt = (LAS unsigned long long*)(F.lds + PTAB_OFF);
#pragma unroll
        for (int i = 0; i < 27; ++i) pt[i] = (unsigned long long)(uintptr_t)args.in[i];
        pt[27] = (unsigned long long)(uintptr_t)args.out; pt[28] = (unsigned long long)(uintptr_t)args.ws; }
    __syncthreads();
    TS_STAMP(0);
#define PTR_(i) ld_ptr(F.lds, (i))
#define IN_(i) ((const float*)PTR_(i))
#define X_ ((float*)PTR_(27))
#define WSB_(off) (PTR_(28) + (off))
#define WIN ((bf16_t*)WSB_(WS_WIN))
#define WOUT ((bf16_t*)WSB_(WS_WOUT))
#define FGU ((bf16_t*)WSB_(WS_FGU))
#define FD ((bf16_t*)WSB_(WS_FD))
#define MGU ((bf16_t*)WSB_(WS_MGU))
#define MD ((bf16_t*)WSB_(WS_MD))
#define PG ((bf16_t*)WSB_(WS_PG))
#define PP ((bf16_t*)WSB_(WS_PP))
#define XN ((bf16_t*)WSB_(WS_XN))
#define P16 ((bf16_t*)WSB_(WS_P16))
#define U ((bf16_t*)WSB_(WS_U))
#define MIX ((bf16_t*)WSB_(WS_MIX))
#define CVB ((bf16_t*)WSB_(WS_CV))
#define H ((bf16_t*)WSB_(WS_H))
#define XBB ((bf16_t*)WSB_(WS_XBB))
#define XA8 ((unsigned char*)WSB_(WS_XA8))
#define XB8 ((unsigned char*)WSB_(WS_CV))
#define SSQ_(i) ((pg8::ssq_t*)WSB_(WS_SSQ) + (size_t)(i) * T)
#define RS ((float*)WSB_(WS_WGT + 512 * 1024))
#define XG ((bf16_t*)WSB_(WS_XG))
#define HM ((bf16_t*)WSB_(WS_HM))
#define SSQM ((float*)WSB_(WS_SSQM))
#define SSQS ((float*)WSB_(WS_SSQS))
#define KMEAN ((float*)WSB_(WS_KMEAN))
#define ROUTE ((int*)WSB_(WS_ROUTE))
#define TOK ((int*)WSB_(WS_TOK))
#define WGT ((float*)WSB_(WS_WGT))
#define WGCNT ((int*)WSB_(WS_WGCNT))
    PHASE_BEGIN
    {
        LAS float* scr = (LAS float*)(F.lds + RING_OFF + F.wave * XP_SCR); const int gw = F.vcu * NWAVES + F.wave, NGW = NWG * NWAVES;
        {   const float* W = IN_(I_WIN); bf16_t* WT = WIN; const int nblk = NU / 64, items = (D / 64) * nblk;
            for (int it = gw; it < items; it += NGW) { const int kb = it / nblk, nb = it % nblk; xpose_item<false>(W, DPROJ_SRC, win_srccol(nb * 64 + 4 * (F.lane & 15)), kb * 64, WT, D, nb * 64, scr, F.lane, IN_(I_LNMIX), F.zf); } }
        {
            const float* xs = IN_(I_X); bf16_t* xb = XBB; pg8::ssq_t* sq = SSQ_(0); f32x4 v[8];
            for (int m = gw; m < T; m += NGW) { (void)load_row_ssq(F, xs + (size_t)m * D, v); float s = 0.f;
#pragma unroll
                for (int j = 0; j < 8; ++j) { u32x2 w; w.x = pk2(v[j].x, v[j].y); w.y = pk2(v[j].z, v[j].w); ((u32x2*)(xb + (size_t)m * D) + F.lane)[64 * j] = w;
                    const float a = bflo(w.x), b = bfhi(w.x), c = bflo(w.y), d = bfhi(w.y); s += (a * a + b * b) + (c * c + d * d); }
                s = wave_sum(s);
                if (F.lane == 0) sq[m] = (pg8::ssq_t)(s * pg8::SSQ_SCALE + 0.5f); }
        }
    }
    PHASE_END(false)
    PHASE_BEGIN
    if (F.bx < NGEMM0) {
        pg8::StaticOrder S; S.init(T, NU, NGEMM0, F.bx); pg8::EpiBf16 E{U, NU, SSQ_(0), 1.0f, (LAS float*)(F.lds + RING_BYTES), (volatile LAS unsigned*)(F.lds + MISC_OFF) + 24, 0x20000u};
        pg8::Gemm g{XBB, WIN, D, D, D, 0}; pg8::gemm_phase<pg8::EpiBf16, pg8::StaticOrder, true>(F.lds + RING_OFF, g, S, E, F.tid);
        REFRESH_TID();
        { LAS float* scr = (LAS float*)(F.lds + RING_OFF + F.wave * XP_SCR); const int gw = F.bx * NWAVES + F.wave, NGW = NGEMM0 * NWAVES;
          for (int e = NEXP - NEXP_TAIL; e < NEXP; ++e) {
            if (e < NEXP - NEXP_LATE) xpose_gu(F, IN_(I_MWG) + (size_t)e * D * DFFE, IN_(I_MWU) + (size_t)e * D * DFFE, D, DFFE, MGU + (size_t)e * 2 * DFFE * (D / 2), scr, gw, NGW, IN_(I_LNFFN) + D);
            xpose_plain<MOE_DOWN_FP8 != 0>(F, IN_(I_MWD) + (size_t)e * DFFE * D, DFFE, D, MD + (size_t)e * D * (MOE_DOWN_FP8 ? DFFE / 2 : DFFE), scr, gw, NGW, nullptr); } }
    } else {
        LAS float* scr = (LAS float*)(F.lds + RING_OFF + F.wave * XP_SCR); const int gw = (F.bx - NGEMM0) * NWAVES + F.wave, NGW = (NWG - NGEMM0) * NWAVES;
        for (int l = 0; l < DEPTH; ++l) {
            if (l == 1) {
                const float* W = IN_(I_WIN) + (size_t)l * D * DPROJ_SRC; bf16_t* WT = WIN + (size_t)l * NU * D;
                const int nblk = NU / 64, items = (D / 64) * nblk;
                for (int it = gw; it < items; it += NGW) { const int kb = it / nblk, nb = it % nblk; xpose_item<INPROJ1_FP8 != 0>(W, DPROJ_SRC, win_srccol(nb * 64 + 4 * (F.lane & 15)), kb * 64, WT, D, nb * 64, scr, F.lane, IN_(I_LNMIX) + (size_t)l * D, F.zf); }
            }
            xpose_plain(F, IN_(I_WOUT) + (size_t)l * D * D, D, D, WOUT + (size_t)l * D * D, scr, gw, NGW, nullptr);
            xpose_plain<true>(F, IN_(I_PGATE) + (size_t)l * D * D, D, D, PG + (size_t)l * D * (D / 2), scr, gw, NGW, IN_(I_LNPLE) + (size_t)l * D);
            xpose_plain(F, IN_(I_PPROJ) + (size_t)l * PLE * D, PLE, D, PP + (size_t)l * D * PLE, scr, gw, NGW, nullptr);
        }
        xpose_gu(F, IN_(I_FWG), IN_(I_FWU), D, DFF, FGU, scr, gw, NGW, IN_(I_LNFFN));
        xpose_plain<FFN_DOWN_FP8 != 0>(F, IN_(I_FWD), DFF, D, FD, scr, gw, NGW, nullptr);
        {
            const f32x4* ps = (const f32x4*)IN_(I_P); u32x2* pd = (u32x2*)P16; const size_t n4 = (size_t)DEPTH * T * PLE / 4, st = (size_t)(NWG - NGEMM0) * NTHR;
            for (size_t i = (size_t)(F.bx - NGEMM0) * NTHR + F.tid; i < n4; i += 8 * st) { f32x4 v[8];
#pragma unroll
                for (int k = 0; k < 8; ++k) if (i + k * st < n4) v[k] = ps[i + k * st];
#pragma unroll
                for (int k = 0; k < 8; ++k) if (i + k * st < n4) { u32x2 o; o.x = pk2(v[k].x, v[k].y); o.y = pk2(v[k].z, v[k].w); pd[i + k * st] = o; } }
        }
        for (int e = 0; e < NEXP - NEXP_TAIL; ++e) {
            xpose_gu(F, IN_(I_MWG) + (size_t)e * D * DFFE, IN_(I_MWU) + (size_t)e * D * DFFE, D, DFFE, MGU + (size_t)e * 2 * DFFE * (D / 2), scr, gw, NGW, IN_(I_LNFFN) + D);
            xpose_plain<MOE_DOWN_FP8 != 0>(F, IN_(I_MWD) + (size_t)e * DFFE * D, DFFE, D, MD + (size_t)e * D * (MOE_DOWN_FP8 ? DFFE / 2 : DFFE), scr, gw, NGW, nullptr);
        }
    }
    PHASE_END(false)

    for (int l = 0; l < DEPTH; ++l) {
        if (l > 0) {
        PHASE_BEGIN
        if (INPROJ1_FP8 && l == 1) { REFRESH_TID(); pg8::StaticOrder S; S.init(T, NU, NWG, F.bx); pg8::EpiBf16 E{U, NU, SSQ_(3 * l), W8_INV, nullptr, nullptr, 0u};
            pg8::Gemm g{(const bf16_t*)XB8, WIN + (size_t)l * NU * D, D / 2, D / 2, D / 2, 0}; pg8::gemm_phase<pg8::EpiBf16, pg8::StaticOrder, true, true>(F.lds + RING_OFF, g, S, E, F.tid); }
        else { REFRESH_TID(); pg8::StaticOrder S; S.init(T, NU, NWG, F.bx); pg8::EpiBf16 E{U, NU, SSQ_(3 * l), 1.0f, (LAS float*)(F.lds + RING_BYTES), (volatile LAS unsigned*)(F.lds + MISC_OFF) + 24, 0x30000u};
            pg8::Gemm g{XBB, WIN + (size_t)l * NU * D, D, D, D, 0}; pg8::gemm_phase<pg8::EpiBf16, pg8::StaticOrder, true>(F.lds + RING_OFF, g, S, E, F.tid); }
        REFRESH_TID();
        { constexpr int IP1_REM = ((T / 256) * (NU / 256)) % NWG;
          if (NEXP_LATE > 0 && IP1_REM > 0 && F.bx >= IP1_REM) { LAS float* scr = (LAS float*)(F.lds + RING_OFF + F.wave * XP_SCR); const int gw = (F.bx - IP1_REM) * NWAVES + F.wave, NGW = (NWG - IP1_REM) * NWAVES;
            for (int e = NEXP - NEXP_LATE; e < NEXP; ++e)
              xpose_gu(F, IN_(I_MWG) + (size_t)e * D * DFFE, IN_(I_MWU) + (size_t)e * D * DFFE, D, DFFE, MGU + (size_t)e * 2 * DFFE * (D / 2), scr, gw, NGW, IN_(I_LNFFN) + D); } }
        PHASE_END(false)
        }
        PHASE_BEGIN
        {
            conv_phase(F, U, CVB, IN_(I_MCW) + (size_t)l * 4 * 1024, IN_(I_MCB) + (size_t)l * 1024, IN_(I_SCW) + (size_t)l * 4 * 1536, IN_(I_SCB) + (size_t)l * 1536);
            REFRESH_TID();
            kmean_items(F, U, KMEAN);
        }
        PHASE_END(false)
        PHASE_BEGIN
        {
            for (int u = F.vcu; u < NB * 16; u += NWG)
                ssd_unit(F, u >> 4, u & 15, U, CVB, MIX, SSQS, IN_(I_SDTB) + l * 16, IN_(I_SALOG) + l * 16, IN_(I_SD) + l * 16);
#ifdef PROBE_SSD2
            if (l == 0) { REFRESH_TID(); for (int u = F.vcu; u < NB * 16; u += NWG)
                ssd_unit(F, u >> 4, u & 15, U, CVB, MIX, SSQS, IN_(I_SDTB) + l * 16, IN_(I_SALOG) + l * 16, IN_(I_SD) + l * 16); REFRESH_TID(); }
#endif
            for (int u = F.vcu; u < NB * 16; u += NWG)
                mlstm_unit(F, u >> 4, (u >> 2) & 3, u & 3, U, CVB, MIX, SSQM, IN_(I_MGB) + l * 8);
        }
        PHASE_END(false)
        PHASE_BEGIN
        {
            for (int u = F.vcu; u < NB * 4 * 4; u += NWG) { const int bh = u >> 2, s = u & 3;
                moba_unit(F, bh >> 2, bh & 3, 7 - s, U, MIX, KMEAN); moba_unit(F, bh >> 2, bh & 3, s, U, MIX, KMEAN); }
            REFRESH_TID();
            mixnorm_rows(F, U, MIX, SSQM, SSQS, IN_(I_MNG) + (size_t)l * 512, IN_(I_SNG) + (size_t)l * 1024);
        }
        PHASE_END(false)
        PHASE_BEGIN
        { pg8::Gemm g{MIX, WOUT + (size_t)l * D * D, D, D, D, 0}; pg8::StaticOrder S; S.init(T, D, NWG, F.bx); STAGGER(920);
#ifdef PROBE_OUT2
          { pg8::EpiResidualStat E0{XBB, XN, XA8, PROBE_SSQ0, D, 0.5f}; pg8::gemm_phase<pg8::EpiResidualStat, pg8::StaticOrder, RES_ALIGN>(F.lds + RING_OFF, g, S, E0, F.tid); }
          xcd_barrier(bar);
          pg8::EpiResidualStat E{XN, XN, XA8, SSQ_(3 * l + 1), D, 0.5f};
#else
          pg8::EpiResidualStat E{XBB, XN, XA8, SSQ_(3 * l + 1), D, 1.0f};
#endif
          pg8::gemm_phase<pg8::EpiResidualStat, pg8::StaticOrder, RES_ALIGN>(F.lds + RING_OFF, g, S, E, F.tid); }
        PHASE_END(false)
        if (l == 0) {
            PHASE_BEGIN
            { pg8::Gemm g{(const bf16_t*)XA8, FGU, D / 2, D / 2, D / 2, 0}; pg8::StaticOrder S; S.init(T, 2 * DFF, NWG, F.bx); pg8::EpiSwiGLU<FFN_DOWN_FP8 != 0> E{H, DFF, nullptr, 0, SSQ_(3 * l + 1), nullptr, W8_INV, nullptr, nullptr};
              pg8::gemm_phase<pg8::EpiSwiGLU<FFN_DOWN_FP8 != 0>, pg8::StaticOrder, true, true>(F.lds + RING_OFF, g, S, E, F.tid); }
            PHASE_END(false)
            PHASE_BEGIN
            { constexpr int KD = FFN_DOWN_FP8 ? DFF / 2 : DFF; pg8::Gemm g{H, FD, KD, KD, KD, 0}; pg8::StaticOrder S; S.init(T, D, NWG, F.bx); pg8::EpiResidualStat E{XN, XN, XA8, SSQ_(3 * l + 2), D, FFN_DOWN_FP8 ? W8_INV * H8_INV : 1.0f};
              pg8::gemm_phase<pg8::EpiResidualStat, pg8::StaticOrder, RES_ALIGN, FFN_DOWN_FP8 != 0>(F.lds + RING_OFF, g, S, E, F.tid); }
            REFRESH_TID();
            { pg8::Gemm g{P16 + (size_t)l * T * PLE, PP + (size_t)l * D * PLE, PLE, PLE, PLE, 0}; pg8::StaticOrder S; S.init(T, D, NWG, F.bx); pg8::EpiBf16 E{(bf16_t*)WSB_(WS_PPB0), D, nullptr, 1.0f, nullptr, nullptr, 0u};
              pg8::gemm_phase<pg8::EpiBf16, pg8::StaticOrder, true>(F.lds + RING_OFF, g, S, E, F.tid); }
            PHASE_END(false)
        } else {
            PHASE_BEGIN
            moe_route(F, XN, IN_(I_LNFFN) + (size_t)l * D, IN_(I_ROUTER), ROUTE, WGCNT, TOK);
            PHASE_END(false)
            PHASE_BEGIN
            moe_gather(F, XA8, ROUTE, WGCNT, (unsigned char*)XG, TOK, WGT, RS);
            PHASE_END(false)
            {
                const LAS int* lt = (const LAS int*)(F.lds + LTAB_OFF);
                PHASE_BEGIN
                { const int rtb = lt[LT_CUMT + 8], rtc = lt[LT_CUMT + 16];
                  const int r0 = ((rtb - lt[LT_CUMT]) * (D / 256)) % NWG, nl = r0 > 0 ? NWG - r0 : 0, n1 = (rtc - rtb) * (2 * DFFE / 256), nu = rtc * (2 * DFFE / 256), ndmax = 3 * nl < n1 ? 3 * nl : n1, drem = (nu - ndmax) % NWG, ndtry = ndmax - ((NWG - drem) % NWG), ndef = ndtry >= 0 ? ndtry : ndmax;
                  pg8::Gemm g{XG, MGU, D / 2, D / 2, D / 2, (size_t)2 * DFFE * (D / 2)}; pg8::MoeOrderGU S{rtb, rtc, 2 * DFFE / 256, NWG, F.bx, 0, nu - ndef, lt + LT_TAB}; pg8::EpiSwiGLU<MOE_DOWN_FP8 != 0> E{HM, DFFE, WGT, 0, nullptr, RS, W8_INV, (LAS float*)(F.lds + RING_BYTES), (volatile LAS unsigned*)(F.lds + MISC_OFF) + 24};
                  pg8::gemm_phase<pg8::EpiSwiGLU<MOE_DOWN_FP8 != 0>, pg8::MoeOrderGU, true, true>(F.lds + RING_OFF, g, S, E, F.tid);
                }
                PHASE_END(false)
            }
            for (int slot = 0; slot < 2; ++slot) {
                const LAS int* lt = (const LAS int*)(F.lds + LTAB_OFF);
                PHASE_BEGIN
                { const int rt0 = lt[LT_CUMT + 8 * slot], rt1 = lt[LT_CUMT + 8 * slot + 8];
                  constexpr int KM = MOE_DOWN_FP8 ? DFFE / 2 : DFFE; pg8::Gemm g{HM, MD, KM, KM, KM, (size_t)D * KM}; pg8::MoeOrder S{rt0, rt1 - rt0, D / 256, NWG, F.bx, lt + LT_TAB};
                  #ifdef PROBE_MOEDOWN2
                  { pg8::EpiScatter<false> E0{XN, D, TOK, nullptr, nullptr, 0.5f * (MOE_DOWN_FP8 ? W8_INV * H8_INV : 1.0f)}; pg8::gemm_phase<pg8::EpiScatter<false>, pg8::MoeOrder, RES_ALIGN, MOE_DOWN_FP8 != 0>(F.lds + RING_OFF, g, S, E0, F.tid); } xcd_barrier(bar);
                  const float al_ = 0.5f * (MOE_DOWN_FP8 ? W8_INV * H8_INV : 1.0f);
#else
                  const float al_ = MOE_DOWN_FP8 ? W8_INV * H8_INV : 1.0f;
#endif
                  if (slot == 0) { pg8::EpiScatter<false> E{XN, D, TOK, nullptr, nullptr, al_}; pg8::gemm_phase<pg8::EpiScatter<false>, pg8::MoeOrder, RES_ALIGN, MOE_DOWN_FP8 != 0>(F.lds + RING_OFF, g, S, E, F.tid);
                    REFRESH_TID();
                    const int rtb = lt[LT_CUMT + 8], rtc = lt[LT_CUMT + 16];
                    const int r0 = ((rtb - lt[LT_CUMT]) * (D / 256)) % NWG, nl = r0 > 0 ? NWG - r0 : 0, n1 = (rtc - rtb) * (2 * DFFE / 256), nu = rtc * (2 * DFFE / 256), ndmax = 3 * nl < n1 ? 3 * nl : n1, drem = (nu - ndmax) % NWG, ndtry = ndmax - ((NWG - drem) % NWG), ndef = ndtry >= 0 ? ndtry : ndmax;
                    if (ndef > 0 && F.bx >= r0) { pg8::Gemm g3{XG, MGU, D / 2, D / 2, D / 2, (size_t)2 * DFFE * (D / 2)}; pg8::MoeOrderGU S3{rtb, rtc, 2 * DFFE / 256, nl, F.bx - r0, nu - ndef, nu, lt + LT_TAB}; pg8::EpiSwiGLU<MOE_DOWN_FP8 != 0> E3{HM, DFFE, WGT, 0, nullptr, RS, W8_INV, (LAS float*)(F.lds + RING_BYTES), (volatile LAS unsigned*)(F.lds + MISC_OFF) + 24};
                      pg8::gemm_phase<pg8::EpiSwiGLU<MOE_DOWN_FP8 != 0>, pg8::MoeOrderGU, true, true>(F.lds + RING_OFF, g3, S3, E3, F.tid); } }
                  else { pg8::EpiScatter<true> E{XN, D, TOK, XA8, SSQ_(3 * l + 2), al_}; pg8::gemm_phase<pg8::EpiScatter<true>, pg8::MoeOrder, RES_ALIGN, MOE_DOWN_FP8 != 0>(F.lds + RING_OFF, g, S, E, F.tid);
                    REFRESH_TID();
                    const int rem = ((rt1 - rt0) * (D / 256)) % NWG;
                    if (F.bx >= rem) { pg8::Gemm g2{P16 + (size_t)l * T * PLE, PP + (size_t)l * D * PLE, PLE, PLE, PLE, 0}; pg8::StaticOrder S2; S2.init(T, D, NWG - rem, F.bx - rem); pg8::EpiBf16 E2{(bf16_t*)WSB_(WS_PPB1), D, nullptr, 1.0f, nullptr, nullptr, 0u};
                      pg8::gemm_phase<pg8::EpiBf16, pg8::StaticOrder, true>(F.lds + RING_OFF, g2, S2, E2, F.tid); } } }
                PHASE_END(false)
            }
        }
        PHASE_BEGIN
        { pg8::Gemm g{(const bf16_t*)XA8, PG + (size_t)l * D * (D / 2), D / 2, D / 2, D / 2, 0}; pg8::StaticOrder S; S.init(T, D, NWG, F.bx); pg8::EpiPleGate E{XN, XBB, (const bf16_t*)WSB_(l == 0 ? WS_PPB0 : WS_PPB1), D, SSQ_(3 * l + 2), SSQ_(3 * l + 3), W8_INV, (INPROJ1_FP8 && l == 0) ? XB8 : nullptr};
          pg8::gemm_phase<pg8::EpiPleGate, pg8::StaticOrder, RES_ALIGN, true>(F.lds + RING_OFF, g, S, E, F.tid); }
        PHASE_END(false)
    }
    PHASE_BEGIN
    {
        const float* g = IN_(I_LNFINAL); float* X = X_; const bf16_t* xs = XBB; const pg8::ssq_t* sq = SSQ_(6); const int gw = F.vcu * NWAVES + F.wave, NGW = NWG * NWAVES;
        for (int m0 = gw; m0 < T; m0 += 2 * NGW) {
            u32x2 w[2][8]; float rstd[2];
#pragma unroll
            for (int k = 0; k < 2; ++k) { const int m = m0 + k * NGW; rstd[k] = pg8::ssq_rstd(sq, m); const u32x2* xr = (const u32x2*)(xs + (size_t)m * D) + F.lane;
#pragma unroll
                for (int j = 0; j < 8; ++j) w[k][j] = xr[64 * j]; }
#pragma unroll
            for (int k = 0; k < 2; ++k) { const int m = m0 + k * NGW; f32x4* orow = (f32x4*)(X + (size_t)m * D) + F.lane;
#pragma unroll
                for (int j = 0; j < 8; ++j) { const f32x4 gg = ((const f32x4*)g + F.lane)[64 * j]; f32x4 o; o.x = bflo(w[k][j].x) * rstd[k] * gg.x; o.y = bfhi(w[k][j].x) * rstd[k] * gg.y; o.z = bflo(w[k][j].y) * rstd[k] * gg.z; o.w = bfhi(w[k][j].y) * rstd[k] * gg.w; orow[64 * j] = o; } }
        }
    }
#ifdef PROBE_ML
    REFRESH_TID();
    if (ph >= lo && ph < hi && blockIdx.x == 0 && F.tid == 0) {
        asm volatile("s_waitcnt vmcnt(0)" ::: "memory");
        const unsigned long long* dg = (const unsigned long long*)(args.ws + 2883584);
        const unsigned long long d1 = dg[PROBE_I1], d2 = dg[PROBE_I2];
        X_[0] += 2.0f + (float)d1 * (1.0f / 4000.0f);
        const unsigned long long tgt = __builtin_amdgcn_s_memrealtime() + 8ull * d2;
        while (__builtin_amdgcn_s_memrealtime() < tgt) __builtin_amdgcn_s_sleep(32);
    }
#endif
#ifdef PROBE_TS
    REFRESH_TID();
    if (ph >= lo && ph < hi && blockIdx.x == 0 && F.tid == 0) {
        const LAS unsigned long long* ts = (const LAS unsigned long long*)((LAS unsigned char*)lds_raw + PTAB_OFF + 512);
        const unsigned long long dA = (PROBE_PA == 20 ? __builtin_amdgcn_s_memrealtime() : ts[PROBE_PA + 1]) - ts[PROBE_PA], dB = ts[PROBE_PB + 1] - ts[PROBE_PB];
        asm volatile("s_waitcnt vmcnt(0)" ::: "memory");
        X_[0] += 2.0f + (float)dB * (1.0f / 2000.0f);
        const unsigned long long tgt = __builtin_amdgcn_s_memrealtime() + 8ull * dA;
        while (__builtin_amdgcn_s_memrealtime() < tgt) __builtin_amdgcn_s_sleep(32);
    }
#endif
    PHASE_END(true)
#undef PHASE_BEGIN
#undef PHASE_END
}

extern "C" void kernel_launch(void* const* d_in, const int* in_sizes, int n_in, void* d_out, int out_size, void* d_ws, size_t ws_size, hipStream_t stream) {
    static int grid = 0;
    if (grid == 0) {
        if (n_in != 27 || out_size != T * D || ws_size < WS_END) { fprintf(stderr, "kernel_launch: unexpected shapes (n_in %d, out %d, ws %zu < %zu)\n", n_in, out_size, ws_size, (size_t)WS_END); grid = -1; return; }
        int dev = 0, cus = 0, per_cu = 0;
        if (hipGetDevice(&dev) != hipSuccess || hipDeviceGetAttribute(&cus, hipDeviceAttributeMultiprocessorCount, dev) != hipSuccess) { grid = -1; return; }
        if (hipFuncSetAttribute((const void*)hybrid_fwd, hipFuncAttributeMaxDynamicSharedMemorySize, LDS_BYTES) != hipSuccess) { fprintf(stderr, "kernel_launch: hipFuncSetAttribute failed\n"); grid = -1; return; }
        if (hipOccupancyMaxActiveBlocksPerMultiprocessor(&per_cu, (const void*)hybrid_fwd, NTHR, LDS_BYTES) != hipSuccess || per_cu < 1) fprintf(stderr, "kernel_launch: occupancy query reports %d\n", per_cu);
        (void)hipGetLastError();
        if (cus != 256) { fprintf(stderr, "kernel_launch: built for 256 CUs, device has %d\n", cus); grid = -1; return; }
        grid = cus;
    }
    if (grid < 0) return;
    if (hipMemsetAsync((char*)d_ws + WS_CTL, 0, CTL_ZERO_BYTES, stream) != hipSuccess) return;
    Args a{};
    for (int i = 0; i < 27; ++i) a.in[i] = (const float*)d_in[i];
    a.out = (float*)d_out; a.ws = (unsigned char*)d_ws;
#ifndef MK_SPLIT
    a.ph_lo = 0; a.ph_hi = 1000;
    hipLaunchKernelGGL(hybrid_fwd, dim3(NWG), dim3(NTHR), LDS_BYTES, stream, a);
#else
    for (int p = 0; p < 40; ++p) { a.ph_lo = p; a.ph_hi = p + 1; hipLaunchKernelGGL(hybrid_fwd, dim3(NWG), dim3(NTHR), LDS_BYTES, stream, a); }
#endif
}
```

```cpp
#define FFN_DOWN_FP8 1
#include <hip/hip_runtime.h>
#include <cstdio>
#include <cstdint>

#define GAS __attribute__((address_space(1)))
#define LAS __attribute__((address_space(3)))
typedef unsigned short bf16_t;
typedef short bf16x8 __attribute__((ext_vector_type(8)));
typedef short s16x4 __attribute__((ext_vector_type(4)));
typedef float f32x4 __attribute__((ext_vector_type(4)));
typedef float f32x2 __attribute__((ext_vector_type(2)));
typedef unsigned u32x4 __attribute__((ext_vector_type(4)));
typedef unsigned u32x2 __attribute__((ext_vector_type(2)));
typedef __bf16 bf16x2_t __attribute__((ext_vector_type(2)));

__device__ __forceinline__ unsigned pk2(float lo, float hi) { f32x2 v = {lo, hi}; bf16x2_t b = __builtin_convertvector(v, bf16x2_t); return __builtin_bit_cast(unsigned, b); }
__device__ __forceinline__ float bflo(unsigned w) { return __builtin_bit_cast(float, w << 16); }
__device__ __forceinline__ float bfhi(unsigned w) { return __builtin_bit_cast(float, w & 0xffff0000u); }
__device__ __forceinline__ float bf1(bf16_t h) { return __builtin_bit_cast(float, ((unsigned)h) << 16); }
__device__ __forceinline__ bf16_t f2bf(float f) { return (bf16_t)(pk2(f, 0.f) & 0xffffu); }
__device__ __forceinline__ float fast_exp(float x) { return __builtin_amdgcn_exp2f(x * 1.4426950408889634f); }
__device__ __forceinline__ float sigmoidf_(float x) { return __builtin_amdgcn_rcpf(1.0f + fast_exp(-x)); }
__device__ __forceinline__ float siluf_(float x) { return x * sigmoidf_(x); }
typedef int i32x8 __attribute__((ext_vector_type(8)));
__device__ __forceinline__ unsigned pk4_fp8(float a, float b, float c, float d) { int w; asm("" : "=v"(w)); w = __builtin_amdgcn_cvt_pk_fp8_f32(a, b, w, false); w = __builtin_amdgcn_cvt_pk_fp8_f32(c, d, w, true); return (unsigned)w; }
constexpr float W8_SCALE = 32.0f, W8_INV = 1.0f / 32.0f, H8_SCALE = 4.0f, H8_INV = 0.25f;

namespace pg8 {
constexpr int BM = 256, BK = 64, HALF = 128, HTB = HALF * BK * 2  , STAGE_BYTES = 8 * HTB, NXCD = 8, WGM = 8;

__host__ __device__ __forceinline__ int lds_byte(int r, int c) { const int st = (r >> 4) * 2 + (c >> 5), rr = r & 15, cc = c & 31, ob = rr * 64 + cc * 2; return st * 1024 + (ob ^ (((ob >> 9) & 1) << 5)); }
__host__ __device__ __forceinline__ void stage_rc(int b, int& R, int& C) { const int st = b / 1024, sb = b % 1024, swz = sb ^ (((sb >> 9) & 1) << 5); R = (st >> 1) * 16 + swz / 64; C = (st & 1) * 32 + (swz % 64) / 2; }
__host__ __device__ __forceinline__ int perm32(int rho) { const int n = rho >> 4, i = rho & 15; return 8 * (i >> 2) + 4 * n + (i & 3); }

struct Unit { int pm, pn, e; };
struct Gemm { const bf16_t* A; const bf16_t* Bt; int lda, ldb, K; size_t estride; };

struct StaticOrder {
    int nM, nN, nwg, G, c;
    __device__ void init(int M, int N, int G_, int c_) { nM = M / BM; nN = N / BM; nwg = nM * nN; G = G_; c = c_; }
    __device__ bool next(int i, Unit& u) const {
        const long L = (long)i * G + c; if (L >= nwg) return false;
        int wgid = (int)L; { const int q = nwg / NXCD, r = nwg % NXCD, xcd = wgid % NXCD, off = wgid / NXCD; wgid = (xcd < r ? xcd * (q + 1) : r * (q + 1) + (xcd - r) * q) + off; }
        const int nig = WGM * nN, gid = wgid / nig, fm = gid * WGM, gsz = (nM - fm) < WGM ? (nM - fm) : WGM;
        u.pm = fm + ((wgid % nig) % gsz); u.pn = (wgid % nig) / gsz; u.e = 0; return true;
    }
};
struct MoeOrder {
    int rt0, nrt, nN, G, c; const LAS int* tab;
    __device__ bool next(int i, Unit& u) const {
        const int nwg = nrt * nN; const long L = (long)i * G + c; if (L >= nwg) return false;
        int wgid = (int)L; { const int q = nwg / NXCD, r = nwg % NXCD, xcd = wgid % NXCD, off = wgid / NXCD; wgid = (xcd < r ? xcd * (q + 1) : r * (q + 1) + (xcd - r) * q) + off; }
        const int nig = WGM * nN, gid = wgid / nig, fm = gid * WGM, gsz = (nrt - fm) < WGM ? (nrt - fm) : WGM;
        u.pm = rt0 + fm + ((wgid % nig) % gsz); u.pn = (wgid % nig) / gsz; u.e = tab[u.pm]; return true;
    }
};

struct MoeOrderGU {
    int rtb, rtc, nN, G, c, L0, Lend; const LAS int* tab;
    __device__ bool next(int i, Unit& u) const {
        const int L = L0 + i * G + c; if (L >= Lend || c < 0) return false;
        const int n0 = rtb * nN; int j, nrt, rt0; if (L < n0) { j = L; nrt = rtb; rt0 = 0; } else { j = L - n0; nrt = rtc - rtb; rt0 = rtb; }
        const int nwg = nrt * nN; { const int q = nwg / NXCD, r = nwg % NXCD, xcd = j % NXCD, off = j / NXCD; j = (xcd < r ? xcd * (q + 1) : r * (q + 1) + (xcd - r) * q) + off; }
        const int nig = WGM * nN, gid = j / nig, fm = gid * WGM, gsz = (nrt - fm) < WGM ? (nrt - fm) : WGM;
        u.pm = rt0 + fm + ((j % nig) % gsz); u.pn = (j % nig) / gsz; u.e = tab[u.pm]; return true;
    }
};


__device__ __forceinline__ float epi_shfl(float v, int src) { return __builtin_bit_cast(float, __builtin_amdgcn_ds_bpermute(src << 2, __builtin_bit_cast(int, v))); }
constexpr float RMS_EPS = 1e-6f, INV_D = 1.0f / 2048.0f, SSQ_SCALE = 16777216.0f, SSQ_INV = INV_D / 16777216.0f;
typedef unsigned long long ssq_t;
__device__ __forceinline__ float ssq_rstd(const ssq_t* p, int row) { return __builtin_amdgcn_rsqf((float)p[row] * SSQ_INV + RMS_EPS); }
__device__ __forceinline__ void ssq_add(ssq_t* p, int row, float q) { __hip_atomic_fetch_add(p + row, (ssq_t)(q * SSQ_SCALE + 0.5f), __ATOMIC_RELAXED, __HIP_MEMORY_SCOPE_AGENT); }
struct EpiBf16 {
    static constexpr bool PERM = true;
    bf16_t* O; int ldc; const ssq_t* ssq; float wscale; LAS float* cch; volatile LAS unsigned* ctag; unsigned tagbase;
    __device__ __forceinline__ void operator()(const f32x4 (&acc)[2][2][4][2], const Unit& u, int wr, int wc, int fr, int fq) const {
        const int row0 = u.pm * BM + wr * 64 + fr, col0 = u.pn * BM + wc * 32 + 8 * fq;
        float sv[2][4];
        if (cch && ssq) { const int wid = wr * 4 + wc; LAS float* my = cch + wid * 256;
            const unsigned tg = (unsigned)__builtin_amdgcn_readfirstlane((int)ctag[wid]), want = tagbase + (unsigned)(u.pm + 1);
            if (tg != want) {
#pragma unroll
                for (int ai = 0; ai < 2; ++ai)
#pragma unroll
                    for (int m = 0; m < 4; ++m) { const float r = ssq_rstd(ssq, row0 + ai * HALF + m * 16); if (fq == 0) my[(ai * 4 + m) * 16 + fr] = r; }
                if (fq == 0 && fr == 0) ctag[wid] = want; }
#pragma unroll
            for (int ai = 0; ai < 2; ++ai)
#pragma unroll
                for (int m = 0; m < 4; ++m) sv[ai][m] = my[(ai * 4 + m) * 16 + fr]; }
        else {
#pragma unroll
            for (int ai = 0; ai < 2; ++ai)
#pragma unroll
                for (int m = 0; m < 4; ++m) sv[ai][m] = ssq ? ssq_rstd(ssq, row0 + ai * HALF + m * 16) : 1.0f; }
#pragma unroll
        for (int ai = 0; ai < 2; ++ai)
#pragma unroll
            for (int m = 0; m < 4; ++m) { const int row = row0 + ai * HALF + m * 16; const float s = sv[ai][m] * wscale;
                bf16_t* rowp = O + (size_t)row * ldc + col0;
#pragma unroll
                for (int bj = 0; bj < 2; ++bj) { const f32x4 v0 = acc[ai][bj][m][0] * s, v1 = acc[ai][bj][m][1] * s;
                    u32x4 w; w.x = pk2(v0[0], v0[1]); w.y = pk2(v0[2], v0[3]); w.z = pk2(v1[0], v1[1]); w.w = pk2(v1[2], v1[3]);
                    *(u32x4*)(rowp + bj * HALF) = w; } }
    }
};
template <bool OUT8> struct EpiSwiGLU {
    static constexpr bool PERM = true;
    bf16_t* H; int ldc; const float* wgt; int rt0; const ssq_t* ssq; const float* rs; float wscale;
    LAS float* cch; volatile LAS unsigned* ctag;
    __device__ __forceinline__ void operator()(const f32x4 (&acc)[2][2][4][2], const Unit& u, int wr, int wc, int fr, int fq) const {
        const int row0 = u.pm * BM + wr * 64 + fr, col0 = u.pn * HALF + wc * 32 + 8 * fq;
        float sv[2][4], rv[2][4];
        if (cch) { const int wid = wr * 4 + wc; LAS f32x2* my = (LAS f32x2*)(cch + wid * 256);
            const unsigned tg = (unsigned)__builtin_amdgcn_readfirstlane((int)ctag[wid]);
            if (tg != (unsigned)(u.pm + 1)) {
#pragma unroll
                for (int ai = 0; ai < 2; ++ai)
#pragma unroll
                    for (int m = 0; m < 4; ++m) { const int row = row0 + ai * HALF + m * 16; const f32x2 pr = {wgt[row], rs[row]}; if (fq == 0) my[(ai * 4 + m) * 16 + fr] = pr; }
                if (fq == 0 && fr == 0) ctag[wid] = (unsigned)(u.pm + 1); }
#pragma unroll
            for (int ai = 0; ai < 2; ++ai)
#pragma unroll
                for (int m = 0; m < 4; ++m) { const f32x2 pr = my[(ai * 4 + m) * 16 + fr]; sv[ai][m] = pr.x; rv[ai][m] = pr.y; } }
        else {
#pragma unroll
            for (int ai = 0; ai < 2; ++ai)
#pragma unroll
                for (int m = 0; m < 4; ++m) { const int row = row0 + ai * HALF + m * 16; sv[ai][m] = wgt ? wgt[row] : 1.0f; rv[ai][m] = rs ? rs[row] : ssq_rstd(ssq, row); } }
#pragma unroll
        for (int ai = 0; ai < 2; ++ai)
#pragma unroll
            for (int m = 0; m < 4; ++m) { const int row = row0 + ai * HALF + m * 16; const float s = sv[ai][m]; const float rn = rv[ai][m] * wscale;
                const float kn = rn * -1.4426950408889634f, ku = rn * s * (OUT8 ? H8_SCALE : 1.0f);
                const f32x2 rn2 = {rn, rn}, kn2 = {kn, kn}, ku2 = {ku, ku};
                f32x2 o[4];
#pragma unroll
                for (int n = 0; n < 2; ++n)
#pragma unroll
                    for (int h = 0; h < 2; ++h) { const f32x2 g = {acc[ai][0][m][n][2 * h], acc[ai][0][m][n][2 * h + 1]}, uu = {acc[ai][1][m][n][2 * h], acc[ai][1][m][n][2 * h + 1]};
                        const f32x2 t = g * kn2; f32x2 e; e.x = __builtin_amdgcn_exp2f(t.x); e.y = __builtin_amdgcn_exp2f(t.y);
                        const f32x2 d = e + 1.0f; f32x2 r; r.x = __builtin_amdgcn_rcpf(d.x); r.y = __builtin_amdgcn_rcpf(d.y);
                        o[2 * n + h] = ((g * rn2) * r) * (uu * ku2); }
                if constexpr (OUT8) { u32x2 b; b.x = pk4_fp8(o[0].x, o[0].y, o[1].x, o[1].y); b.y = pk4_fp8(o[2].x, o[2].y, o[3].x, o[3].y);
                    *(u32x2*)((unsigned char*)H + (size_t)(row - rt0 * BM) * ldc + col0) = b; }
                else { u32x4 w; w.x = pk2(o[0].x, o[0].y); w.y = pk2(o[1].x, o[1].y); w.z = pk2(o[2].x, o[2].y); w.w = pk2(o[3].x, o[3].y);
                    *(u32x4*)(H + (size_t)(row - rt0 * BM) * ldc + col0) = w; } }
    }
};
__device__ __forceinline__ void unpack8(const u32x4 w, float (&f)[8]) { f[0] = bflo(w.x); f[1] = bfhi(w.x); f[2] = bflo(w.y); f[3] = bfhi(w.y); f[4] = bflo(w.z); f[5] = bfhi(w.z); f[6] = bflo(w.w); f[7] = bfhi(w.w); }
__device__ __forceinline__ float store_row8(bf16_t* XSo, unsigned char* X8, size_t off, const float (&x)[8]) {
    u32x4 w; w.x = pk2(x[0], x[1]); w.y = pk2(x[2], x[3]); w.z = pk2(x[4], x[5]); w.w = pk2(x[6], x[7]); *(u32x4*)(XSo + off) = w;
    if (X8) { u32x2 b; b.x = pk4_fp8(x[0], x[1], x[2], x[3]); b.y = pk4_fp8(x[4], x[5], x[6], x[7]); *(u32x2*)(X8 + off) = b; }
    float r[8]; unpack8(w, r); return ((r[0] * r[0] + r[1] * r[1]) + (r[2] * r[2] + r[3] * r[3])) + ((r[4] * r[4] + r[5] * r[5]) + (r[6] * r[6] + r[7] * r[7]));
}
struct EpiResidualStat {
    static constexpr bool PERM = true;
    const bf16_t* XSi; bf16_t* XSo; unsigned char* X8; ssq_t* ssq; int ldc; float alpha;
    __device__ __forceinline__ void operator()(const f32x4 (&acc)[2][2][4][2], const Unit& u, int wr, int wc, int fr, int fq) const {
        const int row0 = u.pm * BM + wr * 64 + fr, col0 = u.pn * BM + wc * 32 + 8 * fq, lane = fq * 16 + fr;
#pragma unroll
        for (int ai = 0; ai < 2; ++ai) {
            u32x4 xi[4][2]; float q[4];
#pragma unroll
            for (int m = 0; m < 4; ++m)
#pragma unroll
                for (int bj = 0; bj < 2; ++bj) xi[m][bj] = *(const u32x4*)(XSi + (size_t)(row0 + ai * HALF + m * 16) * ldc + col0 + bj * HALF);
#pragma unroll
            for (int m = 0; m < 4; ++m) { const size_t off = (size_t)(row0 + ai * HALF + m * 16) * ldc + col0; q[m] = 0.f;
#pragma unroll
                for (int bj = 0; bj < 2; ++bj) { float x[8]; unpack8(xi[m][bj], x);
#pragma unroll
                    for (int j = 0; j < 4; ++j) { x[j] += acc[ai][bj][m][0][j] * alpha; x[4 + j] += acc[ai][bj][m][1][j] * alpha; }
                    q[m] += store_row8(XSo, X8, off + bj * HALF, x); } }
#pragma unroll
            for (int m = 0; m < 4; ++m) { q[m] += epi_shfl(q[m], lane ^ 16); q[m] += epi_shfl(q[m], lane ^ 32); }
            if (fq == 0 && ssq) {
#pragma unroll
                for (int m = 0; m < 4; ++m) ssq_add(ssq, row0 + ai * HALF + m * 16, q[m]); }
        }
    }
};
template <bool STAT> struct EpiScatter {
    static constexpr bool PERM = true;
    bf16_t* XS; int ldc; const int* tok; unsigned char* X8; ssq_t* ssq; float alpha;
    __device__ __forceinline__ void operator()(const f32x4 (&acc)[2][2][4][2], const Unit& u, int wr, int wc, int fr, int fq) const {
        const int row0 = u.pm * BM + wr * 64 + fr, col0 = u.pn * BM + wc * 32 + 8 * fq, lane = fq * 16 + fr;
        int tk[2][4];
#pragma unroll
        for (int ai = 0; ai < 2; ++ai)
#pragma unroll
            for (int m = 0; m < 4; ++m) tk[ai][m] = tok[row0 + ai * HALF + m * 16];
#pragma unroll
        for (int ai = 0; ai < 2; ++ai) {
            u32x4 xi[4][2]; float q[4];
#pragma unroll
            for (int m = 0; m < 4; ++m) { const int t = tk[ai][m] >= 0 ? tk[ai][m] : 0;
#pragma unroll
                for (int bj = 0; bj < 2; ++bj) xi[m][bj] = *(const u32x4*)(XS + (size_t)t * ldc + col0 + bj * HALF); }
#pragma unroll
            for (int m = 0; m < 4; ++m) { const int t = tk[ai][m]; q[m] = 0.f;
                if (t >= 0) { const size_t off = (size_t)t * ldc + col0;
#pragma unroll
                    for (int bj = 0; bj < 2; ++bj) { float x[8]; unpack8(xi[m][bj], x);
#pragma unroll
                        for (int j = 0; j < 4; ++j) { x[j] += acc[ai][bj][m][0][j] * alpha; x[4 + j] += acc[ai][bj][m][1][j] * alpha; }
                        q[m] += store_row8(XS, STAT ? X8 : nullptr, off + bj * HALF, x); } } }
            if (STAT) {
#pragma unroll
                for (int m = 0; m < 4; ++m) { q[m] += epi_shfl(q[m], lane ^ 16); q[m] += epi_shfl(q[m], lane ^ 32); }
                if (fq == 0) {
#pragma unroll
                    for (int m = 0; m < 4; ++m) if (tk[ai][m] >= 0) ssq_add(ssq, tk[ai][m], q[m]); } }
        }
    }
};
struct EpiPleGate {
    static constexpr bool PERM = true;
    const bf16_t* XSi; bf16_t* XSo; const bf16_t* PPB; int ldc; const ssq_t* ssq_in; ssq_t* ssq_out; float wscale; unsigned char* X8o; LAS float* cch; volatile LAS unsigned* ctag; unsigned tagbase;
    __device__ __forceinline__ void operator()(const f32x4 (&acc)[2][2][4][2], const Unit& u, int wr, int wc, int fr, int fq) const {
        const int row0 = u.pm * BM + wr * 64 + fr, col0 = u.pn * BM + wc * 32 + 8 * fq, lane = fq * 16 + fr;
        float rc[2][4];
        if (cch) { const int wid = wr * 4 + wc; LAS float* my = cch + wid * 256;
            const unsigned tg = (unsigned)__builtin_amdgcn_readfirstlane((int)ctag[wid]), want = tagbase + (unsigned)(u.pm + 1);
            if (tg != want) {
#pragma unroll
                for (int ai = 0; ai < 2; ++ai)
#pragma unroll
                    for (int m = 0; m < 4; ++m) { const float r = ssq_rstd(ssq_in, row0 + ai * HALF + m * 16); if (fq == 0) my[(ai * 4 + m) * 16 + fr] = r; }
                if (fq == 0 && fr == 0) ctag[wid] = want; }
#pragma unroll
            for (int ai = 0; ai < 2; ++ai)
#pragma unroll
                for (int m = 0; m < 4; ++m) rc[ai][m] = my[(ai * 4 + m) * 16 + fr]; }
        else {
#pragma unroll
            for (int ai = 0; ai < 2; ++ai)
#pragma unroll
                for (int m = 0; m < 4; ++m) rc[ai][m] = ssq_rstd(ssq_in, row0 + ai * HALF + m * 16); }
#pragma unroll
        for (int ai = 0; ai < 2; ++ai) {
            u32x4 xi[4][2], pp[4][2]; float q[4], rn[4];
#pragma unroll
            for (int m = 0; m < 4; ++m) { rn[m] = rc[ai][m] * wscale;
#pragma unroll
                for (int bj = 0; bj < 2; ++bj) { const size_t o = (size_t)(row0 + ai * HALF + m * 16) * ldc + col0 + bj * HALF; xi[m][bj] = *(const u32x4*)(XSi + o); pp[m][bj] = *(const u32x4*)(PPB + o); } }
#pragma unroll
            for (int m = 0; m < 4; ++m) { const size_t off = (size_t)(row0 + ai * HALF + m * 16) * ldc + col0; q[m] = 0.f;
#pragma unroll
                for (int bj = 0; bj < 2; ++bj) { float x[8], p[8]; unpack8(xi[m][bj], x); unpack8(pp[m][bj], p);
                    const float kn = rn[m] * -1.4426950408889634f; const f32x2 kn2 = {kn, kn};
#pragma unroll
                    for (int n = 0; n < 2; ++n)
#pragma unroll
                        for (int h = 0; h < 2; ++h) { const f32x2 a = {acc[ai][bj][m][n][2 * h], acc[ai][bj][m][n][2 * h + 1]}; const f32x2 t = a * kn2;
                            f32x2 e; e.x = __builtin_amdgcn_exp2f(t.x); e.y = __builtin_amdgcn_exp2f(t.y); const f32x2 d = e + 1.0f; f32x2 r; r.x = __builtin_amdgcn_rcpf(d.x); r.y = __builtin_amdgcn_rcpf(d.y);
                            const f32x2 pv = {p[4 * n + 2 * h], p[4 * n + 2 * h + 1]}, xv = {x[4 * n + 2 * h], x[4 * n + 2 * h + 1]}; const f32x2 o = pv * r + xv; x[4 * n + 2 * h] = o.x; x[4 * n + 2 * h + 1] = o.y; }
                    q[m] += store_row8(XSo, X8o, off + bj * HALF, x); } }
#pragma unroll
            for (int m = 0; m < 4; ++m) { q[m] += epi_shfl(q[m], lane ^ 16); q[m] += epi_shfl(q[m], lane ^ 32); }
            if (fq == 0) {
#pragma unroll
                for (int m = 0; m < 4; ++m) ssq_add(ssq_out, row0 + ai * HALF + m * 16, q[m]); }
        }
    }
};

template <class Epi, class Sched, bool ALIGN_EPI, bool FP8 = false>
__device__ __forceinline__ void gemm_phase(LAS unsigned char* lds, const Gemm g, const Sched& S, const Epi& E, int tid_in) {
    int tid_ = tid_in; asm volatile("" : "+v"(tid_));
    const int tid = tid_, wid = __builtin_amdgcn_readfirstlane(tid >> 6), lane = tid & 63, wr = wid >> 2, wc = wid & 3, fr = lane & 15, fq = lane >> 4;
    const int K = g.K, nt = K / BK;
    unsigned voffA[2], voffB[2];
#pragma unroll
    for (int i = 0; i < 2; ++i) { int R, C; stage_rc(tid * 16 + i * 8192, R, C); const int Rb = Epi::PERM ? ((R & ~31) + perm32(R & 31)) : R;
        voffA[i] = (unsigned)(R * g.lda + C) * 2u; voffB[i] = (unsigned)(Rb * g.ldb + C) * 2u; }
    const __amdgpu_buffer_rsrc_t rA = __builtin_amdgcn_make_buffer_rsrc((void*)g.A, 0, 0xffffffff, 0x00020000), rB = __builtin_amdgcn_make_buffer_rsrc((void*)g.Bt, 0, 0xffffffff, 0x00020000);
    const unsigned kstep = (unsigned)(BK * 2);
    const unsigned hstepA = (unsigned)HALF * g.lda * 2u, hstepB = (unsigned)HALF * g.ldb * 2u;
    const unsigned tstepA = 2u * hstepA, tstepB = 2u * hstepB, estepB = (unsigned)(g.estride * 2);
    const unsigned ldsw = (unsigned)wid * 1024u;
    const int aoff = lds_byte(wr * 64 + fr, fq * 8), boff = lds_byte(wc * 32 + fr, fq * 8);
#define PG8_SA(b, h) (((b) * 2 + (h)) * HTB)
#define PG8_SB(b, h) ((4 + (b) * 2 + (h)) * HTB)
#define PG8_STAGE(bufoff, rs, soff, voff) do { _Pragma("unroll") for (int _i = 0; _i < 2; ++_i) \
        __builtin_amdgcn_raw_ptr_buffer_load_lds((rs), (LAS unsigned*)(lds + (bufoff) + ldsw + _i * 8192), 16, (voff)[_i], (soff), 0, 0); } while (0)
#define PG8_LD8(base) __builtin_bit_cast(i32x8, __builtin_shufflevector(*(const LAS u32x4*)(base), *(const LAS u32x4*)((base) + 1024), 0, 1, 2, 3, 4, 5, 6, 7))
#define PG8_LDA(dst, b, h) do { if constexpr (FP8) { _Pragma("unroll") for (int m = 0; m < 4; ++m) dst##8[m] = PG8_LD8(lds + PG8_SA(b, h) + aoff + m * 2048); } \
        else { _Pragma("unroll") for (int m = 0; m < 4; ++m) _Pragma("unroll") for (int k = 0; k < 2; ++k) dst[m][k] = *(const LAS bf16x8*)(lds + PG8_SA(b, h) + aoff + m * 2048 + k * 1024); } } while (0)
#define PG8_LDB(dst, b, h) do { if constexpr (FP8) { _Pragma("unroll") for (int n = 0; n < 2; ++n) dst##8[n] = PG8_LD8(lds + PG8_SB(b, h) + boff + n * 2048); } \
        else { _Pragma("unroll") for (int n = 0; n < 2; ++n) _Pragma("unroll") for (int k = 0; k < 2; ++k) dst[n][k] = *(const LAS bf16x8*)(lds + PG8_SB(b, h) + boff + n * 2048 + k * 1024); } } while (0)
#define PG8_MMA(ai, bj, At, Bt) do { __builtin_amdgcn_s_setprio(1); \
        if constexpr (FP8) { _Pragma("unroll") for (int m = 0; m < 4; ++m) _Pragma("unroll") for (int n = 0; n < 2; ++n) \
            acc[ai][bj][m][n] = __builtin_amdgcn_mfma_scale_f32_16x16x128_f8f6f4(Bt##8[n], At##8[m], acc[ai][bj][m][n], 0, 0, 0, 0x7f7f7f7f, 0, 0x7f7f7f7f); } \
        else { _Pragma("unroll") for (int m = 0; m < 4; ++m) _Pragma("unroll") for (int n = 0; n < 2; ++n) _Pragma("unroll") for (int k = 0; k < 2; ++k) \
            acc[ai][bj][m][n] = __builtin_amdgcn_mfma_f32_16x16x32_bf16(Bt[n][k], At[m][k], acc[ai][bj][m][n], 0, 0, 0); } \
        __builtin_amdgcn_s_setprio(0); } while (0)
#define PG8_WAIT_V(n) asm volatile("s_waitcnt vmcnt(" #n ")" ::: "memory")
#define PG8_WAIT_L(n) asm volatile("s_waitcnt lgkmcnt(" #n ")" ::: "memory")
#define PG8_BAR __builtin_amdgcn_s_barrier()
#define PG8_SCHED __builtin_amdgcn_sched_barrier(0)
    Unit cur, nxt; int ui = 0;
    if (!S.next(0, cur)) return;
    f32x4 acc[2][2][4][2];
    int zi_ = 0; asm volatile("" : "+s"(zi_)); const float zf_ = __builtin_bit_cast(float, zi_);
#pragma unroll
    for (int a = 0; a < 2; ++a)
#pragma unroll
        for (int b = 0; b < 2; ++b)
#pragma unroll
            for (int m = 0; m < 4; ++m)
#pragma unroll
                for (int n = 0; n < 2; ++n) acc[a][b][m][n] = (f32x4){zf_, zf_, zf_, zf_};
    bf16x8 At[4][2], B0[2][2], B1[2][2];
    i32x8 At8[4], B08[2], B18[2];
    unsigned cA = (unsigned)cur.pm * tstepA, cB = (unsigned)cur.e * estepB + (unsigned)cur.pn * tstepB;
    PG8_STAGE(PG8_SB(0, 0), rB, cB, voffB); PG8_STAGE(PG8_SB(0, 1), rB, cB + hstepB, voffB); PG8_STAGE(PG8_SA(0, 0), rA, cA, voffA); PG8_STAGE(PG8_SA(0, 1), rA, cA + hstepA, voffA);
    if (wr == 1) PG8_BAR;
    PG8_WAIT_V(2); PG8_BAR;
    PG8_STAGE(PG8_SB(1, 0), rB, cB + kstep, voffB); PG8_STAGE(PG8_SA(1, 0), rA, cA + kstep, voffA); PG8_STAGE(PG8_SB(1, 1), rB, cB + hstepB + kstep, voffB);
    PG8_WAIT_V(6); PG8_BAR;
    for (;;) {
        const bool has_next = S.next(ui + 1, nxt);
        const unsigned nA = has_next ? (unsigned)nxt.pm * tstepA : cA, nB = has_next ? (unsigned)nxt.e * estepB + (unsigned)nxt.pn * tstepB : cB;
        asm volatile(".p2align 8" ::: "memory");
        for (int t = 0; t < nt; t += 2) {
            const bool last = (t == nt - 2);
            const unsigned a1 = cA + (unsigned)(t + 1) * kstep;
            const unsigned a2 = last ? nA : cA + (unsigned)(t + 2) * kstep, b2 = last ? nB : cB + (unsigned)(t + 2) * kstep;
            const unsigned a3 = a2 + kstep, b3 = b2 + kstep;
            PG8_LDB(B0, 0, 0); PG8_LDB(B1, 0, 1); PG8_SCHED; PG8_LDA(At, 0, 0); PG8_STAGE(PG8_SA(1, 1), rA, a1 + hstepA, voffA);
            PG8_WAIT_V(8); PG8_WAIT_L(0); PG8_BAR; PG8_MMA(0, 0, At, B0); PG8_MMA(0, 1, At, B1); PG8_BAR; PG8_SCHED;
            PG8_LDA(At, 0, 1); PG8_STAGE(PG8_SB(0, 0), rB, b2, voffB); PG8_STAGE(PG8_SB(0, 1), rB, b2 + hstepB, voffB); PG8_STAGE(PG8_SA(0, 0), rA, a2, voffA);
            PG8_WAIT_V(8); PG8_WAIT_L(0); PG8_BAR; PG8_MMA(1, 0, At, B0); PG8_MMA(1, 1, At, B1); PG8_BAR; PG8_SCHED;
            PG8_LDB(B0, 1, 0); PG8_LDB(B1, 1, 1); PG8_SCHED; PG8_LDA(At, 1, 0); PG8_STAGE(PG8_SA(0, 1), rA, a2 + hstepA, voffA);
            PG8_WAIT_V(8); PG8_WAIT_L(0); PG8_BAR; PG8_MMA(0, 0, At, B0); PG8_MMA(0, 1, At, B1); PG8_BAR; PG8_SCHED;
            PG8_LDA(At, 1, 1); PG8_STAGE(PG8_SB(1, 0), rB, b3, voffB); PG8_STAGE(PG8_SB(1, 1), rB, b3 + hstepB, voffB); PG8_STAGE(PG8_SA(1, 0), rA, a3, voffA);
            PG8_WAIT_V(8); PG8_WAIT_L(0); PG8_BAR; PG8_MMA(1, 0, At, B0); PG8_MMA(1, 1, At, B1); PG8_BAR; PG8_SCHED;
        }
        if constexpr (ALIGN_EPI) { if (wr == 0) PG8_BAR; }
        { unsigned z_ = 0u; asm volatile("" : "+s"(z_)); const int l2 = (int)__builtin_amdgcn_mbcnt_hi(~0u, __builtin_amdgcn_mbcnt_lo(~0u, z_)); E(acc, cur, wr, wc, l2 & 15, l2 >> 4); }
        if (!has_next) break;
#pragma unroll
        for (int a = 0; a < 2; ++a)
#pragma unroll
            for (int b = 0; b < 2; ++b)
#pragma unroll
                for (int m = 0; m < 4; ++m)
#pragma unroll
                    for (int n = 0; n < 2; ++n) acc[a][b][m][n] = (f32x4){zf_, zf_, zf_, zf_};
        cur = nxt; cA = nA; cB = nB; ++ui;
        if constexpr (ALIGN_EPI) { if (wr == 1) PG8_BAR; }
    }
    PG8_WAIT_V(0);
    if constexpr (!ALIGN_EPI) { if (wr == 0) PG8_BAR; }
    PG8_BAR;
#undef PG8_SA
#undef PG8_SB
#undef PG8_STAGE
#undef PG8_LDA
#undef PG8_LDB
#undef PG8_MMA
#undef PG8_LD8
#undef PG8_WAIT_V
#undef PG8_WAIT_L
#undef PG8_BAR
#undef PG8_SCHED
}
}
constexpr int NB = 16, SEQ = 2048, T = NB * SEQ, D = 2048, DEPTH = 2;
constexpr int DPROJ_SRC = 6168, NU = 6400;
constexpr int DFF = 5632, NEXP = 8, DFFE = 7168, PLE = 256;
constexpr float EPS = 1e-6f;
constexpr int UQ = 0, UK = 512, UV = 1024, UO = 1536, UZ = 2048, UXBC = 3072, UAQ = 4608, UAK = 5120, UAV = 5632, UMI = 6144, UMF = 6148, UDT = 6152;
constexpr int MIXM = 0, MIXS = 512, MIXA = 1536;
constexpr int NWAVES = 8, NTHR = 512, NWG = 256;

constexpr size_t MiB = 1u << 20;
constexpr size_t WS_CTL = 0, CTL_ZERO_BYTES = 3 * MiB;
constexpr size_t WS_SSQ = 1 * MiB;
constexpr size_t WS_WIN = 4 * MiB;
constexpr size_t WS_WOUT = WS_WIN + 50 * MiB;
constexpr size_t WS_FGU = WS_WOUT + 16 * MiB;
constexpr size_t WS_FD = WS_FGU + 44 * MiB;
constexpr size_t WS_MGU = WS_FD + 22 * MiB;
constexpr size_t WS_MD = WS_MGU + 448 * MiB;
constexpr size_t WS_PG = WS_MD + 224 * MiB;
constexpr size_t WS_PP = WS_PG + 16 * MiB;
constexpr size_t WS_XN = WS_PP + 2 * MiB;
constexpr size_t WS_P16 = WS_XN + 128 * MiB;
constexpr size_t WS_R = WS_P16 + 32 * MiB;
constexpr size_t WS_U = WS_R;
constexpr size_t WS_MIX = WS_R + 400 * MiB;
constexpr size_t WS_CV = WS_R + 528 * MiB;
constexpr size_t WS_H = WS_R;
constexpr size_t WS_PPB0 = WS_R + 352 * MiB, WS_PPB1 = WS_R;
constexpr size_t WS_XG = WS_R;
constexpr size_t WS_HM = WS_R + 272 * MiB;
constexpr size_t WS_MISC = WS_R + 748 * MiB;
constexpr size_t WS_SSQM = WS_MISC;
constexpr size_t WS_SSQS = WS_SSQM + 4 * MiB;
constexpr size_t WS_KMEAN = WS_SSQS + 2 * MiB;
constexpr size_t WS_ROUTE = WS_KMEAN + 1 * MiB;
constexpr size_t WS_TOK = WS_ROUTE + 1 * MiB;
constexpr size_t WS_WGT = WS_TOK + 1 * MiB;
constexpr size_t WS_WGCNT = WS_WGT + 1 * MiB;
constexpr size_t WS_XBB = WS_WGCNT + 1 * MiB;
constexpr size_t WS_XA8 = WS_XBB + 128 * MiB;
constexpr size_t WS_END = WS_XA8 + 64 * MiB;
constexpr int MOE_ROWS = 69632, MOE_SLOT_ROWS = 34816;
constexpr int CW_TMO = 0, CW_BAR = 4096;

constexpr int RING_OFF = 0, RING_BYTES = 131072;
constexpr int LDSCTL_OFF = 139264;
constexpr int MISC_OFF = LDSCTL_OFF;
constexpr int LTAB_OFF = LDSCTL_OFF + 256;
constexpr int PTAB_OFF = LDSCTL_OFF + 6144;
constexpr int LDS_BYTES = 147456;

#define XB_TMO      128
#define XB_XCNT(j)  (256  + 64 * (j))
#define XB_XSUB(j)  (1280 + 64 * (j))
#define XB_XGEN(j)  (2304 + 64 * (j))
#define XB_TOP      3328
#define XB_TOPGEN   3392
#define XCD_BAR_WORDS 3456
#define XB_SPIN_CAP (1u << 18)

__device__ __forceinline__ unsigned xb_ld(unsigned* p)              { return __hip_atomic_load(p, __ATOMIC_RELAXED, __HIP_MEMORY_SCOPE_AGENT); }
__device__ __forceinline__ unsigned xb_add(unsigned* p, unsigned v) { return __hip_atomic_fetch_add(p, v, __ATOMIC_RELAXED, __HIP_MEMORY_SCOPE_AGENT); }
__device__ __forceinline__ unsigned xb_xcc_id() { return (unsigned)__builtin_amdgcn_s_getreg((3 << 11) | 20) & 0xFu; }
#define XB_SPIN(cond, bar) do { unsigned _sp = 0; while (cond) { __builtin_amdgcn_s_sleep(1); \
    if ((++_sp & 255u) == 0u) { if (xb_ld(&(bar)[XB_TMO])) break; if (_sp > XB_SPIN_CAP) { atomicAdd(&(bar)[XB_TMO], 1u); break; } } } } while (0)

struct XcdBarrier { unsigned* bar; unsigned x; volatile LAS unsigned* st; };

__device__ __forceinline__ XcdBarrier xcd_barrier_post(unsigned* bar, volatile LAS unsigned* st) {
    XcdBarrier b; b.bar = bar; b.x = xb_xcc_id(); b.st = st;
    if (threadIdx.x == 0) (void)xb_add(&bar[XB_XCNT(b.x)], 1u);
    return b;
}
__device__ __forceinline__ void xcd_barrier_complete(unsigned* bar, unsigned x, unsigned& nloc, unsigned& nx) {
    const unsigned G = NWG;
    unsigned sum, cnt, mine, sp = 0u;
    for (;;) {
        sum = 0u; cnt = 0u; mine = 0u;
#pragma unroll
        for (unsigned j = 0; j < 16; ++j) { const unsigned c = xb_ld(&bar[XB_XCNT(j)]); sum += c; cnt += (c > 0u) ? 1u : 0u; mine = (j == x) ? c : mine; }
        if (sum == G) break;
        __builtin_amdgcn_s_sleep(1);
        if ((++sp & 255u) == 0u) { if (xb_ld(&bar[XB_TMO])) break; if (sp > XB_SPIN_CAP) { atomicAdd(&bar[XB_TMO], 1u); break; } }
    }
    nloc = mine > 0u ? mine : 1u; nx = cnt > 0u ? cnt : 1u;
}
__device__ __forceinline__ void xcd_barrier(const XcdBarrier& b) {
    asm volatile("s_waitcnt vmcnt(0)" ::: "memory");
    __syncthreads();
    if (threadIdx.x == 0) {
        unsigned* bar = b.bar;
        __builtin_amdgcn_s_waitcnt(0);
        unsigned nloc = b.st[0], nx = b.st[1];
        if (nloc == 0u) { xcd_barrier_complete(bar, b.x, nloc, nx); b.st[0] = nloc; b.st[1] = nx; }
        const unsigned old = xb_add(&bar[XB_XSUB(b.x)], 1u);
        const unsigned gen = old / nloc;
        if (old + 1u == (gen + 1u) * nloc) {
            __builtin_amdgcn_fence(__ATOMIC_RELEASE, "agent");
            asm volatile("s_waitcnt vmcnt(0)" ::: "memory");
            const unsigned og = xb_add(&bar[XB_TOP], 1u);
            const unsigned tg = og / nx;
            if (og + 1u == (tg + 1u) * nx) xb_add(&bar[XB_TOPGEN], 1u);
            else XB_SPIN(xb_ld(&bar[XB_TOPGEN]) == tg, bar);
            __builtin_amdgcn_fence(__ATOMIC_ACQUIRE, "agent");
            xb_add(&bar[XB_XGEN(b.x)], 1u);
            asm volatile("s_waitcnt vmcnt(0)" ::: "memory");
        } else {
            XB_SPIN(xb_ld(&bar[XB_XGEN(b.x)]) == gen, bar);
            __builtin_amdgcn_fence(__ATOMIC_ACQUIRE, "agent");
            asm volatile("s_waitcnt vmcnt(0)" ::: "memory");
        }
    }
    __syncthreads();
}

struct Args {
    const float* in[27]; float* out; unsigned char* ws; int ph_lo, ph_hi;
};
struct Frame {
    LAS unsigned char* lds;
    int tid, lane, wave, vcu, bx;
    float zf; unsigned zu;
};
__device__ __forceinline__ float lshfl(float v, int src) { return __builtin_bit_cast(float, __builtin_amdgcn_ds_bpermute(src << 2, __builtin_bit_cast(int, v))); }
#define SHFL_XOR(v, o) lshfl((v), F.lane ^ (o))
#define SHFL_UP(v, o) lshfl((v), F.lane - (o))
#define SHFL_IDX(v, i) lshfl((v), (i))
__device__ __forceinline__ float wave_sum_l(float v, int lane) {
#pragma unroll
    for (int o = 1; o < 64; o <<= 1) v += lshfl(v, lane ^ o);
    return v;
}
#define wave_sum(v) wave_sum_l((v), F.lane)
#define WG_BAR() __syncthreads()
__device__ __forceinline__ void stagger(int cls, int ticks) {
    if (cls) { const unsigned long long tgt = __builtin_amdgcn_s_memrealtime() + (unsigned long long)(cls * ticks);
        while (__builtin_amdgcn_s_memrealtime() < tgt) __builtin_amdgcn_s_sleep(16); }
}
#ifdef USE_STAGGER
#define STAGGER(ticks) stagger((F.bx >> 3) & 3, (ticks))
#else
#define STAGGER(ticks) do {} while (0)
#endif
__device__ __forceinline__ unsigned char* ld_ptr(LAS unsigned char* lds, int i) {
    const unsigned long long v = ((const LAS unsigned long long*)(lds + PTAB_OFF))[i];
    const unsigned lo = __builtin_amdgcn_readfirstlane((unsigned)v), hi = __builtin_amdgcn_readfirstlane((unsigned)(v >> 32));
    return (unsigned char*)(__attribute__((address_space(1))) unsigned char*)(uintptr_t)(((unsigned long long)hi << 32) | lo);
}

constexpr int XP_SCR = 64 * 65 * 4;
template <bool F8 = false> __device__ __forceinline__ void xpose_item(const float* W, int ldsrc, int srccol4, int k0, bf16_t* WT, int K, int drow0, LAS float* scr, int lane, const float* gain, float zf = 0.f) {
    f32x4 v[16];
    const int r = lane >> 4, c4 = 4 * (lane & 15);
#pragma unroll
    for (int i = 0; i < 16; ++i) v[i] = (srccol4 >= 0) ? __builtin_nontemporal_load((const f32x4*)(W + (size_t)(k0 + 4 * i + r) * ldsrc + srccol4)) : (f32x4){zf, zf, zf, zf};
    if (gain) {
#pragma unroll
        for (int i = 0; i < 16; ++i) v[i] = v[i] * gain[k0 + 4 * i + r]; }
#pragma unroll
    for (int i = 0; i < 16; ++i) { LAS float* s = scr + (4 * i + r) * 65 + c4; s[0] = v[i].x; s[1] = v[i].y; s[2] = v[i].z; s[3] = v[i].w; }
    asm volatile("s_waitcnt lgkmcnt(0)" ::: "memory");
    const int c = lane & 7;
#pragma unroll
    for (int j = 0; j < 8; ++j) { const int n = (lane >> 3) + 8 * j; const LAS float* s = scr + (8 * c) * 65 + n;
        if constexpr (F8) { u32x2 o; o.x = pk4_fp8(s[0 * 65] * W8_SCALE, s[1 * 65] * W8_SCALE, s[2 * 65] * W8_SCALE, s[3 * 65] * W8_SCALE); o.y = pk4_fp8(s[4 * 65] * W8_SCALE, s[5 * 65] * W8_SCALE, s[6 * 65] * W8_SCALE, s[7 * 65] * W8_SCALE);
            __builtin_nontemporal_store(o, (u32x2*)((unsigned char*)WT + (size_t)(drow0 + n) * K + k0 + 8 * c)); }
        else { u32x4 o; o.x = pk2(s[0 * 65], s[1 * 65]); o.y = pk2(s[2 * 65], s[3 * 65]); o.z = pk2(s[4 * 65], s[5 * 65]); o.w = pk2(s[6 * 65], s[7 * 65]);
            __builtin_nontemporal_store(o, (u32x4*)(WT + (size_t)(drow0 + n) * K + k0 + 8 * c)); } }
    asm volatile("s_waitcnt lgkmcnt(0)" ::: "memory");
}
__device__ __forceinline__ int win_srccol(int d) {
    if (d < 2048) return d;
    if (d < 3072) return 2056 + (d - 2048);
    if (d < 4608) return 3080 + (d - 3072);
    if (d < 6144) return 4632 + (d - 4608);
    if (d < 6152) return 2048 + (d - 6144);
    if (d < 6168) return 4616 + (d - 6152);
    return -1;
}
template <bool F8 = false> __device__ __forceinline__ void xpose_plain(Frame& F, const float* W, int K, int N, bf16_t* WT, LAS float* scr, int gw, int NGW, const float* gain) {
    const int nblk = N / 64, items = (K / 64) * nblk;
    for (int it = gw; it < items; it += NGW) { const int kb = it / nblk, nb = it % nblk; xpose_item<F8>(W, N, nb * 64 + 4 * (F.lane & 15), kb * 64, WT, K, nb * 64, scr, F.lane, gain); }
}
__device__ __forceinline__ void xpose_gu(Frame& F, const float* Wg, const float* Wu, int K, int N, bf16_t* WT, LAS float* scr, int gw, int NGW, const float* gain) {
    const int nblk = 2 * N / 64, items = (K / 64) * nblk;
    for (int it = gw; it < items; it += NGW) { const int kb = it / nblk, nb = it % nblk; const int drow0 = nb * 64, tile = drow0 >> 8, within = drow0 & 255;
        const float* W = within < 128 ? Wg : Wu; const int sc = tile * 128 + (within & 127) + 4 * (F.lane & 15);
        xpose_item<true>(W, N, sc, kb * 64, WT, K, drow0, scr, F.lane, gain); }
}
__device__ __forceinline__ float load_row_ssq(Frame& F, const float* xrow, f32x4 (&v)[8]) {
    const f32x4* xr = (const f32x4*)xrow + F.lane; float s = 0.f;
#pragma unroll
    for (int j = 0; j < 8; ++j) { v[j] = xr[64 * j]; s += (v[j].x * v[j].x + v[j].y * v[j].y) + (v[j].z * v[j].z + v[j].w * v[j].w); }
    return wave_sum(s);
}
__device__ __forceinline__ float load_row16_ssq(Frame& F, const bf16_t* xrow, float (&v)[4][8]) {
    const u32x4* xr = (const u32x4*)xrow + F.lane; float s = 0.f;
#pragma unroll
    for (int j = 0; j < 4; ++j) { const u32x4 w = xr[64 * j]; v[j][0] = bflo(w.x); v[j][1] = bfhi(w.x); v[j][2] = bflo(w.y); v[j][3] = bfhi(w.y); v[j][4] = bflo(w.z); v[j][5] = bfhi(w.z); v[j][6] = bflo(w.w); v[j][7] = bfhi(w.w);
#pragma unroll
        for (int i = 0; i < 8; ++i) s += v[j][i] * v[j][i]; }
    return wave_sum(s);
}
typedef short v4i16_t __attribute__((ext_vector_type(4)));
__device__ __forceinline__ f32x4 mfma16(bf16x8 a, bf16x8 b, f32x4 c) { return __builtin_amdgcn_mfma_f32_16x16x32_bf16(a, b, c, 0, 0, 0); }
__device__ __forceinline__ s16x4 tr_read(const LAS unsigned char* p) { return __builtin_bit_cast(s16x4, __builtin_amdgcn_ds_read_tr16_b64_v4i16((LAS v4i16_t*)p)); }
__device__ __forceinline__ bf16x8 cat4(s16x4 a, s16x4 b) { return (bf16x8){a[0], a[1], a[2], a[3], b[0], b[1], b[2], b[3]}; }
__device__ __forceinline__ bf16x8 pack8f(const float (&v)[8]) { u32x4 w; w.x = pk2(v[0], v[1]); w.y = pk2(v[2], v[3]); w.z = pk2(v[4], v[5]); w.w = pk2(v[6], v[7]); return __builtin_bit_cast(bf16x8, w); }
__device__ __forceinline__ float softplusf_(float x) { return x > 20.f ? x : __logf(1.0f + __expf(x)); }
__device__ __forceinline__ float logsigmoidf_(float x) { return fminf(x, 0.f) - __logf(1.0f + __expf(-fabsf(x))); }

constexpr int SLD = 272;

constexpr int NCV = 2560;
#define CONV_LOAD(it_, arr) do { const int cg_ = (it_) % 320, tb_ = ((it_) / 320) & 127, b_ = (it_) / (320 * 128); \
        const int uc_ = cg_ < 128 ? 8 * cg_ : UXBC + (8 * cg_ - 1024); const bf16_t* up_ = U + ((size_t)b_ * SEQ + tb_ * 16) * NU + uc_; \
        if (tb_ > 0) { arr[0] = *(const u32x4*)(up_ - 3 * (ptrdiff_t)NU); arr[1] = *(const u32x4*)(up_ - 2 * (ptrdiff_t)NU); arr[2] = *(const u32x4*)(up_ - (ptrdiff_t)NU); } \
        else { arr[0] = (u32x4){F.zu, F.zu, F.zu, F.zu}; arr[1] = arr[0]; arr[2] = arr[0]; } \
        _Pragma("unroll") for (int t_ = 0; t_ < 16; ++t_) arr[3 + t_] = *(const u32x4*)(up_ + (size_t)t_ * NU); } while (0)
__device__ __forceinline__ void conv_phase(Frame& F, const bf16_t* __restrict__ U, bf16_t* __restrict__ CV, const float* __restrict__ mcw, const float* __restrict__ mcb, const float* __restrict__ scw, const float* __restrict__ scb) {
    LAS float* cw = (LAS float*)F.lds;
    WG_BAR();
    {
        f32x4 vm[3], vs[4];
#pragma unroll
        for (int it = 0; it < 3; ++it) { const int idx = F.tid + NTHR * it; if (idx < 5 * 256) { const int j = idx >> 8, c4 = idx & 255; vm[it] = *(const f32x4*)((j < 4 ? mcw + j * 1024 : mcb) + 4 * c4); } }
#pragma unroll
        for (int it = 0; it < 4; ++it) { const int idx = F.tid + NTHR * it; if (idx < 5 * 384) { const int j = idx / 384, c4 = idx % 384; vs[it] = *(const f32x4*)((j < 4 ? scw + j * 1536 : scb) + 4 * c4); } }
#pragma unroll
        for (int it = 0; it < 3; ++it) { const int idx = F.tid + NTHR * it; if (idx < 5 * 256) { const int j = idx >> 8, c4 = idx & 255; *(LAS f32x4*)(cw + j * 2560 + 4 * c4) = vm[it]; } }
#pragma unroll
        for (int it = 0; it < 4; ++it) { const int idx = F.tid + NTHR * it; if (idx < 5 * 384) { const int j = idx / 384, c4 = idx % 384; *(LAS f32x4*)(cw + j * 2560 + 1024 + 4 * c4) = vs[it]; } }
    }
    WG_BAR();
    const int gt = F.vcu * NTHR + F.tid; constexpr int STRIDE = NWG * NTHR, NIT = NB * 128 * 320 / STRIDE;
    static_assert(NIT * STRIDE == NB * 128 * 320, "conv items divide evenly");
    u32x4 cur[19], nxt[19];
    CONV_LOAD(gt, cur);
#pragma unroll 1
    for (int k = 0; k < NIT; ++k) {
        unsigned zl_ = 0u; asm volatile("" : "+s"(zl_)); const int ln_ = (int)__builtin_amdgcn_mbcnt_hi(~0u, __builtin_amdgcn_mbcnt_lo(~0u, zl_));
        const int it = F.vcu * NTHR + F.wave * 64 + k * STRIDE + ln_; const int cg = it % 320, tb = (it / 320) & 127, b = it / (320 * 128); const int cvcol = 8 * cg;
        if (k + 1 < NIT) CONV_LOAD(it + STRIDE, nxt);
        f32x2 wt[4][4], bs[4];
#pragma unroll
        for (int j = 0; j < 4; ++j) { const f32x4 a = *(const LAS f32x4*)(cw + j * 2560 + cvcol), c2 = *(const LAS f32x4*)(cw + j * 2560 + cvcol + 4);
            wt[j][0] = (f32x2){a[0], a[1]}; wt[j][1] = (f32x2){a[2], a[3]}; wt[j][2] = (f32x2){c2[0], c2[1]}; wt[j][3] = (f32x2){c2[2], c2[3]}; }
        { const f32x4 a = *(const LAS f32x4*)(cw + 4 * 2560 + cvcol), c2 = *(const LAS f32x4*)(cw + 4 * 2560 + cvcol + 4); bs[0] = (f32x2){a[0], a[1]}; bs[1] = (f32x2){a[2], a[3]}; bs[2] = (f32x2){c2[0], c2[1]}; bs[3] = (f32x2){c2[2], c2[3]}; }
        const float sc = (cg >= 64 && cg < 128) ? 0.08838834764831845f : 1.0f;
        bf16_t* op = CV + ((size_t)b * SEQ + tb * 16) * NCV + cvcol;
        f32x2 h0[4], h1[4], h2[4];
#pragma unroll
        for (int i = 0; i < 4; ++i) { h0[i] = (f32x2){bflo(cur[0][i]), bfhi(cur[0][i])}; h1[i] = (f32x2){bflo(cur[1][i]), bfhi(cur[1][i])}; h2[i] = (f32x2){bflo(cur[2][i]), bfhi(cur[2][i])}; }
#pragma unroll
        for (int t = 0; t < 16; ++t) {
            f32x2 h3[4], y[4];
#pragma unroll
            for (int i = 0; i < 4; ++i) { h3[i] = (f32x2){bflo(cur[3 + t][i]), bfhi(cur[3 + t][i])};
                f32x2 a = bs[i] + h0[i] * wt[0][i]; a = a + h1[i] * wt[1][i]; a = a + h2[i] * wt[2][i]; a = a + h3[i] * wt[3][i];
                const f32x2 e = a * (-1.4426950408889634f); f32x2 d; d.x = __builtin_amdgcn_exp2f(e.x); d.y = __builtin_amdgcn_exp2f(e.y); d = d + 1.0f;
                f32x2 r; r.x = __builtin_amdgcn_rcpf(d.x); r.y = __builtin_amdgcn_rcpf(d.y); y[i] = (a * sc) * r; }
            u32x4 o; o.x = pk2(y[0].x, y[0].y); o.y = pk2(y[1].x, y[1].y); o.z = pk2(y[2].x, y[2].y); o.w = pk2(y[3].x, y[3].y);
            *(u32x4*)(op + (size_t)t * NCV) = o;
#pragma unroll
            for (int i = 0; i < 4; ++i) { h0[i] = h1[i]; h1[i] = h2[i]; h2[i] = h3[i]; }
        }
        if (k + 1 < NIT) {
#pragma unroll
            for (int i = 0; i < 19; ++i) cur[i] = nxt[i]; }
    }
}
#undef CONV_LOAD

constexpr int XLD = 144;
constexpr int SS_Z = 110592;
constexpr int SS_CM = 0, SS_BM = 34816, SS_X = 69632, SS_HB = 88064, SS_F = 105472;
__device__ __forceinline__ void ssd_unit(Frame& F, int b, int hh, const bf16_t* __restrict__ U, const bf16_t* __restrict__ CV, bf16_t* __restrict__ MIX, float* __restrict__ SSQS,
                                         const float* __restrict__ dt_bias, const float* __restrict__ a_log, const float* __restrict__ d_skip) {
    LAS unsigned char* L = F.lds;
    const int tid = F.tid, lane = F.lane, w = F.wave, c16 = lane & 15, g4 = lane >> 4, grp = hh >> 3;
    WG_BAR();
    for (int i = tid; i < 64 * SLD / 4; i += NTHR) ((LAS unsigned*)(L + SS_HB))[i] = 0u;
    const float Aneg = -__expf(a_log[hh]), dtb = dt_bias[hh], Dsk = d_skip[hh];
    f32x4 hst[4];
#pragma unroll
    for (int i = 0; i < 4; ++i) hst[i] = (f32x4){F.zf, F.zf, F.zf, F.zf};
    const bf16_t* cvb = CV + (size_t)b * SEQ * NCV + 1024;
    u32x4 pc[4], pb_[4], px[2], pz[2]; unsigned graw0 = 0, graw1 = 0;
#define SSD_PREFETCH(cc) do { const size_t r0_ = (size_t)(cc) * 128; \
        _Pragma("unroll") for (int i = 0; i < 4; ++i) { const int q_ = tid + 512 * i; pc[i] = *(const u32x4*)(cvb + (r0_ + (q_ >> 4)) * NCV + 1280 + grp * 128 + 8 * (q_ & 15)); pb_[i] = *(const u32x4*)(cvb + (r0_ + (q_ >> 4)) * NCV + 1024 + grp * 128 + 8 * (q_ & 15)); } \
        _Pragma("unroll") for (int i = 0; i < 2; ++i) { const int q_ = tid + 512 * i; px[i] = *(const u32x4*)(cvb + (r0_ + (q_ >> 3)) * NCV + hh * 64 + 8 * (q_ & 7)); \
            pz[i] = *(const u32x4*)(U + ((size_t)b * SEQ + r0_ + (q_ >> 3)) * NU + UZ + hh * 64 + 8 * (q_ & 7)); } \
        if (w == 0) { graw0 = U[((size_t)b * SEQ + r0_ + lane) * NU + UDT + hh]; graw1 = U[((size_t)b * SEQ + r0_ + 64 + lane) * NU + UDT + hh]; } } while (0)
#define SSD_PF_CB(cc, i) do { const size_t r0_ = (size_t)(cc) * 128; int tq_ = tid; asm volatile("" : "+v"(tq_)); const int q_ = tq_ + 512 * (i); pc[i] = *(const u32x4*)(cvb + (r0_ + (q_ >> 4)) * NCV + 1280 + grp * 128 + 8 * (q_ & 15)); pb_[i] = *(const u32x4*)(cvb + (r0_ + (q_ >> 4)) * NCV + 1024 + grp * 128 + 8 * (q_ & 15)); } while (0)
#define SSD_PF_X(cc) do { const size_t r0_ = (size_t)(cc) * 128; int tq_ = tid; asm volatile("" : "+v"(tq_)); \
        _Pragma("unroll") for (int i = 0; i < 2; ++i) { const int q_ = tq_ + 512 * i; px[i] = *(const u32x4*)(cvb + (r0_ + (q_ >> 3)) * NCV + hh * 64 + 8 * (q_ & 7)); } \
        if (w == 0) { graw0 = U[((size_t)b * SEQ + r0_ + lane) * NU + UDT + hh]; graw1 = U[((size_t)b * SEQ + r0_ + 64 + lane) * NU + UDT + hh]; } } while (0)
#define SSD_GATES(buf) do { LAS float* fa_ = (LAS float*)(L + SS_F) + (buf) * 512; \
        const float dt0 = softplusf_(bf1((bf16_t)graw0) + dtb), dt1 = softplusf_(bf1((bf16_t)graw1) + dtb); float s0 = dt0 * Aneg, s1 = dt1 * Aneg; \
        _Pragma("unroll") for (int o = 1; o < 64; o <<= 1) { const float x0 = SHFL_UP(s0, o), x1 = SHFL_UP(s1, o); if (lane >= o) { s0 += x0; s1 += x1; } } \
        s1 += SHFL_IDX(s0, 63); const float tot = SHFL_IDX(s1, 63); \
        fa_[lane] = s0; fa_[64 + lane] = s1; fa_[128 + lane] = dt0; fa_[192 + lane] = dt1; fa_[256 + lane] = __expf(tot - s0) * dt0; fa_[320 + lane] = __expf(tot - s1) * dt1; fa_[384 + lane] = __expf(s0); fa_[448 + lane] = __expf(s1); } while (0)
    SSD_PREFETCH(0);
    if (w == 0) SSD_GATES(0);
#ifdef PROBE_ML
    unsigned long long pmt = 0, pa[7] = {0, 0, 0, 0, 0, 0, 0}; const unsigned long long pc0 = __builtin_amdgcn_s_memtime(), pr0 = __builtin_amdgcn_s_memrealtime();
#define PST(k) do { const unsigned long long t_ = __builtin_amdgcn_s_memrealtime(); pa[k] += t_ - pmt; pmt = t_; } while (0)
#endif
    for (int c = 0; c < 16; ++c) {
        const size_t row0 = (size_t)b * SEQ + c * 128;
#ifdef PROBE_ML
        pmt = __builtin_amdgcn_s_memrealtime();
#endif
#pragma unroll
        for (int i = 0; i < 4; ++i) { const int q_ = tid + 512 * i; *(LAS u32x4*)(L + SS_CM + (q_ >> 4) * SLD + (q_ & 15) * 16) = pc[i]; *(LAS u32x4*)(L + SS_BM + (q_ >> 4) * SLD + (q_ & 15) * 16) = pb_[i]; }
#pragma unroll
        for (int i = 0; i < 2; ++i) { const int q_ = tid + 512 * i; *(LAS u32x4*)(L + SS_X + (q_ >> 3) * XLD + (q_ & 7) * 16) = px[i]; *(LAS u32x4*)(L + SS_Z + (q_ >> 3) * XLD + (q_ & 7) * 16) = pz[i]; }
        WG_BAR();
#ifdef PROBE_ML
        PST(0);
#endif
        {
            const LAS float* fa = (const LAS float*)(L + SS_F) + (c & 1) * 512; const LAS float* fdt = fa + 128; const LAS float* fwdt = fa + 256; const LAS float* feac = fa + 384;
            const int l = 16 * w + c16; const size_t row = row0 + l;
#ifdef PROBE_ML
            PST(6);
#endif
            f32x4 accd[4], acco[4];
#pragma unroll
            for (int i = 0; i < 4; ++i) accd[i] = (f32x4){F.zf, F.zf, F.zf, F.zf};
            const float acl = fa[l]; const int q = c16 >> 2, pp = c16 & 3;
            bf16x8 cfr[4];
#pragma unroll
            for (int kn = 0; kn < 4; ++kn) cfr[kn] = *(const LAS bf16x8*)(L + SS_CM + (16 * w + c16) * SLD + (32 * kn + 8 * g4) * 2);
            for (int ks = 0; ks <= (w >> 1); ++ks) {
                float mv[8];
#pragma unroll
                for (int half = 0; half < 2; ++half) {
                    bf16x8 a0[4];
#pragma unroll
                    for (int kn = 0; kn < 4; ++kn) a0[kn] = *(const LAS bf16x8*)(L + SS_BM + (32 * ks + 16 * half + c16) * SLD + (32 * kn + 8 * g4) * 2);
                    const f32x4 fa0 = *(const LAS f32x4*)(fa + 32 * ks + 16 * half + 4 * g4), fd0 = *(const LAS f32x4*)(fdt + 32 * ks + 16 * half + 4 * g4);
                    __builtin_amdgcn_sched_barrier(0);
                    f32x4 gt0 = (f32x4){F.zf, F.zf, F.zf, F.zf};
#pragma unroll
                    for (int kn = 0; kn < 4; ++kn) gt0 = mfma16(a0[kn], cfr[kn], gt0);
#pragma unroll
                    for (int r = 0; r < 4; ++r) { const int s0 = 32 * ks + 16 * half + 4 * g4 + r; const float v0 = gt0[r] * __expf(acl - fa0[r]) * fd0[r]; mv[4 * half + r] = (s0 <= l) ? v0 : 0.f; }
                }
                s16x4 tA[4], tB[4];
#pragma unroll
                for (int pb = 0; pb < 4; ++pb) { tA[pb] = tr_read(L + SS_X + (32 * ks + 4 * g4 + q) * XLD + (16 * pb + 4 * pp) * 2); tB[pb] = tr_read(L + SS_X + (32 * ks + 16 + 4 * g4 + q) * XLD + (16 * pb + 4 * pp) * 2); }
                __builtin_amdgcn_sched_barrier(0);
                const bf16x8 bfrag = pack8f(mv);
#pragma unroll
                for (int pb = 0; pb < 4; ++pb) accd[pb] = mfma16(cat4(tA[pb], tB[pb]), bfrag, accd[pb]);
            }
            __builtin_amdgcn_sched_barrier(0);
            if (c + 1 < 16) SSD_PREFETCH(c + 1);
            __builtin_amdgcn_sched_barrier(0);
#pragma unroll
            for (int i = 0; i < 4; ++i) acco[i] = (f32x4){F.zf, F.zf, F.zf, F.zf};
#ifdef PROBE_ML
            PST(1);
#endif
#pragma unroll
            for (int kn = 0; kn < 4; ++kn) {
#pragma unroll
                for (int pb = 0; pb < 4; ++pb) { const bf16x8 a = *(const LAS bf16x8*)(L + SS_HB + (16 * pb + c16) * SLD + (32 * kn + 8 * g4) * 2); acco[pb] = mfma16(a, cfr[kn], acco[pb]); } }
#ifdef PROBE_ML
            PST(2);
#endif
            const float el = feac[l]; float ssq = 0.f;
#pragma unroll
            for (int pb = 0; pb < 4; ++pb) { const int p0 = 16 * pb + 4 * g4;
                const u32x2 zw = *(const LAS u32x2*)(L + SS_Z + l * XLD + p0 * 2); const float z[4] = {bflo(zw.x), bfhi(zw.x), bflo(zw.y), bfhi(zw.y)}; float o[4];
                const u32x2 xw = *(const LAS u32x2*)(L + SS_X + l * XLD + p0 * 2); const float xv[4] = {bflo(xw.x), bfhi(xw.x), bflo(xw.y), bfhi(xw.y)};
#pragma unroll
                for (int r = 0; r < 4; ++r) { const float y = accd[pb][r] + el * acco[pb][r] + Dsk * xv[r]; o[r] = y * siluf_(z[r]); ssq += o[r] * o[r]; }
                u32x2 ow; ow.x = pk2(o[0], o[1]); ow.y = pk2(o[2], o[3]); *(u32x2*)(MIX + row * 2048 + MIXS + hh * 64 + p0) = ow; }
            ssq += SHFL_XOR(ssq, 16); ssq += SHFL_XOR(ssq, 32);
            if (g4 == 0) SSQS[row * 16 + hh] = ssq;
#ifdef PROBE_ML
            PST(3);
#endif
            const float dec = feac[127];
#pragma unroll
            for (int pb = 0; pb < 4; ++pb) hst[pb] = hst[pb] * dec;
#pragma unroll
            for (int ks = 0; ks < 4; ++ks) {
                const s16x4 tA = tr_read(L + SS_BM + (32 * ks + 8 * g4 + q) * SLD + (16 * w + 4 * pp) * 2), tB = tr_read(L + SS_BM + (32 * ks + 8 * g4 + 4 + q) * SLD + (16 * w + 4 * pp) * 2);
                const f32x4 w0 = *(const LAS f32x4*)(fwdt + 32 * ks + 8 * g4), w1 = *(const LAS f32x4*)(fwdt + 32 * ks + 8 * g4 + 4);
                s16x4 xA[4], xB[4];
#pragma unroll
                for (int pb = 0; pb < 4; ++pb) { xA[pb] = tr_read(L + SS_X + (32 * ks + 8 * g4 + q) * XLD + (16 * pb + 4 * pp) * 2); xB[pb] = tr_read(L + SS_X + (32 * ks + 8 * g4 + 4 + q) * XLD + (16 * pb + 4 * pp) * 2); }
                const float bv[8] = {bf1((bf16_t)tA[0]) * w0[0], bf1((bf16_t)tA[1]) * w0[1], bf1((bf16_t)tA[2]) * w0[2], bf1((bf16_t)tA[3]) * w0[3], bf1((bf16_t)tB[0]) * w1[0], bf1((bf16_t)tB[1]) * w1[1], bf1((bf16_t)tB[2]) * w1[2], bf1((bf16_t)tB[3]) * w1[3]};
                const bf16x8 bfrag = pack8f(bv);
#pragma unroll
                for (int pb = 0; pb < 4; ++pb) hst[pb] = mfma16(cat4(xA[pb], xB[pb]), bfrag, hst[pb]);
            }
            if (w == 0 && c + 1 < 16) SSD_GATES((c + 1) & 1);
        }
#ifdef PROBE_ML
        PST(4);
#endif
        WG_BAR();
#pragma unroll
        for (int pb = 0; pb < 4; ++pb)
#pragma unroll
            for (int r = 0; r < 4; ++r) *(LAS bf16_t*)(L + SS_HB + (16 * pb + 4 * g4 + r) * SLD + (16 * w + c16) * 2) = f2bf(hst[pb][r]);
#ifdef PROBE_ML
        PST(5);
#endif
    }
#ifdef PROBE_ML
    if (F.bx == 0 && lane == 0) { unsigned long long* dg = (unsigned long long*)((unsigned char*)MIX - WS_MIX + 2883584); for (int k = 0; k < 7; ++k) dg[32 + 8 * w + k] = pa[k]; if (w == 7) { const unsigned long long dc = __builtin_amdgcn_s_memtime() - pc0, dr = __builtin_amdgcn_s_memrealtime() - pr0; dg[120] = dc * 400ull / dr; dg[121] = dr; } }
#endif
#undef SSD_PREFETCH
#undef SSD_PF_CB
#undef SSD_PF_X
#undef SSD_GATES
}

constexpr int VL2 = 80;
constexpr int ML_Q = 0, ML_K = 17408, ML_V = 34816, ML_CB = 39936, ML_F = 48640;
__device__ __forceinline__ void mlstm_unit(Frame& F, int b, int h, int vs, const bf16_t* __restrict__ U, const bf16_t* __restrict__ CV, bf16_t* __restrict__ MIX, float* __restrict__ SSQM, const float* __restrict__ gate_b) {
    LAS unsigned char* L = F.lds;
    const int tid = F.tid, lane = F.lane, w = F.wave, c16 = lane & 15, g4 = lane >> 4;
    LAS float* fbase = (LAS float*)(L + ML_F); LAS float* fnvec = fbase + 768;
    WG_BAR();
    for (int i = tid; i < 32 * SLD / 4; i += NTHR) ((LAS unsigned*)(L + ML_CB))[i] = 0u;
    if (tid < 128) fnvec[tid] = 0.f;
    const float bi = gate_b[h], bfg = gate_b[4 + h];
    float m_prev = 0.f;
    f32x4 cst[2], nacc; cst[0] = (f32x4){F.zf, F.zf, F.zf, F.zf}; cst[1] = cst[0]; nacc = cst[0];
    const bf16_t* cvq = CV + (size_t)b * SEQ * NCV + h * 128; const bf16_t* uv = U + (size_t)b * SEQ * NU + UV + h * 128 + vs * 32;
    u32x4 pq[2], pkk[2], pvv; unsigned gri = 0, grf = 0;
#define ML_PREFETCH(cc) do { const size_t r0_ = (size_t)(cc) * 64; \
        _Pragma("unroll") for (int i = 0; i < 2; ++i) { const int q_ = tid + 512 * i; pq[i] = *(const u32x4*)(cvq + (r0_ + (q_ >> 4)) * NCV + 8 * (q_ & 15)); pkk[i] = *(const u32x4*)(cvq + (r0_ + (q_ >> 4)) * NCV + 512 + 8 * (q_ & 15)); } \
        if (tid < 256) pvv = *(const u32x4*)(uv + (r0_ + (tid >> 2)) * NU + 8 * (tid & 3)); \
        if (w == 0) { gri = U[((size_t)b * SEQ + r0_ + lane) * NU + UMI + h]; grf = U[((size_t)b * SEQ + r0_ + lane) * NU + UMF + h]; } } while (0)
#define ML_GATES(buf) do { LAS float* fg_ = fbase + (buf) * 384; \
        const float li = bf1((bf16_t)gri) + bi, lf = logsigmoidf_(bf1((bf16_t)grf) + bfg); float bc = lf; \
        _Pragma("unroll") for (int o = 1; o < 64; o <<= 1) { const float x = SHFL_UP(bc, o); if (lane >= o) bc += x; } \
        const float total = SHFL_IDX(bc, 63), ct = li - bc; float cm = ct; \
        _Pragma("unroll") for (int o = 1; o < 64; o <<= 1) { const float x = SHFL_UP(cm, o); if (lane >= o) cm = fmaxf(cm, x); } \
        const float mj = bc + fmaxf(m_prev, cm); \
        fg_[lane] = bc - mj; fg_[64 + lane] = ct; fg_[128 + lane] = __expf(bc + m_prev - mj); fg_[192 + lane] = __expf(-mj); \
        const float m_new = total + fmaxf(m_prev, SHFL_IDX(cm, 63)); \
        fg_[256 + lane] = __expf(total - m_new + ct); if (lane == 0) fg_[320] = __expf(total + m_prev - m_new); \
        m_prev = m_new; } while (0)
    ML_PREFETCH(0);
    if (w == 0) ML_GATES(0);
#ifdef PROBE_ML
    unsigned long long pm0 = 0, pm1 = 0, pm2 = 0, pa1 = 0, pa2 = 0, pa3 = 0;
#endif
    for (int c = 0; c < 32; ++c) {
        const size_t row0 = (size_t)b * SEQ + c * 64;
#ifdef PROBE_ML
        pm0 = __builtin_amdgcn_s_memrealtime();
#endif
#pragma unroll
        for (int i = 0; i < 2; ++i) { const int q_ = tid + 512 * i; *(LAS u32x4*)(L + ML_Q + (q_ >> 4) * SLD + (q_ & 15) * 16) = pq[i]; *(LAS u32x4*)(L + ML_K + (q_ >> 4) * SLD + (q_ & 15) * 16) = pkk[i]; }
        if (tid < 256) *(LAS u32x4*)(L + ML_V + (tid >> 2) * VL2 + (tid & 3) * 16) = pvv;
        WG_BAR();
#ifdef PROBE_ML
        pm1 = __builtin_amdgcn_s_memrealtime(); pa1 += pm1 - pm0;
#endif
        if (c + 1 < 32) ML_PREFETCH(c + 1);
        {
            const LAS float* frow = fbase + (c & 1) * 384; const LAS float* fcol = frow + 64; const LAS float* fsint = frow + 128; const LAS float* femj = frow + 192; const LAS float* favec = frow + 256;
            const int jb = w & 3, vb = w >> 2; const int j = 16 * jb + c16; const float rt = frow[j]; const int q = c16 >> 2, pp = c16 & 3;
            f32x4 accD = (f32x4){F.zf, F.zf, F.zf, F.zf}, accI = accD; float dsum = 0.f;
            bf16x8 qfr[4];
#pragma unroll
            for (int kk = 0; kk < 4; ++kk) qfr[kk] = *(const LAS bf16x8*)(L + ML_Q + (16 * jb + c16) * SLD + (32 * kk + 8 * g4) * 2);
            for (int ks = 0; ks <= (jb >> 1); ++ks) {
                float mv[8];
#pragma unroll
                for (int half = 0; half < 2; ++half) {
                    bf16x8 a0[4];
#pragma unroll
                    for (int kk = 0; kk < 4; ++kk) a0[kk] = *(const LAS bf16x8*)(L + ML_K + (32 * ks + 16 * half + c16) * SLD + (32 * kk + 8 * g4) * 2);
                    const f32x4 fc0 = *(const LAS f32x4*)(fcol + 32 * ks + 16 * half + 4 * g4);
                    __builtin_amdgcn_sched_barrier(0);
                    f32x4 st = (f32x4){F.zf, F.zf, F.zf, F.zf};
#pragma unroll
                    for (int kk = 0; kk < 4; ++kk) st = mfma16(a0[kk], qfr[kk], st);
#pragma unroll
                    for (int r = 0; r < 4; ++r) { const int s = 32 * ks + 16 * half + 4 * g4 + r; float v = st[r] * __expf(rt + fc0[r]); v = (s <= j) ? v : 0.f; mv[4 * half + r] = v; dsum += v; }
                }
                const s16x4 tA = tr_read(L + ML_V + (32 * ks + 4 * g4 + q) * VL2 + (16 * vb + 4 * pp) * 2), tB = tr_read(L + ML_V + (32 * ks + 16 + 4 * g4 + q) * VL2 + (16 * vb + 4 * pp) * 2);
                const bf16x8 bfrag = pack8f(mv);
                accD = mfma16(cat4(tA, tB), bfrag, accD);
            }
            {
                bf16x8 cf[4];
#pragma unroll
                for (int kk = 0; kk < 4; ++kk) cf[kk] = *(const LAS bf16x8*)(L + ML_CB + (16 * vb + c16) * SLD + (32 * kk + 8 * g4) * 2);
                __builtin_amdgcn_sched_barrier(0);
#pragma unroll
                for (int kk = 0; kk < 4; ++kk) accI = mfma16(cf[kk], qfr[kk], accI);
            }
            float nq = 0.f;
#pragma unroll
            for (int i = 0; i < 4; ++i) { const u32x4 qr = *(const LAS u32x4*)(L + ML_Q + (16 * jb + c16) * SLD + (32 * g4 + 8 * i) * 2);
                const f32x4 n0 = *(const LAS f32x4*)(fnvec + 32 * g4 + 8 * i), n1 = *(const LAS f32x4*)(fnvec + 32 * g4 + 8 * i + 4);
                nq += bflo(qr.x) * n0[0] + bfhi(qr.x) * n0[1] + bflo(qr.y) * n0[2] + bfhi(qr.y) * n0[3] + bflo(qr.z) * n1[0] + bfhi(qr.z) * n1[1] + bflo(qr.w) * n1[2] + bfhi(qr.w) * n1[3]; }
            nq += SHFL_XOR(nq, 16); nq += SHFL_XOR(nq, 32);
            dsum += SHFL_XOR(dsum, 16); dsum += SHFL_XOR(dsum, 32);
            const float si = fsint[j]; const float den = si * nq + dsum; const float inv = 1.0f / fmaxf(fabsf(den), femj[j]);
            const size_t row = row0 + j; float o[4], ssq = 0.f;
#pragma unroll
            for (int r = 0; r < 4; ++r) { o[r] = (si * accI[r] + accD[r]) * inv; ssq += o[r] * o[r]; }
            u32x2 ow; ow.x = pk2(o[0], o[1]); ow.y = pk2(o[2], o[3]); *(u32x2*)(MIX + row * 2048 + MIXM + h * 128 + vs * 32 + 16 * vb + 4 * g4) = ow;
            ssq += SHFL_XOR(ssq, 16); ssq += SHFL_XOR(ssq, 32);
            if (g4 == 0) SSQM[row * 32 + h * 8 + vs * 2 + vb] = ssq;
            const float dec = frow[320];
            cst[0] = cst[0] * dec; cst[1] = cst[1] * dec; nacc = nacc * dec;
#pragma unroll
            for (int ks = 0; ks < 2; ++ks) {
                const s16x4 tA = tr_read(L + ML_K + (32 * ks + 8 * g4 + q) * SLD + (16 * w + 4 * pp) * 2), tB = tr_read(L + ML_K + (32 * ks + 8 * g4 + 4 + q) * SLD + (16 * w + 4 * pp) * 2);
                const f32x4 w0 = *(const LAS f32x4*)(favec + 32 * ks + 8 * g4), w1 = *(const LAS f32x4*)(favec + 32 * ks + 8 * g4 + 4);
                s16x4 xA[2], xB[2];
#pragma unroll
                for (int vb2 = 0; vb2 < 2; ++vb2) { xA[vb2] = tr_read(L + ML_V + (32 * ks + 8 * g4 + q) * VL2 + (16 * vb2 + 4 * pp) * 2); xB[vb2] = tr_read(L + ML_V + (32 * ks + 8 * g4 + 4 + q) * VL2 + (16 * vb2 + 4 * pp) * 2); }
                const float bv[8] = {bf1((bf16_t)tA[0]) * w0[0], bf1((bf16_t)tA[1]) * w0[1], bf1((bf16_t)tA[2]) * w0[2], bf1((bf16_t)tA[3]) * w0[3], bf1((bf16_t)tB[0]) * w1[0], bf1((bf16_t)tB[1]) * w1[1], bf1((bf16_t)tB[2]) * w1[2], bf1((bf16_t)tB[3]) * w1[3]};
                const bf16x8 bfrag = pack8f(bv);
                const bf16x8 ones8 = {(short)0x3f80, (short)0x3f80, (short)0x3f80, (short)0x3f80, (short)0x3f80, (short)0x3f80, (short)0x3f80, (short)0x3f80};
                nacc = mfma16(ones8, bfrag, nacc);
#pragma unroll
                for (int vb2 = 0; vb2 < 2; ++vb2) cst[vb2] = mfma16(cat4(xA[vb2], xB[vb2]), bfrag, cst[vb2]);
            }
            if (w == 0 && c + 1 < 32) ML_GATES((c + 1) & 1);
        }
#ifdef PROBE_ML
        pm2 = __builtin_amdgcn_s_memrealtime(); pa2 += pm2 - pm1;
#endif
        WG_BAR();
#pragma unroll
        for (int vb2 = 0; vb2 < 2; ++vb2)
#pragma unroll
            for (int r = 0; r < 4; ++r) *(LAS bf16_t*)(L + ML_CB + (16 * vb2 + 4 * g4 + r) * SLD + (16 * w + c16) * 2) = f2bf(cst[vb2][r]);
        if (g4 == 0) fnvec[16 * w + c16] = nacc[0];
#ifdef PROBE_ML
        pa3 += __builtin_amdgcn_s_memrealtime() - pm2;
#endif
    }
#ifdef PROBE_ML
    if (F.bx == 0 && lane == 0) { unsigned long long* dg = (unsigned long long*)((unsigned char*)MIX - WS_MIX + 2883584); dg[4 * w] = pa1; dg[4 * w + 1] = pa2; dg[4 * w + 2] = pa3; }
#endif
#undef ML_PREFETCH
#undef ML_GATES
}

constexpr int MB_K0 = 0, MB_V0 = 17408, MB_K1 = 34816, MB_V1 = 52224, MB_KM = 69632, MB_SEL = 73216;
__device__ __forceinline__ void moba_unit(Frame& F, int b, int h, int qb, const bf16_t* __restrict__ U, bf16_t* __restrict__ MIX, const float* __restrict__ KMEAN) {
    LAS unsigned char* L = F.lds;
    const int tid = F.tid, lane = F.lane, w = F.wave, c16 = lane & 15, g4 = lane >> 4;
    LAS float* km = (LAS float*)(L + MB_KM); LAS int* sel = (LAS int*)(L + MB_SEL);
    const size_t row0 = (size_t)b * SEQ + 256 * qb;
    WG_BAR();
    bf16x8 Qf[2][4]; u32x4 pk[2], pv[2];
    const int kr = tid >> 3, ch = tid & 7;
#pragma unroll
    for (int qq = 0; qq < 2; ++qq) { const bf16_t* qp = U + (row0 + 32 * w + 16 * qq + c16) * NU + UAQ + h * 128 + 8 * g4;
#pragma unroll
        for (int ds = 0; ds < 4; ++ds) Qf[qq][ds] = *(const bf16x8*)(qp + 32 * ds); }
    { const bf16_t* kp = U + ((size_t)b * SEQ + kr) * NU + UAK + h * 128; const bf16_t* vp = U + ((size_t)b * SEQ + kr) * NU + UAV + h * 128;
      pk[0] = *(const u32x4*)(kp + 8 * ch); pk[1] = *(const u32x4*)(kp + 8 * (ch + 8)); pv[0] = *(const u32x4*)(vp + 8 * ch); pv[1] = *(const u32x4*)(vp + 8 * (ch + 8)); }
    for (int i = tid; i < qb * 128; i += NTHR) { const float* kq = KMEAN + ((size_t)(b * 4 + h) * 8) * 128 + i; km[i] = (kq[0] + kq[NB * 4 * 8 * 128]) + (kq[2 * NB * 4 * 8 * 128] + kq[3 * NB * 4 * 8 * 128]); }
    WG_BAR();
    if (tid < 256) {
        int mask = (1 << qb) - 1;
        if (qb > 3) {
            float sc[7];
#pragma unroll
            for (int j = 0; j < 7; ++j) sc[j] = 0.f;
            const bf16_t* qp = U + (row0 + tid) * NU + UAQ + h * 128;
            for (int d8 = 0; d8 < 16; ++d8) { const u32x4 qr = *(const u32x4*)(qp + 8 * d8); const float qv[8] = {bflo(qr.x), bfhi(qr.x), bflo(qr.y), bfhi(qr.y), bflo(qr.z), bfhi(qr.z), bflo(qr.w), bfhi(qr.w)};
#pragma unroll
                for (int j = 0; j < 7; ++j) if (j < qb) { const f32x4 k0 = *(const LAS f32x4*)(km + j * 128 + 8 * d8), k1 = *(const LAS f32x4*)(km + j * 128 + 8 * d8 + 4);
                    sc[j] += qv[0] * k0[0] + qv[1] * k0[1] + qv[2] * k0[2] + qv[3] * k0[3] + qv[4] * k1[0] + qv[5] * k1[1] + qv[6] * k1[2] + qv[7] * k1[3]; } }
            mask = 0;
#pragma unroll
            for (int it = 0; it < 3; ++it) { float best = -__builtin_inff(); int bi = 0;
#pragma unroll
                for (int j = 0; j < 7; ++j) if (j < qb && !((mask >> j) & 1) && sc[j] > best) { best = sc[j]; bi = j; }
                mask |= 1 << bi; }
        }
        sel[tid] = mask;
    }
    WG_BAR();
    int msk[2]; float mrun[2], lsum[2]; f32x4 O[2][8];
#pragma unroll
    for (int qq = 0; qq < 2; ++qq) {
        msk[qq] = sel[32 * w + 16 * qq + c16]; mrun[qq] = -1e30f; lsum[qq] = 0.f;
#pragma unroll
        for (int db = 0; db < 8; ++db) O[qq][db] = (f32x4){F.zf, F.zf, F.zf, F.zf}; }
    const int ntiles = 4 * (qb + 1);
    const float SC = 0.08838834764831845f * 1.4426950408889634f;
    for (int tt = 0; tt < ntiles; ++tt) {
        const int kofs = (tt & 1) ? MB_K1 : MB_K0, vofs = (tt & 1) ? MB_V1 : MB_V0;
        *(LAS u32x4*)(L + kofs + kr * SLD + ch * 16) = pk[0]; *(LAS u32x4*)(L + kofs + kr * SLD + (ch + 8) * 16) = pk[1];
        *(LAS u32x4*)(L + vofs + kr * SLD + ch * 16) = pv[0]; *(LAS u32x4*)(L + vofs + kr * SLD + (ch + 8) * 16) = pv[1];
        WG_BAR();
        if (tt + 1 < ntiles) { const bf16_t* kp = U + ((size_t)b * SEQ + 64 * (tt + 1) + kr) * NU + UAK + h * 128; const bf16_t* vp = U + ((size_t)b * SEQ + 64 * (tt + 1) + kr) * NU + UAV + h * 128;
            pk[0] = *(const u32x4*)(kp + 8 * ch); pk[1] = *(const u32x4*)(kp + 8 * (ch + 8)); pv[0] = *(const u32x4*)(vp + 8 * ch); pv[1] = *(const u32x4*)(vp + 8 * (ch + 8)); }
        const int jblk = tt >> 2; const bool own = (jblk == qb);
        f32x4 st[4][2];
#pragma unroll
        for (int kb = 0; kb < 4; ++kb) { st[kb][0] = (f32x4){F.zf, F.zf, F.zf, F.zf}; st[kb][1] = st[kb][0];
#pragma unroll
            for (int ds = 0; ds < 4; ++ds) { const bf16x8 a = *(const LAS bf16x8*)(L + kofs + (16 * kb + c16) * SLD + (32 * ds + 8 * g4) * 2);
                st[kb][0] = mfma16(a, Qf[0][ds], st[kb][0]); st[kb][1] = mfma16(a, Qf[1][ds], st[kb][1]); } }
        bf16x8 pf[2][2];
#pragma unroll
        for (int qq = 0; qq < 2; ++qq) {
            const float NEG = -__builtin_inff();
            if (own) { const int qi = 32 * w + 16 * qq + c16, kbase = 64 * (tt & 3) + 4 * g4;
#pragma unroll
                for (int kb = 0; kb < 4; ++kb)
#pragma unroll
                    for (int r = 0; r < 4; ++r) if (kbase + 16 * kb + r > qi) st[kb][qq][r] = NEG;
            } else if (!((msk[qq] >> jblk) & 1)) {
#pragma unroll
                for (int kb = 0; kb < 4; ++kb) st[kb][qq] = (f32x4){NEG, NEG, NEG, NEG};
            }
            float rm = st[0][qq][0];
#pragma unroll
            for (int kb = 0; kb < 4; ++kb)
#pragma unroll
                for (int r = 0; r < 4; ++r) rm = fmaxf(rm, st[kb][qq][r]);
            rm = fmaxf(rm, SHFL_XOR(rm, 16)); rm = fmaxf(rm, SHFL_XOR(rm, 32));
            const float mn = fmaxf(mrun[qq], rm), alpha = __builtin_amdgcn_exp2f((mrun[qq] - mn) * SC), mnsc = -mn * SC; mrun[qq] = mn;
            float ps = 0.f; float pvv[4][4];
#pragma unroll
            for (int kb = 0; kb < 4; ++kb)
#pragma unroll
                for (int r = 0; r < 4; ++r) { const float pe = __builtin_amdgcn_exp2f(__builtin_fmaf(st[kb][qq][r], SC, mnsc)); pvv[kb][r] = pe; ps += pe; }
            lsum[qq] = lsum[qq] * alpha + ps;
            if (__builtin_amdgcn_ballot_w64(alpha != 1.0f) != 0ull) {
#pragma unroll
                for (int db = 0; db < 8; ++db) O[qq][db] = O[qq][db] * alpha; }
#pragma unroll
            for (int ks = 0; ks < 2; ++ks) { const float v8[8] = {pvv[2 * ks][0], pvv[2 * ks][1], pvv[2 * ks][2], pvv[2 * ks][3], pvv[2 * ks + 1][0], pvv[2 * ks + 1][1], pvv[2 * ks + 1][2], pvv[2 * ks + 1][3]}; pf[qq][ks] = pack8f(v8); }
        }
        const int q = c16 >> 2, p = c16 & 3;
#pragma unroll
        for (int ks = 0; ks < 2; ++ks)
#pragma unroll
            for (int db = 0; db < 8; ++db) {
                const s16x4 tA = tr_read(L + vofs + (32 * ks + 4 * g4 + q) * SLD + (16 * db + 4 * p) * 2), tB = tr_read(L + vofs + (32 * ks + 16 + 4 * g4 + q) * SLD + (16 * db + 4 * p) * 2);
                const bf16x8 a = cat4(tA, tB);
                O[0][db] = mfma16(a, pf[0][ks], O[0][db]); O[1][db] = mfma16(a, pf[1][ks], O[1][db]);
            }
    }
#pragma unroll
    for (int qq = 0; qq < 2; ++qq) { float ls = lsum[qq]; ls += SHFL_XOR(ls, 16); ls += SHFL_XOR(ls, 32); const float inv = 1.0f / ls;
        bf16_t* op = MIX + (row0 + 32 * w + 16 * qq + c16) * 2048 + MIXA + h * 128 + 4 * g4;
#pragma unroll
        for (int db = 0; db < 8; ++db) { u32x2 ow; ow.x = pk2(O[qq][db][0] * inv, O[qq][db][1] * inv); ow.y = pk2(O[qq][db][2] * inv, O[qq][db][3] * inv); *(u32x2*)(op + 16 * db) = ow; } }
}
constexpr int KM_Q = NB * 4 * 8 * 128;
__device__ __forceinline__ void kmean_items(Frame& F, const bf16_t* __restrict__ U, float* __restrict__ KMEAN) {
    const int gw = F.vcu * NWAVES + F.wave, NGW = NWG * NWAVES;
    for (int it4 = gw; it4 < NB * 4 * 8 * 4; it4 += NGW) {
        const int q = it4 & 3, it = it4 >> 2; const int blk = it & 7, h = (it >> 3) & 3, b = it >> 5;
        const int lane = F.lane, cg = lane & 15, rg = lane >> 4;
        const bf16_t* kp = U + ((size_t)b * SEQ + 256 * blk + 64 * q + rg) * NU + UAK + h * 128 + 8 * cg;
        u32x4 v[16];
#pragma unroll
        for (int i = 0; i < 16; ++i) v[i] = *(const u32x4*)(kp + (size_t)(4 * i) * NU);
        float s[8];
#pragma unroll
        for (int j = 0; j < 8; ++j) s[j] = 0.f;
#pragma unroll
        for (int i = 0; i < 16; ++i) { s[0] += bflo(v[i].x); s[1] += bfhi(v[i].x); s[2] += bflo(v[i].y); s[3] += bfhi(v[i].y); s[4] += bflo(v[i].z); s[5] += bfhi(v[i].z); s[6] += bflo(v[i].w); s[7] += bfhi(v[i].w); }
#pragma unroll
        for (int j = 0; j < 8; ++j) { s[j] += SHFL_XOR(s[j], 16); s[j] += SHFL_XOR(s[j], 32); }
        if (rg == 0) { float* op = KMEAN + (size_t)q * KM_Q + (size_t)it * 128 + 8 * cg;
            *(f32x4*)op = (f32x4){s[0] * (1.f / 256.f), s[1] * (1.f / 256.f), s[2] * (1.f / 256.f), s[3] * (1.f / 256.f)}; *(f32x4*)(op + 4) = (f32x4){s[4] * (1.f / 256.f), s[5] * (1.f / 256.f), s[6] * (1.f / 256.f), s[7] * (1.f / 256.f)}; }
    }
}
static_assert(T % (4 * NWG * NWAVES) == 0, "mixnorm row batches");
__device__ __forceinline__ void mixnorm_rows(Frame& F, const bf16_t* __restrict__ U, bf16_t* __restrict__ MIX, const float* __restrict__ SSQM, const float* __restrict__ SSQS,
                                             const float* __restrict__ m_norm_g, const float* __restrict__ s_norm_g) {
    const int gw = F.vcu * NWAVES + F.wave, NGW = NWG * NWAVES, lane = F.lane;
    const int colm = 8 * lane, hm = colm >> 7;
    const f32x4 gm0 = *(const f32x4*)(m_norm_g + colm), gm1 = *(const f32x4*)(m_norm_g + colm + 4);
    f32x4 gs0[2], gs1[2];
#pragma unroll
    for (int i = 0; i < 2; ++i) { gs0[i] = *(const f32x4*)(s_norm_g + 512 * i + 8 * lane); gs1[i] = *(const f32x4*)(s_norm_g + 512 * i + 8 * lane + 4); }
    for (int row0 = gw; row0 < T; row0 += 4 * NGW) {
        f32x4 qm0[4], qm1[4], qs0[4][2], qs1[4][2]; u32x4 hvm[4], ovm[4], hvs[4][2];
#pragma unroll
        for (int k = 0; k < 4; ++k) { const int row = row0 + k * NGW;
            qm0[k] = *(const f32x4*)(SSQM + (size_t)row * 32 + hm * 8); qm1[k] = *(const f32x4*)(SSQM + (size_t)row * 32 + hm * 8 + 4);
            hvm[k] = *(const u32x4*)(MIX + (size_t)row * 2048 + MIXM + colm); ovm[k] = *(const u32x4*)(U + (size_t)row * NU + UO + colm);
#pragma unroll
            for (int i = 0; i < 2; ++i) { qs0[k][i] = *(const f32x4*)(SSQS + (size_t)row * 16 + 8 * i); qs1[k][i] = *(const f32x4*)(SSQS + (size_t)row * 16 + 8 * i + 4); hvs[k][i] = *(const u32x4*)(MIX + (size_t)row * 2048 + MIXS + 512 * i + 8 * lane); } }
#pragma unroll
        for (int k = 0; k < 4; ++k) { const int row = row0 + k * NGW;
            {   const float ssq = (qm0[k][0] + qm0[k][1]) + (qm0[k][2] + qm0[k][3]) + (qm1[k][0] + qm1[k][1]) + (qm1[k][2] + qm1[k][3]);
                const float r = 1.0f / sqrtf(ssq * (1.f / 128.f) + EPS); const u32x4 hv = hvm[k], ov = ovm[k]; u32x4 o;
                o.x = pk2(bflo(hv.x) * r * gm0[0] * sigmoidf_(bflo(ov.x)), bfhi(hv.x) * r * gm0[1] * sigmoidf_(bfhi(ov.x)));
                o.y = pk2(bflo(hv.y) * r * gm0[2] * sigmoidf_(bflo(ov.y)), bfhi(hv.y) * r * gm0[3] * sigmoidf_(bfhi(ov.y)));
                o.z = pk2(bflo(hv.z) * r * gm1[0] * sigmoidf_(bflo(ov.z)), bfhi(hv.z) * r * gm1[1] * sigmoidf_(bfhi(ov.z)));
                o.w = pk2(bflo(hv.w) * r * gm1[2] * sigmoidf_(bflo(ov.w)), bfhi(hv.w) * r * gm1[3] * sigmoidf_(bfhi(ov.w)));
                *(u32x4*)(MIX + (size_t)row * 2048 + MIXM + colm) = o; }
#pragma unroll
            for (int i = 0; i < 2; ++i) { const f32x4 q0 = qs0[k][i], q1 = qs1[k][i];
                const float ssq = (q0[0] + q0[1]) + (q0[2] + q0[3]) + (q1[0] + q1[1]) + (q1[2] + q1[3]);
                const float r = 1.0f / sqrtf(ssq * (1.f / 512.f) + EPS); const u32x4 hv = hvs[k][i]; u32x4 o;
                o.x = pk2(bflo(hv.x) * r * gs0[i][0], bfhi(hv.x) * r * gs0[i][1]); o.y = pk2(bflo(hv.y) * r * gs0[i][2], bfhi(hv.y) * r * gs0[i][3]);
                o.z = pk2(bflo(hv.z) * r * gs1[i][0], bfhi(hv.z) * r * gs1[i][1]); o.w = pk2(bflo(hv.w) * r * gs1[i][2], bfhi(hv.w) * r * gs1[i][3]);
                *(u32x4*)(MIX + (size_t)row * 2048 + MIXS + 512 * i + 8 * lane) = o; } }
    }
}
constexpr int LT_TAB = 0, LT_CUMT = 320, LT_LCNT = 340, LT_BASE = 356, LT_TOT = 372, LT_GOFF = 388, LT_PART = 416, LT_PRE = 928;
__device__ __forceinline__ void moe_route(Frame& F, const bf16_t* XS, const float* g, const float* Wr, int* ROUTE, int* WGCNT, int* TOK) {
    LAS unsigned char* L = F.lds; LAS int* lt = (LAS int*)(L + LTAB_OFF); const int lane = F.lane;
    constexpr int WSTR = D + 4;
    LAS float* Wt = (LAS float*)L;
    LAS float* Cw = (LAS float*)(L + 66048) + F.wave * 256;
    WG_BAR();
    for (int i = F.tid; i < D * NEXP / 4; i += NTHR) { const int k = i >> 1, half = i & 1; const f32x4 v = ((const f32x4*)Wr)[i] * g[k];
        Wt[(4 * half + 0) * WSTR + k] = v[0]; Wt[(4 * half + 1) * WSTR + k] = v[1]; Wt[(4 * half + 2) * WSTR + k] = v[2]; Wt[(4 * half + 3) * WSTR + k] = v[3]; }
    if (F.tid < 16) lt[LT_LCNT + F.tid] = 0;
    for (int i = F.bx * NTHR + F.tid; i < MOE_ROWS; i += NWG * NTHR) TOK[i] = -1;
    WG_BAR();
    const int ri = lane & 15, kq = lane >> 4, row0 = 128 * F.bx + 16 * F.wave;
    const u32x4* xr = (const u32x4*)(XS + (size_t)(row0 + ri) * D) + kq;
    const LAS float* wl = Wt + (lane & 7) * WSTR + 8 * kq;
    f32x4 acc = (f32x4){F.zf, F.zf, F.zf, F.zf}; float ssq = 0.f;
    u32x4 cur[8], nxt[8];
#pragma unroll
    for (int c = 0; c < 8; ++c) cur[c] = xr[4 * c];
#pragma unroll 1
    for (int tb = 0; tb < 8; ++tb) {
        if (tb + 1 < 8) {
#pragma unroll
            for (int c = 0; c < 8; ++c) nxt[c] = xr[4 * (8 * (tb + 1) + c)]; }
#pragma unroll
        for (int c = 0; c < 8; ++c) {
            const f32x4 w0 = *(const LAS f32x4*)(wl + 32 * (8 * tb + c)), w1 = *(const LAS f32x4*)(wl + 32 * (8 * tb + c) + 4);
            const u32x4 r = cur[c]; const float xv[8] = {bflo(r.x), bfhi(r.x), bflo(r.y), bfhi(r.y), bflo(r.z), bfhi(r.z), bflo(r.w), bfhi(r.w)};
            const float wv[8] = {w0[0], w0[1], w0[2], w0[3], w1[0], w1[1], w1[2], w1[3]};
#pragma unroll
            for (int u = 0; u < 8; ++u) { ssq += xv[u] * xv[u]; acc = __builtin_amdgcn_mfma_f32_16x16x4f32(xv[u], wv[u], acc, 0, 0, 0); }
        }
        if (tb + 1 < 8) {
#pragma unroll
            for (int c = 0; c < 8; ++c) cur[c] = nxt[c]; }
    }
    ssq += SHFL_XOR(ssq, 16); ssq += SHFL_XOR(ssq, 32);
    const float rstd = 1.0f / sqrtf(ssq * (1.f / D) + EPS);
#pragma unroll
    for (int r = 0; r < 4; ++r) Cw[(4 * kq + r) * 16 + ri] = acc[r];
    if (lane < 16) {
        const f32x4 l0 = *(const LAS f32x4*)(Cw + lane * 16), l1 = *(const LAS f32x4*)(Cw + lane * 16 + 4);
        const float lg[8] = {l0[0] * rstd, l0[1] * rstd, l0[2] * rstd, l0[3] * rstd, l1[0] * rstd, l1[1] * rstd, l1[2] * rstd, l1[3] * rstd};
        const int row = row0 + lane;
        int e0 = 0; float b0 = lg[0];
#pragma unroll
        for (int e = 1; e < 8; ++e) if (lg[e] > b0) { b0 = lg[e]; e0 = e; }
        int e1 = -1; float b1 = -__builtin_inff();
#pragma unroll
        for (int e = 0; e < 8; ++e) if (e != e0 && lg[e] > b1) { b1 = lg[e]; e1 = e; }
        if (e1 < 0) e1 = (e0 == 0) ? 1 : 0;
        const float w1 = 1.0f / (1.0f + __expf(b0 - b1)), w0 = 1.0f - w1;
        const int r0 = __hip_atomic_fetch_add(lt + LT_LCNT + e0, 1, __ATOMIC_RELAXED, __HIP_MEMORY_SCOPE_WORKGROUP), r1 = __hip_atomic_fetch_add(lt + LT_LCNT + 8 + e1, 1, __ATOMIC_RELAXED, __HIP_MEMORY_SCOPE_WORKGROUP);
        ROUTE[row] = e0 | (e1 << 8); ROUTE[T + row] = r0; ROUTE[2 * T + row] = r1; ((float*)ROUTE)[3 * T + row] = w0; ((float*)ROUTE)[4 * T + row] = w1; ((float*)ROUTE)[5 * T + row] = rstd;
    }
    WG_BAR();
    if (F.tid < 16) WGCNT[F.bx * 16 + F.tid] = lt[LT_LCNT + F.tid];
}
__device__ __forceinline__ void moe_tables(Frame& F, const int* WGCNT) {
    LAS unsigned char* L = F.lds; LAS int* lt = (LAS int*)(L + LTAB_OFF); const int tid = F.tid, c = F.bx;
    WG_BAR();
    { const int g = tid & 15, chn = tid >> 4; int s = 0;
#pragma unroll
      for (int i = 0; i < 8; ++i) s += WGCNT[(8 * chn + i) * 16 + g];
      lt[LT_PART + chn * 16 + g] = s; }
    WG_BAR();
    if (tid < 16) { int run = 0; for (int chn = 0; chn < 32; ++chn) { lt[LT_PRE + chn * 16 + tid] = run; run += lt[LT_PART + chn * 16 + tid]; } lt[LT_TOT + tid] = run; }
    WG_BAR();
    if (tid == 0) { int off = 0;
        for (int g = 0; g < 16; ++g) { const int nt = (lt[LT_TOT + g] + 255) >> 8; lt[LT_CUMT + g] = off >> 8; lt[LT_GOFF + g] = off; for (int t = 0; t < nt; ++t) lt[LT_TAB + (off >> 8) + t] = g & 7; off += nt << 8; }
        lt[LT_CUMT + 16] = off >> 8; }
    WG_BAR();
    if (tid < 16) { int bs = lt[LT_GOFF + tid] + lt[LT_PRE + (c >> 3) * 16 + tid]; for (int w2 = 8 * (c >> 3); w2 < c; ++w2) bs += WGCNT[w2 * 16 + tid]; lt[LT_BASE + tid] = bs; }
    WG_BAR();
}
__device__ __forceinline__ void moe_gather(Frame& F, const unsigned char* XA8, const int* ROUTE, const int* WGCNT, unsigned char* XG8, int* TOK, float* WGT, float* RS) {
    LAS unsigned char* L = F.lds; LAS int* lt = (LAS int*)(L + LTAB_OFF); const int lane = F.lane, c = F.bx;
    int ee[8], ra[8], rb[8]; float wa[8], wb[8], rr[8]; u32x4 xv[8][2];
#define MG_LOAD(i0) do { _Pragma("unroll") for (int k = 0; k < 8; ++k) { const int row = 128 * c + 16 * F.wave + (i0) + k; ee[k] = ROUTE[row]; ra[k] = ROUTE[T + row]; rb[k] = ROUTE[2 * T + row]; \
            wa[k] = ((const float*)ROUTE)[3 * T + row]; wb[k] = ((const float*)ROUTE)[4 * T + row]; rr[k] = ((const float*)ROUTE)[5 * T + row]; \
            const u32x4* src = (const u32x4*)(XA8 + (size_t)row * D) + lane; xv[k][0] = src[0]; xv[k][1] = src[64]; } } while (0)
#define MG_STORE(i0) do { _Pragma("unroll") for (int k = 0; k < 8; ++k) { const int row = 128 * c + 16 * F.wave + (i0) + k; const int e0 = ee[k] & 255, e1 = ee[k] >> 8; \
            const int pos0 = lt[LT_BASE + e0] + ra[k], pos1 = lt[LT_BASE + 8 + e1] + rb[k]; \
            u32x4* d0 = (u32x4*)(XG8 + (size_t)pos0 * D) + lane; u32x4* d1 = (u32x4*)(XG8 + (size_t)pos1 * D) + lane; \
            d0[0] = xv[k][0]; d0[64] = xv[k][1]; d1[0] = xv[k][0]; d1[64] = xv[k][1]; \
            if (lane == 0) { TOK[pos0] = row; TOK[pos1] = row; WGT[pos0] = wa[k]; WGT[pos1] = wb[k]; RS[pos0] = rr[k]; RS[pos1] = rr[k]; } } } while (0)
    MG_LOAD(0);
    moe_tables(F, WGCNT);
    MG_STORE(0);
    MG_LOAD(8);
    MG_STORE(8);
#undef MG_LOAD
#undef MG_STORE
}

#ifndef NEXP_LATE
#define NEXP_LATE 1
#endif
#ifndef NEXP_TAIL
#define NEXP_TAIL 2
#endif
#ifndef NGEMM0
#define NGEMM0 192
#endif
#ifndef INPROJ1_FP8
#define INPROJ1_FP8 0
#endif
#ifndef FFN_DOWN_FP8
#define FFN_DOWN_FP8 0
#endif
#ifndef MOE_DOWN_FP8
#define MOE_DOWN_FP8 1
#endif
#ifndef PROBE_SSQ0
#define PROBE_SSQ0 SSQ_(7)
#endif
#ifndef RES_ALIGN
#define RES_ALIGN false
#endif
enum { I_X = 0, I_P, I_LNMIX, I_WIN, I_WOUT, I_MCW, I_MCB, I_MGB, I_MNG, I_SCW, I_SCB, I_SDTB, I_SALOG, I_SD, I_SNG, I_LNFFN, I_FWG, I_FWU, I_FWD, I_ROUTER, I_MWG, I_MWU, I_MWD, I_LNPLE, I_PPROJ, I_PGATE, I_LNFINAL };

__global__ void __launch_bounds__(NTHR, 2) hybrid_fwd(Args args) {
    extern __shared__ __attribute__((aligned(16))) unsigned char lds_raw[];
    Frame F;
    F.lds = (LAS unsigned char*)lds_raw;
    F.tid = threadIdx.x; F.lane = F.tid & 63; F.wave = __builtin_amdgcn_readfirstlane(F.tid >> 6);
    F.zf = 0.f; F.zu = 0u;
    const int wave0 = F.wave;
    F.bx = blockIdx.x; F.vcu = (F.bx % 8) * (NWG / 8) + F.bx / 8;
    volatile LAS unsigned* MISC = (volatile LAS unsigned*)(F.lds + MISC_OFF);
    for (int u = F.tid; u < 64; u += NTHR) MISC[u] = 0u;
    __syncthreads();
    unsigned* ctl = (unsigned*)(args.ws + WS_CTL);
    XcdBarrier bar = xcd_barrier_post(ctl + CW_BAR, MISC + 8);
    const int lo = args.ph_lo, hi = args.ph_hi; int ph = 0;
#define PHASE_BEGIN if (ph >= lo && ph < hi) { { int w_ = wave0; asm volatile("" : "+s"(w_)); unsigned z_ = 0u; asm volatile("" : "+s"(z_)); int t_ = (int)__builtin_amdgcn_mbcnt_hi(~0u, __builtin_amdgcn_mbcnt_lo(~0u, z_)); asm volatile("" : "+v"(t_)); t_ += w_ * 64; F.tid = t_; F.lane = t_ & 63; F.wave = w_; F.zu = z_; F.zf = __builtin_bit_cast(float, z_); LAS unsigned char* b_ = (LAS unsigned char*)lds_raw; asm volatile("" : "+s"(b_)); F.lds = b_; int x_ = blockIdx.x; asm volatile("" : "+s"(x_)); F.bx = x_; F.vcu = (x_ % 8) * (NWG / 8) + x_ / 8; }
#define REFRESH_TID() do { int w_ = wave0; asm volatile("" : "+s"(w_)); unsigned z_ = 0u; asm volatile("" : "+s"(z_)); int t_ = (int)__builtin_amdgcn_mbcnt_hi(~0u, __builtin_amdgcn_mbcnt_lo(~0u, z_)); asm volatile("" : "+v"(t_)); t_ += w_ * 64; F.tid = t_; F.lane = t_ & 63; F.wave = w_; F.zu = z_; F.zf = __builtin_bit_cast(float, z_); } while (0)
#ifdef PROBE_TS
#define TS_STAMP(idx) do { unsigned zz_ = 0u; asm volatile("" : "+s"(zz_)); const int ll_ = (int)__builtin_amdgcn_mbcnt_hi(~0u, __builtin_amdgcn_mbcnt_lo(~0u, zz_)); if (blockIdx.x == 0 && wave0 == 0 && ll_ == 0) ((LAS unsigned long long*)((LAS unsigned char*)lds_raw + PTAB_OFF + 512))[(idx)] = __builtin_amdgcn_s_memrealtime(); } while (0)
#else
#define TS_STAMP(idx) do {} while (0)
#endif
#define PHASE_END(last) if (!(last) && ph + 1 < hi) xcd_barrier(bar); TS_STAMP(ph + 1); } ++ph;

    if (F.tid == 0) { LAS unsigned long long* pt = (LAS unsigned long long*)(F.lds + PTAB_OFF);
#pragma unroll
        for (int i = 0; i < 27; ++i) pt[i] = (unsigned long long)(uintptr_t)args.in[i];
        pt[27] = (unsigned long long)(uintptr_t)args.out; pt[28] = (unsigned long long)(uintptr_t)args.ws; }
    __syncthreads();
    TS_STAMP(0);
#define PTR_(i) ld_ptr(F.lds, (i))
#define IN_(i) ((const float*)PTR_(i))
#define X_ ((float*)PTR_(27))
#define WSB_(off) (PTR_(28) + (off))
#define WIN ((bf16_t*)WSB_(WS_WIN))
#define WOUT ((bf16_t*)WSB_(WS_WOUT))
#define FGU ((bf16_t*)WSB_(WS_FGU))
#define FD ((bf16_t*)WSB_(WS_FD))
#define MGU ((bf16_t*)WSB_(WS_MGU))
#define MD ((bf16_t*)WSB_(WS_MD))
#define PG ((bf16_t*)WSB_(WS_PG))
#define PP ((bf16_t*)WSB_(WS_PP))
#define XN ((bf16_t*)WSB_(WS_XN))
#define P16 ((bf16_t*)WSB_(WS_P16))
#define U ((bf16_t*)WSB_(WS_U))
#define MIX ((bf16_t*)WSB_(WS_MIX))
#define CVB ((bf16_t*)WSB_(WS_CV))
#define H ((bf16_t*)WSB_(WS_H))
#define XBB ((bf16_t*)WSB_(WS_XBB))
#define XA8 ((unsigned char*)WSB_(WS_XA8))
#define XB8 ((unsigned char*)WSB_(WS_CV))
#define SSQ_(i) ((pg8::ssq_t*)WSB_(WS_SSQ) + (size_t)(i) * T)
#define RS ((float*)WSB_(WS_WGT + 512 * 1024))
#define XG ((bf16_t*)WSB_(WS_XG))
#define HM ((bf16_t*)WSB_(WS_HM))
#define SSQM ((float*)WSB_(WS_SSQM))
#define SSQS ((float*)WSB_(WS_SSQS))
#define KMEAN ((float*)WSB_(WS_KMEAN))
#define ROUTE ((int*)WSB_(WS_ROUTE))
#define TOK ((int*)WSB_(WS_TOK))
#define WGT ((float*)WSB_(WS_WGT))
#define WGCNT ((int*)WSB_(WS_WGCNT))
    PHASE_BEGIN
    {
        LAS float* scr = (LAS float*)(F.lds + RING_OFF + F.wave * XP_SCR); const int gw = F.vcu * NWAVES + F.wave, NGW = NWG * NWAVES;
        {   const float* W = IN_(I_WIN); bf16_t* WT = WIN; const int nblk = NU / 64, items = (D / 64) * nblk;
            for (int it = gw; it < items; it += NGW) { const int kb = it / nblk, nb = it % nblk; xpose_item<false>(W, DPROJ_SRC, win_srccol(nb * 64 + 4 * (F.lane & 15)), kb * 64, WT, D, nb * 64, scr, F.lane, IN_(I_LNMIX), F.zf); } }
        {
            const float* xs = IN_(I_X); bf16_t* xb = XBB; pg8::ssq_t* sq = SSQ_(0); f32x4 v[8];
            for (int m = gw; m < T; m += NGW) { (void)load_row_ssq(F, xs + (size_t)m * D, v); float s = 0.f;
#pragma unroll
                for (int j = 0; j < 8; ++j) { u32x2 w; w.x = pk2(v[j].x, v[j].y); w.y = pk2(v[j].z, v[j].w); ((u32x2*)(xb + (size_t)m * D) + F.lane)[64 * j] = w;
                    const float a = bflo(w.x), b = bfhi(w.x), c = bflo(w.y), d = bfhi(w.y); s += (a * a + b * b) + (c * c + d * d); }
                s = wave_sum(s);
                if (F.lane == 0) sq[m] = (pg8::ssq_t)(s * pg8::SSQ_SCALE + 0.5f); }
        }
    }
    PHASE_END(false)
    PHASE_BEGIN
    if (F.bx < NGEMM0) {
        pg8::StaticOrder S; S.init(T, NU, NGEMM0, F.bx); pg8::EpiBf16 E{U, NU, SSQ_(0), 1.0f, (LAS float*)(F.lds + RING_BYTES), (volatile LAS unsigned*)(F.lds + MISC_OFF) + 24, 0x20000u};
        pg8::Gemm g{XBB, WIN, D, D, D, 0}; pg8::gemm_phase<pg8::EpiBf16, pg8::StaticOrder, true>(F.lds + RING_OFF, g, S, E, F.tid);
        REFRESH_TID();
        { LAS float* scr = (LAS float*)(F.lds + RING_OFF + F.wave * XP_SCR); const int gw = F.bx * NWAVES + F.wave, NGW = NGEMM0 * NWAVES;
          for (int e = NEXP - NEXP_TAIL; e < NEXP; ++e) {
            if (e < NEXP - NEXP_LATE) xpose_gu(F, IN_(I_MWG) + (size_t)e * D * DFFE, IN_(I_MWU) + (size_t)e * D * DFFE, D, DFFE, MGU + (size_t)e * 2 * DFFE * (D / 2), scr, gw, NGW, IN_(I_LNFFN) + D);
            xpose_plain<MOE_DOWN_FP8 != 0>(F, IN_(I_MWD) + (size_t)e * DFFE * D, DFFE, D, MD + (size_t)e * D * (MOE_DOWN_FP8 ? DFFE / 2 : DFFE), scr, gw, NGW, nullptr); } }
    } else {
        LAS float* scr = (LAS float*)(F.lds + RING_OFF + F.wave * XP_SCR); const int gw = (F.bx - NGEMM0) * NWAVES + F.wave, NGW = (NWG - NGEMM0) * NWAVES;
        for (int l = 0; l < DEPTH; ++l) {
            if (l == 1) {
                const float* W = IN_(I_WIN) + (size_t)l * D * DPROJ_SRC; bf16_t* WT = WIN + (size_t)l * NU * D;
                const int nblk = NU / 64, items = (D / 64) * nblk;
                for (int it = gw; it < items; it += NGW) { const int kb = it / nblk, nb = it % nblk; xpose_item<INPROJ1_FP8 != 0>(W, DPROJ_SRC, win_srccol(nb * 64 + 4 * (F.lane & 15)), kb * 64, WT, D, nb * 64, scr, F.lane, IN_(I_LNMIX) + (size_t)l * D, F.zf); }
            }
            xpose_plain(F, IN_(I_WOUT) + (size_t)l * D * D, D, D, WOUT + (size_t)l * D * D, scr, gw, NGW, nullptr);
            xpose_plain<true>(F, IN_(I_PGATE) + (size_t)l * D * D, D, D, PG + (size_t)l * D * (D / 2), scr, gw, NGW, IN_(I_LNPLE) + (size_t)l * D);
            xpose_plain(F, IN_(I_PPROJ) + (size_t)l * PLE * D, PLE, D, PP + (size_t)l * D * PLE, scr, gw, NGW, nullptr);
        }
        xpose_gu(F, IN_(I_FWG), IN_(I_FWU), D, DFF, FGU, scr, gw, NGW, IN_(I_LNFFN));
        xpose_plain<FFN_DOWN_FP8 != 0>(F, IN_(I_FWD), DFF, D, FD, scr, gw, NGW, nullptr);
        {
            const f32x4* ps = (const f32x4*)IN_(I_P); u32x2* pd = (u32x2*)P16; const size_t n4 = (size_t)DEPTH * T * PLE / 4, st = (size_t)(NWG - NGEMM0) * NTHR;
            for (size_t i = (size_t)(F.bx - NGEMM0) * NTHR + F.tid; i < n4; i += 8 * st) { f32x4 v[8];
#pragma unroll
                for (int k = 0; k < 8; ++k) if (i + k * st < n4) v[k] = ps[i + k * st];
#pragma unroll
                for (int k = 0; k < 8; ++k) if (i + k * st < n4) { u32x2 o; o.x = pk2(v[k].x, v[k].y); o.y = pk2(v[k].z, v[k].w); pd[i + k * st] = o; } }
        }
        for (int e = 0; e < NEXP - NEXP_TAIL; ++e) {
            xpose_gu(F, IN_(I_MWG) + (size_t)e * D * DFFE, IN_(I_MWU) + (size_t)e * D * DFFE, D, DFFE, MGU + (size_t)e * 2 * DFFE * (D / 2), scr, gw, NGW, IN_(I_LNFFN) + D);
            xpose_plain<MOE_DOWN_FP8 != 0>(F, IN_(I_MWD) + (size_t)e * DFFE * D, DFFE, D, MD + (size_t)e * D * (MOE_DOWN_FP8 ? DFFE / 2 : DFFE), scr, gw, NGW, nullptr);
        }
    }
    PHASE_END(false)

    for (int l = 0; l < DEPTH; ++l) {
        if (l > 0) {
        PHASE_BEGIN
        if (INPROJ1_FP8 && l == 1) { REFRESH_TID(); pg8::StaticOrder S; S.init(T, NU, NWG, F.bx); pg8::EpiBf16 E{U, NU, SSQ_(3 * l), W8_INV, nullptr, nullptr, 0u};
            pg8::Gemm g{(const bf16_t*)XB8, WIN + (size_t)l * NU * D, D / 2, D / 2, D / 2, 0}; pg8::gemm_phase<pg8::EpiBf16, pg8::StaticOrder, true, true>(F.lds + RING_OFF, g, S, E, F.tid); }
        else { REFRESH_TID(); pg8::StaticOrder S; S.init(T, NU, NWG, F.bx); pg8::EpiBf16 E{U, NU, SSQ_(3 * l), 1.0f, (LAS float*)(F.lds + RING_BYTES), (volatile LAS unsigned*)(F.lds + MISC_OFF) + 24, 0x30000u};
            pg8::Gemm g{XBB, WIN + (size_t)l * NU * D, D, D, D, 0}; pg8::gemm_phase<pg8::EpiBf16, pg8::StaticOrder, true>(F.lds + RING_OFF, g, S, E, F.tid); }
        REFRESH_TID();
        { constexpr int IP1_REM = ((T / 256) * (NU / 256)) % NWG;
          if (NEXP_LATE > 0 && IP1_REM > 0 && F.bx >= IP1_REM) { LAS float* scr = (LAS float*)(F.lds + RING_OFF + F.wave * XP_SCR); const int gw = (F.bx - IP1_REM) * NWAVES + F.wave, NGW = (NWG - IP1_REM) * NWAVES;
            for (int e = NEXP - NEXP_LATE; e < NEXP; ++e)
              xpose_gu(F, IN_(I_MWG) + (size_t)e * D * DFFE, IN_(I_MWU) + (size_t)e * D * DFFE, D, DFFE, MGU + (size_t)e * 2 * DFFE * (D / 2), scr, gw, NGW, IN_(I_LNFFN) + D); } }
        PHASE_END(false)
        }
        PHASE_BEGIN
        {
            conv_phase(F, U, CVB, IN_(I_MCW) + (size_t)l * 4 * 1024, IN_(I_MCB) + (size_t)l * 1024, IN_(I_SCW) + (size_t)l * 4 * 1536, IN_(I_SCB) + (size_t)l * 1536);
            REFRESH_TID();
            kmean_items(F, U, KMEAN);
        }
        PHASE_END(false)
        PHASE_BEGIN
        {
            for (int u = F.vcu; u < NB * 16; u += NWG)
                ssd_unit(F, u >> 4, u & 15, U, CVB, MIX, SSQS, IN_(I_SDTB) + l * 16, IN_(I_SALOG) + l * 16, IN_(I_SD) + l * 16);
#ifdef PROBE_SSD2
            if (l == 0) { REFRESH_TID(); for (int u = F.vcu; u < NB * 16; u += NWG)
                ssd_unit(F, u >> 4, u & 15, U, CVB, MIX, SSQS, IN_(I_SDTB) + l * 16, IN_(I_SALOG) + l * 16, IN_(I_SD) + l * 16); REFRESH_TID(); }
#endif
            for (int u = F.vcu; u < NB * 16; u += NWG)
                mlstm_unit(F, u >> 4, (u >> 2) & 3, u & 3, U, CVB, MIX, SSQM, IN_(I_MGB) + l * 8);
        }
        PHASE_END(false)
        PHASE_BEGIN
        {
            for (int u = F.vcu; u < NB * 4 * 4; u += NWG) { const int bh = u >> 2, s = u & 3;
                moba_unit(F, bh >> 2, bh & 3, 7 - s, U, MIX, KMEAN); moba_unit(F, bh >> 2, bh & 3, s, U, MIX, KMEAN); }
            REFRESH_TID();
            mixnorm_rows(F, U, MIX, SSQM, SSQS, IN_(I_MNG) + (size_t)l * 512, IN_(I_SNG) + (size_t)l * 1024);
        }
        PHASE_END(false)
        PHASE_BEGIN
        { pg8::Gemm g{MIX, WOUT + (size_t)l * D * D, D, D, D, 0}; pg8::StaticOrder S; S.init(T, D, NWG, F.bx); STAGGER(920);
#ifdef PROBE_OUT2
          { pg8::EpiResidualStat E0{XBB, XN, XA8, PROBE_SSQ0, D, 0.5f}; pg8::gemm_phase<pg8::EpiResidualStat, pg8::StaticOrder, RES_ALIGN>(F.lds + RING_OFF, g, S, E0, F.tid); }
          xcd_barrier(bar);
          pg8::EpiResidualStat E{XN, XN, XA8, SSQ_(3 * l + 1), D, 0.5f};
#else
          pg8::EpiResidualStat E{XBB, XN, XA8, SSQ_(3 * l + 1), D, 1.0f};
#endif
          pg8::gemm_phase<pg8::EpiResidualStat, pg8::StaticOrder, RES_ALIGN>(F.lds + RING_OFF, g, S, E, F.tid); }
        PHASE_END(false)
        if (l == 0) {
            PHASE_BEGIN
            { pg8::Gemm g{(const bf16_t*)XA8, FGU, D / 2, D / 2, D / 2, 0}; pg8::StaticOrder S; S.init(T, 2 * DFF, NWG, F.bx); pg8::EpiSwiGLU<FFN_DOWN_FP8 != 0> E{H, DFF, nullptr, 0, SSQ_(3 * l + 1), nullptr, W8_INV, nullptr, nullptr};
              pg8::gemm_phase<pg8::EpiSwiGLU<FFN_DOWN_FP8 != 0>, pg8::StaticOrder, true, true>(F.lds + RING_OFF, g, S, E, F.tid); }
            PHASE_END(false)
            PHASE_BEGIN
            { constexpr int KD = FFN_DOWN_FP8 ? DFF / 2 : DFF; pg8::Gemm g{H, FD, KD, KD, KD, 0}; pg8::StaticOrder S; S.init(T, D, NWG, F.bx); pg8::EpiResidualStat E{XN, XN, XA8, SSQ_(3 * l + 2), D, FFN_DOWN_FP8 ? W8_INV * H8_INV : 1.0f};
              pg8::gemm_phase<pg8::EpiResidualStat, pg8::StaticOrder, RES_ALIGN, FFN_DOWN_FP8 != 0>(F.lds + RING_OFF, g, S, E, F.tid); }
            REFRESH_TID();
            { pg8::Gemm g{P16 + (size_t)l * T * PLE, PP + (size_t)l * D * PLE, PLE, PLE, PLE, 0}; pg8::StaticOrder S; S.init(T, D, NWG, F.bx); pg8::EpiBf16 E{(bf16_t*)WSB_(WS_PPB0), D, nullptr, 1.0f, nullptr, nullptr, 0u};
              pg8::gemm_phase<pg8::EpiBf16, pg8::StaticOrder, true>(F.lds + RING_OFF, g, S, E, F.tid); }
            PHASE_END(false)
        } else {
            PHASE_BEGIN
            moe_route(F, XN, IN_(I_LNFFN) + (size_t)l * D, IN_(I_ROUTER), ROUTE, WGCNT, TOK);
            PHASE_END(false)
            PHASE_BEGIN
            moe_gather(F, XA8, ROUTE, WGCNT, (unsigned char*)XG, TOK, WGT, RS);
            PHASE_END(false)
            {
                const LAS int* lt = (const LAS int*)(F.lds + LTAB_OFF);
                PHASE_BEGIN
                { const int rtb = lt[LT_CUMT + 8], rtc = lt[LT_CUMT + 16];
                  const int r0 = ((rtb - lt[LT_CUMT]) * (D / 256)) % NWG, nl = r0 > 0 ? NWG - r0 : 0, n1 = (rtc - rtb) * (2 * DFFE / 256), nu = rtc * (2 * DFFE / 256), ndmax = 3 * nl < n1 ? 3 * nl : n1, drem = (nu - ndmax) % NWG, ndtry = ndmax - ((NWG - drem) % NWG), ndef = ndtry >= 0 ? ndtry : ndmax;
                  pg8::Gemm g{XG, MGU, D / 2, D / 2, D / 2, (size_t)2 * DFFE * (D / 2)}; pg8::MoeOrderGU S{rtb, rtc, 2 * DFFE / 256, NWG, F.bx, 0, nu - ndef, lt + LT_TAB}; pg8::EpiSwiGLU<MOE_DOWN_FP8 != 0> E{HM, DFFE, WGT, 0, nullptr, RS, W8_INV, (LAS float*)(F.lds + RING_BYTES), (volatile LAS unsigned*)(F.lds + MISC_OFF) + 24};
                  pg8::gemm_phase<pg8::EpiSwiGLU<MOE_DOWN_FP8 != 0>, pg8::MoeOrderGU, true, true>(F.lds + RING_OFF, g, S, E, F.tid);
                }
                PHASE_END(false)
            }
            for (int slot = 0; slot < 2; ++slot) {
                const LAS int* lt = (const LAS int*)(F.lds + LTAB_OFF);
                PHASE_BEGIN
                { const int rt0 = lt[LT_CUMT + 8 * slot], rt1 = lt[LT_CUMT + 8 * slot + 8];
                  constexpr int KM = MOE_DOWN_FP8 ? DFFE / 2 : DFFE; pg8::Gemm g{HM, MD, KM, KM, KM, (size_t)D * KM}; pg8::MoeOrder S{rt0, rt1 - rt0, D / 256, NWG, F.bx, lt + LT_TAB};
                  #ifdef PROBE_MOEDOWN2
                  { pg8::EpiScatter<false> E0{XN, D, TOK, nullptr, nullptr, 0.5f * (MOE_DOWN_FP8 ? W8_INV * H8_INV : 1.0f)}; pg8::gemm_phase<pg8::EpiScatter<false>, pg8::MoeOrder, RES_ALIGN, MOE_DOWN_FP8 != 0>(F.lds + RING_OFF, g, S, E0, F.tid); } xcd_barrier(bar);
                  const float al_ = 0.5f * (MOE_DOWN_FP8 ? W8_INV * H8_INV : 1.0f);
#else
                  const float al_ = MOE_DOWN_FP8 ? W8_INV * H8_INV : 1.0f;
#endif
                  if (slot == 0) { pg8::EpiScatter<false> E{XN, D, TOK, nullptr, nullptr, al_}; pg8::gemm_phase<pg8::EpiScatter<false>, pg8::MoeOrder, RES_ALIGN, MOE_DOWN_FP8 != 0>(F.lds + RING_OFF, g, S, E, F.tid);
                    REFRESH_TID();
                    const int rtb = lt[LT_CUMT + 8], rtc = lt[LT_CUMT + 16];
                    const int r0 = ((rtb - lt[LT_CUMT]) * (D / 256)) % NWG, nl = r0 > 0 ? NWG - r0 : 0, n1 = (rtc - rtb) * (2 * DFFE / 256), nu = rtc * (2 * DFFE / 256), ndmax = 3 * nl < n1 ? 3 * nl : n1, drem = (nu - ndmax) % NWG, ndtry = ndmax - ((NWG - drem) % NWG), ndef = ndtry >= 0 ? ndtry : ndmax;
                    if (ndef > 0 && F.bx >= r0) { pg8::Gemm g3{XG, MGU, D / 2, D / 2, D / 2, (size_t)2 * DFFE * (D / 2)}; pg8::MoeOrderGU S3{rtb, rtc, 2 * DFFE / 256, nl, F.bx - r0, nu - ndef, nu, lt + LT_TAB}; pg8::EpiSwiGLU<MOE_DOWN_FP8 != 0> E3{HM, DFFE, WGT, 0, nullptr, RS, W8_INV, (LAS float*)(F.lds + RING_BYTES), (volatile LAS unsigned*)(F.lds + MISC_OFF) + 24};
                      pg8::gemm_phase<pg8::EpiSwiGLU<MOE_DOWN_FP8 != 0>, pg8::MoeOrderGU, true, true>(F.lds + RING_OFF, g3, S3, E3, F.tid); } }
                  else { pg8::EpiScatter<true> E{XN, D, TOK, XA8, SSQ_(3 * l + 2), al_}; pg8::gemm_phase<pg8::EpiScatter<true>, pg8::MoeOrder, RES_ALIGN, MOE_DOWN_FP8 != 0>(F.lds + RING_OFF, g, S, E, F.tid);
                    REFRESH_TID();
                    const int rem = ((rt1 - rt0) * (D / 256)) % NWG;
                    if (F.bx >= rem) { pg8::Gemm g2{P16 + (size_t)l * T * PLE, PP + (size_t)l * D * PLE, PLE, PLE, PLE, 0}; pg8::StaticOrder S2; S2.init(T, D, NWG - rem, F.bx - rem); pg8::EpiBf16 E2{(bf16_t*)WSB_(WS_PPB1), D, nullptr, 1.0f, nullptr, nullptr, 0u};
                      pg8::gemm_phase<pg8::EpiBf16, pg8::StaticOrder, true>(F.lds + RING_OFF, g2, S2, E2, F.tid); } } }
                PHASE_END(false)
            }
        }
        PHASE_BEGIN
        { pg8::Gemm g{(const bf16_t*)XA8, PG + (size_t)l * D * (D / 2), D / 2, D / 2, D / 2, 0}; pg8::StaticOrder S; S.init(T, D, NWG, F.bx); pg8::EpiPleGate E{XN, XBB, (const bf16_t*)WSB_(l == 0 ? WS_PPB0 : WS_PPB1), D, SSQ_(3 * l + 2), SSQ_(3 * l + 3), W8_INV, (INPROJ1_FP8 && l == 0) ? XB8 : nullptr, (LAS float*)(F.lds + RING_BYTES), (volatile LAS unsigned*)(F.lds + MISC_OFF) + 24, 0x50000u + ((unsigned)l << 16)};
          pg8::gemm_phase<pg8::EpiPleGate, pg8::StaticOrder, RES_ALIGN, true>(F.lds + RING_OFF, g, S, E, F.tid); }
        PHASE_END(false)
    }
    PHASE_BEGIN
    {
        const float* g = IN_(I_LNFINAL); float* X = X_; const bf16_t* xs = XBB; const pg8::ssq_t* sq = SSQ_(6); const int gw = F.vcu * NWAVES + F.wave, NGW = NWG * NWAVES;
        for (int m0 = gw; m0 < T; m0 += 2 * NGW) {
            u32x2 w[2][8]; float rstd[2];
#pragma unroll
            for (int k = 0; k < 2; ++k) { const int m = m0 + k * NGW; rstd[k] = pg8::ssq_rstd(sq, m); const u32x2* xr = (const u32x2*)(xs + (size_t)m * D) + F.lane;
#pragma unroll
                for (int j = 0; j < 8; ++j) w[k][j] = xr[64 * j]; }
#pragma unroll
            for (int k = 0; k < 2; ++k) { const int m = m0 + k * NGW; f32x4* orow = (f32x4*)(X + (size_t)m * D) + F.lane;
#pragma unroll
                for (int j = 0; j < 8; ++j) { const f32x4 gg = ((const f32x4*)g + F.lane)[64 * j]; f32x4 o; o.x = bflo(w[k][j].x) * rstd[k] * gg.x; o.y = bfhi(w[k][j].x) * rstd[k] * gg.y; o.z = bflo(w[k][j].y) * rstd[k] * gg.z; o.w = bfhi(w[k][j].y) * rstd[k] * gg.w; orow[64 * j] = o; } }
        }
    }
#ifdef PROBE_ML
    REFRESH_TID();
    if (ph >= lo && ph < hi && blockIdx.x == 0 && F.tid == 0) {
        asm volatile("s_waitcnt vmcnt(0)" ::: "memory");
        const unsigned long long* dg = (const unsigned long long*)(args.ws + 2883584);
        const unsigned long long d1 = dg[PROBE_I1], d2 = dg[PROBE_I2];
        X_[0] += 2.0f + (float)d1 * (1.0f / 4000.0f);
        const unsigned long long tgt = __builtin_amdgcn_s_memrealtime() + 8ull * d2;
        while (__builtin_amdgcn_s_memrealtime() < tgt) __builtin_amdgcn_s_sleep(32);
    }
#endif
#ifdef PROBE_TS
    REFRESH_TID();
    if (ph >= lo && ph < hi && blockIdx.x == 0 && F.tid == 0) {
        const LAS unsigned long long* ts = (const LAS unsigned long long*)((LAS unsigned char*)lds_raw + PTAB_OFF + 512);
        const unsigned long long dA = (PROBE_PA == 20 ? __builtin_amdgcn_s_memrealtime() : ts[PROBE_PA + 1]) - ts[PROBE_PA], dB = ts[PROBE_PB + 1] - ts[PROBE_PB];
        asm volatile("s_waitcnt vmcnt(0)" ::: "memory");
        X_[0] += 2.0f + (float)dB * (1.0f / 2000.0f);
        const unsigned long long tgt = __builtin_amdgcn_s_memrealtime() + 8ull * dA;
        while (__builtin_amdgcn_s_memrealtime() < tgt) __builtin_amdgcn_s_sleep(32);
    }
#endif
    PHASE_END(true)
#undef PHASE_BEGIN
#undef PHASE_END
}

extern "C" void kernel_launch(void* const* d_in, const int* in_sizes, int n_in, void* d_out, int out_size, void* d_ws, size_t ws_size, hipStream_t stream) {
    static int grid = 0;
    if (grid == 0) {
        if (n_in != 27 || out_size != T * D || ws_size < WS_END) { fprintf(stderr, "kernel_launch: unexpected shapes (n_in %d, out %d, ws %zu < %zu)\n", n_in, out_size, ws_size, (size_t)WS_END); grid = -1; return; }
        int dev = 0, cus = 0, per_cu = 0;
        if (hipGetDevice(&dev) != hipSuccess || hipDeviceGetAttribute(&cus, hipDeviceAttributeMultiprocessorCount, dev) != hipSuccess) { grid = -1; return; }
        if (hipFuncSetAttribute((const void*)hybrid_fwd, hipFuncAttributeMaxDynamicSharedMemorySize, LDS_BYTES) != hipSuccess) { fprintf(stderr, "kernel_launch: hipFuncSetAttribute failed\n"); grid = -1; return; }
        if (hipOccupancyMaxActiveBlocksPerMultiprocessor(&per_cu, (const void*)hybrid_fwd, NTHR, LDS_BYTES) != hipSuccess || per_cu < 1) fprintf(stderr, "kernel_launch: occupancy query reports %d\n", per_cu);
        (void)hipGetLastError();
        if (cus != 256) { fprintf(stderr, "kernel_launch: built for 256 CUs, device has %d\n", cus); grid = -1; return; }
        grid = cus;
    }
    if (grid < 0) return;
    if (hipMemsetAsync((char*)d_ws + WS_CTL, 0, CTL_ZERO_BYTES, stream) != hipSuccess) return;
    Args a{};
    for (int i = 0; i < 27; ++i) a.in[i] = (const float*)d_in[i];
    a.out = (float*)d_out; a.ws = (unsigned char*)d_ws;
#ifndef MK_SPLIT
    a.ph_lo = 0; a.ph_hi = 1000;
    hipLaunchKernelGGL(hybrid_fwd, dim3(NWG), dim3(NTHR), LDS_BYTES, stream, a);
#else
    for (int p = 0; p < 40; ++p) { a.ph_lo = p; a.ph_hi = p + 1; hipLaunchKernelGGL(hybrid_fwd, dim3(NWG), dim3(NTHR), LDS_BYTES, stream, a); }
#endif
}
```
